# Optimizing an MI355X kernel written in HIP

```python
import math
import jax, jax.numpy as jnp
from jax import lax
import numpy as np

D_MODEL = 4096
BATCH = 4
SEQ = 4096
DEPTH = 1

N_HEADS_A = 16
HEAD_DIM_A = 128
N_IDX_HEADS = 32
IDX_DIM = 128
TOPK_MAX = 256
Q_BLOCK = 128
N_BUCKETS = 32
MAX_DISTANCE = 128
GMLP_WIDTH = 2048
N_GROUPS_B = 8
GROUP_DIM_B = GMLP_WIDTH // N_GROUPS_B
CHUNK = 128
D_FF = ((-(-8 * D_MODEL // 3) + 255) // 256) * 256
D_PLE = 256
EPS = 1e-6

A_WIDTH = N_HEADS_A * HEAD_DIM_A
SPLIT_SIZES = (A_WIDTH, HEAD_DIM_A, HEAD_DIM_A, N_IDX_HEADS * IDX_DIM, IDX_DIM, N_IDX_HEADS, 2 * GMLP_WIDTH, D_MODEL, D_MODEL)
IN_COLS = sum(SPLIT_SIZES)

kernel_name = "hybrid_dsa_gmlp_gated_block"


def rmsnorm(x, g):
    xf = x.astype(jnp.float32)
    y = xf * lax.rsqrt(jnp.mean(xf * xf, axis=-1, keepdims=True) + EPS)
    return (y * g.astype(jnp.float32)).astype(x.dtype)


def layernorm(x, g, b):
    xf = x.astype(jnp.float32)
    mu = jnp.mean(xf, axis=-1, keepdims=True)
    var = jnp.mean(jnp.square(xf - mu), axis=-1, keepdims=True)
    y = (xf - mu) * lax.rsqrt(var + EPS)
    return (y * g.astype(jnp.float32) + b.astype(jnp.float32)).astype(x.dtype)


def t5_bucket(n):
    max_exact = N_BUCKETS // 2
    n = jnp.maximum(n, 0)
    nf = jnp.maximum(n, 1).astype(jnp.float32)
    large = max_exact + (jnp.log(nf / max_exact) / math.log(MAX_DISTANCE / max_exact) * (N_BUCKETS - max_exact)).astype(jnp.int32)
    large = jnp.minimum(large, N_BUCKETS - 1)
    return jnp.where(n < max_exact, n, large)


def dsa_attention(q, k, v, q_idx, k_idx, w_idx, rel_bias):
    B, S = q.shape[0], q.shape[1]
    k_sel = min(TOPK_MAX, S // 4)
    n_blk = S // Q_BLOCK
    idx_scale = IDX_DIM ** -0.5 * N_IDX_HEADS ** -0.5
    attn_scale = HEAD_DIM_A ** -0.5
    key_pos = jnp.arange(S, dtype=jnp.int32)
    k_idx_f = k_idx.astype(jnp.float32)
    gather = jax.vmap(lambda t, i: t[i])

    def blk(a):
        return jnp.swapaxes(a.reshape((B, n_blk, Q_BLOCK) + a.shape[2:]), 0, 1)

    def one_block(args):
        j, qb, qib, wb = args
        q_pos = j * Q_BLOCK + jnp.arange(Q_BLOCK, dtype=jnp.int32)
        dots = jnp.einsum('bqhd,bsd->bqhs', qib.astype(jnp.float32), k_idx_f)
        score = jnp.einsum('bqhs,bqh->bqs', jax.nn.relu(dots), wb.astype(jnp.float32)) * idx_scale
        causal = key_pos[None, :] <= q_pos[:, None]
        score = jnp.where(causal[None], score, -jnp.inf)
        _, idx = lax.top_k(score, k_sel)
        ks = gather(k, idx)
        vs = gather(v, idx)
        valid = idx <= q_pos[None, :, None]
        bias = rel_bias[t5_bucket(q_pos[None, :, None] - idx)]
        logits = jnp.einsum('bqhd,bqkd->bhqk', qb, ks).astype(jnp.float32) * attn_scale
        logits = logits + jnp.transpose(bias, (0, 3, 1, 2)).astype(jnp.float32)
        logits = jnp.where(valid[:, None], logits, -jnp.inf)
        probs = jax.nn.softmax(logits, axis=-1).astype(vs.dtype)
        return jnp.einsum('bhqk,bqkd->bqhd', probs, vs)

    out = lax.map(one_block, (jnp.arange(n_blk, dtype=jnp.int32), blk(q), blk(q_idx), blk(w_idx)))
    return jnp.swapaxes(out, 0, 1).reshape(B, S, N_HEADS_A * HEAD_DIM_A)


def chunked_sgu(uv, ln_g, ln_b, w_s, b_s):
    B, S = uv.shape[0], uv.shape[1]
    uv = jax.nn.gelu(uv)
    u, v = uv[..., :GMLP_WIDTH], uv[..., GMLP_WIDTH:]
    v = layernorm(v, ln_g, ln_b)
    vg = v.reshape(B, S // CHUNK, CHUNK, N_GROUPS_B, GROUP_DIM_B)
    tril = jnp.tril(jnp.ones((CHUNK, CHUNK), dtype=bool))
    ws = jnp.where(tril[None], w_s, jnp.zeros_like(w_s))
    mixed = jnp.einsum('gts,bcsgd->bctgd', ws, vg) + jnp.transpose(b_s)[None, None, :, :, None]
    return u * mixed.reshape(B, S, GMLP_WIDTH)


def setup_inputs(seed: int = 0) -> dict:
    key = jax.random.key(seed)
    ks = jax.random.split(key, 24)
    nrm = lambda k, shape, s: jax.random.normal(k, shape, jnp.float32) * s
    L = DEPTH
    return {
        "x": nrm(ks[0], (BATCH, SEQ, D_MODEL), 1.0),
        "p": nrm(ks[1], (DEPTH, BATCH, SEQ, D_PLE), 1.0),
        "w_in": nrm(ks[2], (L, D_MODEL, IN_COLS), D_MODEL ** -0.5),
        "q_norm_g": 1.0 + nrm(ks[3], (L, HEAD_DIM_A), 0.02),
        "k_norm_g": 1.0 + nrm(ks[4], (L, HEAD_DIM_A), 0.02),
        "rel_bias": nrm(ks[5], (N_BUCKETS, N_HEADS_A), 0.5),
        "sgu_ln_g": 1.0 + nrm(ks[6], (L, GMLP_WIDTH), 0.02),
        "sgu_ln_b": nrm(ks[7], (L, GMLP_WIDTH), 0.02),
        "sgu_w": nrm(ks[8], (L, N_GROUPS_B, CHUNK, CHUNK), CHUNK ** -0.5),
        "sgu_b": 1.0 + nrm(ks[9], (L, N_GROUPS_B, CHUNK), 0.02),
        "w_branch_a": nrm(ks[10], (L, A_WIDTH, D_MODEL), A_WIDTH ** -0.5),
        "w_branch_b": nrm(ks[11], (L, GMLP_WIDTH, D_MODEL), GMLP_WIDTH ** -0.5),
        "w_out": nrm(ks[12], (L, D_MODEL, D_MODEL), D_MODEL ** -0.5),
        "norm_mix_g": 1.0 + nrm(ks[13], (L, D_MODEL), 0.02),
        "norm_ffn_g": 1.0 + nrm(ks[14], (L, D_MODEL), 0.02),
        "w_gate_ffn": nrm(ks[15], (L, D_MODEL, D_FF), D_MODEL ** -0.5),
        "w_up_ffn": nrm(ks[16], (L, D_MODEL, D_FF), D_MODEL ** -0.5),
        "w_down_ffn": nrm(ks[17], (L, D_FF, D_MODEL), D_FF ** -0.5),
        "w_ple": nrm(ks[18], (L, D_PLE, D_MODEL), D_PLE ** -0.5),
        "ple_norm_g": 1.0 + nrm(ks[19], (L, D_MODEL), 0.02),
        "w_ple_gate": nrm(ks[20], (L, D_MODEL, D_MODEL), D_MODEL ** -0.5),
        "norm_ple_g": 1.0 + nrm(ks[21], (L, D_MODEL), 0.02),
    }


def reference(x, p, w_in, q_norm_g, k_norm_g, rel_bias, sgu_ln_g, sgu_ln_b, sgu_w, sgu_b, w_branch_a, w_branch_b, w_out, norm_mix_g, norm_ffn_g, w_gate_ffn, w_up_ffn, w_down_ffn, w_ple, ple_norm_g, w_ple_gate, norm_ple_g):
    B, S = x.shape[0], x.shape[1]
    offsets = []
    acc = 0
    for sz in SPLIT_SIZES[:-1]:
        acc += sz
        offsets.append(acc)
    for i in range(DEPTH):
        h = rmsnorm(x, norm_mix_g[i])
        proj = h @ w_in[i]
        q, k, v, q_idx, k_idx, w_idx, uv, g_a, g_b = jnp.split(proj, offsets, axis=-1)
        q = rmsnorm(q.reshape(B, S, N_HEADS_A, HEAD_DIM_A), q_norm_g[i])
        k = rmsnorm(k, k_norm_g[i])
        q_idx = q_idx.reshape(B, S, N_IDX_HEADS, IDX_DIM)
        y_a = dsa_attention(q, k, v, q_idx, k_idx, w_idx, rel_bias)
        y_b = chunked_sgu(uv, sgu_ln_g[i], sgu_ln_b[i], sgu_w[i], sgu_b[i])
        merged = jax.nn.sigmoid(g_a) * (y_a @ w_branch_a[i]) + jax.nn.sigmoid(g_b) * (y_b @ w_branch_b[i])
        x = x + merged @ w_out[i]
        h2 = rmsnorm(x, norm_ffn_g[i])
        x = x + (jax.nn.silu(h2 @ w_gate_ffn[i]) * (h2 @ w_up_ffn[i])) @ w_down_ffn[i]
        pe = rmsnorm(p[i] @ w_ple[i], ple_norm_g[i])
        gate = jax.nn.sigmoid(rmsnorm(x, norm_ple_g[i]) @ w_ple_gate[i])
        x = x + gate * pe
    return x
```

```cpp
#include <hip/hip_runtime.h>
#include <cstdio>
#include <cstdint>

#define GAS __attribute__((address_space(1)))
#define LAS __attribute__((address_space(3)))
typedef unsigned short bf16;
typedef unsigned v4u __attribute__((ext_vector_type(4)));
typedef unsigned v2u __attribute__((ext_vector_type(2)));
typedef float f32x4 __attribute__((ext_vector_type(4)));
typedef float f32x2 __attribute__((ext_vector_type(2)));
typedef float f32x16 __attribute__((ext_vector_type(16)));
typedef short bf16x8 __attribute__((ext_vector_type(8)));
typedef short s16x4 __attribute__((ext_vector_type(4)));
typedef GAS unsigned gu32;

constexpr int NB = 4, SEQ = 4096, DM = 4096, MTOK = NB * SEQ;
constexpr int NHA = 16, HDA = 128, NIH = 32, IDXD = 128, TOPK = 256;
constexpr int GWID = 2048, NGRP = 8, GDIM = 256, CHK = 128;
constexpr int DFF = 11008, DPLE = 256;
constexpr int INCOLS = 18848, INPAD = 18944;
constexpr float EPS = 1e-6f;
constexpr float LOG2E = 1.4426950408889634f;

constexpr size_t MiB = 1u << 20;
constexpr size_t WS_CTL = 0, CTL_ZERO_BYTES = 1 * MiB;
constexpr size_t WS_IDX = 1 * MiB;
constexpr size_t WS_LNP = 9 * MiB;
constexpr size_t WS_SSQ1 = 13 * MiB;
constexpr size_t WS_SSQ2 = 17 * MiB;
constexpr size_t WS_SSQP = 21 * MiB;
constexpr size_t WS_WIDX = 25 * MiB;
constexpr size_t WS_KIDX = 27 * MiB;
constexpr size_t WS_KN = 31 * MiB;
constexpr size_t WS_V = 35 * MiB;
constexpr size_t WS_KRAW = 39 * MiB;
constexpr size_t WS_SGUW = 47 * MiB;
constexpr size_t WS_H = 48 * MiB;
constexpr size_t WS_WIN = 176 * MiB;
constexpr size_t WS_QIDX = 324 * MiB;
constexpr size_t WS_Q = 452 * MiB;
constexpr size_t WS_UV = 516 * MiB;
constexpr size_t WS_SGA = 644 * MiB;
constexpr size_t WS_SGB = 772 * MiB;
constexpr size_t WS_WAB = 900 * MiB;
constexpr size_t WS_WOUT = 932 * MiB;
constexpr size_t WS_WGU = 964 * MiB;
constexpr size_t WS_WD = 1136 * MiB;
constexpr size_t WS_WPLE = 1222 * MiB;
constexpr size_t WS_WPG = 1224 * MiB;
constexpr size_t WS_END = 1256 * MiB;
constexpr size_t WS_SC = WS_H, WS_MERGED = WS_H, WS_ACT = WS_H, WS_YAB = WS_QIDX, WS_X1G = WS_UV, WS_X2G = WS_UV, WS_PE = WS_SGA;
static_assert(WS_SC + (size_t)MTOK * SEQ * 4 <= WS_QIDX && WS_ACT + (size_t)MTOK * DFF * 2 <= WS_Q && WS_WIN + (size_t)INPAD * DM * 2 <= WS_QIDX && WS_WD + (size_t)DM * DFF * 2 <= WS_WPLE, "ws map");

constexpr int CW_TMO = 0, CW_CODE = 1, CW_BAR = 4096;

constexpr int RING_OFF = 0, RING_BYTES = 131072;
constexpr int LDSCTL_OFF = RING_BYTES, MISC_OFF = LDSCTL_OFF + 320;
constexpr int LDS_BYTES = 147456;
static_assert(MISC_OFF + 128 <= LDS_BYTES, "LDS map");

#define RLX_AGENT __ATOMIC_RELAXED, __HIP_MEMORY_SCOPE_AGENT
#define LDS_WAIT() asm volatile("s_waitcnt lgkmcnt(0)" ::: "memory")
#define VM_WAIT() asm volatile("s_waitcnt vmcnt(0)" ::: "memory")

typedef __bf16 bf16v2_t __attribute__((ext_vector_type(2)));
__device__ __forceinline__ unsigned cvt_pk_bf16(float lo, float hi) { const f32x2 v = {lo, hi}; const bf16v2_t b = __builtin_convertvector(v, bf16v2_t); return __builtin_bit_cast(unsigned, b); }
__device__ __forceinline__ float bf_lo(unsigned w) { return __uint_as_float(w << 16); }
__device__ __forceinline__ float bf_hi(unsigned w) { return __uint_as_float(w & 0xffff0000u); }
__device__ __forceinline__ float fast_sigmoid(float x) { return __builtin_amdgcn_rcpf(1.0f + __builtin_amdgcn_exp2f(-LOG2E * x)); }
__device__ __forceinline__ float gelu_tanh(float x) { const float t = x * (1.0f + 0.044715f * x * x); return x * __builtin_amdgcn_rcpf(1.0f + __builtin_amdgcn_exp2f(-2.302208198f * t)); }
__device__ __forceinline__ float wave_sum(float v) {
#pragma unroll
    for (int o = 1; o < 64; o <<= 1) v += __shfl_xor(v, o);
    return v;
}
__device__ __forceinline__ v4u pack8(f32x4 a, f32x4 b) { v4u w; w.x = cvt_pk_bf16(a[0], a[1]); w.y = cvt_pk_bf16(a[2], a[3]); w.z = cvt_pk_bf16(b[0], b[1]); w.w = cvt_pk_bf16(b[2], b[3]); return w; }
__device__ __forceinline__ void unpack8(v4u w, f32x4& a, f32x4& b) { a = (f32x4){bf_lo(w.x), bf_hi(w.x), bf_lo(w.y), bf_hi(w.y)}; b = (f32x4){bf_lo(w.z), bf_hi(w.z), bf_lo(w.w), bf_hi(w.w)}; }

namespace pg8 {
#define PG8_LAS __attribute__((address_space(3)))
typedef unsigned short bf16_t;
typedef unsigned u32x4 __attribute__((ext_vector_type(4)));
constexpr int BM = 256, BK = 64, HALF = 128, HTB = HALF * BK * 2, STAGE_BYTES = 8 * HTB, NXCD = 8, WGM = 8;

__host__ __device__ __forceinline__ int lds_byte(int r, int c) { const int st = (r >> 4) * 2 + (c >> 5), rr = r & 15, cc = c & 31, ob = rr * 64 + cc * 2; return st * 1024 + (ob ^ (((ob >> 9) & 1) << 5)); }
__host__ __device__ __forceinline__ void stage_rc(int b, int& R, int& C) { const int st = b / 1024, sb = b % 1024, swz = sb ^ (((sb >> 9) & 1) << 5); R = (st >> 1) * 16 + swz / 64; C = (st & 1) * 32 + (swz % 64) / 2; }
__host__ __device__ __forceinline__ int perm32(int rho) { const int n = rho >> 4, i = rho & 15; return 8 * (i >> 2) + 4 * n + (i & 3); }

struct Unit { int pm, pn; };
struct Gemm { const bf16_t* A; const bf16_t* Bt; int M, N, K; };

struct StaticOrder {
    int nM, nN, nwg, G, c;
    __host__ __device__ void init(int M, int N, int G_, int c_) { nM = M / BM; nN = N / BM; nwg = nM * nN; G = G_; c = c_; }
    __host__ __device__ bool next(int i, Unit& u) const {
        const long L = (long)i * G + c; if (L >= nwg) return false;
        int wgid = (int)L; { const int q = nwg / NXCD, r = nwg % NXCD, xcd = wgid % NXCD, off = wgid / NXCD; wgid = (xcd < r ? xcd * (q + 1) : r * (q + 1) + (xcd - r) * q) + off; }
        const int nig = WGM * nN, gid = wgid / nig, fm = gid * WGM, gsz = (nM - fm) < WGM ? (nM - fm) : WGM;
        u.pm = fm + ((wgid % nig) % gsz); u.pn = (wgid % nig) / gsz; return true;
    }
    __device__ __forceinline__ void a_ready(const Unit&) const {}
    __device__ __forceinline__ void done(const Unit&) const {}
};

typedef f32x4 Acc[2][2][4][2];

__device__ __forceinline__ float row_total64(const float* tab, int row, int fq) {
    const float* p = tab + ((size_t)(fq * 4) * MTOK + row) * 4;
    const f32x4 a = *(const f32x4*)p, b = *(const f32x4*)(p + (size_t)MTOK * 4), c = *(const f32x4*)(p + (size_t)MTOK * 8), d = *(const f32x4*)(p + (size_t)MTOK * 12);
    float s = ((a[0] + a[1]) + (a[2] + a[3])) + ((b[0] + b[1]) + (b[2] + b[3])) + ((c[0] + c[1]) + (c[2] + c[3])) + ((d[0] + d[1]) + (d[2] + d[3]));
    s += __shfl_xor(s, 16); s += __shfl_xor(s, 32); return s;
}

struct EpiInProj {
    static constexpr bool PERM = true, AFTER_DRAIN = false, HAS_MID = false;
    bf16_t *Q, *V, *QIDX, *KIDX, *UV, *SGA, *SGB; float *KRAW, *WIDX, *LNP;
    __device__ __forceinline__ void mid(Acc&, const Unit&, int, int, int, int) const {}
    template <int ACT> __device__ __forceinline__ void plain(const Acc& acc, bf16_t* O, int ldc, int colt, int row0, int cl) const {
#pragma unroll
        for (int ai = 0; ai < 2; ++ai)
#pragma unroll
            for (int m = 0; m < 4; ++m) { bf16_t* rowp = O + (size_t)(row0 + ai * HALF + m * 16) * ldc + colt + cl;
#pragma unroll
                for (int bj = 0; bj < 2; ++bj) { f32x4 v0 = acc[ai][bj][m][0], v1 = acc[ai][bj][m][1];
                    if (ACT == 1) {
#pragma unroll
                        for (int j = 0; j < 4; ++j) { v0[j] = gelu_tanh(v0[j]); v1[j] = gelu_tanh(v1[j]); } }
                    if (ACT == 2) {
#pragma unroll
                        for (int j = 0; j < 4; ++j) { v0[j] = fast_sigmoid(v0[j]); v1[j] = fast_sigmoid(v1[j]); } }
                    *(u32x4*)(rowp + bj * HALF) = pack8(v0, v1); }
                __builtin_amdgcn_sched_barrier(0); }
    }
    __device__ __forceinline__ void operator()(const Acc& acc, const Unit& u, int wr, int wc, int fr, int fq) const {
        asm volatile("" : "+v"(fr), "+v"(fq));
        const int row0 = u.pm * BM + wr * 64 + fr, cl = wc * 32 + 8 * fq, pn = u.pn;
        if (pn < 8 || (pn > 8 && pn < 25)) { const bool isq = pn < 8; plain<0>(acc, isq ? Q : QIDX, isq ? 2048 : 4096, isq ? pn * 256 : (pn - 9) * 256, row0, cl); }
        else if (pn == 8) {
#pragma unroll
            for (int ai = 0; ai < 2; ++ai)
#pragma unroll
                for (int m = 0; m < 4; ++m) { const size_t r = (size_t)(row0 + ai * HALF + m * 16);
                    *(f32x4*)(KRAW + r * 128 + cl) = acc[ai][0][m][0]; *(f32x4*)(KRAW + r * 128 + cl + 4) = acc[ai][0][m][1];
                    *(u32x4*)(V + r * 128 + cl) = pack8(acc[ai][1][m][0], acc[ai][1][m][1]); }
        }
        else if (pn == 25) {
#pragma unroll
            for (int ai = 0; ai < 2; ++ai)
#pragma unroll
                for (int m = 0; m < 4; ++m) { const size_t r = (size_t)(row0 + ai * HALF + m * 16);
                    *(u32x4*)(KIDX + r * 128 + cl) = pack8(acc[ai][0][m][0], acc[ai][0][m][1]);
                    if (wc == 0) { *(f32x4*)(WIDX + r * 32 + 8 * fq) = acc[ai][1][m][0]; *(f32x4*)(WIDX + r * 32 + 8 * fq + 4) = acc[ai][1][m][1]; } }
        }
        else if (pn < 42) {
            const bool isv = pn >= 34;
#pragma unroll
            for (int ai = 0; ai < 2; ++ai)
#pragma unroll
                for (int m = 0; m < 4; ++m) { const size_t r = (size_t)(row0 + ai * HALF + m * 16); bf16_t* rowp = UV + r * 4096 + (pn - 26) * 256 + cl; float s = 0.f, q = 0.f;
#pragma unroll
                    for (int bj = 0; bj < 2; ++bj) { f32x4 v0 = acc[ai][bj][m][0], v1 = acc[ai][bj][m][1];
#pragma unroll
                        for (int j = 0; j < 4; ++j) { v0[j] = gelu_tanh(v0[j]); v1[j] = gelu_tanh(v1[j]); s += v0[j] + v1[j]; q += v0[j] * v0[j] + v1[j] * v1[j]; }
                        *(u32x4*)(rowp + bj * HALF) = pack8(v0, v1); }
                    s += __shfl_xor(s, 16); s += __shfl_xor(s, 32); q += __shfl_xor(q, 16); q += __shfl_xor(q, 32);
                    if (isv && fq == 0) *(f32x2*)(LNP + (((size_t)(pn - 34) * MTOK + r) * 4 + wc) * 2) = (f32x2){s, q};
                    __builtin_amdgcn_sched_barrier(0); }
        }
        else { const bool isa = pn < 58; plain<2>(acc, isa ? SGA : SGB, 4096, isa ? (pn - 42) * 256 : (pn - 58) * 256, row0, cl); }
    }
};

struct EpiMerge {
    static constexpr bool PERM = true, AFTER_DRAIN = false, HAS_MID = true;
    const bf16_t *SGA, *SGB; bf16_t* O;
    __device__ __forceinline__ void mid(Acc& acc, const Unit& u, int wr, int wc, int fr, int fq) const {
        asm volatile("" : "+v"(fr), "+v"(fq));
        const int row0 = u.pm * BM + wr * 64 + fr, col0 = u.pn * BM + wc * 32 + 8 * fq;
#pragma unroll
        for (int ai = 0; ai < 2; ++ai)
#pragma unroll
            for (int m = 0; m < 4; ++m) { const size_t off = (size_t)(row0 + ai * HALF + m * 16) * 4096 + col0;
#pragma unroll
                for (int bj = 0; bj < 2; ++bj) { const u32x4 wa = *(const u32x4*)(SGA + off + bj * HALF), wb = *(const u32x4*)(SGB + off + bj * HALF);
                    f32x4 a0, a1, b0, b1; unpack8(wa, a0, a1); unpack8(wb, b0, b1);
#pragma unroll
                    for (int j = 0; j < 4; ++j) { acc[ai][bj][m][0][j] *= a0[j] * __builtin_amdgcn_rcpf(b0[j]); acc[ai][bj][m][1][j] *= a1[j] * __builtin_amdgcn_rcpf(b1[j]); } }
                __builtin_amdgcn_sched_barrier(0); }
    }
    __device__ __forceinline__ void operator()(const Acc& acc, const Unit& u, int wr, int wc, int fr, int fq) const {
        asm volatile("" : "+v"(fr), "+v"(fq));
        const int row0 = u.pm * BM + wr * 64 + fr, col0 = u.pn * BM + wc * 32 + 8 * fq;
#pragma unroll
        for (int ai = 0; ai < 2; ++ai)
#pragma unroll
            for (int m = 0; m < 4; ++m) { const size_t off = (size_t)(row0 + ai * HALF + m * 16) * 4096 + col0;
#pragma unroll
                for (int bj = 0; bj < 2; ++bj) { const u32x4 wb = *(const u32x4*)(SGB + off + bj * HALF); f32x4 b0, b1; unpack8(wb, b0, b1);
                    *(u32x4*)(O + off + bj * HALF) = pack8(acc[ai][bj][m][0] * b0, acc[ai][bj][m][1] * b1); }
                __builtin_amdgcn_sched_barrier(0); }
    }
};

struct EpiResid {
    static constexpr bool PERM = true, AFTER_DRAIN = false, HAS_MID = false;
    const float* XIN; float* XOUT; bf16_t* XG; const float* gain; float* SSQ;
    __device__ __forceinline__ void mid(Acc&, const Unit&, int, int, int, int) const {}
    __device__ __forceinline__ void operator()(const Acc& acc, const Unit& u, int wr, int wc, int fr, int fq) const {
        asm volatile("" : "+v"(fr), "+v"(fq));
        const int row0 = u.pm * BM + wr * 64 + fr, col0 = u.pn * BM + wc * 32 + 8 * fq;
        f32x4 gv[2][2];
#pragma unroll
        for (int bj = 0; bj < 2; ++bj) { gv[bj][0] = *(const f32x4*)(gain + col0 + bj * HALF); gv[bj][1] = *(const f32x4*)(gain + col0 + bj * HALF + 4); }
#pragma unroll
        for (int ai = 0; ai < 2; ++ai)
#pragma unroll
            for (int m = 0; m < 4; ++m) { const size_t r = (size_t)(row0 + ai * HALF + m * 16), off = r * 4096 + col0; float q = 0.f;
#pragma unroll
                for (int bj = 0; bj < 2; ++bj) { f32x4 v0 = *(const f32x4*)(XIN + off + bj * HALF) + acc[ai][bj][m][0], v1 = *(const f32x4*)(XIN + off + bj * HALF + 4) + acc[ai][bj][m][1];
                    *(f32x4*)(XOUT + off + bj * HALF) = v0; *(f32x4*)(XOUT + off + bj * HALF + 4) = v1;
#pragma unroll
                    for (int j = 0; j < 4; ++j) q += v0[j] * v0[j] + v1[j] * v1[j];
                    *(u32x4*)(XG + off + bj * HALF) = pack8(v0 * gv[bj][0], v1 * gv[bj][1]); }
                q += __shfl_xor(q, 16); q += __shfl_xor(q, 32);
                if (fq == 0) SSQ[((size_t)u.pn * MTOK + r) * 4 + wc] = q;
                __builtin_amdgcn_sched_barrier(0); }
    }
};

struct EpiPe {
    static constexpr bool PERM = true, AFTER_DRAIN = false, HAS_MID = false;
    bf16_t* PE; float* SSQ;
    __device__ __forceinline__ void mid(Acc&, const Unit&, int, int, int, int) const {}
    __device__ __forceinline__ void operator()(const Acc& acc, const Unit& u, int wr, int wc, int fr, int fq) const {
        asm volatile("" : "+v"(fr), "+v"(fq));
        const int row0 = u.pm * BM + wr * 64 + fr, col0 = u.pn * BM + wc * 32 + 8 * fq;
#pragma unroll
        for (int ai = 0; ai < 2; ++ai)
#pragma unroll
            for (int m = 0; m < 4; ++m) { const size_t r = (size_t)(row0 + ai * HALF + m * 16), off = r * 4096 + col0; float q = 0.f;
#pragma unroll
                for (int bj = 0; bj < 2; ++bj) { const f32x4 v0 = acc[ai][bj][m][0], v1 = acc[ai][bj][m][1];
#pragma unroll
                    for (int j = 0; j < 4; ++j) q += v0[j] * v0[j] + v1[j] * v1[j];
                    *(u32x4*)(PE + off + bj * HALF) = pack8(v0, v1); }
                q += __shfl_xor(q, 16); q += __shfl_xor(q, 32);
                if (fq == 0) SSQ[((size_t)u.pn * MTOK + r) * 4 + wc] = q;
                __builtin_amdgcn_sched_barrier(0); }
    }
};

struct EpiGateUp {
    static constexpr bool PERM = true, AFTER_DRAIN = false, HAS_MID = false;
    const float* SSQ; bf16_t* ACT;
    __device__ __forceinline__ void mid(Acc&, const Unit&, int, int, int, int) const {}
    __device__ __forceinline__ void operator()(const Acc& acc, const Unit& u, int wr, int wc, int fr, int fq) const {
        asm volatile("" : "+v"(fr), "+v"(fq));
        const int row0 = u.pm * BM + wr * 64 + fr, col0 = u.pn * HALF + wc * 32 + 8 * fq;
#pragma unroll
        for (int ai = 0; ai < 2; ++ai)
#pragma unroll
            for (int m = 0; m < 4; ++m) { const int r = row0 + ai * HALF + m * 16;
                const float rs = 1.0f / sqrtf(row_total64(SSQ, r, fq) * (1.0f / 4096.0f) + EPS);
                f32x4 o0, o1;
#pragma unroll
                for (int j = 0; j < 4; ++j) { const float g0 = acc[ai][0][m][0][j] * rs, g1 = acc[ai][0][m][1][j] * rs;
                    o0[j] = g0 * fast_sigmoid(g0) * (acc[ai][1][m][0][j] * rs); o1[j] = g1 * fast_sigmoid(g1) * (acc[ai][1][m][1][j] * rs); }
                *(u32x4*)(ACT + (size_t)r * DFF + col0) = pack8(o0, o1);
                __builtin_amdgcn_sched_barrier(0); }
    }
};

struct EpiFinal {
    static constexpr bool PERM = true, AFTER_DRAIN = false, HAS_MID = false;
    const float *SSQ2, *SSQP, *pleg; const bf16_t* PE; float* OUT;
    __device__ __forceinline__ void mid(Acc&, const Unit&, int, int, int, int) const {}
    __device__ __forceinline__ void operator()(const Acc& acc, const Unit& u, int wr, int wc, int fr, int fq) const {
        asm volatile("" : "+v"(fr), "+v"(fq));
        const int row0 = u.pm * BM + wr * 64 + fr, col0 = u.pn * BM + wc * 32 + 8 * fq;
        f32x4 gv[2][2];
#pragma unroll
        for (int bj = 0; bj < 2; ++bj) { gv[bj][0] = *(const f32x4*)(pleg + col0 + bj * HALF); gv[bj][1] = *(const f32x4*)(pleg + col0 + bj * HALF + 4); }
#pragma unroll
        for (int ai = 0; ai < 2; ++ai)
#pragma unroll
            for (int m = 0; m < 4; ++m) { const int r = row0 + ai * HALF + m * 16; const size_t off = (size_t)r * 4096 + col0;
                const float r3 = 1.0f / sqrtf(row_total64(SSQ2, r, fq) * (1.0f / 4096.0f) + EPS), rp = 1.0f / sqrtf(row_total64(SSQP, r, fq) * (1.0f / 4096.0f) + EPS);
#pragma unroll
                for (int bj = 0; bj < 2; ++bj) { const u32x4 pw = *(const u32x4*)(PE + off + bj * HALF); f32x4 p0, p1; unpack8(pw, p0, p1);
                    f32x4 x0 = *(const f32x4*)(OUT + off + bj * HALF), x1 = *(const f32x4*)(OUT + off + bj * HALF + 4);
#pragma unroll
                    for (int j = 0; j < 4; ++j) { x0[j] += fast_sigmoid(acc[ai][bj][m][0][j] * r3) * (p0[j] * rp * gv[bj][0][j]); x1[j] += fast_sigmoid(acc[ai][bj][m][1][j] * r3) * (p1[j] * rp * gv[bj][1][j]); }
                    *(f32x4*)(OUT + off + bj * HALF) = x0; *(f32x4*)(OUT + off + bj * HALF + 4) = x1; }
                __builtin_amdgcn_sched_barrier(0); }
    }
};
template <class Epi, class Sched, bool ALIGN_EPI = false, bool SP2 = false>
__device__ __forceinline__ void gemm_phase(PG8_LAS unsigned char* lds, const Gemm g, const Sched& S, const Epi& E, const int tid) {
    const int wid = __builtin_amdgcn_readfirstlane(tid >> 6), lane = tid & 63, wr = wid >> 2, wc = wid & 3, fr = lane & 15, fq = lane >> 4;
    const int K = g.K, nt = K / BK;
    unsigned voffA[2], voffB[2];
#pragma unroll
    for (int i = 0; i < 2; ++i) { int R, C; stage_rc(tid * 16 + i * 8192, R, C); const int Rb = Epi::PERM ? ((R & ~31) + perm32(R & 31)) : R;
        voffA[i] = (unsigned)(R * K + C) * 2u; voffB[i] = (unsigned)(Rb * K + C) * 2u; }
    const size_t kstep = (size_t)(BK * 2);
    const size_t hstep = (size_t)HALF * K * 2;
    const size_t tstep = 2 * hstep;
    const unsigned ldsw = (unsigned)wid * 1024u;
    const int aoff = lds_byte(wr * 64 + fr, fq * 8), boff = lds_byte(wc * 32 + fr, fq * 8);
#define PG8_SA(b, h) (((b) * 2 + (h)) * HTB)
#define PG8_SB(b, h) ((4 + (b) * 2 + (h)) * HTB)
#define PG8_STAGE(bufoff, gbase, voff) do { _Pragma("unroll") for (int _i = 0; _i < 2; ++_i) \
        __builtin_amdgcn_global_load_lds((const unsigned*)((const char*)(gbase) + (voff)[_i]), (PG8_LAS unsigned*)(lds + (bufoff) + ldsw + _i * 8192), 16, 0, 0); } while (0)
#define PG8_LDA(dst, b, h) do { _Pragma("unroll") for (int m = 0; m < 4; ++m) _Pragma("unroll") for (int k = 0; k < 2; ++k) dst[m][k] = *(const PG8_LAS bf16x8*)(lds + PG8_SA(b, h) + aoff + m * 2048 + k * 1024); } while (0)
#define PG8_LDB(dst, b, h) do { _Pragma("unroll") for (int n = 0; n < 2; ++n) _Pragma("unroll") for (int k = 0; k < 2; ++k) dst[n][k] = *(const PG8_LAS bf16x8*)(lds + PG8_SB(b, h) + boff + n * 2048 + k * 1024); } while (0)
#define PG8_MMA(ai, bj, At, Bt) do { __builtin_amdgcn_s_setprio(1); _Pragma("unroll") for (int m = 0; m < 4; ++m) _Pragma("unroll") for (int n = 0; n < 2; ++n) _Pragma("unroll") for (int k = 0; k < 2; ++k) \
        acc[ai][bj][m][n] = __builtin_amdgcn_mfma_f32_16x16x32_bf16(Bt[n][k], At[m][k], acc[ai][bj][m][n], 0, 0, 0); __builtin_amdgcn_s_setprio(0); } while (0)
#define PG8_WAIT_V(n) asm volatile("s_waitcnt vmcnt(" #n ")" ::: "memory")
#define PG8_WAIT_L(n) asm volatile("s_waitcnt lgkmcnt(" #n ")" ::: "memory")
#define PG8_BAR __builtin_amdgcn_s_barrier()
#define PG8_SCHED __builtin_amdgcn_sched_barrier(0)
    Unit cur, nxt; int ui = 0;
    if (!S.next(0, cur)) return;
    f32x4 acc[2][2][4][2];
#pragma unroll
    for (int a = 0; a < 2; ++a)
#pragma unroll
        for (int b = 0; b < 2; ++b)
#pragma unroll
            for (int m = 0; m < 4; ++m)
#pragma unroll
                for (int n = 0; n < 2; ++n) acc[a][b][m][n] = (f32x4){0.f, 0.f, 0.f, 0.f};
    bf16x8 At[4][2], B0[2][2], B1[2][2];
    const char* cA = (const char*)g.A + (size_t)cur.pm * tstep; const char* cB = (const char*)g.Bt + (size_t)cur.pn * tstep;
    S.a_ready(cur);
    if constexpr (SP2) {
        PG8_STAGE(PG8_SB(0, 0), cB, voffB); PG8_STAGE(PG8_SB(0, 1), cB + hstep, voffB); PG8_STAGE(PG8_SA(0, 0), cA, voffA); PG8_STAGE(PG8_SA(0, 1), cA + hstep, voffA);
        if (wr == 1) PG8_BAR;
        PG8_WAIT_V(2); PG8_BAR;
        PG8_STAGE(PG8_SB(1, 0), cB + kstep, voffB); PG8_STAGE(PG8_SA(1, 0), cA + kstep, voffA); PG8_STAGE(PG8_SB(1, 1), cB + hstep + kstep, voffB);
        PG8_WAIT_V(6); PG8_BAR;
    } else {
        PG8_STAGE(PG8_SB(0, 0), cB, voffB); PG8_STAGE(PG8_SA(0, 0), cA, voffA); PG8_STAGE(PG8_SB(0, 1), cB + hstep, voffB); PG8_STAGE(PG8_SA(0, 1), cA + hstep, voffA);
        if (wr == 1) PG8_BAR;
        PG8_WAIT_V(4); PG8_BAR;
        PG8_STAGE(PG8_SB(1, 0), cB + kstep, voffB); PG8_STAGE(PG8_SA(1, 0), cA + kstep, voffA); PG8_STAGE(PG8_SB(1, 1), cB + hstep + kstep, voffB);
        PG8_WAIT_V(6); PG8_BAR;
    }
    for (;;) {
        const bool has_next = S.next(ui + 1, nxt);
        const char* nA = has_next ? (const char*)g.A + (size_t)nxt.pm * tstep : cA; const char* nB = has_next ? (const char*)g.Bt + (size_t)nxt.pn * tstep : cB;
        for (int t = 0; t < nt; t += 2) {
            const bool last = (t == nt - 2);
            const char* a1 = cA + (size_t)(t + 1) * kstep;
            const char* a2 = last ? nA : cA + (size_t)(t + 2) * kstep; const char* b2 = last ? nB : cB + (size_t)(t + 2) * kstep;
            const char* a3 = a2 + kstep; const char* b3 = b2 + kstep;
            if (last && has_next) S.a_ready(nxt);
            if constexpr (Epi::HAS_MID) { if (t == (nt >> 1)) E.mid(acc, cur, wr, wc, fr, fq); }
            if constexpr (SP2) {
            PG8_LDB(B0, 0, 0); PG8_LDB(B1, 0, 1); PG8_SCHED; PG8_LDA(At, 0, 0); PG8_STAGE(PG8_SA(1, 1), a1 + hstep, voffA);
            PG8_WAIT_V(8); PG8_WAIT_L(0); PG8_BAR; PG8_MMA(0, 0, At, B0); PG8_MMA(0, 1, At, B1); PG8_BAR; PG8_SCHED;
            PG8_LDA(At, 0, 1); PG8_STAGE(PG8_SB(0, 0), b2, voffB); PG8_STAGE(PG8_SB(0, 1), b2 + hstep, voffB); PG8_STAGE(PG8_SA(0, 0), a2, voffA);
            PG8_WAIT_V(8); PG8_WAIT_L(0); PG8_BAR; PG8_MMA(1, 0, At, B0); PG8_MMA(1, 1, At, B1); PG8_BAR; PG8_SCHED;
            PG8_LDB(B0, 1, 0); PG8_LDB(B1, 1, 1); PG8_SCHED; PG8_LDA(At, 1, 0); PG8_STAGE(PG8_SA(0, 1), a2 + hstep, voffA);
            PG8_WAIT_V(8); PG8_WAIT_L(0); PG8_BAR; PG8_MMA(0, 0, At, B0); PG8_MMA(0, 1, At, B1); PG8_BAR; PG8_SCHED;
            PG8_LDA(At, 1, 1); PG8_STAGE(PG8_SB(1, 0), b3, voffB); PG8_STAGE(PG8_SB(1, 1), b3 + hstep, voffB); PG8_STAGE(PG8_SA(1, 0), a3, voffA);
            PG8_WAIT_V(8); PG8_WAIT_L(0); PG8_BAR; PG8_MMA(1, 0, At, B0); PG8_MMA(1, 1, At, B1); PG8_BAR; PG8_SCHED;
            } else {
            PG8_LDB(B0, 0, 0); PG8_SCHED; PG8_LDA(At, 0, 0); PG8_STAGE(PG8_SA(1, 1), a1 + hstep, voffA);
            PG8_WAIT_L(8); PG8_BAR; PG8_WAIT_L(0); PG8_MMA(0, 0, At, B0); PG8_BAR; PG8_SCHED;
            PG8_LDB(B1, 0, 1); PG8_STAGE(PG8_SB(0, 0), b2, voffB);
            PG8_BAR; PG8_WAIT_L(0); PG8_MMA(0, 1, At, B1); PG8_BAR;
            PG8_LDA(At, 0, 1); PG8_STAGE(PG8_SA(0, 0), a2, voffA);
            PG8_BAR; PG8_WAIT_L(0); PG8_MMA(1, 0, At, B0); PG8_BAR; PG8_SCHED;
            PG8_STAGE(PG8_SB(0, 1), b2 + hstep, voffB);
            PG8_WAIT_V(6); PG8_BAR; PG8_MMA(1, 1, At, B1); PG8_BAR;
            PG8_LDB(B0, 1, 0); PG8_SCHED; PG8_LDA(At, 1, 0); PG8_STAGE(PG8_SA(0, 1), a2 + hstep, voffA);
            PG8_WAIT_L(8); PG8_BAR; PG8_WAIT_L(0); PG8_MMA(0, 0, At, B0); PG8_BAR; PG8_SCHED;
            PG8_LDB(B1, 1, 1); PG8_STAGE(PG8_SB(1, 0), b3, voffB);
            PG8_BAR; PG8_WAIT_L(0); PG8_MMA(0, 1, At, B1); PG8_BAR;
            PG8_LDA(At, 1, 1); PG8_STAGE(PG8_SA(1, 0), a3, voffA);
            PG8_BAR; PG8_WAIT_L(0); PG8_MMA(1, 0, At, B0); PG8_BAR; PG8_SCHED;
            PG8_STAGE(PG8_SB(1, 1), b3 + hstep, voffB);
            PG8_WAIT_V(6); PG8_BAR; PG8_MMA(1, 1, At, B1); PG8_BAR;
            }
        }
        if constexpr (ALIGN_EPI) { if (wr == 0) PG8_BAR; }
        if constexpr (!Epi::AFTER_DRAIN) { E(acc, cur, wr, wc, fr, fq); S.done(cur); }
        if (!has_next) break;
#pragma unroll
        for (int a = 0; a < 2; ++a)
#pragma unroll
            for (int b = 0; b < 2; ++b)
#pragma unroll
                for (int m = 0; m < 4; ++m)
#pragma unroll
                    for (int n = 0; n < 2; ++n) acc[a][b][m][n] = (f32x4){0.f, 0.f, 0.f, 0.f};
        cur = nxt; cA = nA; cB = nB; ++ui;
        if constexpr (ALIGN_EPI) { if (wr == 1) PG8_BAR; }
    }
    PG8_WAIT_V(0);
    if constexpr (!ALIGN_EPI) { if (wr == 0) PG8_BAR; }
    PG8_BAR;
    if constexpr (Epi::AFTER_DRAIN) { E.fused(acc, cur, wr, wc, fr, fq, lds, wid, lane); S.done(cur); }
#undef PG8_SA
#undef PG8_SB
#undef PG8_STAGE
#undef PG8_LDA
#undef PG8_LDB
#undef PG8_MMA
#undef PG8_WAIT_V
#undef PG8_WAIT_L
#undef PG8_BAR
#undef PG8_SCHED
}
}
#define XB_TMO      128
#define XB_XCNT(j)  (256  + 64 * (j))
#define XB_XSUB(j)  (1280 + 64 * (j))
#define XB_XGEN(j)  (2304 + 64 * (j))
#define XB_TOP      3328
#define XB_TOPGEN   3392
#define XCD_BAR_WORDS 3456
#define XB_SPIN_CAP (1u << 20)

__device__ __forceinline__ unsigned xb_ld(unsigned* p)              { return __hip_atomic_load(p, __ATOMIC_RELAXED, __HIP_MEMORY_SCOPE_AGENT); }
__device__ __forceinline__ unsigned xb_add(unsigned* p, unsigned v) { return __hip_atomic_fetch_add(p, v, __ATOMIC_RELAXED, __HIP_MEMORY_SCOPE_AGENT); }
__device__ __forceinline__ unsigned xb_xcc_id() { return (unsigned)__builtin_amdgcn_s_getreg((3 << 11) | 20) & 0xFu; }
#define XB_SPIN(cond, bar) do { unsigned _sp = 0; while (cond) { __builtin_amdgcn_s_sleep(1); \
    if ((++_sp & 255u) == 0u) { if (xb_ld(&(bar)[XB_TMO])) break; if (_sp > XB_SPIN_CAP) { atomicAdd(&(bar)[XB_TMO], 1u); break; } } } } while (0)

struct XcdBarrier {
    unsigned* bar; unsigned x;
    volatile LAS unsigned* st;
};

__device__ __forceinline__ XcdBarrier xcd_barrier_post(unsigned* bar, volatile LAS unsigned* st) {
    XcdBarrier b; b.bar = bar; b.x = xb_xcc_id(); b.st = st;
    if (threadIdx.x == 0) (void)xb_add(&bar[XB_XCNT(b.x)], 1u);
    return b;
}
__device__ __forceinline__ void xcd_barrier_complete(unsigned* bar, unsigned x, unsigned& nloc, unsigned& nx) {
    const unsigned G = gridDim.x * gridDim.y * gridDim.z;
    unsigned sum, cnt, mine, sp = 0u;
    for (;;) {
        sum = 0u; cnt = 0u; mine = 0u;
#pragma unroll
        for (unsigned j = 0; j < 16; ++j) { const unsigned c = xb_ld(&bar[XB_XCNT(j)]); sum += c; cnt += (c > 0u) ? 1u : 0u; mine = (j == x) ? c : mine; }
        if (sum == G) break;
        __builtin_amdgcn_s_sleep(1);
        if ((++sp & 255u) == 0u) { if (xb_ld(&bar[XB_TMO])) break; if (sp > XB_SPIN_CAP) { atomicAdd(&bar[XB_TMO], 1u); break; } }
    }
    nloc = mine > 0u ? mine : 1u; nx = cnt > 0u ? cnt : 1u;
}

__device__ __forceinline__ void xcd_barrier(const XcdBarrier& b) {
    asm volatile("s_waitcnt vmcnt(0)" ::: "memory");
    __syncthreads();
    if (threadIdx.x == 0) {
        unsigned* bar = b.bar;
        __builtin_amdgcn_s_waitcnt(0);
        unsigned nloc = b.st[0], nx = b.st[1];
        if (nloc == 0u) { xcd_barrier_complete(bar, b.x, nloc, nx); b.st[0] = nloc; b.st[1] = nx; }
        const unsigned old = xb_add(&bar[XB_XSUB(b.x)], 1u);
        const unsigned gen = old / nloc;
        if (old + 1u == (gen + 1u) * nloc) {
            __builtin_amdgcn_fence(__ATOMIC_RELEASE, "agent");
            asm volatile("s_waitcnt vmcnt(0)" ::: "memory");
            const unsigned og = xb_add(&bar[XB_TOP], 1u);
            const unsigned tg = og / nx;
            if (og + 1u == (tg + 1u) * nx) xb_add(&bar[XB_TOPGEN], 1u);
            else XB_SPIN(xb_ld(&bar[XB_TOPGEN]) == tg, bar);
            __builtin_amdgcn_fence(__ATOMIC_ACQUIRE, "agent");
            xb_add(&bar[XB_XGEN(b.x)], 1u);
            asm volatile("s_waitcnt vmcnt(0)" ::: "memory");
        } else {
            XB_SPIN(xb_ld(&bar[XB_XGEN(b.x)]) == gen, bar);
            __builtin_amdgcn_fence(__ATOMIC_ACQUIRE, "agent");
            asm volatile("s_waitcnt vmcnt(0)" ::: "memory");
        }
    }
    __syncthreads();
}

template <int MAP> __device__ __forceinline__ int rowmap(int n) {
    if (MAP == 1) return n < 6560 ? n : n + 96;
    if (MAP == 2) return (n >> 7) * 256 + (n & 127);
    if (MAP == 3) return (n >> 7) * 256 + 128 + (n & 127);
    return n;
}
template <int MAP> __device__ __forceinline__ void p0_item(const float* W, int N, bf16* dst, int ldd, int koff, LAS float* scr, int item, int lane) {
    const int nblk = N / 32, kb = item / nblk, nb = item % nblk, k0 = 64 * kb, n0 = 32 * nb;
#pragma unroll 8
    for (int i = 0; i < 32; ++i) { const int kk = 2 * i + (lane >> 5); scr[kk * 33 + (lane & 31)] = W[(size_t)(k0 + kk) * N + n0 + (lane & 31)]; }
    LDS_WAIT(); asm volatile("" ::: "memory");
    const int c = lane & 7, r0 = rowmap<MAP>(n0);
#pragma unroll
    for (int j = 0; j < 4; ++j) { const int n = (lane >> 3) + 8 * j; const LAS float* s = scr + (8 * c) * 33 + n;
        v4u o; o.x = cvt_pk_bf16(s[0 * 33], s[1 * 33]); o.y = cvt_pk_bf16(s[2 * 33], s[3 * 33]); o.z = cvt_pk_bf16(s[4 * 33], s[5 * 33]); o.w = cvt_pk_bf16(s[6 * 33], s[7 * 33]);
        *(GAS v4u*)(dst + (size_t)(r0 + n) * ldd + koff + k0 + 8 * c) = o; }
    LDS_WAIT(); asm volatile("" ::: "memory");
}
__device__ __forceinline__ void rms_row_to_bf16(const float* xrow, const float* gain, bf16* orow, int lane) {
    const GAS f32x4* xr = (const GAS f32x4*)xrow + lane;
    f32x4 v[16]; float s = 0.f;
#pragma unroll
    for (int j = 0; j < 16; ++j) { v[j] = xr[64 * j]; s += (v[j].x * v[j].x + v[j].y * v[j].y) + (v[j].z * v[j].z + v[j].w * v[j].w); }
    const float r = 1.0f / sqrtf(wave_sum(s) * (1.0f / DM) + EPS);
    GAS v2u* o8 = (GAS v2u*)orow + lane;
#pragma unroll
    for (int j = 0; j < 16; ++j) { const f32x4 gv = ((const GAS f32x4*)gain)[lane + 64 * j]; v2u w; w.x = cvt_pk_bf16(v[j].x * r * gv.x, v[j].y * r * gv.y); w.y = cvt_pk_bf16(v[j].z * r * gv.z, v[j].w * r * gv.w); o8[64 * j] = w; }
}

__device__ __forceinline__ unsigned ordkey(float v) { const unsigned u = __float_as_uint(v); return u ^ ((u >> 31) ? 0xffffffffu : 0x80000000u); }
__device__ __forceinline__ int mbcnt64(unsigned long long m) { return (int)__builtin_amdgcn_mbcnt_hi((unsigned)(m >> 32), __builtin_amdgcn_mbcnt_lo((unsigned)m, 0u)); }

__device__ __forceinline__ int wave_count(int cl) { int c = 0;
#pragma unroll
    for (int b = 0; b < 7; ++b) c += __popcll(__ballot((cl >> b) & 1)) << b;
    return c; }
__device__ __forceinline__ void topk_row(const float* sc, int N, unsigned short* out, int lane) {
    asm volatile("" : "+v"(lane));
    if (N <= TOPK) {
#pragma unroll
        for (int i = 0; i < 4; ++i) out[lane + 64 * i] = (unsigned short)(lane + 64 * i);
        return;
    }
    unsigned key[64];
#pragma unroll
    for (int i = 0; i < 64; ++i) { key[i] = 0u; if (i * 64 < N) { const int e = lane + 64 * i; const float v = sc[e < N ? e : 0]; key[i] = e < N ? ordkey(v) : 0u; } }
    unsigned T = 0u;
    for (int bit = 31; bit >= 0; --bit) {
        const unsigned cand = T | (1u << bit); int cl = 0;
#pragma unroll
        for (int i = 0; i < 64; ++i) if (i * 64 < N) cl += (key[i] >= cand) ? 1 : 0;
        const int c = wave_count(cl);
        if (c >= TOPK) { T = cand; if (c == TOPK) break; }
    }
    int cgl = 0;
#pragma unroll
    for (int i = 0; i < 64; ++i) if (i * 64 < N) cgl += (key[i] > T) ? 1 : 0;
    const int cgt = wave_count(cgl);
    const int need_eq = TOPK - cgt; int base = 0, eqb = 0;
#pragma unroll
    for (int i = 0; i < 64; ++i) if (i * 64 < N) {
        const bool gt = key[i] > T, eq = key[i] == T;
        const unsigned long long meq = __ballot(eq);
        const bool sel = gt || (eq && (eqb + mbcnt64(meq)) < need_eq);
        const unsigned long long ms = __ballot(sel);
        if (sel) out[base + mbcnt64(ms)] = (unsigned short)(lane + 64 * i);
        base += __popcll(ms); eqb += __popcll(meq);
    }
}

__device__ __forceinline__ void indexer_unit(LAS unsigned char* lds, int tid, int wave, int lane, int b, int qg,
                                             const bf16* QIDX, const bf16* KIDX, const float* WIDX, float* SC, unsigned short* IDX) {
    LAS unsigned char* KT = lds;
    LAS float* WT = (LAS float*)(lds + 65536);
    asm volatile("" : "+v"(lane), "+v"(tid));
    const int q0 = qg * 32, nkeys = q0 + 32, r = lane & 31, hh = lane >> 5;
    const size_t rowb = (size_t)b * SEQ;
    __syncthreads();
    if (tid < 256) *(LAS f32x4*)(WT + tid * 4) = *(const GAS f32x4*)(WIDX + (rowb + q0) * 32 + tid * 4);
    bf16x8 A[4][8];
#pragma unroll
    for (int qi = 0; qi < 4; ++qi)
#pragma unroll
        for (int kk = 0; kk < 8; ++kk) A[qi][kk] = *(const GAS bf16x8*)(QIDX + (rowb + q0 + 4 * wave + qi) * 4096 + r * 128 + kk * 16 + hh * 8);
    const int nch = (nkeys + 127) >> 7;
    const int srow = 16 * wave + (lane >> 4), slot = lane & 15;
#define IDX_STAGE(ch_, buf_) do { _Pragma("unroll") for (int i_ = 0; i_ < 4; ++i_) { const int krow_ = srow + 4 * i_; \
        __builtin_amdgcn_global_load_lds((const GAS unsigned*)(KIDX + (rowb + (ch_) * 128 + krow_) * 128 + ((slot ^ (krow_ & 15)) << 3)), (LAS unsigned*)((buf_) + (16 * wave + 4 * i_) * 256), 16, 0, 0); } } while (0)
    IDX_STAGE(0, KT);
    for (int ch = 0; ch < nch; ++ch) {
        LAS unsigned char* buf = KT + (ch & 1) * 32768;
        VM_WAIT();
        __syncthreads();
        if (ch + 1 < nch) IDX_STAGE(ch + 1, KT + ((ch + 1) & 1) * 32768);
        const int rem = (nkeys - ch * 128) >> 5, ntile = rem < 4 ? rem : 4;
        for (int tile = 0; tile < ntile; ++tile) {
            bf16x8 Bf[8];
#pragma unroll
            for (int kk = 0; kk < 8; ++kk) Bf[kk] = *(const LAS bf16x8*)(buf + (tile * 32 + r) * 256 + (((2 * kk + hh) ^ (r & 15)) << 4));
            const int key = ch * 128 + tile * 32 + r;
#pragma unroll
            for (int qi = 0; qi < 4; ++qi) {
                f32x16 acc;
#pragma unroll
                for (int e = 0; e < 16; ++e) acc[e] = 0.f;
#pragma unroll
                for (int kk = 0; kk < 8; ++kk) acc = __builtin_amdgcn_mfma_f32_32x32x16_bf16(A[qi][kk], Bf[kk], acc, 0, 0, 0);
                float sc = 0.f;
#pragma unroll
                for (int j = 0; j < 4; ++j) { const f32x4 w4 = *(const LAS f32x4*)(WT + (4 * wave + qi) * 32 + 8 * j + 4 * hh);
#pragma unroll
                    for (int e = 0; e < 4; ++e) sc += fmaxf(acc[4 * j + e], 0.f) * w4[e]; }
                sc += __shfl_xor(sc, 32);
                const int qpos = q0 + 4 * wave + qi;
                if (hh == 0 && key <= qpos) SC[(rowb + qpos) * 4096 + key] = sc;
                __builtin_amdgcn_sched_barrier(0);
            }
        }
    }
#undef IDX_STAGE
    VM_WAIT();
#pragma unroll 1
    for (int qi = 0; qi < 4; ++qi) { const int qpos = q0 + 4 * wave + qi; topk_row(SC + (rowb + qpos) * 4096, qpos + 1, IDX + (rowb + qpos) * 256, lane); }
}

__device__ __forceinline__ void sgu_unit(LAS unsigned char* lds, int tid, int wave, int lane, int cidx, int grp,
                                         const bf16* UV, const float* LNP, const bf16* SGUW, const float* lng, const float* lnb, const float* sgub, bf16* YAB) {
    constexpr int VP = 544, WP = 272;
    LAS unsigned char* VN = lds;
    LAS unsigned char* WL = lds + 128 * VP;
    LAS float* ST = (LAS float*)(lds + 128 * VP + 128 * WP);
    const int t0 = cidx * 128;
    __syncthreads();
    if (tid < 128) { float s = 0.f, q = 0.f;
#pragma unroll
        for (int i = 0; i < 8; ++i) { const GAS f32x4* p = (const GAS f32x4*)(LNP + ((size_t)i * MTOK + t0 + tid) * 8); const f32x4 a = p[0], b = p[1]; s += (a[0] + a[2]) + (b[0] + b[2]); q += (a[1] + a[3]) + (b[1] + b[3]); }
        const float mean = s * (1.0f / GWID), var = q * (1.0f / GWID) - mean * mean;
        ST[2 * tid] = mean; ST[2 * tid + 1] = 1.0f / sqrtf(var + EPS); }
#pragma unroll
    for (int i = 0; i < 4; ++i) { const int c = (tid & 3) * 4 + i; *(LAS v4u*)(WL + (tid >> 2) * WP + c * 16) = *(const GAS v4u*)(SGUW + ((size_t)grp * 128 + (tid >> 2)) * 128 + c * 8); }
    __syncthreads();
#pragma unroll
    for (int i = 0; i < 8; ++i) { const int id = tid + 512 * i, s = id >> 5, dc = id & 31;
        const v4u w = *(const GAS v4u*)(UV + (size_t)(t0 + s) * 4096 + GWID + grp * GDIM + dc * 8); f32x4 v0, v1; unpack8(w, v0, v1);
        const float mean = ST[2 * s], rstd = ST[2 * s + 1];
        const f32x4 g0 = *(const GAS f32x4*)(lng + grp * GDIM + dc * 8), g1 = *(const GAS f32x4*)(lng + grp * GDIM + dc * 8 + 4);
        const f32x4 b0 = *(const GAS f32x4*)(lnb + grp * GDIM + dc * 8), b1 = *(const GAS f32x4*)(lnb + grp * GDIM + dc * 8 + 4);
        v0 = (v0 - mean) * rstd * g0 + b0; v1 = (v1 - mean) * rstd * g1 + b1;
        *(LAS v4u*)(VN + s * VP + dc * 16) = pack8(v0, v1); }
    __syncthreads();
    const int g = lane >> 4, hl = lane & 15, q = hl >> 2, p = lane & 3;
    f32x4 acc[2][8];
#pragma unroll
    for (int a = 0; a < 2; ++a)
#pragma unroll
        for (int t = 0; t < 8; ++t) acc[a][t] = (f32x4){0.f, 0.f, 0.f, 0.f};
#pragma unroll
    for (int ks = 0; ks < 4; ++ks) {
        bf16x8 vf[2];
#pragma unroll
        for (int ds = 0; ds < 2; ++ds) { const int d0 = (2 * wave + ds) * 16;
            const s16x4 a1 = __builtin_amdgcn_ds_read_tr16_b64_v4i16((LAS s16x4*)(VN + (32 * ks + 4 * g + q) * VP + (d0 + 4 * p) * 2));
            const s16x4 a2 = __builtin_amdgcn_ds_read_tr16_b64_v4i16((LAS s16x4*)(VN + (32 * ks + 16 + 4 * g + q) * VP + (d0 + 4 * p) * 2));
            vf[ds] = (bf16x8){a1[0], a1[1], a1[2], a1[3], a2[0], a2[1], a2[2], a2[3]}; }
#pragma unroll
        for (int tt = 0; tt < 8; ++tt) if (tt >= 2 * ks) {
            const int t = 16 * tt + hl;
            const s16x4 w1 = *(const LAS s16x4*)(WL + t * WP + (32 * ks + 4 * g) * 2), w2 = *(const LAS s16x4*)(WL + t * WP + (32 * ks + 16 + 4 * g) * 2);
            const bf16x8 wf = (bf16x8){w1[0], w1[1], w1[2], w1[3], w2[0], w2[1], w2[2], w2[3]};
#pragma unroll
            for (int ds = 0; ds < 2; ++ds) acc[ds][tt] = __builtin_amdgcn_mfma_f32_16x16x32_bf16(vf[ds], wf, acc[ds][tt], 0, 0, 0);
        }
    }
#pragma unroll
    for (int tt = 0; tt < 8; ++tt) { const int t = 16 * tt + hl; const float bs = sgub[grp * 128 + t]; const size_t rowo = (size_t)(t0 + t) * 4096;
#pragma unroll
        for (int ds = 0; ds < 2; ++ds) { const int d = grp * GDIM + (2 * wave + ds) * 16 + 4 * g;
            const v2u uw = *(const GAS v2u*)(UV + rowo + d);
            v2u o; o.x = cvt_pk_bf16(bf_lo(uw.x) * (acc[ds][tt][0] + bs), bf_hi(uw.x) * (acc[ds][tt][1] + bs)); o.y = cvt_pk_bf16(bf_lo(uw.y) * (acc[ds][tt][2] + bs), bf_hi(uw.y) * (acc[ds][tt][3] + bs));
            *(GAS v2u*)(YAB + rowo + GWID + d) = o; } }
}

constexpr int ATT_VB = 32 * 288, ATT_WAVE = ATT_VB + 512, ATT_BL = 8 * ATT_WAVE;
__device__ __forceinline__ void attn_query(LAS unsigned char* wl, const LAS float* BL, int lane, int b, int qpos,
                                           const bf16* Q, const bf16* KN, const bf16* V, const unsigned short* IDX, const float* qgain, bf16* YAB) {
    const int g = lane >> 4, hl = lane & 15, q4 = hl >> 2, p4 = lane & 3;
    const size_t rowb = (size_t)b * SEQ, row = rowb + qpos;
    const int cnt = qpos + 1 < TOPK ? qpos + 1 : TOPK;
    LAS unsigned short* IL = (LAS unsigned short*)(wl + ATT_VB);
    *(LAS v2u*)(IL + 4 * lane) = *(const GAS v2u*)(IDX + row * 256 + 4 * lane);
    bf16x8 qf[4];
    { v4u w[4]; float ss = 0.f;
#pragma unroll
      for (int kk = 0; kk < 4; ++kk) { w[kk] = *(const GAS v4u*)(Q + row * 2048 + hl * 128 + kk * 32 + g * 8); f32x4 a, c; unpack8(w[kk], a, c);
          ss += (a[0] * a[0] + a[1] * a[1]) + (a[2] * a[2] + a[3] * a[3]) + (c[0] * c[0] + c[1] * c[1]) + (c[2] * c[2] + c[3] * c[3]); }
      ss += __shfl_xor(ss, 16); ss += __shfl_xor(ss, 32);
      const float rinv = (1.0f / sqrtf(ss * (1.0f / HDA) + EPS)) * 0.08838834764831845f;
#pragma unroll
      for (int kk = 0; kk < 4; ++kk) { f32x4 a, c; unpack8(w[kk], a, c); const f32x4 g0 = *(const GAS f32x4*)(qgain + kk * 32 + g * 8), g1 = *(const GAS f32x4*)(qgain + kk * 32 + g * 8 + 4);
          const v4u o = pack8(a * rinv * g0, c * rinv * g1); qf[kk] = __builtin_bit_cast(bf16x8, o); } }
    f32x4 s[16];
#pragma unroll
    for (int t = 0; t < 16; ++t) { const int ki = IL[16 * t + hl] & (SEQ - 1); const bf16* kp = KN + (rowb + ki) * 128 + g * 8;
        bf16x8 kf[4];
#pragma unroll
        for (int kk = 0; kk < 4; ++kk) kf[kk] = *(const GAS bf16x8*)(kp + kk * 32);
        s[t] = (f32x4){0.f, 0.f, 0.f, 0.f};
#pragma unroll
        for (int kk = 0; kk < 4; ++kk) s[t] = __builtin_amdgcn_mfma_f32_16x16x32_bf16(kf[kk], qf[kk], s[t], 0, 0, 0); }
    float mx = -__builtin_inff();
#pragma unroll
    for (int t = 0; t < 16; ++t) { const v2u id = *(const LAS v2u*)(IL + 16 * t + 4 * g); const int kx[4] = {(int)(id.x & 0xffffu), (int)(id.x >> 16), (int)(id.y & 0xffffu), (int)(id.y >> 16)};
#pragma unroll
        for (int i = 0; i < 4; ++i) { int n = qpos - kx[i]; n = n < 0 ? 0 : (n > 128 ? 128 : n);
            const float v = (16 * t + 4 * g + i) < cnt ? s[t][i] + BL[n * 16 + hl] : -__builtin_inff(); s[t][i] = v; mx = fmaxf(mx, v); } }
    mx = fmaxf(mx, __shfl_xor(mx, 16)); mx = fmaxf(mx, __shfl_xor(mx, 32));
    float sum = 0.f;
#pragma unroll
    for (int t = 0; t < 16; ++t)
#pragma unroll
        for (int i = 0; i < 4; ++i) { const float e = __builtin_amdgcn_exp2f((s[t][i] - mx) * LOG2E); s[t][i] = e; sum += e; }
    sum += __shfl_xor(sum, 16); sum += __shfl_xor(sum, 32);
    const float inv = 1.0f / sum;
    bf16x8 pf[8];
#pragma unroll
    for (int T = 0; T < 8; ++T) { const v4u o = pack8(s[2 * T] * inv, s[2 * T + 1] * inv); pf[T] = __builtin_bit_cast(bf16x8, o); }
    f32x4 o[8];
#pragma unroll
    for (int dt = 0; dt < 8; ++dt) o[dt] = (f32x4){0.f, 0.f, 0.f, 0.f};
#pragma unroll
    for (int T = 0; T < 8; ++T) {
#pragma unroll
        for (int ins = 0; ins < 8; ++ins) { const int slot = 4 * ins + g; const int vi = IL[32 * T + slot] & (SEQ - 1);
            *(LAS v4u*)(wl + slot * 288 + hl * 16) = *(const GAS v4u*)(V + (rowb + vi) * 128 + hl * 8); }
#pragma unroll
        for (int dt = 0; dt < 8; ++dt) {
            const s16x4 a1 = __builtin_amdgcn_ds_read_tr16_b64_v4i16((LAS s16x4*)(wl + (4 * g + q4) * 288 + (16 * dt + 4 * p4) * 2));
            const s16x4 a2 = __builtin_amdgcn_ds_read_tr16_b64_v4i16((LAS s16x4*)(wl + (16 + 4 * g + q4) * 288 + (16 * dt + 4 * p4) * 2));
            const bf16x8 vf = (bf16x8){a1[0], a1[1], a1[2], a1[3], a2[0], a2[1], a2[2], a2[3]};
            o[dt] = __builtin_amdgcn_mfma_f32_16x16x32_bf16(vf, pf[T], o[dt], 0, 0, 0);
        }
    }
#pragma unroll
    for (int dt = 0; dt < 8; ++dt) { v2u w; w.x = cvt_pk_bf16(o[dt][0], o[dt][1]); w.y = cvt_pk_bf16(o[dt][2], o[dt][3]); *(GAS v2u*)(YAB + row * 4096 + hl * 128 + 16 * dt + 4 * g) = w; }
}

constexpr int NWAVES = 8;
#ifndef MK_N_LAUNCHES
#define MK_N_LAUNCHES 9
#endif
constexpr int N_PHASES = 9;
constexpr int N_LAUNCHES = MK_N_LAUNCHES;
constexpr size_t WS_PB = WS_END;
constexpr size_t WS_NEED = WS_END + 8 * MiB;

__device__ __forceinline__ int lane_now() { int l; asm volatile("v_mbcnt_lo_u32_b32 %0, -1, 0\n\tv_mbcnt_hi_u32_b32 %0, -1, %0" : "=v"(l)); return l; }
struct Args { const float* in[22]; float* out; unsigned char* ws; int ph_lo, ph_hi, li, pad; };
enum { I_X = 0, I_P, I_WIN, I_QNG, I_KNG, I_RELB, I_LNG, I_LNB, I_SGUW, I_SGUB, I_WA, I_WB, I_WOUT, I_NMIX, I_NFFN, I_WG, I_WU, I_WD, I_WPLE, I_PLENG, I_WPG, I_NPLE };

__global__ void __launch_bounds__(NWAVES * 64, 2) fwd_kernel(Args args) {
    extern __shared__ __attribute__((aligned(16))) unsigned char lds_raw[];
    LAS unsigned char* lds = (LAS unsigned char*)lds_raw;
    volatile LAS unsigned* MISC = (volatile LAS unsigned*)(lds + MISC_OFF);
    const int wave = __builtin_amdgcn_readfirstlane(threadIdx.x >> 6);
#define PHASE_IDS() const int lane = lane_now(), tid = wave * 64 + lane
    const int G = gridDim.x, cu = blockIdx.x;
    const int gw = cu * NWAVES + wave, NGW = G * NWAVES;
    unsigned char* ws = args.ws;
    gu32* ctl = (gu32*)(ws + WS_CTL);
    for (int u = threadIdx.x; u < (LDS_BYTES - LDSCTL_OFF) / 4; u += NWAVES * 64) ((LAS unsigned*)(lds + LDSCTL_OFF))[u] = 0u;
    __syncthreads();
    XcdBarrier bar; bar.bar = (unsigned*)(ctl + CW_BAR) + args.li * XCD_BAR_WORDS; bar.x = 0; bar.st = nullptr;
    if (N_LAUNCHES == 1) bar = xcd_barrier_post((unsigned*)(ctl + CW_BAR), MISC + 8);
#define GRID_BAR() do { if (N_LAUNCHES == 1) xcd_barrier(bar); } while (0)
    const int lo = args.ph_lo, hi = args.ph_hi;
#ifndef PH_MASK
#define PH_MASK 0x1ff
#endif
#define IN(k) ((((PH_MASK) >> (k)) & 1) && lo <= (k) && (k) < hi)
#define BOTH(k) (IN(k) && IN((k) + 1))

    bf16* const H = (bf16*)(ws + WS_H); bf16* const WIN = (bf16*)(ws + WS_WIN); bf16* const QIDX = (bf16*)(ws + WS_QIDX); bf16* const Qb = (bf16*)(ws + WS_Q);
    bf16* const UV = (bf16*)(ws + WS_UV); bf16* const SGA = (bf16*)(ws + WS_SGA); bf16* const SGB = (bf16*)(ws + WS_SGB);
    bf16* const WAB = (bf16*)(ws + WS_WAB); bf16* const WOUT = (bf16*)(ws + WS_WOUT); bf16* const WGU = (bf16*)(ws + WS_WGU); bf16* const WD = (bf16*)(ws + WS_WD);
    bf16* const WPLE = (bf16*)(ws + WS_WPLE); bf16* const WPG = (bf16*)(ws + WS_WPG); bf16* const PB = (bf16*)(ws + WS_PB);
    unsigned short* const IDX = (unsigned short*)(ws + WS_IDX); float* const LNP = (float*)(ws + WS_LNP);
    float* const SSQ1 = (float*)(ws + WS_SSQ1); float* const SSQ2 = (float*)(ws + WS_SSQ2); float* const SSQP = (float*)(ws + WS_SSQP);
    float* const WIDX = (float*)(ws + WS_WIDX); bf16* const KIDX = (bf16*)(ws + WS_KIDX); bf16* const KN = (bf16*)(ws + WS_KN); bf16* const Vb = (bf16*)(ws + WS_V);
    float* const KRAW = (float*)(ws + WS_KRAW); bf16* const SGUW = (bf16*)(ws + WS_SGUW);
    float* const SC = (float*)(ws + WS_SC); bf16* const MERGED = (bf16*)(ws + WS_MERGED); bf16* const ACT = (bf16*)(ws + WS_ACT); bf16* const YAB = (bf16*)(ws + WS_YAB);
    bf16* const X1G = (bf16*)(ws + WS_X1G); bf16* const X2G = (bf16*)(ws + WS_X2G); bf16* const PE = (bf16*)(ws + WS_PE);

    if (IN(0)) {
        PHASE_IDS();
        LAS float* scr = (LAS float*)(lds + RING_OFF + wave * 16384);
        constexpr int I_IN = 64 * (INCOLS / 32), I_A = 32 * 128, I_SQ = 64 * 128, I_G = 64 * (DFF / 32), I_D = (DFF / 64) * 128, I_PL = 4 * 128;
        constexpr int NITEMS = I_IN + 2 * I_A + I_SQ + 2 * I_G + I_D + I_PL + I_SQ;
        for (int it = gw; it < NITEMS; it += NGW) {
            int r = it;
            if (r < I_IN) { p0_item<1>(args.in[I_WIN], INCOLS, WIN, DM, 0, scr, r, lane); continue; } r -= I_IN;
            if (r < I_A) { p0_item<0>(args.in[I_WA], DM, WAB, DM, 0, scr, r, lane); continue; } r -= I_A;
            if (r < I_A) { p0_item<0>(args.in[I_WB], DM, WAB, DM, 2048, scr, r, lane); continue; } r -= I_A;
            if (r < I_SQ) { p0_item<0>(args.in[I_WOUT], DM, WOUT, DM, 0, scr, r, lane); continue; } r -= I_SQ;
            if (r < I_G) { p0_item<2>(args.in[I_WG], DFF, WGU, DM, 0, scr, r, lane); continue; } r -= I_G;
            if (r < I_G) { p0_item<3>(args.in[I_WU], DFF, WGU, DM, 0, scr, r, lane); continue; } r -= I_G;
            if (r < I_D) { p0_item<0>(args.in[I_WD], DM, WD, DFF, 0, scr, r, lane); continue; } r -= I_D;
            if (r < I_PL) { p0_item<0>(args.in[I_WPLE], DM, WPLE, DPLE, 0, scr, r, lane); continue; } r -= I_PL;
            p0_item<0>(args.in[I_WPG], DM, WPG, DM, 0, scr, r, lane);
        }
        for (int m = gw; m < MTOK; m += NGW) rms_row_to_bf16(args.in[I_X] + (size_t)m * DM, args.in[I_NMIX], H + (size_t)m * DM, lane);
        { const float* P = args.in[I_P]; const int gt = cu * 512 + tid, NT = G * 512;
          for (int i = gt; i < MTOK * DPLE / 4; i += NT) { const f32x4 v = *(const GAS f32x4*)(P + (size_t)i * 4); v2u w; w.x = cvt_pk_bf16(v.x, v.y); w.y = cvt_pk_bf16(v.z, v.w); *(GAS v2u*)(PB + (size_t)i * 4) = w; }
          const float* SW = args.in[I_SGUW];
          for (int i = gt; i < NGRP * CHK * CHK / 2; i += NT) { const int e = 2 * i, t = (e >> 7) & 127, s = e & 127; const f32x2 v = *(const GAS f32x2*)(SW + e);
              *(GAS unsigned*)(SGUW + e) = cvt_pk_bf16(s <= t ? v.x : 0.f, (s + 1) <= t ? v.y : 0.f); } }
        if (BOTH(0)) GRID_BAR();
    }

    if (IN(1)) {
        PHASE_IDS();
        pg8::Gemm g{H, WIN, MTOK, INPAD, DM}; pg8::StaticOrder S; S.init(MTOK, INPAD, G, cu);
        pg8::EpiInProj E{Qb, Vb, QIDX, KIDX, UV, SGA, SGB, KRAW, WIDX, LNP};
        pg8::gemm_phase<pg8::EpiInProj, pg8::StaticOrder, true, true>(lds + RING_OFF, g, S, E, tid);
        if (BOTH(1)) GRID_BAR();
    }

    if (IN(2)) {
        PHASE_IDS();
        { const float* kg = args.in[I_KNG];
          for (int rp = gw; rp < MTOK / 2; rp += NGW) { const int row = 2 * rp + (lane >> 5), c = (lane & 31) * 4;
              const f32x4 v = *(const GAS f32x4*)(KRAW + (size_t)row * 128 + c); float ss = (v.x * v.x + v.y * v.y) + (v.z * v.z + v.w * v.w);
#pragma unroll
              for (int o = 1; o < 32; o <<= 1) ss += __shfl_xor(ss, o);
              const float r = 1.0f / sqrtf(ss * (1.0f / HDA) + EPS); const f32x4 gv = *(const GAS f32x4*)(kg + c);
              v2u w; w.x = cvt_pk_bf16(v.x * r * gv.x, v.y * r * gv.y); w.y = cvt_pk_bf16(v.z * r * gv.z, v.w * r * gv.w); *(GAS v2u*)(KN + (size_t)row * 128 + c) = w; } }
        constexpr int NU = NB * (SEQ / 32);
        for (int j = cu; j < NU; j += G) { const int rnd = j / G, pos = j % G; int u;
            if ((rnd & 1) == 0) u = j; else { const int hiu = (rnd + 1) * G < NU ? (rnd + 1) * G : NU; u = hiu - 1 - pos; if (u < rnd * G) continue; }
            indexer_unit(lds + RING_OFF, tid, wave, lane, u % NB, u / NB, QIDX, KIDX, WIDX, SC, IDX); }
        if (BOTH(2)) GRID_BAR();
    }

    if (IN(3)) {
        PHASE_IDS();
        for (int u = cu; u < (MTOK / CHK) * NGRP; u += G) sgu_unit(lds + RING_OFF, tid, wave, lane, u >> 3, u & 7, UV, LNP, SGUW, args.in[I_LNG], args.in[I_LNB], args.in[I_SGUB], YAB);
        __syncthreads();
        LAS float* BL = (LAS float*)(lds + RING_OFF + ATT_BL);
        { const float* rb = args.in[I_RELB];
          for (int i = tid; i < 129 * 16; i += NWAVES * 64) { const int n = i >> 4, h = i & 15; int bk;
              if (n < 16) bk = n; else { bk = 16 + (int)(logf((float)n * (1.0f / 16.0f)) / 2.0794415416798357f * 16.0f); bk = bk > 31 ? 31 : bk; }
              BL[i] = rb[bk * 16 + h]; } }
        __syncthreads();
        for (int qi = gw; qi < MTOK; qi += NGW) attn_query(lds + RING_OFF + wave * ATT_WAVE, BL, lane, qi / SEQ, qi % SEQ, Qb, KN, Vb, IDX, args.in[I_QNG], YAB);
        if (BOTH(3)) GRID_BAR();
    }

    if (IN(4)) {
        PHASE_IDS();
        pg8::Gemm g{YAB, WAB, MTOK, DM, DM}; pg8::StaticOrder S; S.init(MTOK, DM, G, cu);
        pg8::EpiMerge E{SGA, SGB, MERGED};
        pg8::gemm_phase<pg8::EpiMerge, pg8::StaticOrder, true, true>(lds + RING_OFF, g, S, E, tid);
        if (BOTH(4)) GRID_BAR();
    }

    if (IN(5)) {
        PHASE_IDS();
        { pg8::Gemm g{MERGED, WOUT, MTOK, DM, DM}; pg8::StaticOrder S; S.init(MTOK, DM, G, cu);
          pg8::EpiResid E{args.in[I_X], args.out, X1G, args.in[I_NFFN], SSQ1};
          pg8::gemm_phase<pg8::EpiResid, pg8::StaticOrder, true, true>(lds + RING_OFF, g, S, E, tid); }
        { pg8::Gemm g{PB, WPLE, MTOK, DM, DPLE}; pg8::StaticOrder S; S.init(MTOK, DM, G, cu);
          pg8::EpiPe E{PE, SSQP};
          pg8::gemm_phase<pg8::EpiPe, pg8::StaticOrder, true, true>(lds + RING_OFF, g, S, E, tid); }
        if (BOTH(5)) GRID_BAR();
    }

    if (IN(6)) {
        PHASE_IDS();
        pg8::Gemm g{X1G, WGU, MTOK, 2 * DFF, DM}; pg8::StaticOrder S; S.init(MTOK, 2 * DFF, G, cu);
        pg8::EpiGateUp E{SSQ1, ACT};
        pg8::gemm_phase<pg8::EpiGateUp, pg8::StaticOrder, true, true>(lds + RING_OFF, g, S, E, tid);
        if (BOTH(6)) GRID_BAR();
    }

    if (IN(7)) {
        PHASE_IDS();
        pg8::Gemm g{ACT, WD, MTOK, DM, DFF}; pg8::StaticOrder S; S.init(MTOK, DM, G, cu);
        pg8::EpiResid E{args.out, args.out, X2G, args.in[I_NPLE], SSQ2};
        pg8::gemm_phase<pg8::EpiResid, pg8::StaticOrder, true, true>(lds + RING_OFF, g, S, E, tid);
        if (BOTH(7)) GRID_BAR();
    }

    if (IN(8)) {
        PHASE_IDS();
        pg8::Gemm g{X2G, WPG, MTOK, DM, DM}; pg8::StaticOrder S; S.init(MTOK, DM, G, cu);
        pg8::EpiFinal E{SSQ2, SSQP, args.in[I_PLENG], PE, args.out};
        pg8::gemm_phase<pg8::EpiFinal, pg8::StaticOrder, true, true>(lds + RING_OFF, g, S, E, tid);
    }

#if defined(DUMP_AFTER)
    if (lo == N_PHASES) {
        const size_t gt = (size_t)cu * 512 + threadIdx.x, NT = (size_t)G * 512;
        for (size_t i = gt; i < (size_t)MTOK * DM; i += NT) { const size_t m = i >> 12; const int c = (int)(i & 4095); float v = 0.f;
#if DUMP_AFTER == 3
            v = bf_lo((unsigned)YAB[i]);
#elif DUMP_AFTER == 2
            v = c < 256 ? (float)IDX[m * 256 + c] : (c < 384 ? bf_lo((unsigned)KN[m * 128 + c - 256]) : 0.f);
#elif DUMP_AFTER == 1
#if DUMP_SEL == 0
            v = bf_lo((unsigned)QIDX[i]);
#elif DUMP_SEL == 1
            v = bf_lo((unsigned)UV[i]);
#elif DUMP_SEL == 2
            v = bf_lo((unsigned)SGA[i]) + bf_lo((unsigned)SGB[i]);
#elif DUMP_SEL == 3
            v = bf_lo((unsigned)Qb[m * 2048 + (c & 2047)]);
            if (c < 128) v += KRAW[m * 128 + c] + bf_lo((unsigned)Vb[m * 128 + c]) + bf_lo((unsigned)KIDX[m * 128 + c]);
            if (c < 32) v += WIDX[m * 32 + c];
#endif
#elif DUMP_AFTER == 0
            v = bf_lo((unsigned)H[i]) + bf_lo((unsigned)WIN[i]) + bf_lo((unsigned)WIN[(size_t)(INPAD - 4096) * DM + i]) + bf_lo((unsigned)WGU[i]) + bf_lo((unsigned)WD[i]) + bf_lo((unsigned)WAB[i]);
#endif
            args.out[i] = v; }
    }
#endif
#undef IN
#undef BOTH
#undef GRID_BAR
}

extern "C" void kernel_launch(void* const* d_in, const int* in_sizes, int n_in, void* d_out, int out_size, void* d_ws, size_t ws_size, hipStream_t stream) {
    static int grid = 0;
    if (grid == 0) {
        if (n_in != 22 || in_sizes[0] != MTOK * DM || out_size != MTOK * DM || ws_size < WS_NEED) {
            fprintf(stderr, "kernel_launch: unexpected problem (n_in %d, in0 %d, out %d, ws %zu, need %zu); nothing launched\n", n_in, n_in > 0 ? in_sizes[0] : -1, out_size, ws_size, (size_t)WS_NEED); grid = -1; return; }
        int dev = 0, cus = 0, per_cu = 0;
        if (hipGetDevice(&dev) != hipSuccess || hipDeviceGetAttribute(&cus, hipDeviceAttributeMultiprocessorCount, dev) != hipSuccess) { grid = -1; return; }
        if (hipFuncSetAttribute((const void*)fwd_kernel, hipFuncAttributeMaxDynamicSharedMemorySize, LDS_BYTES) != hipSuccess) { fprintf(stderr, "kernel_launch: hipFuncSetAttribute failed\n"); grid = -1; return; }
        if (hipOccupancyMaxActiveBlocksPerMultiprocessor(&per_cu, (const void*)fwd_kernel, NWAVES * 64, LDS_BYTES) != hipSuccess || per_cu < 1)
            fprintf(stderr, "kernel_launch: note: occupancy query reports %d workgroups per CU\n", per_cu);
        (void)hipGetLastError();
        grid = cus;
    }
    if (grid < 0) return;
    if (hipMemsetAsync((char*)d_ws + WS_CTL, 0, CTL_ZERO_BYTES, stream) != hipSuccess) return;
    Args a{};
    for (int i = 0; i < 22; ++i) a.in[i] = (const float*)d_in[i];
    a.out = (float*)d_out; a.ws = (unsigned char*)d_ws;
#if defined(DUMP_AFTER)
    for (int li = 0; li <= DUMP_AFTER + 1; ++li) {
        a.ph_lo = li <= DUMP_AFTER ? li : N_PHASES; a.ph_hi = a.ph_lo + 1; a.li = 0;
#else
    for (int li = 0; li < N_LAUNCHES; ++li) {
        a.ph_lo = (N_LAUNCHES == 1) ? 0 : li; a.ph_hi = (N_LAUNCHES == 1) ? N_PHASES : li + 1; a.li = (N_LAUNCHES == 1) ? 0 : 0;
#endif
        hipLaunchKernelGGL(fwd_kernel, dim3(grid), dim3(NWAVES * 64), LDS_BYTES, stream, a);
        const hipError_t le = hipPeekAtLastError();
        if (le != hipSuccess) { fprintf(stderr, "kernel_launch: launch %d failed: %s\n", li, hipGetErrorName(le)); break; }
    }
}
```

```cpp
#include <hip/hip_runtime.h>
#include <cstdio>
#include <cstdint>

#define GAS __attribute__((address_space(1)))
#define LAS __attribute__((address_space(3)))
typedef unsigned short bf16;
typedef unsigned v4u __attribute__((ext_vector_type(4)));
typedef unsigned v2u __attribute__((ext_vector_type(2)));
typedef float f32x4 __attribute__((ext_vector_type(4)));
typedef float f32x2 __attribute__((ext_vector_type(2)));
typedef float f32x16 __attribute__((ext_vector_type(16)));
typedef short bf16x8 __attribute__((ext_vector_type(8)));
typedef short s16x4 __attribute__((ext_vector_type(4)));
typedef GAS unsigned gu32;

constexpr int NB = 4, SEQ = 4096, DM = 4096, MTOK = NB * SEQ;
constexpr int NHA = 16, HDA = 128, NIH = 32, IDXD = 128, TOPK = 256;
constexpr int GWID = 2048, NGRP = 8, GDIM = 256, CHK = 128;
constexpr int DFF = 11008, DPLE = 256;
constexpr int INCOLS = 18848, INPAD = 18944;
constexpr float EPS = 1e-6f;
constexpr float LOG2E = 1.4426950408889634f;

constexpr size_t MiB = 1u << 20;
constexpr size_t WS_CTL = 0, CTL_ZERO_BYTES = 1 * MiB;
constexpr size_t WS_IDX = 1 * MiB;
constexpr size_t WS_LNP = 9 * MiB;
constexpr size_t WS_SSQ1 = 13 * MiB;
constexpr size_t WS_SSQ2 = 17 * MiB;
constexpr size_t WS_SSQP = 21 * MiB;
constexpr size_t WS_WIDX = 25 * MiB;
constexpr size_t WS_KIDX = 27 * MiB;
constexpr size_t WS_KN = 31 * MiB;
constexpr size_t WS_V = 35 * MiB;
constexpr size_t WS_KRAW = 39 * MiB;
constexpr size_t WS_SGUW = 47 * MiB;
constexpr size_t WS_H = 48 * MiB;
constexpr size_t WS_WIN = 176 * MiB;
constexpr size_t WS_QIDX = 324 * MiB;
constexpr size_t WS_Q = 452 * MiB;
constexpr size_t WS_UV = 516 * MiB;
constexpr size_t WS_SGA = 644 * MiB;
constexpr size_t WS_SGB = 772 * MiB;
constexpr size_t WS_WAB = 900 * MiB;
constexpr size_t WS_WOUT = 932 * MiB;
constexpr size_t WS_WGU = 964 * MiB;
constexpr size_t WS_WD = 1136 * MiB;
constexpr size_t WS_WPLE = 1222 * MiB;
constexpr size_t WS_WPG = 1224 * MiB;
constexpr size_t WS_END = 1256 * MiB;
constexpr size_t WS_SC = WS_H, WS_MERGED = WS_H, WS_ACT = WS_H, WS_YAB = WS_QIDX, WS_X1G = WS_UV, WS_X2G = WS_UV, WS_PE = WS_SGA;
static_assert(WS_SC + (size_t)MTOK * SEQ * 4 <= WS_QIDX && WS_ACT + (size_t)MTOK * DFF * 2 <= WS_Q && WS_WIN + (size_t)INPAD * DM * 2 <= WS_QIDX && WS_WD + (size_t)DM * DFF * 2 <= WS_WPLE, "ws map");

constexpr int CW_TMO = 0, CW_CODE = 1, CW_BAR = 4096;

constexpr int RING_OFF = 0, RING_BYTES = 131072;
constexpr int LDSCTL_OFF = RING_BYTES, MISC_OFF = LDSCTL_OFF + 320;
constexpr int LDS_BYTES = 147456;
static_assert(MISC_OFF + 128 <= LDS_BYTES, "LDS map");

#define RLX_AGENT __ATOMIC_RELAXED, __HIP_MEMORY_SCOPE_AGENT
#define LDS_WAIT() asm volatile("s_waitcnt lgkmcnt(0)" ::: "memory")
#define VM_WAIT() asm volatile("s_waitcnt vmcnt(0)" ::: "memory")

typedef __bf16 bf16v2_t __attribute__((ext_vector_type(2)));
__device__ __forceinline__ unsigned cvt_pk_bf16(float lo, float hi) { const f32x2 v = {lo, hi}; const bf16v2_t b = __builtin_convertvector(v, bf16v2_t); return __builtin_bit_cast(unsigned, b); }
__device__ __forceinline__ float bf_lo(unsigned w) { return __uint_as_float(w << 16); }
__device__ __forceinline__ float bf_hi(unsigned w) { return __uint_as_float(w & 0xffff0000u); }
__device__ __forceinline__ float fast_sigmoid(float x) { return __builtin_amdgcn_rcpf(1.0f + __builtin_amdgcn_exp2f(-LOG2E * x)); }
__device__ __forceinline__ float gelu_tanh(float x) { const float t = x * (1.0f + 0.044715f * x * x); return x * __builtin_amdgcn_rcpf(1.0f + __builtin_amdgcn_exp2f(-2.302208198f * t)); }
__device__ __forceinline__ float wave_sum(float v) {
#pragma unroll
    for (int o = 1; o < 64; o <<= 1) v += __shfl_xor(v, o);
    return v;
}
__device__ __forceinline__ v4u pack8(f32x4 a, f32x4 b) { v4u w; w.x = cvt_pk_bf16(a[0], a[1]); w.y = cvt_pk_bf16(a[2], a[3]); w.z = cvt_pk_bf16(b[0], b[1]); w.w = cvt_pk_bf16(b[2], b[3]); return w; }
__device__ __forceinline__ void unpack8(v4u w, f32x4& a, f32x4& b) { a = (f32x4){bf_lo(w.x), bf_hi(w.x), bf_lo(w.y), bf_hi(w.y)}; b = (f32x4){bf_lo(w.z), bf_hi(w.z), bf_lo(w.w), bf_hi(w.w)}; }

namespace pg8 {
#define PG8_LAS __attribute__((address_space(3)))
typedef unsigned short bf16_t;
typedef unsigned u32x4 __attribute__((ext_vector_type(4)));
constexpr int BM = 256, BK = 64, HALF = 128, HTB = HALF * BK * 2, STAGE_BYTES = 8 * HTB, NXCD = 8, WGM = 8;

__host__ __device__ __forceinline__ int lds_byte(int r, int c) { const int st = (r >> 4) * 2 + (c >> 5), rr = r & 15, cc = c & 31, ob = rr * 64 + cc * 2; return st * 1024 + (ob ^ (((ob >> 9) & 1) << 5)); }
__host__ __device__ __forceinline__ void stage_rc(int b, int& R, int& C) { const int st = b / 1024, sb = b % 1024, swz = sb ^ (((sb >> 9) & 1) << 5); R = (st >> 1) * 16 + swz / 64; C = (st & 1) * 32 + (swz % 64) / 2; }
__host__ __device__ __forceinline__ int perm32(int rho) { const int n = rho >> 4, i = rho & 15; return 8 * (i >> 2) + 4 * n + (i & 3); }

struct Unit { int pm, pn; };
struct Gemm { const bf16_t* A; const bf16_t* Bt; int M, N, K; };

struct StaticOrder {
    int nM, nN, nwg, G, c;
    __host__ __device__ void init(int M, int N, int G_, int c_) { nM = M / BM; nN = N / BM; nwg = nM * nN; G = G_; c = c_; }
    __host__ __device__ bool next(int i, Unit& u) const {
        const long L = (long)i * G + c; if (L >= nwg) return false;
        int wgid = (int)L; { const int q = nwg / NXCD, r = nwg % NXCD, xcd = wgid % NXCD, off = wgid / NXCD; wgid = (xcd < r ? xcd * (q + 1) : r * (q + 1) + (xcd - r) * q) + off; }
        const int nig = WGM * nN, gid = wgid / nig, fm = gid * WGM, gsz = (nM - fm) < WGM ? (nM - fm) : WGM;
        u.pm = fm + ((wgid % nig) % gsz); u.pn = (wgid % nig) / gsz; return true;
    }
    __device__ __forceinline__ void a_ready(const Unit&) const {}
    __device__ __forceinline__ void done(const Unit&) const {}
};

typedef f32x4 Acc[2][2][4][2];

__device__ __forceinline__ float row_total64(const float* tab, int row, int fq) {
    const float* p = tab + ((size_t)(fq * 4) * MTOK + row) * 4;
    const f32x4 a = *(const f32x4*)p, b = *(const f32x4*)(p + (size_t)MTOK * 4), c = *(const f32x4*)(p + (size_t)MTOK * 8), d = *(const f32x4*)(p + (size_t)MTOK * 12);
    float s = ((a[0] + a[1]) + (a[2] + a[3])) + ((b[0] + b[1]) + (b[2] + b[3])) + ((c[0] + c[1]) + (c[2] + c[3])) + ((d[0] + d[1]) + (d[2] + d[3]));
    s += __shfl_xor(s, 16); s += __shfl_xor(s, 32); return s;
}

struct EpiInProj {
    static constexpr bool PERM = true, AFTER_DRAIN = false, HAS_MID = false;
    bf16_t *Q, *V, *QIDX, *KIDX, *UV, *SGA, *SGB; float *KRAW, *WIDX, *LNP;
    __device__ __forceinline__ void mid(Acc&, const Unit&, int, int, int, int) const {}
    template <int ACT> __device__ __forceinline__ void plain(const Acc& acc, bf16_t* O, int ldc, int colt, int row0, int cl) const {
#pragma unroll
        for (int ai = 0; ai < 2; ++ai)
#pragma unroll
            for (int m = 0; m < 4; ++m) { bf16_t* rowp = O + (size_t)(row0 + ai * HALF + m * 16) * ldc + colt + cl;
#pragma unroll
                for (int bj = 0; bj < 2; ++bj) { f32x4 v0 = acc[ai][bj][m][0], v1 = acc[ai][bj][m][1];
                    if (ACT == 1) {
#pragma unroll
                        for (int j = 0; j < 4; ++j) { v0[j] = gelu_tanh(v0[j]); v1[j] = gelu_tanh(v1[j]); } }
                    if (ACT == 2) {
#pragma unroll
                        for (int j = 0; j < 4; ++j) { v0[j] = fast_sigmoid(v0[j]); v1[j] = fast_sigmoid(v1[j]); } }
                    *(u32x4*)(rowp + bj * HALF) = pack8(v0, v1); }
                __builtin_amdgcn_sched_barrier(0); }
    }
    __device__ __forceinline__ void operator()(const Acc& acc, const Unit& u, int wr, int wc, int fr, int fq) const {
        asm volatile("" : "+v"(fr), "+v"(fq));
        const int row0 = u.pm * BM + wr * 64 + fr, cl = wc * 32 + 8 * fq, pn = u.pn;
        if (pn < 8 || (pn > 8 && pn < 25)) { const bool isq = pn < 8; plain<0>(acc, isq ? Q : QIDX, isq ? 2048 : 4096, isq ? pn * 256 : (pn - 9) * 256, row0, cl); }
        else if (pn == 8) {
#pragma unroll
            for (int ai = 0; ai < 2; ++ai)
#pragma unroll
                for (int m = 0; m < 4; ++m) { const size_t r = (size_t)(row0 + ai * HALF + m * 16);
                    *(f32x4*)(KRAW + r * 128 + cl) = acc[ai][0][m][0]; *(f32x4*)(KRAW + r * 128 + cl + 4) = acc[ai][0][m][1];
                    *(u32x4*)(V + r * 128 + cl) = pack8(acc[ai][1][m][0], acc[ai][1][m][1]); }
        }
        else if (pn == 25) {
#pragma unroll
            for (int ai = 0; ai < 2; ++ai)
#pragma unroll
                for (int m = 0; m < 4; ++m) { const size_t r = (size_t)(row0 + ai * HALF + m * 16);
                    *(u32x4*)(KIDX + r * 128 + cl) = pack8(acc[ai][0][m][0], acc[ai][0][m][1]);
                    if (wc == 0) { *(f32x4*)(WIDX + r * 32 + 8 * fq) = acc[ai][1][m][0]; *(f32x4*)(WIDX + r * 32 + 8 * fq + 4) = acc[ai][1][m][1]; } }
        }
        else if (pn < 42) {
            const bool isv = pn >= 34;
#pragma unroll
            for (int ai = 0; ai < 2; ++ai)
#pragma unroll
                for (int m = 0; m < 4; ++m) { const size_t r = (size_t)(row0 + ai * HALF + m * 16); bf16_t* rowp = UV + r * 4096 + (pn - 26) * 256 + cl; float s = 0.f, q = 0.f;
#pragma unroll
                    for (int bj = 0; bj < 2; ++bj) { f32x4 v0 = acc[ai][bj][m][0], v1 = acc[ai][bj][m][1];
#pragma unroll
                        for (int j = 0; j < 4; ++j) { v0[j] = gelu_tanh(v0[j]); v1[j] = gelu_tanh(v1[j]); s += v0[j] + v1[j]; q += v0[j] * v0[j] + v1[j] * v1[j]; }
                        *(u32x4*)(rowp + bj * HALF) = pack8(v0, v1); }
                    s += __shfl_xor(s, 16); s += __shfl_xor(s, 32); q += __shfl_xor(q, 16); q += __shfl_xor(q, 32);
                    if (isv && fq == 0) *(f32x2*)(LNP + (((size_t)(pn - 34) * MTOK + r) * 4 + wc) * 2) = (f32x2){s, q};
                    __builtin_amdgcn_sched_barrier(0); }
        }
        else { const bool isa = pn < 58; plain<2>(acc, isa ? SGA : SGB, 4096, isa ? (pn - 42) * 256 : (pn - 58) * 256, row0, cl); }
    }
};

struct EpiMerge {
    static constexpr bool PERM = true, AFTER_DRAIN = false, HAS_MID = true;
    const bf16_t *SGA, *SGB; bf16_t* O;
    __device__ __forceinline__ void mid(Acc& acc, const Unit& u, int wr, int wc, int fr, int fq) const {
        asm volatile("" : "+v"(fr), "+v"(fq));
        const int row0 = u.pm * BM + wr * 64 + fr, col0 = u.pn * BM + wc * 32 + 8 * fq;
#pragma unroll
        for (int ai = 0; ai < 2; ++ai)
#pragma unroll
            for (int m = 0; m < 4; ++m) { const size_t off = (size_t)(row0 + ai * HALF + m * 16) * 4096 + col0;
#pragma unroll
                for (int bj = 0; bj < 2; ++bj) { const u32x4 wa = *(const u32x4*)(SGA + off + bj * HALF), wb = *(const u32x4*)(SGB + off + bj * HALF);
                    f32x4 a0, a1, b0, b1; unpack8(wa, a0, a1); unpack8(wb, b0, b1);
#pragma unroll
                    for (int j = 0; j < 4; ++j) { acc[ai][bj][m][0][j] *= a0[j] * __builtin_amdgcn_rcpf(b0[j]); acc[ai][bj][m][1][j] *= a1[j] * __builtin_amdgcn_rcpf(b1[j]); } }
                __builtin_amdgcn_sched_barrier(0); }
    }
    __device__ __forceinline__ void operator()(const Acc& acc, const Unit& u, int wr, int wc, int fr, int fq) const {
        asm volatile("" : "+v"(fr), "+v"(fq));
        const int row0 = u.pm * BM + wr * 64 + fr, col0 = u.pn * BM + wc * 32 + 8 * fq;
#pragma unroll
        for (int ai = 0; ai < 2; ++ai)
#pragma unroll
            for (int m = 0; m < 4; ++m) { const size_t off = (size_t)(row0 + ai * HALF + m * 16) * 4096 + col0;
#pragma unroll
                for (int bj = 0; bj < 2; ++bj) { const u32x4 wb = *(const u32x4*)(SGB + off + bj * HALF); f32x4 b0, b1; unpack8(wb, b0, b1);
                    *(u32x4*)(O + off + bj * HALF) = pack8(acc[ai][bj][m][0] * b0, acc[ai][bj][m][1] * b1); }
                __builtin_amdgcn_sched_barrier(0); }
    }
};

struct EpiResid {
    static constexpr bool PERM = true, AFTER_DRAIN = false, HAS_MID = false;
    const float* XIN; float* XOUT; bf16_t* XG; const float* gain; float* SSQ;
    __device__ __forceinline__ void mid(Acc&, const Unit&, int, int, int, int) const {}
    __device__ __forceinline__ void operator()(const Acc& acc, const Unit& u, int wr, int wc, int fr, int fq) const {
        asm volatile("" : "+v"(fr), "+v"(fq));
        const int row0 = u.pm * BM + wr * 64 + fr, col0 = u.pn * BM + wc * 32 + 8 * fq;
        f32x4 gv[2][2];
#pragma unroll
        for (int bj = 0; bj < 2; ++bj) { gv[bj][0] = *(const f32x4*)(gain + col0 + bj * HALF); gv[bj][1] = *(const f32x4*)(gain + col0 + bj * HALF + 4); }
#pragma unroll
        for (int ai = 0; ai < 2; ++ai)
#pragma unroll
            for (int m = 0; m < 4; ++m) { const size_t r = (size_t)(row0 + ai * HALF + m * 16), off = r * 4096 + col0; float q = 0.f;
#pragma unroll
                for (int bj = 0; bj < 2; ++bj) { f32x4 v0 = *(const f32x4*)(XIN + off + bj * HALF) + acc[ai][bj][m][0], v1 = *(const f32x4*)(XIN + off + bj * HALF + 4) + acc[ai][bj][m][1];
                    *(f32x4*)(XOUT + off + bj * HALF) = v0; *(f32x4*)(XOUT + off + bj * HALF + 4) = v1;
#pragma unroll
                    for (int j = 0; j < 4; ++j) q += v0[j] * v0[j] + v1[j] * v1[j];
                    *(u32x4*)(XG + off + bj * HALF) = pack8(v0 * gv[bj][0], v1 * gv[bj][1]); }
                q += __shfl_xor(q, 16); q += __shfl_xor(q, 32);
                if (fq == 0) SSQ[((size_t)u.pn * MTOK + r) * 4 + wc] = q;
                __builtin_amdgcn_sched_barrier(0); }
    }
};

struct EpiPe {
    static constexpr bool PERM = true, AFTER_DRAIN = false, HAS_MID = false;
    bf16_t* PE; float* SSQ;
    __device__ __forceinline__ void mid(Acc&, const Unit&, int, int, int, int) const {}
    __device__ __forceinline__ void operator()(const Acc& acc, const Unit& u, int wr, int wc, int fr, int fq) const {
        asm volatile("" : "+v"(fr), "+v"(fq));
        const int row0 = u.pm * BM + wr * 64 + fr, col0 = u.pn * BM + wc * 32 + 8 * fq;
#pragma unroll
        for (int ai = 0; ai < 2; ++ai)
#pragma unroll
            for (int m = 0; m < 4; ++m) { const size_t r = (size_t)(row0 + ai * HALF + m * 16), off = r * 4096 + col0; float q = 0.f;
#pragma unroll
                for (int bj = 0; bj < 2; ++bj) { const f32x4 v0 = acc[ai][bj][m][0], v1 = acc[ai][bj][m][1];
#pragma unroll
                    for (int j = 0; j < 4; ++j) q += v0[j] * v0[j] + v1[j] * v1[j];
                    *(u32x4*)(PE + off + bj * HALF) = pack8(v0, v1); }
                q += __shfl_xor(q, 16); q += __shfl_xor(q, 32);
                if (fq == 0) SSQ[((size_t)u.pn * MTOK + r) * 4 + wc] = q;
                __builtin_amdgcn_sched_barrier(0); }
    }
};

struct EpiGateUp {
    static constexpr bool PERM = true, AFTER_DRAIN = false, HAS_MID = false;
    const float* SSQ; bf16_t* ACT;
    __device__ __forceinline__ void mid(Acc&, const Unit&, int, int, int, int) const {}
    __device__ __forceinline__ void operator()(const Acc& acc, const Unit& u, int wr, int wc, int fr, int fq) const {
        asm volatile("" : "+v"(fr), "+v"(fq));
        const int row0 = u.pm * BM + wr * 64 + fr, col0 = u.pn * HALF + wc * 32 + 8 * fq;
#pragma unroll
        for (int ai = 0; ai < 2; ++ai)
#pragma unroll
            for (int m = 0; m < 4; ++m) { const int r = row0 + ai * HALF + m * 16;
                const float rs = 1.0f / sqrtf(row_total64(SSQ, r, fq) * (1.0f / 4096.0f) + EPS);
                f32x4 o0, o1;
#pragma unroll
                for (int j = 0; j < 4; ++j) { const float g0 = acc[ai][0][m][0][j] * rs, g1 = acc[ai][0][m][1][j] * rs;
                    o0[j] = g0 * fast_sigmoid(g0) * (acc[ai][1][m][0][j] * rs); o1[j] = g1 * fast_sigmoid(g1) * (acc[ai][1][m][1][j] * rs); }
                *(u32x4*)(ACT + (size_t)r * DFF + col0) = pack8(o0, o1);
                __builtin_amdgcn_sched_barrier(0); }
    }
};

struct EpiFinal {
    static constexpr bool PERM = true, AFTER_DRAIN = false, HAS_MID = false;
    const float *SSQ2, *SSQP, *pleg; const bf16_t* PE; float* OUT;
    __device__ __forceinline__ void mid(Acc&, const Unit&, int, int, int, int) const {}
    __device__ __forceinline__ void operator()(const Acc& acc, const Unit& u, int wr, int wc, int fr, int fq) const {
        asm volatile("" : "+v"(fr), "+v"(fq));
        const int row0 = u.pm * BM + wr * 64 + fr, col0 = u.pn * BM + wc * 32 + 8 * fq;
        f32x4 gv[2][2];
#pragma unroll
        for (int bj = 0; bj < 2; ++bj) { gv[bj][0] = *(const f32x4*)(pleg + col0 + bj * HALF); gv[bj][1] = *(const f32x4*)(pleg + col0 + bj * HALF + 4); }
#pragma unroll
        for (int ai = 0; ai < 2; ++ai)
#pragma unroll
            for (int m = 0; m < 4; ++m) { const int r = row0 + ai * HALF + m * 16; const size_t off = (size_t)r * 4096 + col0;
                const float r3 = 1.0f / sqrtf(row_total64(SSQ2, r, fq) * (1.0f / 4096.0f) + EPS), rp = 1.0f / sqrtf(row_total64(SSQP, r, fq) * (1.0f / 4096.0f) + EPS);
#pragma unroll
                for (int bj = 0; bj < 2; ++bj) { const u32x4 pw = *(const u32x4*)(PE + off + bj * HALF); f32x4 p0, p1; unpack8(pw, p0, p1);
                    f32x4 x0 = *(const f32x4*)(OUT + off + bj * HALF), x1 = *(const f32x4*)(OUT + off + bj * HALF + 4);
#pragma unroll
                    for (int j = 0; j < 4; ++j) { x0[j] += fast_sigmoid(acc[ai][bj][m][0][j] * r3) * (p0[j] * rp * gv[bj][0][j]); x1[j] += fast_sigmoid(acc[ai][bj][m][1][j] * r3) * (p1[j] * rp * gv[bj][1][j]); }
                    *(f32x4*)(OUT + off + bj * HALF) = x0; *(f32x4*)(OUT + off + bj * HALF + 4) = x1; }
                __builtin_amdgcn_sched_barrier(0); }
    }
};
template <class Epi, class Sched, bool ALIGN_EPI = false, bool SP2 = false>
__device__ __forceinline__ void gemm_phase(PG8_LAS unsigned char* lds, const Gemm g, const Sched& S, const Epi& E, const int tid) {
    const int wid = __builtin_amdgcn_readfirstlane(tid >> 6), lane = tid & 63, wr = wid >> 2, wc = wid & 3, fr = lane & 15, fq = lane >> 4;
    const int K = g.K, nt = K / BK;
    unsigned voffA[2], voffB[2];
#pragma unroll
    for (int i = 0; i < 2; ++i) { int R, C; stage_rc(tid * 16 + i * 8192, R, C); const int Rb = Epi::PERM ? ((R & ~31) + perm32(R & 31)) : R;
        voffA[i] = (unsigned)(R * K + C) * 2u; voffB[i] = (unsigned)(Rb * K + C) * 2u; }
    const size_t kstep = (size_t)(BK * 2);
    const size_t hstep = (size_t)HALF * K * 2;
    const size_t tstep = 2 * hstep;
    const unsigned ldsw = (unsigned)wid * 1024u;
    const int aoff = lds_byte(wr * 64 + fr, fq * 8), boff = lds_byte(wc * 32 + fr, fq * 8);
#define PG8_SA(b, h) (((b) * 2 + (h)) * HTB)
#define PG8_SB(b, h) ((4 + (b) * 2 + (h)) * HTB)
#define PG8_STAGE(bufoff, gbase, voff) do { _Pragma("unroll") for (int _i = 0; _i < 2; ++_i) \
        __builtin_amdgcn_global_load_lds((const unsigned*)((const char*)(gbase) + (voff)[_i]), (PG8_LAS unsigned*)(lds + (bufoff) + ldsw + _i * 8192), 16, 0, 0); } while (0)
#define PG8_LDA(dst, b, h) do { _Pragma("unroll") for (int m = 0; m < 4; ++m) _Pragma("unroll") for (int k = 0; k < 2; ++k) dst[m][k] = *(const PG8_LAS bf16x8*)(lds + PG8_SA(b, h) + aoff + m * 2048 + k * 1024); } while (0)
#define PG8_LDB(dst, b, h) do { _Pragma("unroll") for (int n = 0; n < 2; ++n) _Pragma("unroll") for (int k = 0; k < 2; ++k) dst[n][k] = *(const PG8_LAS bf16x8*)(lds + PG8_SB(b, h) + boff + n * 2048 + k * 1024); } while (0)
#define PG8_MMA(ai, bj, At, Bt) do { __builtin_amdgcn_s_setprio(1); _Pragma("unroll") for (int m = 0; m < 4; ++m) _Pragma("unroll") for (int n = 0; n < 2; ++n) _Pragma("unroll") for (int k = 0; k < 2; ++k) \
        acc[ai][bj][m][n] = __builtin_amdgcn_mfma_f32_16x16x32_bf16(Bt[n][k], At[m][k], acc[ai][bj][m][n], 0, 0, 0); __builtin_amdgcn_s_setprio(0); } while (0)
#define PG8_WAIT_V(n) asm volatile("s_waitcnt vmcnt(" #n ")" ::: "memory")
#define PG8_WAIT_L(n) asm volatile("s_waitcnt lgkmcnt(" #n ")" ::: "memory")
#define PG8_BAR __builtin_amdgcn_s_barrier()
#define PG8_SCHED __builtin_amdgcn_sched_barrier(0)
    Unit cur, nxt; int ui = 0;
    if (!S.next(0, cur)) return;
    f32x4 acc[2][2][4][2];
#pragma unroll
    for (int a = 0; a < 2; ++a)
#pragma unroll
        for (int b = 0; b < 2; ++b)
#pragma unroll
            for (int m = 0; m < 4; ++m)
#pragma unroll
                for (int n = 0; n < 2; ++n) acc[a][b][m][n] = (f32x4){0.f, 0.f, 0.f, 0.f};
    bf16x8 At[4][2], B0[2][2], B1[2][2];
    const char* cA = (const char*)g.A + (size_t)cur.pm * tstep; const char* cB = (const char*)g.Bt + (size_t)cur.pn * tstep;
    S.a_ready(cur);
    if constexpr (SP2) {
        PG8_STAGE(PG8_SB(0, 0), cB, voffB); PG8_STAGE(PG8_SB(0, 1), cB + hstep, voffB); PG8_STAGE(PG8_SA(0, 0), cA, voffA); PG8_STAGE(PG8_SA(0, 1), cA + hstep, voffA);
        if (wr == 1) PG8_BAR;
        PG8_WAIT_V(2); PG8_BAR;
        PG8_STAGE(PG8_SB(1, 0), cB + kstep, voffB); PG8_STAGE(PG8_SA(1, 0), cA + kstep, voffA); PG8_STAGE(PG8_SB(1, 1), cB + hstep + kstep, voffB);
        PG8_WAIT_V(6); PG8_BAR;
    } else {
        PG8_STAGE(PG8_SB(0, 0), cB, voffB); PG8_STAGE(PG8_SA(0, 0), cA, voffA); PG8_STAGE(PG8_SB(0, 1), cB + hstep, voffB); PG8_STAGE(PG8_SA(0, 1), cA + hstep, voffA);
        if (wr == 1) PG8_BAR;
        PG8_WAIT_V(4); PG8_BAR;
        PG8_STAGE(PG8_SB(1, 0), cB + kstep, voffB); PG8_STAGE(PG8_SA(1, 0), cA + kstep, voffA); PG8_STAGE(PG8_SB(1, 1), cB + hstep + kstep, voffB);
        PG8_WAIT_V(6); PG8_BAR;
    }
    for (;;) {
        const bool has_next = S.next(ui + 1, nxt);
        const char* nA = has_next ? (const char*)g.A + (size_t)nxt.pm * tstep : cA; const char* nB = has_next ? (const char*)g.Bt + (size_t)nxt.pn * tstep : cB;
        for (int t = 0; t < nt; t += 2) {
            const bool last = (t == nt - 2);
            const char* a1 = cA + (size_t)(t + 1) * kstep;
            const char* a2 = last ? nA : cA + (size_t)(t + 2) * kstep; const char* b2 = last ? nB : cB + (size_t)(t + 2) * kstep;
            const char* a3 = a2 + kstep; const char* b3 = b2 + kstep;
            if (last && has_next) S.a_ready(nxt);
            if constexpr (Epi::HAS_MID) { if (t == (nt >> 1)) E.mid(acc, cur, wr, wc, fr, fq); }
            if constexpr (SP2) {
            PG8_LDB(B0, 0, 0); PG8_LDB(B1, 0, 1); PG8_SCHED; PG8_LDA(At, 0, 0); PG8_STAGE(PG8_SA(1, 1), a1 + hstep, voffA);
            PG8_WAIT_V(8); PG8_WAIT_L(0); PG8_BAR; PG8_MMA(0, 0, At, B0); PG8_MMA(0, 1, At, B1); PG8_BAR; PG8_SCHED;
            PG8_LDA(At, 0, 1); PG8_STAGE(PG8_SB(0, 0), b2, voffB); PG8_STAGE(PG8_SB(0, 1), b2 + hstep, voffB); PG8_STAGE(PG8_SA(0, 0), a2, voffA);
            PG8_WAIT_V(8); PG8_WAIT_L(0); PG8_BAR; PG8_MMA(1, 0, At, B0); PG8_MMA(1, 1, At, B1); PG8_BAR; PG8_SCHED;
            PG8_LDB(B0, 1, 0); PG8_LDB(B1, 1, 1); PG8_SCHED; PG8_LDA(At, 1, 0); PG8_STAGE(PG8_SA(0, 1), a2 + hstep, voffA);
            PG8_WAIT_V(8); PG8_WAIT_L(0); PG8_BAR; PG8_MMA(0, 0, At, B0); PG8_MMA(0, 1, At, B1); PG8_BAR; PG8_SCHED;
            PG8_LDA(At, 1, 1); PG8_STAGE(PG8_SB(1, 0), b3, voffB); PG8_STAGE(PG8_SB(1, 1), b3 + hstep, voffB); PG8_STAGE(PG8_SA(1, 0), a3, voffA);
            PG8_WAIT_V(8); PG8_WAIT_L(0); PG8_BAR; PG8_MMA(1, 0, At, B0); PG8_MMA(1, 1, At, B1); PG8_BAR; PG8_SCHED;
            } else {
            PG8_LDB(B0, 0, 0); PG8_SCHED; PG8_LDA(At, 0, 0); PG8_STAGE(PG8_SA(1, 1), a1 + hstep, voffA);
            PG8_WAIT_L(8); PG8_BAR; PG8_WAIT_L(0); PG8_MMA(0, 0, At, B0); PG8_BAR; PG8_SCHED;
            PG8_LDB(B1, 0, 1); PG8_STAGE(PG8_SB(0, 0), b2, voffB);
            PG8_BAR; PG8_WAIT_L(0); PG8_MMA(0, 1, At, B1); PG8_BAR;
            PG8_LDA(At, 0, 1); PG8_STAGE(PG8_SA(0, 0), a2, voffA);
            PG8_BAR; PG8_WAIT_L(0); PG8_MMA(1, 0, At, B0); PG8_BAR; PG8_SCHED;
            PG8_STAGE(PG8_SB(0, 1), b2 + hstep, voffB);
            PG8_WAIT_V(6); PG8_BAR; PG8_MMA(1, 1, At, B1); PG8_BAR;
            PG8_LDB(B0, 1, 0); PG8_SCHED; PG8_LDA(At, 1, 0); PG8_STAGE(PG8_SA(0, 1), a2 + hstep, voffA);
            PG8_WAIT_L(8); PG8_BAR; PG8_WAIT_L(0); PG8_MMA(0, 0, At, B0); PG8_BAR; PG8_SCHED;
            PG8_LDB(B1, 1, 1); PG8_STAGE(PG8_SB(1, 0), b3, voffB);
            PG8_BAR; PG8_WAIT_L(0); PG8_MMA(0, 1, At, B1); PG8_BAR;
            PG8_LDA(At, 1, 1); PG8_STAGE(PG8_SA(1, 0), a3, voffA);
            PG8_BAR; PG8_WAIT_L(0); PG8_MMA(1, 0, At, B0); PG8_BAR; PG8_SCHED;
            PG8_STAGE(PG8_SB(1, 1), b3 + hstep, voffB);
            PG8_WAIT_V(6); PG8_BAR; PG8_MMA(1, 1, At, B1); PG8_BAR;
            }
        }
        if constexpr (ALIGN_EPI) { if (wr == 0) PG8_BAR; }
        if constexpr (!Epi::AFTER_DRAIN) { E(acc, cur, wr, wc, fr, fq); S.done(cur); }
        if (!has_next) break;
#pragma unroll
        for (int a = 0; a < 2; ++a)
#pragma unroll
            for (int b = 0; b < 2; ++b)
#pragma unroll
                for (int m = 0; m < 4; ++m)
#pragma unroll
                    for (int n = 0; n < 2; ++n) acc[a][b][m][n] = (f32x4){0.f, 0.f, 0.f, 0.f};
        cur = nxt; cA = nA; cB = nB; ++ui;
        if constexpr (ALIGN_EPI) { if (wr == 1) PG8_BAR; }
    }
    PG8_WAIT_V(0);
    if constexpr (!ALIGN_EPI) { if (wr == 0) PG8_BAR; }
    PG8_BAR;
    if constexpr (Epi::AFTER_DRAIN) { E.fused(acc, cur, wr, wc, fr, fq, lds, wid, lane); S.done(cur); }
#undef PG8_SA
#undef PG8_SB
#undef PG8_STAGE
#undef PG8_LDA
#undef PG8_LDB
#undef PG8_MMA
#undef PG8_WAIT_V
#undef PG8_WAIT_L
#undef PG8_BAR
#undef PG8_SCHED
}
}
#define XB_TMO      128
#define XB_XCNT(j)  (256  + 64 * (j))
#define XB_XSUB(j)  (1280 + 64 * (j))
#define XB_XGEN(j)  (2304 + 64 * (j))
#define XB_TOP      3328
#define XB_TOPGEN   3392
#define XCD_BAR_WORDS 3456
#define XB_SPIN_CAP (1u << 20)

__device__ __forceinline__ unsigned xb_ld(unsigned* p)              { return __hip_atomic_load(p, __ATOMIC_RELAXED, __HIP_MEMORY_SCOPE_AGENT); }
__device__ __forceinline__ unsigned xb_add(unsigned* p, unsigned v) { return __hip_atomic_fetch_add(p, v, __ATOMIC_RELAXED, __HIP_MEMORY_SCOPE_AGENT); }
__device__ __forceinline__ unsigned xb_xcc_id() { return (unsigned)__builtin_amdgcn_s_getreg((3 << 11) | 20) & 0xFu; }
#define XB_SPIN(cond, bar) do { unsigned _sp = 0; while (cond) { __builtin_amdgcn_s_sleep(1); \
    if ((++_sp & 255u) == 0u) { if (xb_ld(&(bar)[XB_TMO])) break; if (_sp > XB_SPIN_CAP) { atomicAdd(&(bar)[XB_TMO], 1u); break; } } } } while (0)

struct XcdBarrier {
    unsigned* bar; unsigned x;
    volatile LAS unsigned* st;
};

__device__ __forceinline__ XcdBarrier xcd_barrier_post(unsigned* bar, volatile LAS unsigned* st) {
    XcdBarrier b; b.bar = bar; b.x = xb_xcc_id(); b.st = st;
    if (threadIdx.x == 0) (void)xb_add(&bar[XB_XCNT(b.x)], 1u);
    return b;
}
__device__ __forceinline__ void xcd_barrier_complete(unsigned* bar, unsigned x, unsigned& nloc, unsigned& nx) {
    const unsigned G = gridDim.x * gridDim.y * gridDim.z;
    unsigned sum, cnt, mine, sp = 0u;
    for (;;) {
        sum = 0u; cnt = 0u; mine = 0u;
#pragma unroll
        for (unsigned j = 0; j < 16; ++j) { const unsigned c = xb_ld(&bar[XB_XCNT(j)]); sum += c; cnt += (c > 0u) ? 1u : 0u; mine = (j == x) ? c : mine; }
        if (sum == G) break;
        __builtin_amdgcn_s_sleep(1);
        if ((++sp & 255u) == 0u) { if (xb_ld(&bar[XB_TMO])) break; if (sp > XB_SPIN_CAP) { atomicAdd(&bar[XB_TMO], 1u); break; } }
    }
    nloc = mine > 0u ? mine : 1u; nx = cnt > 0u ? cnt : 1u;
}

__device__ __forceinline__ void xcd_barrier(const XcdBarrier& b) {
    asm volatile("s_waitcnt vmcnt(0)" ::: "memory");
    __syncthreads();
    if (threadIdx.x == 0) {
        unsigned* bar = b.bar;
        __builtin_amdgcn_s_waitcnt(0);
        unsigned nloc = b.st[0], nx = b.st[1];
        if (nloc == 0u) { xcd_barrier_complete(bar, b.x, nloc, nx); b.st[0] = nloc; b.st[1] = nx; }
        const unsigned old = xb_add(&bar[XB_XSUB(b.x)], 1u);
        const unsigned gen = old / nloc;
        if (old + 1u == (gen + 1u) * nloc) {
            __builtin_amdgcn_fence(__ATOMIC_RELEASE, "agent");
            asm volatile("s_waitcnt vmcnt(0)" ::: "memory");
            const unsigned og = xb_add(&bar[XB_TOP], 1u);
            const unsigned tg = og / nx;
            if (og + 1u == (tg + 1u) * nx) xb_add(&bar[XB_TOPGEN], 1u);
            else XB_SPIN(xb_ld(&bar[XB_TOPGEN]) == tg, bar);
            __builtin_amdgcn_fence(__ATOMIC_ACQUIRE, "agent");
            xb_add(&bar[XB_XGEN(b.x)], 1u);
            asm volatile("s_waitcnt vmcnt(0)" ::: "memory");
        } else {
            XB_SPIN(xb_ld(&bar[XB_XGEN(b.x)]) == gen, bar);
            __builtin_amdgcn_fence(__ATOMIC_ACQUIRE, "agent");
            asm volatile("s_waitcnt vmcnt(0)" ::: "memory");
        }
    }
    __syncthreads();
}

template <int MAP> __device__ __forceinline__ int rowmap(int n) {
    if (MAP == 1) return n < 6560 ? n : n + 96;
    if (MAP == 2) return (n >> 7) * 256 + (n & 127);
    if (MAP == 3) return (n >> 7) * 256 + 128 + (n & 127);
    return n;
}
template <int MAP> __device__ __forceinline__ void p0_item(const float* W, int N, bf16* dst, int ldd, int koff, LAS float* scr, int item, int lane) {
    const int nblk = N / 32, kb = item / nblk, nb = item % nblk, k0 = 64 * kb, n0 = 32 * nb;
#pragma unroll 8
    for (int i = 0; i < 32; ++i) { const int kk = 2 * i + (lane >> 5); scr[kk * 33 + (lane & 31)] = W[(size_t)(k0 + kk) * N + n0 + (lane & 31)]; }
    LDS_WAIT(); asm volatile("" ::: "memory");
    const int c = lane & 7, r0 = rowmap<MAP>(n0);
#pragma unroll
    for (int j = 0; j < 4; ++j) { const int n = (lane >> 3) + 8 * j; const LAS float* s = scr + (8 * c) * 33 + n;
        v4u o; o.x = cvt_pk_bf16(s[0 * 33], s[1 * 33]); o.y = cvt_pk_bf16(s[2 * 33], s[3 * 33]); o.z = cvt_pk_bf16(s[4 * 33], s[5 * 33]); o.w = cvt_pk_bf16(s[6 * 33], s[7 * 33]);
        *(GAS v4u*)(dst + (size_t)(r0 + n) * ldd + koff + k0 + 8 * c) = o; }
    LDS_WAIT(); asm volatile("" ::: "memory");
}
__device__ __forceinline__ void rms_row_to_bf16(const float* xrow, const float* gain, bf16* orow, int lane) {
    const GAS f32x4* xr = (const GAS f32x4*)xrow + lane;
    f32x4 v[16]; float s = 0.f;
#pragma unroll
    for (int j = 0; j < 16; ++j) { v[j] = xr[64 * j]; s += (v[j].x * v[j].x + v[j].y * v[j].y) + (v[j].z * v[j].z + v[j].w * v[j].w); }
    const float r = 1.0f / sqrtf(wave_sum(s) * (1.0f / DM) + EPS);
    GAS v2u* o8 = (GAS v2u*)orow + lane;
#pragma unroll
    for (int j = 0; j < 16; ++j) { const f32x4 gv = ((const GAS f32x4*)gain)[lane + 64 * j]; v2u w; w.x = cvt_pk_bf16(v[j].x * r * gv.x, v[j].y * r * gv.y); w.y = cvt_pk_bf16(v[j].z * r * gv.z, v[j].w * r * gv.w); o8[64 * j] = w; }
}

__device__ __forceinline__ unsigned ordkey(float v) { const unsigned u = __float_as_uint(v); return u ^ ((u >> 31) ? 0xffffffffu : 0x80000000u); }
__device__ __forceinline__ int mbcnt64(unsigned long long m) { return (int)__builtin_amdgcn_mbcnt_hi((unsigned)(m >> 32), __builtin_amdgcn_mbcnt_lo((unsigned)m, 0u)); }

__device__ __forceinline__ int wave_count(int cl) { int c = 0;
#pragma unroll
    for (int b = 0; b < 7; ++b) c += __popcll(__ballot((cl >> b) & 1)) << b;
    return c; }
__device__ __forceinline__ void topk_row(const float* sc, int N, unsigned short* out, int lane) {
    asm volatile("" : "+v"(lane));
    if (N <= TOPK) {
#pragma unroll
        for (int i = 0; i < 4; ++i) out[lane + 64 * i] = (unsigned short)(lane + 64 * i);
        return;
    }
    unsigned key[64];
#pragma unroll
    for (int i = 0; i < 64; ++i) { key[i] = 0u; if (i * 64 < N) { const int e = lane + 64 * i; const float v = sc[e < N ? e : 0]; key[i] = e < N ? ordkey(v) : 0u; } }
    unsigned T = 0u;
    for (int bit = 31; bit >= 0; --bit) {
        const unsigned cand = T | (1u << bit); int cl = 0;
#pragma unroll
        for (int i = 0; i < 64; ++i) if (i * 64 < N) cl += (key[i] >= cand) ? 1 : 0;
        const int c = wave_count(cl);
        if (c >= TOPK) { T = cand; if (c == TOPK) break; }
    }
    int cgl = 0;
#pragma unroll
    for (int i = 0; i < 64; ++i) if (i * 64 < N) cgl += (key[i] > T) ? 1 : 0;
    const int cgt = wave_count(cgl);
    const int need_eq = TOPK - cgt; int base = 0, eqb = 0;
#pragma unroll
    for (int i = 0; i < 64; ++i) if (i * 64 < N) {
        const bool gt = key[i] > T, eq = key[i] == T;
        const unsigned long long meq = __ballot(eq);
        const bool sel = gt || (eq && (eqb + mbcnt64(meq)) < need_eq);
        const unsigned long long ms = __ballot(sel);
        if (sel) out[base + mbcnt64(ms)] = (unsigned short)(lane + 64 * i);
        base += __popcll(ms); eqb += __popcll(meq);
    }
}

__device__ __forceinline__ void indexer_unit(LAS unsigned char* lds, int tid, int wave, int lane, int b, int qg,
                                             const bf16* QIDX, const bf16* KIDX, const float* WIDX, float* SC, unsigned short* IDX) {
    LAS unsigned char* KT = lds;
    LAS float* WT = (LAS float*)(lds + 65536);
    asm volatile("" : "+v"(lane), "+v"(tid));
    const int q0 = qg * 32, nkeys = q0 + 32, r = lane & 31, hh = lane >> 5;
    const size_t rowb = (size_t)b * SEQ;
    __syncthreads();
    if (tid < 256) *(LAS f32x4*)(WT + tid * 4) = *(const GAS f32x4*)(WIDX + (rowb + q0) * 32 + tid * 4);
    bf16x8 A[4][8];
#pragma unroll
    for (int qi = 0; qi < 4; ++qi)
#pragma unroll
        for (int kk = 0; kk < 8; ++kk) A[qi][kk] = *(const GAS bf16x8*)(QIDX + (rowb + q0 + 4 * wave + qi) * 4096 + r * 128 + kk * 16 + hh * 8);
    const int nch = (nkeys + 127) >> 7;
    const int srow = 16 * wave + (lane >> 4), slot = lane & 15;
#define IDX_STAGE(ch_, buf_) do { _Pragma("unroll") for (int i_ = 0; i_ < 4; ++i_) { const int krow_ = srow + 4 * i_; \
        __builtin_amdgcn_global_load_lds((const GAS unsigned*)(KIDX + (rowb + (ch_) * 128 + krow_) * 128 + ((slot ^ (krow_ & 15)) << 3)), (LAS unsigned*)((buf_) + (16 * wave + 4 * i_) * 256), 16, 0, 0); } } while (0)
    IDX_STAGE(0, KT);
    for (int ch = 0; ch < nch; ++ch) {
        LAS unsigned char* buf = KT + (ch & 1) * 32768;
        VM_WAIT();
        __syncthreads();
        if (ch + 1 < nch) IDX_STAGE(ch + 1, KT + ((ch + 1) & 1) * 32768);
        const int rem = (nkeys - ch * 128) >> 5, ntile = rem < 4 ? rem : 4;
        for (int tile = 0; tile < ntile; ++tile) {
            bf16x8 Bf[8];
#pragma unroll
            for (int kk = 0; kk < 8; ++kk) Bf[kk] = *(const LAS bf16x8*)(buf + (tile * 32 + r) * 256 + (((2 * kk + hh) ^ (r & 15)) << 4));
            const int key = ch * 128 + tile * 32 + r;
#pragma unroll
            for (int qi = 0; qi < 4; ++qi) {
                f32x16 acc;
#pragma unroll
                for (int e = 0; e < 16; ++e) acc[e] = 0.f;
#pragma unroll
                for (int kk = 0; kk < 8; ++kk) acc = __builtin_amdgcn_mfma_f32_32x32x16_bf16(A[qi][kk], Bf[kk], acc, 0, 0, 0);
                float sc = 0.f;
#pragma unroll
                for (int j = 0; j < 4; ++j) { const f32x4 w4 = *(const LAS f32x4*)(WT + (4 * wave + qi) * 32 + 8 * j + 4 * hh);
#pragma unroll
                    for (int e = 0; e < 4; ++e) sc += fmaxf(acc[4 * j + e], 0.f) * w4[e]; }
                sc += __shfl_xor(sc, 32);
                const int qpos = q0 + 4 * wave + qi;
                if (hh == 0 && key <= qpos) SC[(rowb + qpos) * 4096 + key] = sc;
                __builtin_amdgcn_sched_barrier(0);
            }
        }
    }
#undef IDX_STAGE
    VM_WAIT();
#pragma unroll 1
    for (int qi = 0; qi < 4; ++qi) { const int qpos = q0 + 4 * wave + qi; topk_row(SC + (rowb + qpos) * 4096, qpos + 1, IDX + (rowb + qpos) * 256, lane); }
}

__device__ __forceinline__ void sgu_unit(LAS unsigned char* lds, int tid, int wave, int lane, int cidx, int grp,
                                         const bf16* UV, const float* LNP, const bf16* SGUW, const float* lng, const float* lnb, const float* sgub, bf16* YAB) {
    constexpr int VP = 544, WP = 272;
    LAS unsigned char* VN = lds;
    LAS unsigned char* WL = lds + 128 * VP;
    LAS float* ST = (LAS float*)(lds + 128 * VP + 128 * WP);
    const int t0 = cidx * 128;
    __syncthreads();
    if (tid < 128) { float s = 0.f, q = 0.f;
#pragma unroll
        for (int i = 0; i < 8; ++i) { const GAS f32x4* p = (const GAS f32x4*)(LNP + ((size_t)i * MTOK + t0 + tid) * 8); const f32x4 a = p[0], b = p[1]; s += (a[0] + a[2]) + (b[0] + b[2]); q += (a[1] + a[3]) + (b[1] + b[3]); }
        const float mean = s * (1.0f / GWID), var = q * (1.0f / GWID) - mean * mean;
        ST[2 * tid] = mean; ST[2 * tid + 1] = 1.0f / sqrtf(var + EPS); }
#pragma unroll
    for (int i = 0; i < 4; ++i) { const int c = (tid & 3) * 4 + i; *(LAS v4u*)(WL + (tid >> 2) * WP + c * 16) = *(const GAS v4u*)(SGUW + ((size_t)grp * 128 + (tid >> 2)) * 128 + c * 8); }
    __syncthreads();
#pragma unroll
    for (int i = 0; i < 8; ++i) { const int id = tid + 512 * i, s = id >> 5, dc = id & 31;
        const v4u w = *(const GAS v4u*)(UV + (size_t)(t0 + s) * 4096 + GWID + grp * GDIM + dc * 8); f32x4 v0, v1; unpack8(w, v0, v1);
        const float mean = ST[2 * s], rstd = ST[2 * s + 1];
        const f32x4 g0 = *(const GAS f32x4*)(lng + grp * GDIM + dc * 8), g1 = *(const GAS f32x4*)(lng + grp * GDIM + dc * 8 + 4);
        const f32x4 b0 = *(const GAS f32x4*)(lnb + grp * GDIM + dc * 8), b1 = *(const GAS f32x4*)(lnb + grp * GDIM + dc * 8 + 4);
        v0 = (v0 - mean) * rstd * g0 + b0; v1 = (v1 - mean) * rstd * g1 + b1;
        *(LAS v4u*)(VN + s * VP + dc * 16) = pack8(v0, v1); }
    __syncthreads();
    const int g = lane >> 4, hl = lane & 15, q = hl >> 2, p = lane & 3;
    f32x4 acc[2][8];
#pragma unroll
    for (int a = 0; a < 2; ++a)
#pragma unroll
        for (int t = 0; t < 8; ++t) acc[a][t] = (f32x4){0.f, 0.f, 0.f, 0.f};
#pragma unroll
    for (int ks = 0; ks < 4; ++ks) {
        bf16x8 vf[2];
#pragma unroll
        for (int ds = 0; ds < 2; ++ds) { const int d0 = (2 * wave + ds) * 16;
            const s16x4 a1 = __builtin_amdgcn_ds_read_tr16_b64_v4i16((LAS s16x4*)(VN + (32 * ks + 4 * g + q) * VP + (d0 + 4 * p) * 2));
            const s16x4 a2 = __builtin_amdgcn_ds_read_tr16_b64_v4i16((LAS s16x4*)(VN + (32 * ks + 16 + 4 * g + q) * VP + (d0 + 4 * p) * 2));
            vf[ds] = (bf16x8){a1[0], a1[1], a1[2], a1[3], a2[0], a2[1], a2[2], a2[3]}; }
#pragma unroll
        for (int tt = 0; tt < 8; ++tt) if (tt >= 2 * ks) {
            const int t = 16 * tt + hl;
            const s16x4 w1 = *(const LAS s16x4*)(WL + t * WP + (32 * ks + 4 * g) * 2), w2 = *(const LAS s16x4*)(WL + t * WP + (32 * ks + 16 + 4 * g) * 2);
            const bf16x8 wf = (bf16x8){w1[0], w1[1], w1[2], w1[3], w2[0], w2[1], w2[2], w2[3]};
#pragma unroll
            for (int ds = 0; ds < 2; ++ds) acc[ds][tt] = __builtin_amdgcn_mfma_f32_16x16x32_bf16(vf[ds], wf, acc[ds][tt], 0, 0, 0);
        }
    }
#pragma unroll
    for (int tt = 0; tt < 8; ++tt) { const int t = 16 * tt + hl; const float bs = sgub[grp * 128 + t]; const size_t rowo = (size_t)(t0 + t) * 4096;
#pragma unroll
        for (int ds = 0; ds < 2; ++ds) { const int d = grp * GDIM + (2 * wave + ds) * 16 + 4 * g;
            const v2u uw = *(const GAS v2u*)(UV + rowo + d);
            v2u o; o.x = cvt_pk_bf16(bf_lo(uw.x) * (acc[ds][tt][0] + bs), bf_hi(uw.x) * (acc[ds][tt][1] + bs)); o.y = cvt_pk_bf16(bf_lo(uw.y) * (acc[ds][tt][2] + bs), bf_hi(uw.y) * (acc[ds][tt][3] + bs));
            *(GAS v2u*)(YAB + rowo + GWID + d) = o; } }
}

constexpr int ATT_VB = 32 * 288, ATT_WAVE = ATT_VB + 512, ATT_BL = 8 * ATT_WAVE;
__device__ __forceinline__ void attn_query(LAS unsigned char* wl, const LAS float* BL, int lane, int b, int qpos,
                                           const bf16* Q, const bf16* KN, const bf16* V, const unsigned short* IDX, const float* qgain, bf16* YAB) {
    const int g = lane >> 4, hl = lane & 15, q4 = hl >> 2, p4 = lane & 3;
    const size_t rowb = (size_t)b * SEQ, row = rowb + qpos;
    const int cnt = qpos + 1 < TOPK ? qpos + 1 : TOPK;
    LAS unsigned short* IL = (LAS unsigned short*)(wl + ATT_VB);
    *(LAS v2u*)(IL + 4 * lane) = *(const GAS v2u*)(IDX + row * 256 + 4 * lane);
    bf16x8 qf[4];
    { v4u w[4]; float ss = 0.f;
#pragma unroll
      for (int kk = 0; kk < 4; ++kk) { w[kk] = *(const GAS v4u*)(Q + row * 2048 + hl * 128 + kk * 32 + g * 8); f32x4 a, c; unpack8(w[kk], a, c);
          ss += (a[0] * a[0] + a[1] * a[1]) + (a[2] * a[2] + a[3] * a[3]) + (c[0] * c[0] + c[1] * c[1]) + (c[2] * c[2] + c[3] * c[3]); }
      ss += __shfl_xor(ss, 16); ss += __shfl_xor(ss, 32);
      const float rinv = (1.0f / sqrtf(ss * (1.0f / HDA) + EPS)) * 0.08838834764831845f;
#pragma unroll
      for (int kk = 0; kk < 4; ++kk) { f32x4 a, c; unpack8(w[kk], a, c); const f32x4 g0 = *(const GAS f32x4*)(qgain + kk * 32 + g * 8), g1 = *(const GAS f32x4*)(qgain + kk * 32 + g * 8 + 4);
          const v4u o = pack8(a * rinv * g0, c * rinv * g1); qf[kk] = __builtin_bit_cast(bf16x8, o); } }
    f32x4 s[16];
#pragma unroll
    for (int t = 0; t < 16; ++t) { const int ki = IL[16 * t + hl] & (SEQ - 1); const bf16* kp = KN + (rowb + ki) * 128 + g * 8;
        bf16x8 kf[4];
#pragma unroll
        for (int kk = 0; kk < 4; ++kk) kf[kk] = *(const GAS bf16x8*)(kp + kk * 32);
        s[t] = (f32x4){0.f, 0.f, 0.f, 0.f};
#pragma unroll
        for (int kk = 0; kk < 4; ++kk) s[t] = __builtin_amdgcn_mfma_f32_16x16x32_bf16(kf[kk], qf[kk], s[t], 0, 0, 0); }
    float mx = -__builtin_inff();
#pragma unroll
    for (int t = 0; t < 16; ++t) { const v2u id = *(const LAS v2u*)(IL + 16 * t + 4 * g); const int kx[4] = {(int)(id.x & 0xffffu), (int)(id.x >> 16), (int)(id.y & 0xffffu), (int)(id.y >> 16)};
#pragma unroll
        for (int i = 0; i < 4; ++i) { int n = qpos - kx[i]; n = n < 0 ? 0 : (n > 128 ? 128 : n);
            const float v = (16 * t + 4 * g + i) < cnt ? s[t][i] + BL[n * 16 + hl] : -__builtin_inff(); s[t][i] = v; mx = fmaxf(mx, v); } }
    mx = fmaxf(mx, __shfl_xor(mx, 16)); mx = fmaxf(mx, __shfl_xor(mx, 32));
    float sum = 0.f;
#pragma unroll
    for (int t = 0; t < 16; ++t)
#pragma unroll
        for (int i = 0; i < 4; ++i) { const float e = __builtin_amdgcn_exp2f((s[t][i] - mx) * LOG2E); s[t][i] = e; sum += e; }
    sum += __shfl_xor(sum, 16); sum += __shfl_xor(sum, 32);
    const float inv = 1.0f / sum;
    bf16x8 pf[8];
#pragma unroll
    for (int T = 0; T < 8; ++T) { const v4u o = pack8(s[2 * T] * inv, s[2 * T + 1] * inv); pf[T] = __builtin_bit_cast(bf16x8, o); }
    f32x4 o[8];
#pragma unroll
    for (int dt = 0; dt < 8; ++dt) o[dt] = (f32x4){0.f, 0.f, 0.f, 0.f};
#pragma unroll
    for (int T = 0; T < 8; ++T) {
#pragma unroll
        for (int ins = 0; ins < 8; ++ins) { const int slot = 4 * ins + g; const int vi = IL[32 * T + slot] & (SEQ - 1);
            *(LAS v4u*)(wl + slot * 288 + hl * 16) = *(const GAS v4u*)(V + (rowb + vi) * 128 + hl * 8); }
#pragma unroll
        for (int dt = 0; dt < 8; ++dt) {
            const s16x4 a1 = __builtin_amdgcn_ds_read_tr16_b64_v4i16((LAS s16x4*)(wl + (4 * g + q4) * 288 + (16 * dt + 4 * p4) * 2));
            const s16x4 a2 = __builtin_amdgcn_ds_read_tr16_b64_v4i16((LAS s16x4*)(wl + (16 + 4 * g + q4) * 288 + (16 * dt + 4 * p4) * 2));
            const bf16x8 vf = (bf16x8){a1[0], a1[1], a1[2], a1[3], a2[0], a2[1], a2[2], a2[3]};
            o[dt] = __builtin_amdgcn_mfma_f32_16x16x32_bf16(vf, pf[T], o[dt], 0, 0, 0);
        }
    }
#pragma unroll
    for (int dt = 0; dt < 8; ++dt) { v2u w; w.x = cvt_pk_bf16(o[dt][0], o[dt][1]); w.y = cvt_pk_bf16(o[dt][2], o[dt][3]); *(GAS v2u*)(YAB + row * 4096 + hl * 128 + 16 * dt + 4 * g) = w; }
}

constexpr int NWAVES = 8;
#ifndef MK_N_LAUNCHES
#define MK_N_LAUNCHES 1
#endif
constexpr int N_PHASES = 9;
constexpr int N_LAUNCHES = MK_N_LAUNCHES;
constexpr size_t WS_PB = WS_END;
constexpr size_t WS_NEED = WS_END + 8 * MiB;

__device__ __forceinline__ int lane_now() { int l; asm volatile("v_mbcnt_lo_u32_b32 %0, -1, 0\n\tv_mbcnt_hi_u32_b32 %0, -1, %0" : "=v"(l)); return l; }
struct Args { const float* in[22]; float* out; unsigned char* ws; int ph_lo, ph_hi, li, pad; };
enum { I_X = 0, I_P, I_WIN, I_QNG, I_KNG, I_RELB, I_LNG, I_LNB, I_SGUW, I_SGUB, I_WA, I_WB, I_WOUT, I_NMIX, I_NFFN, I_WG, I_WU, I_WD, I_WPLE, I_PLENG, I_WPG, I_NPLE };

__global__ void __launch_bounds__(NWAVES * 64, 2) fwd_kernel(Args args) {
    extern __shared__ __attribute__((aligned(16))) unsigned char lds_raw[];
    LAS unsigned char* lds = (LAS unsigned char*)lds_raw;
    volatile LAS unsigned* MISC = (volatile LAS unsigned*)(lds + MISC_OFF);
    const int wave = __builtin_amdgcn_readfirstlane(threadIdx.x >> 6);
#define PHASE_IDS() const int lane = lane_now(), tid = wave * 64 + lane
    const int G = gridDim.x, cu = blockIdx.x;
    const int gw = cu * NWAVES + wave, NGW = G * NWAVES;
    unsigned char* ws = args.ws;
    gu32* ctl = (gu32*)(ws + WS_CTL);
    for (int u = threadIdx.x; u < (LDS_BYTES - LDSCTL_OFF) / 4; u += NWAVES * 64) ((LAS unsigned*)(lds + LDSCTL_OFF))[u] = 0u;
    __syncthreads();
    XcdBarrier bar; bar.bar = (unsigned*)(ctl + CW_BAR) + args.li * XCD_BAR_WORDS; bar.x = 0; bar.st = nullptr;
    if (N_LAUNCHES == 1) bar = xcd_barrier_post((unsigned*)(ctl + CW_BAR), MISC + 8);
#define GRID_BAR() do { if (N_LAUNCHES == 1) xcd_barrier(bar); } while (0)
    const int lo = args.ph_lo, hi = args.ph_hi;
#ifndef PH_MASK
#define PH_MASK 0x1ff
#endif
#define IN(k) ((((PH_MASK) >> (k)) & 1) && lo <= (k) && (k) < hi)
#define BOTH(k) (IN(k) && IN((k) + 1))

    bf16* const H = (bf16*)(ws + WS_H); bf16* const WIN = (bf16*)(ws + WS_WIN); bf16* const QIDX = (bf16*)(ws + WS_QIDX); bf16* const Qb = (bf16*)(ws + WS_Q);
    bf16* const UV = (bf16*)(ws + WS_UV); bf16* const SGA = (bf16*)(ws + WS_SGA); bf16* const SGB = (bf16*)(ws + WS_SGB);
    bf16* const WAB = (bf16*)(ws + WS_WAB); bf16* const WOUT = (bf16*)(ws + WS_WOUT); bf16* const WGU = (bf16*)(ws + WS_WGU); bf16* const WD = (bf16*)(ws + WS_WD);
    bf16* const WPLE = (bf16*)(ws + WS_WPLE); bf16* const WPG = (bf16*)(ws + WS_WPG); bf16* const PB = (bf16*)(ws + WS_PB);
    unsigned short* const IDX = (unsigned short*)(ws + WS_IDX); float* const LNP = (float*)(ws + WS_LNP);
    float* const SSQ1 = (float*)(ws + WS_SSQ1); float* const SSQ2 = (float*)(ws + WS_SSQ2); float* const SSQP = (float*)(ws + WS_SSQP);
    float* const WIDX = (float*)(ws + WS_WIDX); bf16* const KIDX = (bf16*)(ws + WS_KIDX); bf16* const KN = (bf16*)(ws + WS_KN); bf16* const Vb = (bf16*)(ws + WS_V);
    float* const KRAW = (float*)(ws + WS_KRAW); bf16* const SGUW = (bf16*)(ws + WS_SGUW);
    float* const SC = (float*)(ws + WS_SC); bf16* const MERGED = (bf16*)(ws + WS_MERGED); bf16* const ACT = (bf16*)(ws + WS_ACT); bf16* const YAB = (bf16*)(ws + WS_YAB);
    bf16* const X1G = (bf16*)(ws + WS_X1G); bf16* const X2G = (bf16*)(ws + WS_X2G); bf16* const PE = (bf16*)(ws + WS_PE);

    if (IN(0)) {
        PHASE_IDS();
        LAS float* scr = (LAS float*)(lds + RING_OFF + wave * 16384);
        constexpr int I_IN = 64 * (INCOLS / 32), I_A = 32 * 128, I_SQ = 64 * 128, I_G = 64 * (DFF / 32), I_D = (DFF / 64) * 128, I_PL = 4 * 128;
        constexpr int NITEMS = I_IN + 2 * I_A + I_SQ + 2 * I_G + I_D + I_PL + I_SQ;
        for (int it = gw; it < NITEMS; it += NGW) {
            int r = it;
            if (r < I_IN) { p0_item<1>(args.in[I_WIN], INCOLS, WIN, DM, 0, scr, r, lane); continue; } r -= I_IN;
            if (r < I_A) { p0_item<0>(args.in[I_WA], DM, WAB, DM, 0, scr, r, lane); continue; } r -= I_A;
            if (r < I_A) { p0_item<0>(args.in[I_WB], DM, WAB, DM, 2048, scr, r, lane); continue; } r -= I_A;
            if (r < I_SQ) { p0_item<0>(args.in[I_WOUT], DM, WOUT, DM, 0, scr, r, lane); continue; } r -= I_SQ;
            if (r < I_G) { p0_item<2>(args.in[I_WG], DFF, WGU, DM, 0, scr, r, lane); continue; } r -= I_G;
            if (r < I_G) { p0_item<3>(args.in[I_WU], DFF, WGU, DM, 0, scr, r, lane); continue; } r -= I_G;
            if (r < I_D) { p0_item<0>(args.in[I_WD], DM, WD, DFF, 0, scr, r, lane); continue; } r -= I_D;
            if (r < I_PL) { p0_item<0>(args.in[I_WPLE], DM, WPLE, DPLE, 0, scr, r, lane); continue; } r -= I_PL;
            p0_item<0>(args.in[I_WPG], DM, WPG, DM, 0, scr, r, lane);
        }
        for (int m = gw; m < MTOK; m += NGW) rms_row_to_bf16(args.in[I_X] + (size_t)m * DM, args.in[I_NMIX], H + (size_t)m * DM, lane);
        { const float* P = args.in[I_P]; const int gt = cu * 512 + tid, NT = G * 512;
          for (int i = gt; i < MTOK * DPLE / 4; i += NT) { const f32x4 v = *(const GAS f32x4*)(P + (size_t)i * 4); v2u w; w.x = cvt_pk_bf16(v.x, v.y); w.y = cvt_pk_bf16(v.z, v.w); *(GAS v2u*)(PB + (size_t)i * 4) = w; }
          const float* SW = args.in[I_SGUW];
          for (int i = gt; i < NGRP * CHK * CHK / 2; i += NT) { const int e = 2 * i, t = (e >> 7) & 127, s = e & 127; const f32x2 v = *(const GAS f32x2*)(SW + e);
              *(GAS unsigned*)(SGUW + e) = cvt_pk_bf16(s <= t ? v.x : 0.f, (s + 1) <= t ? v.y : 0.f); } }
        if (BOTH(0)) GRID_BAR();
    }

    if (IN(1)) {
        PHASE_IDS();
        pg8::Gemm g{H, WIN, MTOK, INPAD, DM}; pg8::StaticOrder S; S.init(MTOK, INPAD, G, cu);
        pg8::EpiInProj E{Qb, Vb, QIDX, KIDX, UV, SGA, SGB, KRAW, WIDX, LNP};
        pg8::gemm_phase<pg8::EpiInProj, pg8::StaticOrder, true, true>(lds + RING_OFF, g, S, E, tid);
        if (BOTH(1)) GRID_BAR();
    }

    if (IN(2)) {
        PHASE_IDS();
        { const float* kg = args.in[I_KNG];
          for (int rp = gw; rp < MTOK / 2; rp += NGW) { const int row = 2 * rp + (lane >> 5), c = (lane & 31) * 4;
              const f32x4 v = *(const GAS f32x4*)(KRAW + (size_t)row * 128 + c); float ss = (v.x * v.x + v.y * v.y) + (v.z * v.z + v.w * v.w);
#pragma unroll
              for (int o = 1; o < 32; o <<= 1) ss += __shfl_xor(ss, o);
              const float r = 1.0f / sqrtf(ss * (1.0f / HDA) + EPS); const f32x4 gv = *(const GAS f32x4*)(kg + c);
              v2u w; w.x = cvt_pk_bf16(v.x * r * gv.x, v.y * r * gv.y); w.y = cvt_pk_bf16(v.z * r * gv.z, v.w * r * gv.w); *(GAS v2u*)(KN + (size_t)row * 128 + c) = w; } }
        constexpr int NU = NB * (SEQ / 32);
        for (int j = cu; j < NU; j += G) { const int rnd = j / G, pos = j % G; int u;
            if ((rnd & 1) == 0) u = j; else { const int hiu = (rnd + 1) * G < NU ? (rnd + 1) * G : NU; u = hiu - 1 - pos; if (u < rnd * G) continue; }
            indexer_unit(lds + RING_OFF, tid, wave, lane, u % NB, u / NB, QIDX, KIDX, WIDX, SC, IDX); }
        if (BOTH(2)) GRID_BAR();
    }

    if (IN(3)) {
        PHASE_IDS();
        for (int u = cu; u < (MTOK / CHK) * NGRP; u += G) sgu_unit(lds + RING_OFF, tid, wave, lane, u >> 3, u & 7, UV, LNP, SGUW, args.in[I_LNG], args.in[I_LNB], args.in[I_SGUB], YAB);
        __syncthreads();
        LAS float* BL = (LAS float*)(lds + RING_OFF + ATT_BL);
        { const float* rb = args.in[I_RELB];
          for (int i = tid; i < 129 * 16; i += NWAVES * 64) { const int n = i >> 4, h = i & 15; int bk;
              if (n < 16) bk = n; else { bk = 16 + (int)(logf((float)n * (1.0f / 16.0f)) / 2.0794415416798357f * 16.0f); bk = bk > 31 ? 31 : bk; }
              BL[i] = rb[bk * 16 + h]; } }
        __syncthreads();
        for (int qi = gw; qi < MTOK; qi += NGW) attn_query(lds + RING_OFF + wave * ATT_WAVE, BL, lane, qi / SEQ, qi % SEQ, Qb, KN, Vb, IDX, args.in[I_QNG], YAB);
        if (BOTH(3)) GRID_BAR();
    }

    if (IN(4)) {
        PHASE_IDS();
        pg8::Gemm g{YAB, WAB, MTOK, DM, DM}; pg8::StaticOrder S; S.init(MTOK, DM, G, cu);
        pg8::EpiMerge E{SGA, SGB, MERGED};
        pg8::gemm_phase<pg8::EpiMerge, pg8::StaticOrder, true, true>(lds + RING_OFF, g, S, E, tid);
        if (BOTH(4)) GRID_BAR();
    }

    if (IN(5)) {
        PHASE_IDS();
        { pg8::Gemm g{MERGED, WOUT, MTOK, DM, DM}; pg8::StaticOrder S; S.init(MTOK, DM, G, cu);
          pg8::EpiResid E{args.in[I_X], args.out, X1G, args.in[I_NFFN], SSQ1};
          pg8::gemm_phase<pg8::EpiResid, pg8::StaticOrder, true, true>(lds + RING_OFF, g, S, E, tid); }
        { pg8::Gemm g{PB, WPLE, MTOK, DM, DPLE}; pg8::StaticOrder S; S.init(MTOK, DM, G, cu);
          pg8::EpiPe E{PE, SSQP};
          pg8::gemm_phase<pg8::EpiPe, pg8::StaticOrder, true, true>(lds + RING_OFF, g, S, E, tid); }
        if (BOTH(5)) GRID_BAR();
    }

    if (IN(6)) {
        PHASE_IDS();
        pg8::Gemm g{X1G, WGU, MTOK, 2 * DFF, DM}; pg8::StaticOrder S; S.init(MTOK, 2 * DFF, G, cu);
        pg8::EpiGateUp E{SSQ1, ACT};
        pg8::gemm_phase<pg8::EpiGateUp, pg8::StaticOrder, true, true>(lds + RING_OFF, g, S, E, tid);
        if (BOTH(6)) GRID_BAR();
    }

    if (IN(7)) {
        PHASE_IDS();
        pg8::Gemm g{ACT, WD, MTOK, DM, DFF}; pg8::StaticOrder S; S.init(MTOK, DM, G, cu);
        pg8::EpiResid E{args.out, args.out, X2G, args.in[I_NPLE], SSQ2};
        pg8::gemm_phase<pg8::EpiResid, pg8::StaticOrder, true, true>(lds + RING_OFF, g, S, E, tid);
        if (BOTH(7)) GRID_BAR();
    }

    if (IN(8)) {
        PHASE_IDS();
        pg8::Gemm g{X2G, WPG, MTOK, DM, DM}; pg8::StaticOrder S; S.init(MTOK, DM, G, cu);
        pg8::EpiFinal E{SSQ2, SSQP, args.in[I_PLENG], PE, args.out};
        pg8::gemm_phase<pg8::EpiFinal, pg8::StaticOrder, true, true>(lds + RING_OFF, g, S, E, tid);
    }

#if defined(DUMP_AFTER)
    if (lo == N_PHASES) {
        const size_t gt = (size_t)cu * 512 + threadIdx.x, NT = (size_t)G * 512;
        for (size_t i = gt; i < (size_t)MTOK * DM; i += NT) { const size_t m = i >> 12; const int c = (int)(i & 4095); float v = 0.f;
#if DUMP_AFTER == 3
            v = bf_lo((unsigned)YAB[i]);
#elif DUMP_AFTER == 2
            v = c < 256 ? (float)IDX[m * 256 + c] : (c < 384 ? bf_lo((unsigned)KN[m * 128 + c - 256]) : 0.f);
#elif DUMP_AFTER == 1
#if DUMP_SEL == 0
            v = bf_lo((unsigned)QIDX[i]);
#elif DUMP_SEL == 1
            v = bf_lo((unsigned)UV[i]);
#elif DUMP_SEL == 2
            v = bf_lo((unsigned)SGA[i]) + bf_lo((unsigned)SGB[i]);
#elif DUMP_SEL == 3
            v = bf_lo((unsigned)Qb[m * 2048 + (c & 2047)]);
            if (c < 128) v += KRAW[m * 128 + c] + bf_lo((unsigned)Vb[m * 128 + c]) + bf_lo((unsigned)KIDX[m * 128 + c]);
            if (c < 32) v += WIDX[m * 32 + c];
#endif
#elif DUMP_AFTER == 0
            v = bf_lo((unsigned)H[i]) + bf_lo((unsigned)WIN[i]) + bf_lo((unsigned)WIN[(size_t)(INPAD - 4096) * DM + i]) + bf_lo((unsigned)WGU[i]) + bf_lo((unsigned)WD[i]) + bf_lo((unsigned)WAB[i]);
#endif
            args.out[i] = v; }
    }
#endif
#undef IN
#undef BOTH
#undef GRID_BAR
}

extern "C" void kernel_launch(void* const* d_in, const int* in_sizes, int n_in, void* d_out, int out_size, void* d_ws, size_t ws_size, hipStream_t stream) {
    static int grid = 0;
    if (grid == 0) {
        if (n_in != 22 || in_sizes[0] != MTOK * DM || out_size != MTOK * DM || ws_size < WS_NEED) {
            fprintf(stderr, "kernel_launch: unexpected problem (n_in %d, in0 %d, out %d, ws %zu, need %zu); nothing launched\n", n_in, n_in > 0 ? in_sizes[0] : -1, out_size, ws_size, (size_t)WS_NEED); grid = -1; return; }
        int dev = 0, cus = 0, per_cu = 0;
        if (hipGetDevice(&dev) != hipSuccess || hipDeviceGetAttribute(&cus, hipDeviceAttributeMultiprocessorCount, dev) != hipSuccess) { grid = -1; return; }
        if (hipFuncSetAttribute((const void*)fwd_kernel, hipFuncAttributeMaxDynamicSharedMemorySize, LDS_BYTES) != hipSuccess) { fprintf(stderr, "kernel_launch: hipFuncSetAttribute failed\n"); grid = -1; return; }
        if (hipOccupancyMaxActiveBlocksPerMultiprocessor(&per_cu, (const void*)fwd_kernel, NWAVES * 64, LDS_BYTES) != hipSuccess || per_cu < 1)
            fprintf(stderr, "kernel_launch: note: occupancy query reports %d workgroups per CU\n", per_cu);
        (void)hipGetLastError();
        grid = cus;
    }
    if (grid < 0) return;
    if (hipMemsetAsync((char*)d_ws + WS_CTL, 0, CTL_ZERO_BYTES, stream) != hipSuccess) return;
    Args a{};
    for (int i = 0; i < 22; ++i) a.in[i] = (const float*)d_in[i];
    a.out = (float*)d_out; a.ws = (unsigned char*)d_ws;
#if defined(DUMP_AFTER)
    for (int li = 0; li <= DUMP_AFTER + 1; ++li) {
        a.ph_lo = li <= DUMP_AFTER ? li : N_PHASES; a.ph_hi = a.ph_lo + 1; a.li = 0;
#else
    for (int li = 0; li < N_LAUNCHES; ++li) {
        a.ph_lo = (N_LAUNCHES == 1) ? 0 : li; a.ph_hi = (N_LAUNCHES == 1) ? N_PHASES : li + 1; a.li = (N_LAUNCHES == 1) ? 0 : 0;
#endif
        hipLaunchKernelGGL(fwd_kernel, dim3(grid), dim3(NWAVES * 64), LDS_BYTES, stream, a);
        const hipError_t le = hipPeekAtLastError();
        if (le != hipSuccess) { fprintf(stderr, "kernel_launch: launch %d failed: %s\n", li, hipGetErrorName(le)); break; }
    }
}
```

```cpp
#include <hip/hip_runtime.h>
#include <cstdio>
#include <cstdint>

#define GAS __attribute__((address_space(1)))
#define LAS __attribute__((address_space(3)))
typedef unsigned short bf16;
typedef unsigned v4u __attribute__((ext_vector_type(4)));
typedef unsigned v2u __attribute__((ext_vector_type(2)));
typedef float f32x4 __attribute__((ext_vector_type(4)));
typedef float f32x2 __attribute__((ext_vector_type(2)));
typedef float f32x16 __attribute__((ext_vector_type(16)));
typedef short bf16x8 __attribute__((ext_vector_type(8)));
typedef short s16x4 __attribute__((ext_vector_type(4)));
typedef GAS unsigned gu32;

constexpr int NB = 4, SEQ = 4096, DM = 4096, MTOK = NB * SEQ;
constexpr int NHA = 16, HDA = 128, NIH = 32, IDXD = 128, TOPK = 256;
constexpr int GWID = 2048, NGRP = 8, GDIM = 256, CHK = 128;
constexpr int DFF = 11008, DPLE = 256;
constexpr int INCOLS = 18848, INPAD = 18944;
constexpr float EPS = 1e-6f;
constexpr float LOG2E = 1.4426950408889634f;

constexpr size_t MiB = 1u << 20;
constexpr size_t WS_CTL = 0, CTL_ZERO_BYTES = 1 * MiB;
constexpr size_t WS_IDX = 1 * MiB;
constexpr size_t WS_LNP = 9 * MiB;
constexpr size_t WS_SSQ1 = 13 * MiB;
constexpr size_t WS_SSQ2 = 17 * MiB;
constexpr size_t WS_SSQP = 21 * MiB;
constexpr size_t WS_WIDX = 25 * MiB;
constexpr size_t WS_KIDX = 27 * MiB;
constexpr size_t WS_KN = 31 * MiB;
constexpr size_t WS_V = 35 * MiB;
constexpr size_t WS_KRAW = 39 * MiB;
constexpr size_t WS_SGUW = 47 * MiB;
constexpr size_t WS_H = 48 * MiB;
constexpr size_t WS_WIN = 176 * MiB;
constexpr size_t WS_QIDX = 324 * MiB;
constexpr size_t WS_Q = 452 * MiB;
constexpr size_t WS_UV = 516 * MiB;
constexpr size_t WS_SGA = 644 * MiB;
constexpr size_t WS_SGB = 772 * MiB;
constexpr size_t WS_WAB = 900 * MiB;
constexpr size_t WS_WOUT = 932 * MiB;
constexpr size_t WS_WGU = 964 * MiB;
constexpr size_t WS_WD = 1136 * MiB;
constexpr size_t WS_WPLE = 1222 * MiB;
constexpr size_t WS_WPG = 1224 * MiB;
constexpr size_t WS_END = 1256 * MiB;
constexpr size_t WS_SC = WS_H, WS_MERGED = WS_H, WS_ACT = WS_H, WS_YAB = WS_QIDX, WS_X1G = WS_UV, WS_X2G = WS_UV, WS_PE = WS_SGA;
static_assert(WS_SC + (size_t)MTOK * SEQ * 4 <= WS_QIDX && WS_ACT + (size_t)MTOK * DFF * 2 <= WS_Q && WS_WIN + (size_t)INPAD * DM * 2 <= WS_QIDX && WS_WD + (size_t)DM * DFF * 2 <= WS_WPLE, "ws map");

constexpr int CW_TMO = 0, CW_CODE = 1, CW_BAR = 4096;

constexpr int RING_OFF = 0, RING_BYTES = 131072;
constexpr int LDSCTL_OFF = RING_BYTES, MISC_OFF = LDSCTL_OFF + 320;
constexpr int LDS_BYTES = 147456;
static_assert(MISC_OFF + 128 <= LDS_BYTES, "LDS map");

#define RLX_AGENT __ATOMIC_RELAXED, __HIP_MEMORY_SCOPE_AGENT
#define LDS_WAIT() asm volatile("s_waitcnt lgkmcnt(0)" ::: "memory")
#define VM_WAIT() asm volatile("s_waitcnt vmcnt(0)" ::: "memory")

typedef __bf16 bf16v2_t __attribute__((ext_vector_type(2)));
__device__ __forceinline__ unsigned cvt_pk_bf16(float lo, float hi) { const f32x2 v = {lo, hi}; const bf16v2_t b = __builtin_convertvector(v, bf16v2_t); return __builtin_bit_cast(unsigned, b); }
__device__ __forceinline__ float bf_lo(unsigned w) { return __uint_as_float(w << 16); }
__device__ __forceinline__ float bf_hi(unsigned w) { return __uint_as_float(w & 0xffff0000u); }
__device__ __forceinline__ float fast_sigmoid(float x) { return __builtin_amdgcn_rcpf(1.0f + __builtin_amdgcn_exp2f(-LOG2E * x)); }
__device__ __forceinline__ float gelu_tanh(float x) { const float t = x * (1.0f + 0.044715f * x * x); return x * __builtin_amdgcn_rcpf(1.0f + __builtin_amdgcn_exp2f(-2.302208198f * t)); }
__device__ __forceinline__ float wave_sum(float v) {
#pragma unroll
    for (int o = 1; o < 64; o <<= 1) v += __shfl_xor(v, o);
    return v;
}
__device__ __forceinline__ v4u pack8(f32x4 a, f32x4 b) { v4u w; w.x = cvt_pk_bf16(a[0], a[1]); w.y = cvt_pk_bf16(a[2], a[3]); w.z = cvt_pk_bf16(b[0], b[1]); w.w = cvt_pk_bf16(b[2], b[3]); return w; }
__device__ __forceinline__ void unpack8(v4u w, f32x4& a, f32x4& b) { a = (f32x4){bf_lo(w.x), bf_hi(w.x), bf_lo(w.y), bf_hi(w.y)}; b = (f32x4){bf_lo(w.z), bf_hi(w.z), bf_lo(w.w), bf_hi(w.w)}; }

namespace pg8 {
#define PG8_LAS __attribute__((address_space(3)))
typedef unsigned short bf16_t;
typedef unsigned u32x4 __attribute__((ext_vector_type(4)));
constexpr int BM = 256, BK = 64, HALF = 128, HTB = HALF * BK * 2, STAGE_BYTES = 8 * HTB, NXCD = 8, WGM = 8;

__host__ __device__ __forceinline__ int lds_byte(int r, int c) { const int st = (r >> 4) * 2 + (c >> 5), rr = r & 15, cc = c & 31, ob = rr * 64 + cc * 2; return st * 1024 + (ob ^ (((ob >> 9) & 1) << 5)); }
__host__ __device__ __forceinline__ void stage_rc(int b, int& R, int& C) { const int st = b / 1024, sb = b % 1024, swz = sb ^ (((sb >> 9) & 1) << 5); R = (st >> 1) * 16 + swz / 64; C = (st & 1) * 32 + (swz % 64) / 2; }
__host__ __device__ __forceinline__ int perm32(int rho) { const int n = rho >> 4, i = rho & 15; return 8 * (i >> 2) + 4 * n + (i & 3); }

struct Unit { int pm, pn; };
struct Gemm { const bf16_t* A; const bf16_t* Bt; int M, N, K; };

struct StaticOrder {
    int nM, nN, nwg, G, c;
    __host__ __device__ void init(int M, int N, int G_, int c_) { nM = M / BM; nN = N / BM; nwg = nM * nN; G = G_; c = c_; }
    __host__ __device__ bool next(int i, Unit& u) const {
        const long L = (long)i * G + c; if (L >= nwg) return false;
        int wgid = (int)L; { const int q = nwg / NXCD, r = nwg % NXCD, xcd = wgid % NXCD, off = wgid / NXCD; wgid = (xcd < r ? xcd * (q + 1) : r * (q + 1) + (xcd - r) * q) + off; }
        const int nig = WGM * nN, gid = wgid / nig, fm = gid * WGM, gsz = (nM - fm) < WGM ? (nM - fm) : WGM;
        u.pm = fm + ((wgid % nig) % gsz); u.pn = (wgid % nig) / gsz; return true;
    }
    __device__ __forceinline__ void a_ready(const Unit&) const {}
    __device__ __forceinline__ void done(const Unit&) const {}
};

typedef f32x4 Acc[2][2][4][2];

__device__ __forceinline__ float row_total64(const float* tab, int row, int fq) {
    const float* p = tab + ((size_t)(fq * 4) * MTOK + row) * 4;
    const f32x4 a = *(const f32x4*)p, b = *(const f32x4*)(p + (size_t)MTOK * 4), c = *(const f32x4*)(p + (size_t)MTOK * 8), d = *(const f32x4*)(p + (size_t)MTOK * 12);
    float s = ((a[0] + a[1]) + (a[2] + a[3])) + ((b[0] + b[1]) + (b[2] + b[3])) + ((c[0] + c[1]) + (c[2] + c[3])) + ((d[0] + d[1]) + (d[2] + d[3]));
    s += __shfl_xor(s, 16); s += __shfl_xor(s, 32); return s;
}

struct EpiInProj {
    static constexpr bool PERM = true, AFTER_DRAIN = false, HAS_MID = false;
    bf16_t *Q, *V, *QIDX, *KIDX, *UV, *SGA, *SGB; float *KRAW, *WIDX, *LNP;
    __device__ __forceinline__ void mid(Acc&, const Unit&, int, int, int, int) const {}
    template <int ACT> __device__ __forceinline__ void plain(const Acc& acc, bf16_t* O, int ldc, int colt, int row0, int cl) const {
#pragma unroll
        for (int ai = 0; ai < 2; ++ai)
#pragma unroll
            for (int m = 0; m < 4; ++m) { bf16_t* rowp = O + (size_t)(row0 + ai * HALF + m * 16) * ldc + colt + cl;
#pragma unroll
                for (int bj = 0; bj < 2; ++bj) { f32x4 v0 = acc[ai][bj][m][0], v1 = acc[ai][bj][m][1];
                    if (ACT == 1) {
#pragma unroll
                        for (int j = 0; j < 4; ++j) { v0[j] = gelu_tanh(v0[j]); v1[j] = gelu_tanh(v1[j]); } }
                    if (ACT == 2) {
#pragma unroll
                        for (int j = 0; j < 4; ++j) { v0[j] = fast_sigmoid(v0[j]); v1[j] = fast_sigmoid(v1[j]); } }
                    *(u32x4*)(rowp + bj * HALF) = pack8(v0, v1); }
                __builtin_amdgcn_sched_barrier(0); }
    }
    __device__ __forceinline__ void operator()(const Acc& acc, const Unit& u, int wr, int wc, int fr, int fq) const {
        asm volatile("" : "+v"(fr), "+v"(fq));
        const int row0 = u.pm * BM + wr * 64 + fr, cl = wc * 32 + 8 * fq, pn = u.pn;
        if (pn < 8 || (pn > 8 && pn < 25)) { const bool isq = pn < 8; plain<0>(acc, isq ? Q : QIDX, isq ? 2048 : 4096, isq ? pn * 256 : (pn - 9) * 256, row0, cl); }
        else if (pn == 8) {
#pragma unroll
            for (int ai = 0; ai < 2; ++ai)
#pragma unroll
                for (int m = 0; m < 4; ++m) { const size_t r = (size_t)(row0 + ai * HALF + m * 16);
                    *(f32x4*)(KRAW + r * 128 + cl) = acc[ai][0][m][0]; *(f32x4*)(KRAW + r * 128 + cl + 4) = acc[ai][0][m][1];
                    *(u32x4*)(V + r * 128 + cl) = pack8(acc[ai][1][m][0], acc[ai][1][m][1]); }
        }
        else if (pn == 25) {
#pragma unroll
            for (int ai = 0; ai < 2; ++ai)
#pragma unroll
                for (int m = 0; m < 4; ++m) { const size_t r = (size_t)(row0 + ai * HALF + m * 16);
                    *(u32x4*)(KIDX + r * 128 + cl) = pack8(acc[ai][0][m][0], acc[ai][0][m][1]);
                    if (wc == 0) { *(f32x4*)(WIDX + r * 32 + 8 * fq) = acc[ai][1][m][0]; *(f32x4*)(WIDX + r * 32 + 8 * fq + 4) = acc[ai][1][m][1]; } }
        }
        else if (pn < 42) {
            const bool isv = pn >= 34;
#pragma unroll
            for (int ai = 0; ai < 2; ++ai)
#pragma unroll
                for (int m = 0; m < 4; ++m) { const size_t r = (size_t)(row0 + ai * HALF + m * 16); bf16_t* rowp = UV + r * 4096 + (pn - 26) * 256 + cl; float s = 0.f, q = 0.f;
#pragma unroll
                    for (int bj = 0; bj < 2; ++bj) { f32x4 v0 = acc[ai][bj][m][0], v1 = acc[ai][bj][m][1];
#pragma unroll
                        for (int j = 0; j < 4; ++j) { v0[j] = gelu_tanh(v0[j]); v1[j] = gelu_tanh(v1[j]); s += v0[j] + v1[j]; q += v0[j] * v0[j] + v1[j] * v1[j]; }
                        *(u32x4*)(rowp + bj * HALF) = pack8(v0, v1); }
                    s += __shfl_xor(s, 16); s += __shfl_xor(s, 32); q += __shfl_xor(q, 16); q += __shfl_xor(q, 32);
                    if (isv && fq == 0) *(f32x2*)(LNP + (((size_t)(pn - 34) * MTOK + r) * 4 + wc) * 2) = (f32x2){s, q};
                    __builtin_amdgcn_sched_barrier(0); }
        }
        else { const bool isa = pn < 58; plain<2>(acc, isa ? SGA : SGB, 4096, isa ? (pn - 42) * 256 : (pn - 58) * 256, row0, cl); }
    }
};

struct EpiNull {
    static constexpr bool PERM = true, AFTER_DRAIN = false, HAS_MID = false;
    float* sink;
    __device__ __forceinline__ void mid(Acc&, const Unit&, int, int, int, int) const {}
    __device__ __forceinline__ void operator()(const Acc& acc, const Unit& u, int wr, int wc, int fr, int fq) const {
        f32x4 t = {0.f, 0.f, 0.f, 0.f};
#pragma unroll
        for (int ai = 0; ai < 2; ++ai)
#pragma unroll
            for (int bj = 0; bj < 2; ++bj)
#pragma unroll
                for (int m = 0; m < 4; ++m) t += acc[ai][bj][m][0] + acc[ai][bj][m][1];
        if (t[0] + t[1] + t[2] + t[3] == 123456.789f) sink[u.pm] = t[0];
    }
};

struct EpiMerge {
    static constexpr bool PERM = true, AFTER_DRAIN = false, HAS_MID = true;
    const bf16_t *SGA, *SGB; bf16_t* O;
    __device__ __forceinline__ void mid(Acc& acc, const Unit& u, int wr, int wc, int fr, int fq) const {
        asm volatile("" : "+v"(fr), "+v"(fq));
        const int row0 = u.pm * BM + wr * 64 + fr, col0 = u.pn * BM + wc * 32 + 8 * fq;
#pragma unroll
        for (int ai = 0; ai < 2; ++ai)
#pragma unroll
            for (int m = 0; m < 4; ++m) { const size_t off = (size_t)(row0 + ai * HALF + m * 16) * 4096 + col0;
#pragma unroll
                for (int bj = 0; bj < 2; ++bj) { const u32x4 wa = *(const u32x4*)(SGA + off + bj * HALF), wb = *(const u32x4*)(SGB + off + bj * HALF);
                    f32x4 a0, a1, b0, b1; unpack8(wa, a0, a1); unpack8(wb, b0, b1);
#pragma unroll
                    for (int j = 0; j < 4; ++j) { acc[ai][bj][m][0][j] *= a0[j] * __builtin_amdgcn_rcpf(b0[j]); acc[ai][bj][m][1][j] *= a1[j] * __builtin_amdgcn_rcpf(b1[j]); } }
                __builtin_amdgcn_sched_barrier(0); }
    }
    __device__ __forceinline__ void operator()(const Acc& acc, const Unit& u, int wr, int wc, int fr, int fq) const {
        asm volatile("" : "+v"(fr), "+v"(fq));
        const int row0 = u.pm * BM + wr * 64 + fr, col0 = u.pn * BM + wc * 32 + 8 * fq;
#pragma unroll
        for (int ai = 0; ai < 2; ++ai)
#pragma unroll
            for (int m = 0; m < 4; ++m) { const size_t off = (size_t)(row0 + ai * HALF + m * 16) * 4096 + col0;
#pragma unroll
                for (int bj = 0; bj < 2; ++bj) { const u32x4 wb = *(const u32x4*)(SGB + off + bj * HALF); f32x4 b0, b1; unpack8(wb, b0, b1);
                    *(u32x4*)(O + off + bj * HALF) = pack8(acc[ai][bj][m][0] * b0, acc[ai][bj][m][1] * b1); }
                __builtin_amdgcn_sched_barrier(0); }
    }
};

struct EpiResid {
    static constexpr bool PERM = true, AFTER_DRAIN = false, HAS_MID = false;
    const float* XIN; float* XOUT; bf16_t* XG; const float* gain; float* SSQ;
    __device__ __forceinline__ void mid(Acc&, const Unit&, int, int, int, int) const {}
    __device__ __forceinline__ void operator()(const Acc& acc, const Unit& u, int wr, int wc, int fr, int fq) const {
        asm volatile("" : "+v"(fr), "+v"(fq));
        const int row0 = u.pm * BM + wr * 64 + fr, col0 = u.pn * BM + wc * 32 + 8 * fq;
        f32x4 gv[2][2];
#pragma unroll
        for (int bj = 0; bj < 2; ++bj) { gv[bj][0] = *(const f32x4*)(gain + col0 + bj * HALF); gv[bj][1] = *(const f32x4*)(gain + col0 + bj * HALF + 4); }
#pragma unroll
        for (int ai = 0; ai < 2; ++ai)
#pragma unroll
            for (int m = 0; m < 4; ++m) { const size_t r = (size_t)(row0 + ai * HALF + m * 16), off = r * 4096 + col0; float q = 0.f;
#pragma unroll
                for (int bj = 0; bj < 2; ++bj) { f32x4 v0 = *(const f32x4*)(XIN + off + bj * HALF) + acc[ai][bj][m][0], v1 = *(const f32x4*)(XIN + off + bj * HALF + 4) + acc[ai][bj][m][1];
                    *(f32x4*)(XOUT + off + bj * HALF) = v0; *(f32x4*)(XOUT + off + bj * HALF + 4) = v1;
#pragma unroll
                    for (int j = 0; j < 4; ++j) q += v0[j] * v0[j] + v1[j] * v1[j];
                    *(u32x4*)(XG + off + bj * HALF) = pack8(v0 * gv[bj][0], v1 * gv[bj][1]); }
                q += __shfl_xor(q, 16); q += __shfl_xor(q, 32);
                if (fq == 0) SSQ[((size_t)u.pn * MTOK + r) * 4 + wc] = q;
                __builtin_amdgcn_sched_barrier(0); }
    }
};

struct EpiPe {
    static constexpr bool PERM = true, AFTER_DRAIN = false, HAS_MID = false;
    bf16_t* PE; float* SSQ;
    __device__ __forceinline__ void mid(Acc&, const Unit&, int, int, int, int) const {}
    __device__ __forceinline__ void operator()(const Acc& acc, const Unit& u, int wr, int wc, int fr, int fq) const {
        asm volatile("" : "+v"(fr), "+v"(fq));
        const int row0 = u.pm * BM + wr * 64 + fr, col0 = u.pn * BM + wc * 32 + 8 * fq;
#pragma unroll
        for (int ai = 0; ai < 2; ++ai)
#pragma unroll
            for (int m = 0; m < 4; ++m) { const size_t r = (size_t)(row0 + ai * HALF + m * 16), off = r * 4096 + col0; float q = 0.f;
#pragma unroll
                for (int bj = 0; bj < 2; ++bj) { const f32x4 v0 = acc[ai][bj][m][0], v1 = acc[ai][bj][m][1];
#pragma unroll
                    for (int j = 0; j < 4; ++j) q += v0[j] * v0[j] + v1[j] * v1[j];
                    *(u32x4*)(PE + off + bj * HALF) = pack8(v0, v1); }
                q += __shfl_xor(q, 16); q += __shfl_xor(q, 32);
                if (fq == 0) SSQ[((size_t)u.pn * MTOK + r) * 4 + wc] = q;
                __builtin_amdgcn_sched_barrier(0); }
    }
};

struct EpiGateUp {
    static constexpr bool PERM = true, AFTER_DRAIN = false, HAS_MID = false;
    const float* SSQ; bf16_t* ACT;
    __device__ __forceinline__ void mid(Acc&, const Unit&, int, int, int, int) const {}
    __device__ __forceinline__ void operator()(const Acc& acc, const Unit& u, int wr, int wc, int fr, int fq) const {
        asm volatile("" : "+v"(fr), "+v"(fq));
        const int row0 = u.pm * BM + wr * 64 + fr, col0 = u.pn * HALF + wc * 32 + 8 * fq;
#pragma unroll
        for (int ai = 0; ai < 2; ++ai)
#pragma unroll
            for (int m = 0; m < 4; ++m) { const int r = row0 + ai * HALF + m * 16;
                const float rs = 1.0f / sqrtf(row_total64(SSQ, r, fq) * (1.0f / 4096.0f) + EPS);
                f32x4 o0, o1;
#pragma unroll
                for (int j = 0; j < 4; ++j) { const float g0 = acc[ai][0][m][0][j] * rs, g1 = acc[ai][0][m][1][j] * rs;
                    o0[j] = g0 * fast_sigmoid(g0) * (acc[ai][1][m][0][j] * rs); o1[j] = g1 * fast_sigmoid(g1) * (acc[ai][1][m][1][j] * rs); }
                *(u32x4*)(ACT + (size_t)r * DFF + col0) = pack8(o0, o1);
                __builtin_amdgcn_sched_barrier(0); }
    }
};

struct EpiFinal {
    static constexpr bool PERM = true, AFTER_DRAIN = false, HAS_MID = false;
    const float *SSQ2, *SSQP, *pleg; const bf16_t* PE; float* OUT;
    __device__ __forceinline__ void mid(Acc&, const Unit&, int, int, int, int) const {}
    __device__ __forceinline__ void operator()(const Acc& acc, const Unit& u, int wr, int wc, int fr, int fq) const {
        asm volatile("" : "+v"(fr), "+v"(fq));
        const int row0 = u.pm * BM + wr * 64 + fr, col0 = u.pn * BM + wc * 32 + 8 * fq;
        f32x4 gv[2][2];
#pragma unroll
        for (int bj = 0; bj < 2; ++bj) { gv[bj][0] = *(const f32x4*)(pleg + col0 + bj * HALF); gv[bj][1] = *(const f32x4*)(pleg + col0 + bj * HALF + 4); }
#pragma unroll
        for (int ai = 0; ai < 2; ++ai)
#pragma unroll
            for (int m = 0; m < 4; ++m) { const int r = row0 + ai * HALF + m * 16; const size_t off = (size_t)r * 4096 + col0;
                const float r3 = 1.0f / sqrtf(row_total64(SSQ2, r, fq) * (1.0f / 4096.0f) + EPS), rp = 1.0f / sqrtf(row_total64(SSQP, r, fq) * (1.0f / 4096.0f) + EPS);
#pragma unroll
                for (int bj = 0; bj < 2; ++bj) { const u32x4 pw = *(const u32x4*)(PE + off + bj * HALF); f32x4 p0, p1; unpack8(pw, p0, p1);
                    f32x4 x0 = *(const f32x4*)(OUT + off + bj * HALF), x1 = *(const f32x4*)(OUT + off + bj * HALF + 4);
#pragma unroll
                    for (int j = 0; j < 4; ++j) { x0[j] += fast_sigmoid(acc[ai][bj][m][0][j] * r3) * (p0[j] * rp * gv[bj][0][j]); x1[j] += fast_sigmoid(acc[ai][bj][m][1][j] * r3) * (p1[j] * rp * gv[bj][1][j]); }
                    *(f32x4*)(OUT + off + bj * HALF) = x0; *(f32x4*)(OUT + off + bj * HALF + 4) = x1; }
                __builtin_amdgcn_sched_barrier(0); }
    }
};
template <class Epi, class Sched, bool ALIGN_EPI = false, bool SP2 = false>
__device__ __forceinline__ void gemm_phase(PG8_LAS unsigned char* lds, const Gemm g, const Sched& S, const Epi& E, const int tid) {
    const int wid = __builtin_amdgcn_readfirstlane(tid >> 6), lane = tid & 63, wr = wid >> 2, wc = wid & 3, fr = lane & 15, fq = lane >> 4;
    const int K = g.K, nt = K / BK;
    unsigned voffA[2], voffB[2];
#pragma unroll
    for (int i = 0; i < 2; ++i) { int R, C; stage_rc(tid * 16 + i * 8192, R, C); const int Rb = Epi::PERM ? ((R & ~31) + perm32(R & 31)) : R;
        voffA[i] = (unsigned)(R * K + C) * 2u; voffB[i] = (unsigned)(Rb * K + C) * 2u; }
    const size_t kstep = (size_t)(BK * 2);
    const size_t hstep = (size_t)HALF * K * 2;
    const size_t tstep = 2 * hstep;
    const unsigned ldsw = (unsigned)wid * 1024u;
    const int aoff = lds_byte(wr * 64 + fr, fq * 8), boff = lds_byte(wc * 32 + fr, fq * 8);
#define PG8_SA(b, h) (((b) * 2 + (h)) * HTB)
#define PG8_SB(b, h) ((4 + (b) * 2 + (h)) * HTB)
#define PG8_STAGE(bufoff, gbase, voff) do { _Pragma("unroll") for (int _i = 0; _i < 2; ++_i) \
        __builtin_amdgcn_global_load_lds((const unsigned*)((const char*)(gbase) + (voff)[_i]), (PG8_LAS unsigned*)(lds + (bufoff) + ldsw + _i * 8192), 16, 0, 0); } while (0)
#define PG8_LDA(dst, b, h) do { _Pragma("unroll") for (int m = 0; m < 4; ++m) _Pragma("unroll") for (int k = 0; k < 2; ++k) dst[m][k] = *(const PG8_LAS bf16x8*)(lds + PG8_SA(b, h) + aoff + m * 2048 + k * 1024); } while (0)
#define PG8_LDB(dst, b, h) do { _Pragma("unroll") for (int n = 0; n < 2; ++n) _Pragma("unroll") for (int k = 0; k < 2; ++k) dst[n][k] = *(const PG8_LAS bf16x8*)(lds + PG8_SB(b, h) + boff + n * 2048 + k * 1024); } while (0)
#define PG8_MMA(ai, bj, At, Bt) do { __builtin_amdgcn_s_setprio(1); _Pragma("unroll") for (int m = 0; m < 4; ++m) _Pragma("unroll") for (int n = 0; n < 2; ++n) _Pragma("unroll") for (int k = 0; k < 2; ++k) \
        acc[ai][bj][m][n] = __builtin_amdgcn_mfma_f32_16x16x32_bf16(Bt[n][k], At[m][k], acc[ai][bj][m][n], 0, 0, 0); __builtin_amdgcn_s_setprio(0); } while (0)
#define PG8_WAIT_V(n) asm volatile("s_waitcnt vmcnt(" #n ")" ::: "memory")
#define PG8_WAIT_L(n) asm volatile("s_waitcnt lgkmcnt(" #n ")" ::: "memory")
#define PG8_BAR __builtin_amdgcn_s_barrier()
#define PG8_SCHED __builtin_amdgcn_sched_barrier(0)
    Unit cur, nxt; int ui = 0;
    if (!S.next(0, cur)) return;
    f32x4 acc[2][2][4][2];
#pragma unroll
    for (int a = 0; a < 2; ++a)
#pragma unroll
        for (int b = 0; b < 2; ++b)
#pragma unroll
            for (int m = 0; m < 4; ++m)
#pragma unroll
                for (int n = 0; n < 2; ++n) acc[a][b][m][n] = (f32x4){0.f, 0.f, 0.f, 0.f};
    bf16x8 At[4][2], B0[2][2], B1[2][2];
    const char* cA = (const char*)g.A + (size_t)cur.pm * tstep; const char* cB = (const char*)g.Bt + (size_t)cur.pn * tstep;
    S.a_ready(cur);
    if constexpr (SP2) {
        PG8_STAGE(PG8_SB(0, 0), cB, voffB); PG8_STAGE(PG8_SB(0, 1), cB + hstep, voffB); PG8_STAGE(PG8_SA(0, 0), cA, voffA); PG8_STAGE(PG8_SA(0, 1), cA + hstep, voffA);
        if (wr == 1) PG8_BAR;
        PG8_WAIT_V(2); PG8_BAR;
        PG8_STAGE(PG8_SB(1, 0), cB + kstep, voffB); PG8_STAGE(PG8_SA(1, 0), cA + kstep, voffA); PG8_STAGE(PG8_SB(1, 1), cB + hstep + kstep, voffB);
        PG8_WAIT_V(6); PG8_BAR;
    } else {
        PG8_STAGE(PG8_SB(0, 0), cB, voffB); PG8_STAGE(PG8_SA(0, 0), cA, voffA); PG8_STAGE(PG8_SB(0, 1), cB + hstep, voffB); PG8_STAGE(PG8_SA(0, 1), cA + hstep, voffA);
        if (wr == 1) PG8_BAR;
        PG8_WAIT_V(4); PG8_BAR;
        PG8_STAGE(PG8_SB(1, 0), cB + kstep, voffB); PG8_STAGE(PG8_SA(1, 0), cA + kstep, voffA); PG8_STAGE(PG8_SB(1, 1), cB + hstep + kstep, voffB);
        PG8_WAIT_V(6); PG8_BAR;
    }
    for (;;) {
        const bool has_next = S.next(ui + 1, nxt);
        const char* nA = has_next ? (const char*)g.A + (size_t)nxt.pm * tstep : cA; const char* nB = has_next ? (const char*)g.Bt + (size_t)nxt.pn * tstep : cB;
        for (int t = 0; t < nt; t += 2) {
            const bool last = (t == nt - 2);
            const char* a1 = cA + (size_t)(t + 1) * kstep;
            const char* a2 = last ? nA : cA + (size_t)(t + 2) * kstep; const char* b2 = last ? nB : cB + (size_t)(t + 2) * kstep;
            const char* a3 = a2 + kstep; const char* b3 = b2 + kstep;
            if (last && has_next) S.a_ready(nxt);
            if constexpr (Epi::HAS_MID) { if (t == (nt >> 1)) E.mid(acc, cur, wr, wc, fr, fq); }
            if constexpr (SP2) {
            PG8_LDB(B0, 0, 0); PG8_LDB(B1, 0, 1); PG8_SCHED; PG8_LDA(At, 0, 0); PG8_STAGE(PG8_SA(1, 1), a1 + hstep, voffA);
            PG8_WAIT_V(8); PG8_WAIT_L(0); PG8_BAR; PG8_MMA(0, 0, At, B0); PG8_MMA(0, 1, At, B1); PG8_BAR; PG8_SCHED;
            PG8_LDA(At, 0, 1); PG8_STAGE(PG8_SB(0, 0), b2, voffB); PG8_STAGE(PG8_SB(0, 1), b2 + hstep, voffB); PG8_STAGE(PG8_SA(0, 0), a2, voffA);
            PG8_WAIT_V(8); PG8_WAIT_L(0); PG8_BAR; PG8_MMA(1, 0, At, B0); PG8_MMA(1, 1, At, B1); PG8_BAR; PG8_SCHED;
            PG8_LDB(B0, 1, 0); PG8_LDB(B1, 1, 1); PG8_SCHED; PG8_LDA(At, 1, 0); PG8_STAGE(PG8_SA(0, 1), a2 + hstep, voffA);
            PG8_WAIT_V(8); PG8_WAIT_L(0); PG8_BAR; PG8_MMA(0, 0, At, B0); PG8_MMA(0, 1, At, B1); PG8_BAR; PG8_SCHED;
            PG8_LDA(At, 1, 1); PG8_STAGE(PG8_SB(1, 0), b3, voffB); PG8_STAGE(PG8_SB(1, 1), b3 + hstep, voffB); PG8_STAGE(PG8_SA(1, 0), a3, voffA);
            PG8_WAIT_V(8); PG8_WAIT_L(0); PG8_BAR; PG8_MMA(1, 0, At, B0); PG8_MMA(1, 1, At, B1); PG8_BAR; PG8_SCHED;
            } else {
            PG8_LDB(B0, 0, 0); PG8_SCHED; PG8_LDA(At, 0, 0); PG8_STAGE(PG8_SA(1, 1), a1 + hstep, voffA);
            PG8_WAIT_L(8); PG8_BAR; PG8_WAIT_L(0); PG8_MMA(0, 0, At, B0); PG8_BAR; PG8_SCHED;
            PG8_LDB(B1, 0, 1); PG8_STAGE(PG8_SB(0, 0), b2, voffB);
            PG8_BAR; PG8_WAIT_L(0); PG8_MMA(0, 1, At, B1); PG8_BAR;
            PG8_LDA(At, 0, 1); PG8_STAGE(PG8_SA(0, 0), a2, voffA);
            PG8_BAR; PG8_WAIT_L(0); PG8_MMA(1, 0, At, B0); PG8_BAR; PG8_SCHED;
            PG8_STAGE(PG8_SB(0, 1), b2 + hstep, voffB);
            PG8_WAIT_V(6); PG8_BAR; PG8_MMA(1, 1, At, B1); PG8_BAR;
            PG8_LDB(B0, 1, 0); PG8_SCHED; PG8_LDA(At, 1, 0); PG8_STAGE(PG8_SA(0, 1), a2 + hstep, voffA);
            PG8_WAIT_L(8); PG8_BAR; PG8_WAIT_L(0); PG8_MMA(0, 0, At, B0); PG8_BAR; PG8_SCHED;
            PG8_LDB(B1, 1, 1); PG8_STAGE(PG8_SB(1, 0), b3, voffB);
            PG8_BAR; PG8_WAIT_L(0); PG8_MMA(0, 1, At, B1); PG8_BAR;
            PG8_LDA(At, 1, 1); PG8_STAGE(PG8_SA(1, 0), a3, voffA);
            PG8_BAR; PG8_WAIT_L(0); PG8_MMA(1, 0, At, B0); PG8_BAR; PG8_SCHED;
            PG8_STAGE(PG8_SB(1, 1), b3 + hstep, voffB);
            PG8_WAIT_V(6); PG8_BAR; PG8_MMA(1, 1, At, B1); PG8_BAR;
            }
        }
        if constexpr (ALIGN_EPI) { if (wr == 0) PG8_BAR; }
        if constexpr (!Epi::AFTER_DRAIN) { E(acc, cur, wr, wc, fr, fq); S.done(cur); }
        if (!has_next) break;
#pragma unroll
        for (int a = 0; a < 2; ++a)
#pragma unroll
            for (int b = 0; b < 2; ++b)
#pragma unroll
                for (int m = 0; m < 4; ++m)
#pragma unroll
                    for (int n = 0; n < 2; ++n) acc[a][b][m][n] = (f32x4){0.f, 0.f, 0.f, 0.f};
        cur = nxt; cA = nA; cB = nB; ++ui;
        if constexpr (ALIGN_EPI) { if (wr == 1) PG8_BAR; }
    }
    PG8_WAIT_V(0);
    if constexpr (!ALIGN_EPI) { if (wr == 0) PG8_BAR; }
    PG8_BAR;
    if constexpr (Epi::AFTER_DRAIN) { E.fused(acc, cur, wr, wc, fr, fq, lds, wid, lane); S.done(cur); }
#undef PG8_SA
#undef PG8_SB
#undef PG8_STAGE
#undef PG8_LDA
#undef PG8_LDB
#undef PG8_MMA
#undef PG8_WAIT_V
#undef PG8_WAIT_L
#undef PG8_BAR
#undef PG8_SCHED
}
}
#define XB_TMO      128
#define XB_XCNT(j)  (256  + 64 * (j))
#define XB_XSUB(j)  (1280 + 64 * (j))
#define XB_XGEN(j)  (2304 + 64 * (j))
#define XB_TOP      3328
#define XB_TOPGEN   3392
#define XCD_BAR_WORDS 3456
#define XB_SPIN_CAP (1u << 20)

__device__ __forceinline__ unsigned xb_ld(unsigned* p)              { return __hip_atomic_load(p, __ATOMIC_RELAXED, __HIP_MEMORY_SCOPE_AGENT); }
__device__ __forceinline__ unsigned xb_add(unsigned* p, unsigned v) { return __hip_atomic_fetch_add(p, v, __ATOMIC_RELAXED, __HIP_MEMORY_SCOPE_AGENT); }
__device__ __forceinline__ unsigned xb_xcc_id() { return (unsigned)__builtin_amdgcn_s_getreg((3 << 11) | 20) & 0xFu; }
#define XB_SPIN(cond, bar) do { unsigned _sp = 0; while (cond) { __builtin_amdgcn_s_sleep(1); \
    if ((++_sp & 255u) == 0u) { if (xb_ld(&(bar)[XB_TMO])) break; if (_sp > XB_SPIN_CAP) { atomicAdd(&(bar)[XB_TMO], 1u); break; } } } } while (0)

struct XcdBarrier {
    unsigned* bar; unsigned x;
    volatile LAS unsigned* st;
};

__device__ __forceinline__ XcdBarrier xcd_barrier_post(unsigned* bar, volatile LAS unsigned* st) {
    XcdBarrier b; b.bar = bar; b.x = xb_xcc_id(); b.st = st;
    if (threadIdx.x == 0) (void)xb_add(&bar[XB_XCNT(b.x)], 1u);
    return b;
}
__device__ __forceinline__ void xcd_barrier_complete(unsigned* bar, unsigned x, unsigned& nloc, unsigned& nx) {
    const unsigned G = gridDim.x * gridDim.y * gridDim.z;
    unsigned sum, cnt, mine, sp = 0u;
    for (;;) {
        sum = 0u; cnt = 0u; mine = 0u;
#pragma unroll
        for (unsigned j = 0; j < 16; ++j) { const unsigned c = xb_ld(&bar[XB_XCNT(j)]); sum += c; cnt += (c > 0u) ? 1u : 0u; mine = (j == x) ? c : mine; }
        if (sum == G) break;
        __builtin_amdgcn_s_sleep(1);
        if ((++sp & 255u) == 0u) { if (xb_ld(&bar[XB_TMO])) break; if (sp > XB_SPIN_CAP) { atomicAdd(&bar[XB_TMO], 1u); break; } }
    }
    nloc = mine > 0u ? mine : 1u; nx = cnt > 0u ? cnt : 1u;
}

__device__ __forceinline__ void xcd_barrier(const XcdBarrier& b) {
    asm volatile("s_waitcnt vmcnt(0)" ::: "memory");
    __syncthreads();
    if (threadIdx.x == 0) {
        unsigned* bar = b.bar;
        __builtin_amdgcn_s_waitcnt(0);
        unsigned nloc = b.st[0], nx = b.st[1];
        if (nloc == 0u) { xcd_barrier_complete(bar, b.x, nloc, nx); b.st[0] = nloc; b.st[1] = nx; }
        const unsigned old = xb_add(&bar[XB_XSUB(b.x)], 1u);
        const unsigned gen = old / nloc;
        if (old + 1u == (gen + 1u) * nloc) {
            __builtin_amdgcn_fence(__ATOMIC_RELEASE, "agent");
            asm volatile("s_waitcnt vmcnt(0)" ::: "memory");
            const unsigned og = xb_add(&bar[XB_TOP], 1u);
            const unsigned tg = og / nx;
            if (og + 1u == (tg + 1u) * nx) xb_add(&bar[XB_TOPGEN], 1u);
            else XB_SPIN(xb_ld(&bar[XB_TOPGEN]) == tg, bar);
            __builtin_amdgcn_fence(__ATOMIC_ACQUIRE, "agent");
            xb_add(&bar[XB_XGEN(b.x)], 1u);
            asm volatile("s_waitcnt vmcnt(0)" ::: "memory");
        } else {
            XB_SPIN(xb_ld(&bar[XB_XGEN(b.x)]) == gen, bar);
            __builtin_amdgcn_fence(__ATOMIC_ACQUIRE, "agent");
            asm volatile("s_waitcnt vmcnt(0)" ::: "memory");
        }
    }
    __syncthreads();
}

template <int MAP> __device__ __forceinline__ int rowmap(int n) {
    if (MAP == 1) return n < 6560 ? n : n + 96;
    if (MAP == 2) return (n >> 7) * 256 + (n & 127);
    if (MAP == 3) return (n >> 7) * 256 + 128 + (n & 127);
    return n;
}
__device__ __forceinline__ void p0_load(const float* W, int N, int item, f32x4 (&r)[8], int lane) {
    const int nblk = N / 32, kb = item / nblk, nb = item % nblk;
    const float* p = W + (size_t)(64 * kb + (lane >> 3)) * N + 32 * nb + 4 * (lane & 7);
#pragma unroll
    for (int i = 0; i < 8; ++i) r[i] = *(const GAS f32x4*)(p + (size_t)(8 * i) * N);
}
template <int MAP> __device__ __forceinline__ void p0_finish(const f32x4 (&r)[8], int N, bf16* dst, int ldd, int koff, LAS float* scr, int item, int lane) {
    const int nblk = N / 32, kb = item / nblk, nb = item % nblk, k0 = 64 * kb, n0 = 32 * nb;
#pragma unroll
    for (int i = 0; i < 8; ++i) { LAS float* s = scr + (8 * i + (lane >> 3)) * 33 + 4 * (lane & 7); s[0] = r[i].x; s[1] = r[i].y; s[2] = r[i].z; s[3] = r[i].w; }
    LDS_WAIT(); asm volatile("" ::: "memory");
    const int c = lane & 7, r0 = rowmap<MAP>(n0);
#pragma unroll
    for (int j = 0; j < 4; ++j) { const int n = (lane >> 3) + 8 * j; const LAS float* s = scr + (8 * c) * 33 + n;
        v4u o; o.x = cvt_pk_bf16(s[0 * 33], s[1 * 33]); o.y = cvt_pk_bf16(s[2 * 33], s[3 * 33]); o.z = cvt_pk_bf16(s[4 * 33], s[5 * 33]); o.w = cvt_pk_bf16(s[6 * 33], s[7 * 33]);
        *(GAS v4u*)(dst + (size_t)(r0 + n) * ldd + koff + k0 + 8 * c) = o; }
    LDS_WAIT(); asm volatile("" ::: "memory");
}
__device__ __forceinline__ void rms_row_to_bf16(const float* xrow, const float* gain, bf16* orow, int lane) {
    const GAS f32x4* xr = (const GAS f32x4*)xrow + lane;
    f32x4 v[16]; float s = 0.f;
#pragma unroll
    for (int j = 0; j < 16; ++j) { v[j] = xr[64 * j]; s += (v[j].x * v[j].x + v[j].y * v[j].y) + (v[j].z * v[j].z + v[j].w * v[j].w); }
    const float r = 1.0f / sqrtf(wave_sum(s) * (1.0f / DM) + EPS);
    GAS v2u* o8 = (GAS v2u*)orow + lane;
#pragma unroll
    for (int j = 0; j < 16; ++j) { const f32x4 gv = ((const GAS f32x4*)gain)[lane + 64 * j]; v2u w; w.x = cvt_pk_bf16(v[j].x * r * gv.x, v[j].y * r * gv.y); w.y = cvt_pk_bf16(v[j].z * r * gv.z, v[j].w * r * gv.w); o8[64 * j] = w; }
}

__device__ __forceinline__ unsigned ordkey(float v) { const unsigned u = __float_as_uint(v); return u ^ ((u >> 31) ? 0xffffffffu : 0x80000000u); }
__device__ __forceinline__ int mbcnt64(unsigned long long m) { return (int)__builtin_amdgcn_mbcnt_hi((unsigned)(m >> 32), __builtin_amdgcn_mbcnt_lo((unsigned)m, 0u)); }

__device__ __forceinline__ int wave_count(int cl) { int c = 0;
#pragma unroll
    for (int b = 0; b < 7; ++b) c += __popcll(__ballot((cl >> b) & 1)) << b;
    return c; }
constexpr int TOPK_WAVE_LDS = 6144;
__device__ __forceinline__ void topk_row(const float* sc, int N, unsigned short* out, LAS unsigned char* wl, int lane) {
    asm volatile("" : "+v"(lane));
    if (N <= TOPK) { v2u w; w.x = (unsigned)(4 * lane) | ((unsigned)(4 * lane + 1) << 16); w.y = (unsigned)(4 * lane + 2) | ((unsigned)(4 * lane + 3) << 16); *(GAS v2u*)(out + 4 * lane) = w; return; }
    LAS unsigned* hist = (LAS unsigned*)wl; LAS unsigned short* stg = (LAS unsigned short*)(wl + 4096);
    LAS unsigned* ckl = (LAS unsigned*)(wl + 4608); LAS unsigned short* cel = (LAS unsigned short*)(wl + 5632);
    const int ng = (N + 1023) >> 10;
    unsigned key[4][16];
#pragma unroll
    for (int g = 0; g < 4; ++g) {
#pragma unroll
        for (int j = 0; j < 16; ++j) key[g][j] = 0u;
        if (g < ng) {
#pragma unroll
            for (int j = 0; j < 16; ++j) { const int e = g * 1024 + j * 64 + lane; const float v = sc[e]; key[g][j] = e < N ? ordkey(v) : 0u; }
#pragma unroll
            for (int j = 0; j < 16; ++j) (void)__hip_atomic_fetch_add(hist + (key[g][j] >> 22), 1u << ((key[g][j] >> 17) & 16u), __ATOMIC_RELAXED, __HIP_MEMORY_SCOPE_WORKGROUP);
        } }
    unsigned h[32]; unsigned sl = 0u;
    { const LAS v4u* hp = (const LAS v4u*)(hist + 1024 - 16 * (lane + 1));
#pragma unroll
      for (int i = 0; i < 4; ++i) { const v4u t = hp[i];
          h[8 * i] = t.x & 0xffffu; h[8 * i + 1] = t.x >> 16; h[8 * i + 2] = t.y & 0xffffu; h[8 * i + 3] = t.y >> 16; h[8 * i + 4] = t.z & 0xffffu; h[8 * i + 5] = t.z >> 16; h[8 * i + 6] = t.w & 0xffffu; h[8 * i + 7] = t.w >> 16;
          sl += ((t.x & 0xffffu) + (t.x >> 16)) + ((t.y & 0xffffu) + (t.y >> 16)) + ((t.z & 0xffffu) + (t.z >> 16)) + ((t.w & 0xffffu) + (t.w >> 16)); }
      LAS v4u* hz = (LAS v4u*)(hist + 1024 - 16 * (lane + 1));
#pragma unroll
      for (int i = 0; i < 4; ++i) hz[i] = (v4u){0u, 0u, 0u, 0u}; }
    unsigned El = 0u;
#pragma unroll
    for (int b = 0; b < 13; ++b) El += (unsigned)mbcnt64(__ballot((sl >> b) & 1u)) << b;
    int kb = 0; unsigned ab = 0u, cb = 0u; { unsigned acc = El;
#pragma unroll
      for (int k = 31; k >= 0; --k) { const bool hit = acc < (unsigned)TOPK && acc + h[k] >= (unsigned)TOPK; kb = hit ? k : kb; ab = hit ? acc : ab; cb = hit ? h[k] : cb; acc += h[k]; } }
    const int Ls = __ffsll((long long)__ballot(El < (unsigned)TOPK && El + sl >= (unsigned)TOPK)) - 1;
    const unsigned b1 = (unsigned)(2048 - 32 * (Ls + 1) + __builtin_amdgcn_readlane(kb, Ls));
    const int above = (int)__builtin_amdgcn_readlane((int)ab, Ls), C = (int)__builtin_amdgcn_readlane((int)cb, Ls);
    int base = 0;
    if (C <= 256) {
        int cbase = 0;
#pragma unroll
        for (int g = 0; g < 4; ++g) if (g < ng) {
#pragma unroll
            for (int j = 0; j < 16; ++j) { const unsigned d = key[g][j] >> 21; const bool up = d > b1, cd = d == b1;
                const unsigned long long mu = __ballot(up), mc = __ballot(cd);
                if (up) stg[base + mbcnt64(mu)] = (unsigned short)(g * 1024 + j * 64 + lane);
                if (cd) { const int cp = cbase + mbcnt64(mc); ckl[cp] = key[g][j]; cel[cp] = (unsigned short)(g * 1024 + j * 64 + lane); }
                base += __popcll(mu); cbase += __popcll(mc); } }
        LDS_WAIT();
        unsigned ck[4]; unsigned ce[4];
#pragma unroll
        for (int m = 0; m < 4; ++m) { const int i = lane + 64 * m; ck[m] = i < C ? ckl[i] : 0u; ce[m] = cel[i]; }
        const int need = TOPK - above;
        unsigned T = b1 << 21; bool exact = false;
#pragma unroll 1
        for (int bit = 20; bit >= 0; --bit) { const unsigned cand = T | (1u << bit); int c = 0;
#pragma unroll
            for (int m = 0; m < 4; ++m) c += __popcll(__ballot(ck[m] >= cand));
            if (c >= need) { T = cand; if (c == need) { exact = true; break; } } }
        int need_eq = 1 << 30;
        if (!exact) { int cg = 0;
#pragma unroll
            for (int m = 0; m < 4; ++m) cg += __popcll(__ballot(ck[m] > T));
            need_eq = need - cg; }
        int eqb = 0;
#pragma unroll
        for (int m = 0; m < 4; ++m) { const bool gt = ck[m] > T, eq = ck[m] == T && ck[m] != 0u; const unsigned long long meq = __ballot(eq);
            const bool sel = gt || (eq && (eqb + mbcnt64(meq)) < need_eq); const unsigned long long ms = __ballot(sel);
            if (sel) stg[base + mbcnt64(ms)] = (unsigned short)ce[m];
            base += __popcll(ms); eqb += __popcll(meq); }
    } else {
        unsigned T = 0u; bool exact = false;
#pragma unroll 1
        for (int bit = 31; bit >= 0; --bit) {
            const unsigned cand = T | (1u << bit); int c = 0;
#pragma unroll
            for (int g = 0; g < 4; ++g) if (g < ng) {
#pragma unroll
                for (int j = 0; j < 16; ++j) c += __popcll(__ballot(key[g][j] >= cand)); }
            if (c >= TOPK) { T = cand; if (c == TOPK) { exact = true; break; } }
        }
        int need_eq = 1 << 30;
        if (!exact) { int cg = 0;
#pragma unroll
            for (int g = 0; g < 4; ++g) if (g < ng) {
#pragma unroll
                for (int j = 0; j < 16; ++j) cg += __popcll(__ballot(key[g][j] > T)); }
            need_eq = TOPK - cg; }
        int eqb = 0;
#pragma unroll
        for (int g = 0; g < 4; ++g) if (g < ng) {
#pragma unroll
            for (int j = 0; j < 16; ++j) { const bool gt = key[g][j] > T, eq = key[g][j] == T; const unsigned long long meq = __ballot(eq);
                const bool sel = gt || (eq && (eqb + mbcnt64(meq)) < need_eq); const unsigned long long ms = __ballot(sel);
                if (sel) stg[base + mbcnt64(ms)] = (unsigned short)(g * 1024 + j * 64 + lane);
                base += __popcll(ms); eqb += __popcll(meq); } }
    }
    LDS_WAIT();
    *(GAS v2u*)(out + 4 * lane) = *(const LAS v2u*)(stg + 4 * lane);
    LDS_WAIT();
}

__device__ __forceinline__ void indexer_unit(LAS unsigned char* lds, int tid, int wave, int lane, int b, int qg,
                                             const bf16* QIDX, const bf16* KIDX, const float* WIDX, float* SC, unsigned short* IDX) {
    LAS unsigned char* KT = lds;
    LAS float* WT = (LAS float*)(lds + 65536);
    asm volatile("" : "+v"(lane), "+v"(tid));
    const int q0 = qg * 32, nkeys = q0 + 32, r = lane & 31, hh = lane >> 5;
    const size_t rowb = (size_t)b * SEQ;
    __syncthreads();
    if (tid < 256) *(LAS f32x4*)(WT + tid * 4) = *(const GAS f32x4*)(WIDX + (rowb + q0) * 32 + tid * 4);
    bf16x8 A[4][8];
#pragma unroll
    for (int qi = 0; qi < 4; ++qi)
#pragma unroll
        for (int kk = 0; kk < 8; ++kk) A[qi][kk] = *(const GAS bf16x8*)(QIDX + (rowb + q0 + 4 * wave + qi) * 4096 + r * 128 + kk * 16 + hh * 8);
    const int nch = (nkeys + 127) >> 7;
    const int srow = 16 * wave + (lane >> 4), slot = lane & 15;
#define IDX_STAGE(ch_, buf_) do { _Pragma("unroll") for (int i_ = 0; i_ < 4; ++i_) { const int krow_ = srow + 4 * i_; \
        __builtin_amdgcn_global_load_lds((const GAS unsigned*)(KIDX + (rowb + (ch_) * 128 + krow_) * 128 + ((slot ^ (krow_ & 15)) << 3)), (LAS unsigned*)((buf_) + (16 * wave + 4 * i_) * 256), 16, 0, 0); } } while (0)
    IDX_STAGE(0, KT);
    for (int ch = 0; ch < nch; ++ch) {
        LAS unsigned char* buf = KT + (ch & 1) * 32768;
        VM_WAIT();
        __syncthreads();
        if (ch + 1 < nch) IDX_STAGE(ch + 1, KT + ((ch + 1) & 1) * 32768);
        const int rem = (nkeys - ch * 128) >> 5, ntile = rem < 4 ? rem : 4;
        for (int tile = 0; tile < ntile; ++tile) {
            bf16x8 Bf[8];
#pragma unroll
            for (int kk = 0; kk < 8; ++kk) Bf[kk] = *(const LAS bf16x8*)(buf + (tile * 32 + r) * 256 + (((2 * kk + hh) ^ (r & 15)) << 4));
            const int key = ch * 128 + tile * 32 + r;
#pragma unroll
            for (int qi = 0; qi < 4; ++qi) {
                f32x16 acc;
#pragma unroll
                for (int e = 0; e < 16; ++e) acc[e] = 0.f;
#pragma unroll
                for (int kk = 0; kk < 8; ++kk) acc = __builtin_amdgcn_mfma_f32_32x32x16_bf16(A[qi][kk], Bf[kk], acc, 0, 0, 0);
                float sc = 0.f;
#pragma unroll
                for (int j = 0; j < 4; ++j) { const f32x4 w4 = *(const LAS f32x4*)(WT + (4 * wave + qi) * 32 + 8 * j + 4 * hh);
#pragma unroll
                    for (int e = 0; e < 4; ++e) sc += fmaxf(acc[4 * j + e], 0.f) * w4[e]; }
                sc += __shfl_xor(sc, 32);
                const int qpos = q0 + 4 * wave + qi;
                if (hh == 0 && key <= qpos) SC[(rowb + qpos) * 4096 + key] = sc;
                __builtin_amdgcn_sched_barrier(0);
            }
        }
    }
#undef IDX_STAGE
    VM_WAIT();
#ifndef DUP_TOPK
#define DUP_TOPK 1
#endif
#pragma unroll 1
    for (int qi = 0; qi < 4 * DUP_TOPK; ++qi) { const int qpos = q0 + 4 * wave + (qi & 3); topk_row(SC + (rowb + qpos) * 4096, qpos + 1, IDX + (rowb + qpos) * 256, lds + 69632 + wave * TOPK_WAVE_LDS, lane); }
}

__device__ __forceinline__ void sgu_unit(LAS unsigned char* lds, int tid, int wave, int lane, int cidx, int grp,
                                         const bf16* UV, const float* LNP, const bf16* SGUW, const float* lng, const float* lnb, const float* sgub, bf16* YAB) {
    constexpr int VP = 544, WP = 272;
    LAS unsigned char* VN = lds;
    LAS unsigned char* WL = lds + 128 * VP;
    LAS float* ST = (LAS float*)(lds + 128 * VP + 128 * WP);
    const int t0 = cidx * 128;
    __syncthreads();
    if (tid < 128) { float s = 0.f, q = 0.f;
#pragma unroll
        for (int i = 0; i < 8; ++i) { const GAS f32x4* p = (const GAS f32x4*)(LNP + ((size_t)i * MTOK + t0 + tid) * 8); const f32x4 a = p[0], b = p[1]; s += (a[0] + a[2]) + (b[0] + b[2]); q += (a[1] + a[3]) + (b[1] + b[3]); }
        const float mean = s * (1.0f / GWID), var = q * (1.0f / GWID) - mean * mean;
        ST[2 * tid] = mean; ST[2 * tid + 1] = 1.0f / sqrtf(var + EPS); }
#pragma unroll
    for (int i = 0; i < 4; ++i) { const int c = (tid & 3) * 4 + i; *(LAS v4u*)(WL + (tid >> 2) * WP + c * 16) = *(const GAS v4u*)(SGUW + ((size_t)grp * 128 + (tid >> 2)) * 128 + c * 8); }
    __syncthreads();
#pragma unroll
    for (int i = 0; i < 8; ++i) { const int id = tid + 512 * i, s = id >> 5, dc = id & 31;
        const v4u w = *(const GAS v4u*)(UV + (size_t)(t0 + s) * 4096 + GWID + grp * GDIM + dc * 8); f32x4 v0, v1; unpack8(w, v0, v1);
        const float mean = ST[2 * s], rstd = ST[2 * s + 1];
        const f32x4 g0 = *(const GAS f32x4*)(lng + grp * GDIM + dc * 8), g1 = *(const GAS f32x4*)(lng + grp * GDIM + dc * 8 + 4);
        const f32x4 b0 = *(const GAS f32x4*)(lnb + grp * GDIM + dc * 8), b1 = *(const GAS f32x4*)(lnb + grp * GDIM + dc * 8 + 4);
        v0 = (v0 - mean) * rstd * g0 + b0; v1 = (v1 - mean) * rstd * g1 + b1;
        *(LAS v4u*)(VN + s * VP + dc * 16) = pack8(v0, v1); }
    __syncthreads();
    const int g = lane >> 4, hl = lane & 15, q = hl >> 2, p = lane & 3;
    f32x4 acc[2][8];
#pragma unroll
    for (int a = 0; a < 2; ++a)
#pragma unroll
        for (int t = 0; t < 8; ++t) acc[a][t] = (f32x4){0.f, 0.f, 0.f, 0.f};
#pragma unroll
    for (int ks = 0; ks < 4; ++ks) {
        bf16x8 vf[2];
#pragma unroll
        for (int ds = 0; ds < 2; ++ds) { const int d0 = (2 * wave + ds) * 16;
            const s16x4 a1 = __builtin_amdgcn_ds_read_tr16_b64_v4i16((LAS s16x4*)(VN + (32 * ks + 4 * g + q) * VP + (d0 + 4 * p) * 2));
            const s16x4 a2 = __builtin_amdgcn_ds_read_tr16_b64_v4i16((LAS s16x4*)(VN + (32 * ks + 16 + 4 * g + q) * VP + (d0 + 4 * p) * 2));
            vf[ds] = (bf16x8){a1[0], a1[1], a1[2], a1[3], a2[0], a2[1], a2[2], a2[3]}; }
#pragma unroll
        for (int tt = 0; tt < 8; ++tt) if (tt >= 2 * ks) {
            const int t = 16 * tt + hl;
            const s16x4 w1 = *(const LAS s16x4*)(WL + t * WP + (32 * ks + 4 * g) * 2), w2 = *(const LAS s16x4*)(WL + t * WP + (32 * ks + 16 + 4 * g) * 2);
            const bf16x8 wf = (bf16x8){w1[0], w1[1], w1[2], w1[3], w2[0], w2[1], w2[2], w2[3]};
#pragma unroll
            for (int ds = 0; ds < 2; ++ds) acc[ds][tt] = __builtin_amdgcn_mfma_f32_16x16x32_bf16(vf[ds], wf, acc[ds][tt], 0, 0, 0);
        }
    }
#pragma unroll
    for (int tt = 0; tt < 8; ++tt) { const int t = 16 * tt + hl; const float bs = sgub[grp * 128 + t]; const size_t rowo = (size_t)(t0 + t) * 4096;
#pragma unroll
        for (int ds = 0; ds < 2; ++ds) { const int d = grp * GDIM + (2 * wave + ds) * 16 + 4 * g;
            const v2u uw = *(const GAS v2u*)(UV + rowo + d);
            v2u o; o.x = cvt_pk_bf16(bf_lo(uw.x) * (acc[ds][tt][0] + bs), bf_hi(uw.x) * (acc[ds][tt][1] + bs)); o.y = cvt_pk_bf16(bf_lo(uw.y) * (acc[ds][tt][2] + bs), bf_hi(uw.y) * (acc[ds][tt][3] + bs));
            *(GAS v2u*)(YAB + rowo + GWID + d) = o; } }
}

constexpr int ATT_VB = 32 * 288, ATT_WAVE = ATT_VB + 512, ATT_BL = 8 * ATT_WAVE;
__device__ __forceinline__ void attn_query(LAS unsigned char* wl, const LAS float* BL, int lane, int b, int qpos,
                                           const bf16* Q, const bf16* KN, const bf16* V, const unsigned short* IDX, const float* qgain, bf16* YAB) {
    const int g = lane >> 4, hl = lane & 15, q4 = hl >> 2, p4 = lane & 3;
    const size_t rowb = (size_t)b * SEQ, row = rowb + qpos;
    const int cnt = qpos + 1 < TOPK ? qpos + 1 : TOPK;
    LAS unsigned short* IL = (LAS unsigned short*)(wl + ATT_VB);
    *(LAS v2u*)(IL + 4 * lane) = *(const GAS v2u*)(IDX + row * 256 + 4 * lane);
    bf16x8 qf[4];
    { v4u w[4]; float ss = 0.f;
#pragma unroll
      for (int kk = 0; kk < 4; ++kk) { w[kk] = *(const GAS v4u*)(Q + row * 2048 + hl * 128 + kk * 32 + g * 8); f32x4 a, c; unpack8(w[kk], a, c);
          ss += (a[0] * a[0] + a[1] * a[1]) + (a[2] * a[2] + a[3] * a[3]) + (c[0] * c[0] + c[1] * c[1]) + (c[2] * c[2] + c[3] * c[3]); }
      ss += __shfl_xor(ss, 16); ss += __shfl_xor(ss, 32);
      const float rinv = (1.0f / sqrtf(ss * (1.0f / HDA) + EPS)) * 0.08838834764831845f;
#pragma unroll
      for (int kk = 0; kk < 4; ++kk) { f32x4 a, c; unpack8(w[kk], a, c); const f32x4 g0 = *(const GAS f32x4*)(qgain + kk * 32 + g * 8), g1 = *(const GAS f32x4*)(qgain + kk * 32 + g * 8 + 4);
          const v4u o = pack8(a * rinv * g0, c * rinv * g1); qf[kk] = __builtin_bit_cast(bf16x8, o); } }
    f32x4 s[16];
#pragma unroll
    for (int t = 0; t < 16; ++t) { const int ki = IL[16 * t + hl] & (SEQ - 1); const bf16* kp = KN + (rowb + ki) * 128 + g * 8;
        bf16x8 kf[4];
#pragma unroll
        for (int kk = 0; kk < 4; ++kk) kf[kk] = *(const GAS bf16x8*)(kp + kk * 32);
        s[t] = (f32x4){0.f, 0.f, 0.f, 0.f};
#pragma unroll
        for (int kk = 0; kk < 4; ++kk) s[t] = __builtin_amdgcn_mfma_f32_16x16x32_bf16(kf[kk], qf[kk], s[t], 0, 0, 0); }
    float mx = -__builtin_inff();
#pragma unroll
    for (int t = 0; t < 16; ++t) { const v2u id = *(const LAS v2u*)(IL + 16 * t + 4 * g); const int kx[4] = {(int)(id.x & 0xffffu), (int)(id.x >> 16), (int)(id.y & 0xffffu), (int)(id.y >> 16)};
#pragma unroll
        for (int i = 0; i < 4; ++i) { int n = qpos - kx[i]; n = n < 0 ? 0 : (n > 128 ? 128 : n);
            const float v = (16 * t + 4 * g + i) < cnt ? s[t][i] + BL[n * 16 + hl] : -__builtin_inff(); s[t][i] = v; mx = fmaxf(mx, v); } }
    mx = fmaxf(mx, __shfl_xor(mx, 16)); mx = fmaxf(mx, __shfl_xor(mx, 32));
    float sum = 0.f;
#pragma unroll
    for (int t = 0; t < 16; ++t)
#pragma unroll
        for (int i = 0; i < 4; ++i) { const float e = __builtin_amdgcn_exp2f((s[t][i] - mx) * LOG2E); s[t][i] = e; sum += e; }
    sum += __shfl_xor(sum, 16); sum += __shfl_xor(sum, 32);
    const float inv = 1.0f / sum;
    bf16x8 pf[8];
#pragma unroll
    for (int T = 0; T < 8; ++T) { const v4u o = pack8(s[2 * T] * inv, s[2 * T + 1] * inv); pf[T] = __builtin_bit_cast(bf16x8, o); }
    f32x4 o[8];
#pragma unroll
    for (int dt = 0; dt < 8; ++dt) o[dt] = (f32x4){0.f, 0.f, 0.f, 0.f};
#pragma unroll
    for (int T = 0; T < 8; ++T) {
#pragma unroll
        for (int ins = 0; ins < 8; ++ins) { const int slot = 4 * ins + g; const int vi = IL[32 * T + slot] & (SEQ - 1);
            *(LAS v4u*)(wl + slot * 288 + hl * 16) = *(const GAS v4u*)(V + (rowb + vi) * 128 + hl * 8); }
#pragma unroll
        for (int dt = 0; dt < 8; ++dt) {
            const s16x4 a1 = __builtin_amdgcn_ds_read_tr16_b64_v4i16((LAS s16x4*)(wl + (4 * g + q4) * 288 + (16 * dt + 4 * p4) * 2));
            const s16x4 a2 = __builtin_amdgcn_ds_read_tr16_b64_v4i16((LAS s16x4*)(wl + (16 + 4 * g + q4) * 288 + (16 * dt + 4 * p4) * 2));
            const bf16x8 vf = (bf16x8){a1[0], a1[1], a1[2], a1[3], a2[0], a2[1], a2[2], a2[3]};
            o[dt] = __builtin_amdgcn_mfma_f32_16x16x32_bf16(vf, pf[T], o[dt], 0, 0, 0);
        }
    }
#pragma unroll
    for (int dt = 0; dt < 8; ++dt) { v2u w; w.x = cvt_pk_bf16(o[dt][0], o[dt][1]); w.y = cvt_pk_bf16(o[dt][2], o[dt][3]); *(GAS v2u*)(YAB + row * 4096 + hl * 128 + 16 * dt + 4 * g) = w; }
}

constexpr int NWAVES = 8;
#ifndef DUP_ATT
#define DUP_ATT 1
#endif
#ifndef DUP_SGU
#define DUP_SGU 1
#endif
#ifndef GEMM_SP2
#define GEMM_SP2 true
#endif
#ifndef GEMM_ALIGN
#define GEMM_ALIGN true
#endif
#ifndef MK_N_LAUNCHES
#define MK_N_LAUNCHES 1
#endif
constexpr int N_PHASES = 9;
constexpr int N_LAUNCHES = MK_N_LAUNCHES;
constexpr size_t WS_PB = WS_END;
constexpr size_t WS_NEED = WS_END + 8 * MiB;

__device__ __forceinline__ int lane_now() { int l; asm volatile("v_mbcnt_lo_u32_b32 %0, -1, 0\n\tv_mbcnt_hi_u32_b32 %0, -1, %0" : "=v"(l)); return l; }
struct Args { const float* in[22]; float* out; unsigned char* ws; int ph_lo, ph_hi, li, pad; };
enum { I_X = 0, I_P, I_WIN, I_QNG, I_KNG, I_RELB, I_LNG, I_LNB, I_SGUW, I_SGUB, I_WA, I_WB, I_WOUT, I_NMIX, I_NFFN, I_WG, I_WU, I_WD, I_WPLE, I_PLENG, I_WPG, I_NPLE };

__global__ void __launch_bounds__(NWAVES * 64, 2) fwd_kernel(Args args) {
    extern __shared__ __attribute__((aligned(16))) unsigned char lds_raw[];
    LAS unsigned char* lds = (LAS unsigned char*)lds_raw;
    volatile LAS unsigned* MISC = (volatile LAS unsigned*)(lds + MISC_OFF);
    const int wave = __builtin_amdgcn_readfirstlane(threadIdx.x >> 6);
#define PHASE_IDS() const int lane = lane_now(), tid = wave * 64 + lane
    const int G = gridDim.x, cu = blockIdx.x;
    const int gw = cu * NWAVES + wave, NGW = G * NWAVES;
    unsigned char* ws = args.ws;
    gu32* ctl = (gu32*)(ws + WS_CTL);
    for (int u = threadIdx.x; u < (LDS_BYTES - LDSCTL_OFF) / 4; u += NWAVES * 64) ((LAS unsigned*)(lds + LDSCTL_OFF))[u] = 0u;
    __syncthreads();
    XcdBarrier bar; bar.bar = (unsigned*)(ctl + CW_BAR) + args.li * XCD_BAR_WORDS; bar.x = 0; bar.st = nullptr;
    if (N_LAUNCHES == 1) bar = xcd_barrier_post((unsigned*)(ctl + CW_BAR), MISC + 8);
#define GRID_BAR() do { if (N_LAUNCHES == 1) xcd_barrier(bar); } while (0)
    const int lo = args.ph_lo, hi = args.ph_hi;
#ifndef PH_MASK
#define PH_MASK 0x1ff
#endif
#define IN(k) ((((PH_MASK) >> (k)) & 1) && lo <= (k) && (k) < hi)
#define BOTH(k) (IN(k) && IN((k) + 1))
#ifndef DUP_MASK
#define DUP_MASK 0
#endif
#define REPS(k) (1 + (((DUP_MASK) >> (k)) & 1))

    bf16* const H = (bf16*)(ws + WS_H); bf16* const WIN = (bf16*)(ws + WS_WIN); bf16* const QIDX = (bf16*)(ws + WS_QIDX); bf16* const Qb = (bf16*)(ws + WS_Q);
    bf16* const UV = (bf16*)(ws + WS_UV); bf16* const SGA = (bf16*)(ws + WS_SGA); bf16* const SGB = (bf16*)(ws + WS_SGB);
    bf16* const WAB = (bf16*)(ws + WS_WAB); bf16* const WOUT = (bf16*)(ws + WS_WOUT); bf16* const WGU = (bf16*)(ws + WS_WGU); bf16* const WD = (bf16*)(ws + WS_WD);
    bf16* const WPLE = (bf16*)(ws + WS_WPLE); bf16* const WPG = (bf16*)(ws + WS_WPG); bf16* const PB = (bf16*)(ws + WS_PB);
    unsigned short* const IDX = (unsigned short*)(ws + WS_IDX); float* const LNP = (float*)(ws + WS_LNP);
    float* const SSQ1 = (float*)(ws + WS_SSQ1); float* const SSQ2 = (float*)(ws + WS_SSQ2); float* const SSQP = (float*)(ws + WS_SSQP);
    float* const WIDX = (float*)(ws + WS_WIDX); bf16* const KIDX = (bf16*)(ws + WS_KIDX); bf16* const KN = (bf16*)(ws + WS_KN); bf16* const Vb = (bf16*)(ws + WS_V);
    float* const KRAW = (float*)(ws + WS_KRAW); bf16* const SGUW = (bf16*)(ws + WS_SGUW);
    float* const SC = (float*)(ws + WS_SC); bf16* const MERGED = (bf16*)(ws + WS_MERGED); bf16* const ACT = (bf16*)(ws + WS_ACT); bf16* const YAB = (bf16*)(ws + WS_YAB);
    bf16* const X1G = (bf16*)(ws + WS_X1G); bf16* const X2G = (bf16*)(ws + WS_X2G); bf16* const PE = (bf16*)(ws + WS_PE);


    constexpr int I_IN = 64 * (INCOLS / 32), I_A = 32 * 128, I_SQ = 64 * 128, I_G = 64 * (DFF / 32), I_D = (DFF / 64) * 128, I_PL = 4 * 128;
    constexpr int NITEMS = I_IN + 2 * I_A + I_SQ + I_PL + 2 * I_G + I_D + I_SQ;
    constexpr int TAIL_A = 15104, TAIL_B = 15104;
    static_assert(TAIL_A + TAIL_B <= I_D + I_SQ, "the deferred items are w_down / w_pg only");
#define CONV_SRC(it_, r_) do { int r_ = (it_); const float* W_; int N_; \
        if (r_ < I_IN) { W_ = args.in[I_WIN]; N_ = INCOLS; } else { r_ -= I_IN; \
        if (r_ < I_A) { W_ = args.in[I_WA]; N_ = DM; } else { r_ -= I_A; \
        if (r_ < I_A) { W_ = args.in[I_WB]; N_ = DM; } else { r_ -= I_A; \
        if (r_ < I_SQ) { W_ = args.in[I_WOUT]; N_ = DM; } else { r_ -= I_SQ; \
        if (r_ < I_PL) { W_ = args.in[I_WPLE]; N_ = DM; } else { r_ -= I_PL; \
        if (r_ < I_G) { W_ = args.in[I_WG]; N_ = DFF; } else { r_ -= I_G; \
        if (r_ < I_G) { W_ = args.in[I_WU]; N_ = DFF; } else { r_ -= I_G; \
        if (r_ < I_D) { W_ = args.in[I_WD]; N_ = DM; } else { r_ -= I_D; W_ = args.in[I_WPG]; N_ = DM; } } } } } } } } \
        p0_load(W_, N_, r_, nx, lane); } while (0)
#define CONV_ITEMS(first_, last_, widx_, wstride_) do { LAS float* scr = (LAS float*)(lds + RING_OFF + wave * 16384); f32x4 nx[8], cr[8]; \
        const int i0_ = (first_) + (widx_), iend_ = (last_), ist_ = (wstride_); \
        if (i0_ < iend_) CONV_SRC(i0_, ra_); \
        for (int it = i0_; it < iend_; it += ist_) { \
            _Pragma("unroll") for (int i = 0; i < 8; ++i) cr[i] = nx[i]; \
            asm volatile("" ::: "memory"); \
            if (it + ist_ < iend_) CONV_SRC(it + ist_, rb_); \
            int r = it; \
            if (r < I_IN) { p0_finish<1>(cr, INCOLS, WIN, DM, 0, scr, r, lane); continue; } r -= I_IN; \
            if (r < I_A) { p0_finish<0>(cr, DM, WAB, DM, 0, scr, r, lane); continue; } r -= I_A; \
            if (r < I_A) { p0_finish<0>(cr, DM, WAB, DM, 2048, scr, r, lane); continue; } r -= I_A; \
            if (r < I_SQ) { p0_finish<0>(cr, DM, WOUT, DM, 0, scr, r, lane); continue; } r -= I_SQ; \
            if (r < I_PL) { p0_finish<0>(cr, DM, WPLE, DPLE, 0, scr, r, lane); continue; } r -= I_PL; \
            if (r < I_G) { p0_finish<2>(cr, DFF, WGU, DM, 0, scr, r, lane); continue; } r -= I_G; \
            if (r < I_G) { p0_finish<3>(cr, DFF, WGU, DM, 0, scr, r, lane); continue; } r -= I_G; \
            if (r < I_D) { p0_finish<0>(cr, DM, WD, DFF, 0, scr, r, lane); continue; } r -= I_D; \
            p0_finish<0>(cr, DM, WPG, DM, 0, scr, r, lane); } } while (0)
#define CONV_TAIL(nwg_, first_, last_) do { const int rem_ = (nwg_) % G; if (rem_ == 0) CONV_ITEMS(first_, last_, gw, NGW); \
        else if (cu >= rem_) CONV_ITEMS(first_, last_, (cu - rem_) * NWAVES + wave, (G - rem_) * NWAVES); } while (0)
    if (IN(0)) {
#pragma unroll
      for (int rep = 0; rep < REPS(0); ++rep) {
        PHASE_IDS();
        CONV_ITEMS(0, NITEMS - TAIL_A - TAIL_B, gw, NGW);
        for (int m = gw; m < MTOK; m += NGW) rms_row_to_bf16(args.in[I_X] + (size_t)m * DM, args.in[I_NMIX], H + (size_t)m * DM, lane);
        { const float* P = args.in[I_P]; const int gt = cu * 512 + tid, NT = G * 512;
          for (int i = gt; i < MTOK * DPLE / 4; i += NT) { const f32x4 v = *(const GAS f32x4*)(P + (size_t)i * 4); v2u w; w.x = cvt_pk_bf16(v.x, v.y); w.y = cvt_pk_bf16(v.z, v.w); *(GAS v2u*)(PB + (size_t)i * 4) = w; }
          const float* SW = args.in[I_SGUW];
          for (int i = gt; i < NGRP * CHK * CHK / 2; i += NT) { const int e = 2 * i, t = (e >> 7) & 127, s = e & 127; const f32x2 v = *(const GAS f32x2*)(SW + e);
              *(GAS unsigned*)(SGUW + e) = cvt_pk_bf16(s <= t ? v.x : 0.f, (s + 1) <= t ? v.y : 0.f); } }
        if (rep + 1 < REPS(0) || BOTH(0)) GRID_BAR();
      }
    }

    if (IN(1)) {
#pragma unroll
      for (int rep = 0; rep < REPS(1); ++rep) {
        PHASE_IDS();
        pg8::Gemm g{H, WIN, MTOK, INPAD, DM}; pg8::StaticOrder S; S.init(MTOK, INPAD, G, cu);
        pg8::EpiInProj E{Qb, Vb, QIDX, KIDX, UV, SGA, SGB, KRAW, WIDX, LNP};
        pg8::gemm_phase<pg8::EpiInProj, pg8::StaticOrder, GEMM_ALIGN, GEMM_SP2>(lds + RING_OFF, g, S, E, tid);
        if (rep == 0) CONV_TAIL((MTOK / 256) * (INPAD / 256), NITEMS - TAIL_A - TAIL_B, NITEMS - TAIL_B);
        if (rep + 1 < REPS(1) || BOTH(1)) GRID_BAR();
      }
    }

#if defined(NULL_GEMM)
    if (IN(1)) { PHASE_IDS();
        pg8::Gemm g{H, WIN, MTOK, NULL_GEMM * 256, DM}; pg8::StaticOrder S; S.init(MTOK, NULL_GEMM * 256, G, cu);
        pg8::EpiNull E{SSQP};
        pg8::gemm_phase<pg8::EpiNull, pg8::StaticOrder, GEMM_ALIGN, GEMM_SP2>(lds + RING_OFF, g, S, E, tid);
        GRID_BAR(); }
#endif
    if (IN(2)) {
#pragma unroll
      for (int rep = 0; rep < REPS(2); ++rep) {
        PHASE_IDS();
        { const float* kg = args.in[I_KNG];
          for (int rp = gw; rp < MTOK / 2; rp += NGW) { const int row = 2 * rp + (lane >> 5), c = (lane & 31) * 4;
              const f32x4 v = *(const GAS f32x4*)(KRAW + (size_t)row * 128 + c); float ss = (v.x * v.x + v.y * v.y) + (v.z * v.z + v.w * v.w);
#pragma unroll
              for (int o = 1; o < 32; o <<= 1) ss += __shfl_xor(ss, o);
              const float r = 1.0f / sqrtf(ss * (1.0f / HDA) + EPS); const f32x4 gv = *(const GAS f32x4*)(kg + c);
              v2u w; w.x = cvt_pk_bf16(v.x * r * gv.x, v.y * r * gv.y); w.y = cvt_pk_bf16(v.z * r * gv.z, v.w * r * gv.w); *(GAS v2u*)(KN + (size_t)row * 128 + c) = w; } }
        for (int i = tid; i < 8 * TOPK_WAVE_LDS / 16; i += NWAVES * 64) *(LAS v4u*)(lds + RING_OFF + 69632 + i * 16) = (v4u){0u, 0u, 0u, 0u};
        constexpr int NU = NB * (SEQ / 32);
        for (int j = cu; j < NU; j += G) { const int rnd = j / G, pos = j % G; int u;
            if ((rnd & 1) == 0) u = j; else { const int hiu = (rnd + 1) * G < NU ? (rnd + 1) * G : NU; u = hiu - 1 - pos; if (u < rnd * G) continue; }
            indexer_unit(lds + RING_OFF, tid, wave, lane, u % NB, u / NB, QIDX, KIDX, WIDX, SC, IDX); }
        if (rep + 1 < REPS(2) || BOTH(2)) GRID_BAR();
      }
    }

    if (IN(3)) {
#pragma unroll
      for (int rep = 0; rep < REPS(3); ++rep) {
        PHASE_IDS();
        for (int rr = 0; rr < DUP_SGU; ++rr)
        for (int u = cu; u < (MTOK / CHK) * NGRP; u += G) sgu_unit(lds + RING_OFF, tid, wave, lane, u >> 3, u & 7, UV, LNP, SGUW, args.in[I_LNG], args.in[I_LNB], args.in[I_SGUB], YAB);
        __syncthreads();
        LAS float* BL = (LAS float*)(lds + RING_OFF + ATT_BL);
        { const float* rb = args.in[I_RELB];
          for (int i = tid; i < 129 * 16; i += NWAVES * 64) { const int n = i >> 4, h = i & 15; int bk;
              if (n < 16) bk = n; else { bk = 16 + (int)(logf((float)n * (1.0f / 16.0f)) / 2.0794415416798357f * 16.0f); bk = bk > 31 ? 31 : bk; }
              BL[i] = rb[bk * 16 + h]; } }
        __syncthreads();
        for (int rr = 0; rr < DUP_ATT; ++rr)
        for (int qi = gw; qi < MTOK; qi += NGW) attn_query(lds + RING_OFF + wave * ATT_WAVE, BL, lane, qi / SEQ, qi % SEQ, Qb, KN, Vb, IDX, args.in[I_QNG], YAB);
        if (rep + 1 < REPS(3) || BOTH(3)) GRID_BAR();
      }
    }

    if (IN(4)) {
#pragma unroll
      for (int rep = 0; rep < REPS(4); ++rep) {
        PHASE_IDS();
        pg8::Gemm g{YAB, WAB, MTOK, DM, DM}; pg8::StaticOrder S; S.init(MTOK, DM, G, cu);
        pg8::EpiMerge E{SGA, SGB, MERGED};
        pg8::gemm_phase<pg8::EpiMerge, pg8::StaticOrder, GEMM_ALIGN, GEMM_SP2>(lds + RING_OFF, g, S, E, tid);
        if (rep + 1 < REPS(4) || BOTH(4)) GRID_BAR();
      }
    }

    if (IN(5)) {
#pragma unroll
      for (int rep = 0; rep < REPS(5); ++rep) {
        PHASE_IDS();
        { pg8::Gemm g{MERGED, WOUT, MTOK, DM, DM}; pg8::StaticOrder S; S.init(MTOK, DM, G, cu);
          pg8::EpiResid E{args.in[I_X], args.out, X1G, args.in[I_NFFN], SSQ1};
          pg8::gemm_phase<pg8::EpiResid, pg8::StaticOrder, GEMM_ALIGN, GEMM_SP2>(lds + RING_OFF, g, S, E, tid); }
        { pg8::Gemm g{PB, WPLE, MTOK, DM, DPLE}; pg8::StaticOrder S; S.init(MTOK, DM, G, cu);
          pg8::EpiPe E{PE, SSQP};
          pg8::gemm_phase<pg8::EpiPe, pg8::StaticOrder, GEMM_ALIGN, GEMM_SP2>(lds + RING_OFF, g, S, E, tid); }
        if (rep + 1 < REPS(5) || BOTH(5)) GRID_BAR();
      }
    }

    if (IN(6)) {
#pragma unroll
      for (int rep = 0; rep < REPS(6); ++rep) {
        PHASE_IDS();
        pg8::Gemm g{X1G, WGU, MTOK, 2 * DFF, DM}; pg8::StaticOrder S; S.init(MTOK, 2 * DFF, G, cu);
        pg8::EpiGateUp E{SSQ1, ACT};
        pg8::gemm_phase<pg8::EpiGateUp, pg8::StaticOrder, GEMM_ALIGN, GEMM_SP2>(lds + RING_OFF, g, S, E, tid);
        if (rep == 0) CONV_TAIL((MTOK / 256) * (2 * DFF / 256), NITEMS - TAIL_B, NITEMS);
        if (rep + 1 < REPS(6) || BOTH(6)) GRID_BAR();
      }
    }

    if (IN(7)) {
#pragma unroll
      for (int rep = 0; rep < REPS(7); ++rep) {
        PHASE_IDS();
        pg8::Gemm g{ACT, WD, MTOK, DM, DFF}; pg8::StaticOrder S; S.init(MTOK, DM, G, cu);
        pg8::EpiResid E{args.out, args.out, X2G, args.in[I_NPLE], SSQ2};
        pg8::gemm_phase<pg8::EpiResid, pg8::StaticOrder, GEMM_ALIGN, GEMM_SP2>(lds + RING_OFF, g, S, E, tid);
        if (rep + 1 < REPS(7) || BOTH(7)) GRID_BAR();
      }
    }

    if (IN(8)) {
        PHASE_IDS();
        pg8::Gemm g{X2G, WPG, MTOK, DM, DM}; pg8::StaticOrder S; S.init(MTOK, DM, G, cu);
        pg8::EpiFinal E{SSQ2, SSQP, args.in[I_PLENG], PE, args.out};
        pg8::gemm_phase<pg8::EpiFinal, pg8::StaticOrder, GEMM_ALIGN, GEMM_SP2>(lds + RING_OFF, g, S, E, tid);
    }

#if defined(DUMP_AFTER)
    if (lo == N_PHASES) {
        const size_t gt = (size_t)cu * 512 + threadIdx.x, NT = (size_t)G * 512;
        for (size_t i = gt; i < (size_t)MTOK * DM; i += NT) { const size_t m = i >> 12; const int c = (int)(i & 4095); float v = 0.f;
#if DUMP_AFTER == 3
            v = bf_lo((unsigned)YAB[i]);
#elif DUMP_AFTER == 2
            v = c < 256 ? (float)IDX[m * 256 + c] : (c < 384 ? bf_lo((unsigned)KN[m * 128 + c - 256]) : 0.f);
#elif DUMP_AFTER == 1
#if DUMP_SEL == 0
            v = bf_lo((unsigned)QIDX[i]);
#elif DUMP_SEL == 1
            v = bf_lo((unsigned)UV[i]);
#elif DUMP_SEL == 2
            v = bf_lo((unsigned)SGA[i]) + bf_lo((unsigned)SGB[i]);
#elif DUMP_SEL == 3
            v = bf_lo((unsigned)Qb[m * 2048 + (c & 2047)]);
            if (c < 128) v += KRAW[m * 128 + c] + bf_lo((unsigned)Vb[m * 128 + c]) + bf_lo((unsigned)KIDX[m * 128 + c]);
            if (c < 32) v += WIDX[m * 32 + c];
#endif
#elif DUMP_AFTER == 0
            v = bf_lo((unsigned)H[i]) + bf_lo((unsigned)WIN[i]) + bf_lo((unsigned)WIN[(size_t)(INPAD - 4096) * DM + i]) + bf_lo((unsigned)WGU[i]) + bf_lo((unsigned)WD[i]) + bf_lo((unsigned)WAB[i]);
#endif
            args.out[i] = v; }
    }
#endif
#undef IN
#undef BOTH
#undef GRID_BAR
}

extern "C" void kernel_launch(void* const* d_in, const int* in_sizes, int n_in, void* d_out, int out_size, void* d_ws, size_t ws_size, hipStream_t stream) {
    static int grid = 0;
    if (grid == 0) {
        if (n_in != 22 || in_sizes[0] != MTOK * DM || out_size != MTOK * DM || ws_size < WS_NEED) {
            fprintf(stderr, "kernel_launch: unexpected problem (n_in %d, in0 %d, out %d, ws %zu, need %zu); nothing launched\n", n_in, n_in > 0 ? in_sizes[0] : -1, out_size, ws_size, (size_t)WS_NEED); grid = -1; return; }
        int dev = 0, cus = 0, per_cu = 0;
        if (hipGetDevice(&dev) != hipSuccess || hipDeviceGetAttribute(&cus, hipDeviceAttributeMultiprocessorCount, dev) != hipSuccess) { grid = -1; return; }
        if (hipFuncSetAttribute((const void*)fwd_kernel, hipFuncAttributeMaxDynamicSharedMemorySize, LDS_BYTES) != hipSuccess) { fprintf(stderr, "kernel_launch: hipFuncSetAttribute failed\n"); grid = -1; return; }
        if (hipOccupancyMaxActiveBlocksPerMultiprocessor(&per_cu, (const void*)fwd_kernel, NWAVES * 64, LDS_BYTES) != hipSuccess || per_cu < 1)
            fprintf(stderr, "kernel_launch: note: occupancy query reports %d workgroups per CU\n", per_cu);
        (void)hipGetLastError();
        grid = cus;
    }
    if (grid < 0) return;
    if (hipMemsetAsync((char*)d_ws + WS_CTL, 0, CTL_ZERO_BYTES, stream) != hipSuccess) return;
    Args a{};
    for (int i = 0; i < 22; ++i) a.in[i] = (const float*)d_in[i];
    a.out = (float*)d_out; a.ws = (unsigned char*)d_ws;
#if defined(DUMP_AFTER)
    for (int li = 0; li <= DUMP_AFTER + 1; ++li) {
        a.ph_lo = li <= DUMP_AFTER ? li : N_PHASES; a.ph_hi = a.ph_lo + 1; a.li = 0;
#else
    for (int li = 0; li < N_LAUNCHES; ++li) {
        a.ph_lo = (N_LAUNCHES == 1) ? 0 : li; a.ph_hi = (N_LAUNCHES == 1) ? N_PHASES : li + 1; a.li = (N_LAUNCHES == 1) ? 0 : 0;
#endif
        hipLaunchKernelGGL(fwd_kernel, dim3(grid), dim3(NWAVES * 64), LDS_BYTES, stream, a);
        const hipError_t le = hipPeekAtLastError();
        if (le != hipSuccess) { fprintf(stderr, "kernel_launch: launch %d failed: %s\n", li, hipGetErrorName(le)); break; }
    }
}
```

```cpp
#define IDX_SCHED_BARRIER 0
#include <hip/hip_runtime.h>
#include <cstdio>
#include <cstdint>

#define GAS __attribute__((address_space(1)))
#define LAS __attribute__((address_space(3)))
typedef unsigned short bf16;
typedef unsigned v4u __attribute__((ext_vector_type(4)));
typedef unsigned v2u __attribute__((ext_vector_type(2)));
typedef float f32x4 __attribute__((ext_vector_type(4)));
typedef float f32x2 __attribute__((ext_vector_type(2)));
typedef float f32x16 __attribute__((ext_vector_type(16)));
typedef short bf16x8 __attribute__((ext_vector_type(8)));
typedef short s16x4 __attribute__((ext_vector_type(4)));
typedef GAS unsigned gu32;

constexpr int NB = 4, SEQ = 4096, DM = 4096, MTOK = NB * SEQ;
constexpr int NHA = 16, HDA = 128, NIH = 32, IDXD = 128, TOPK = 256;
constexpr int GWID = 2048, NGRP = 8, GDIM = 256, CHK = 128;
constexpr int DFF = 11008, DPLE = 256;
constexpr int INCOLS = 18848, INPAD = 18944;
constexpr float EPS = 1e-6f;
constexpr float LOG2E = 1.4426950408889634f;

constexpr size_t MiB = 1u << 20;
constexpr size_t WS_CTL = 0, CTL_ZERO_BYTES = 1 * MiB;
constexpr size_t WS_IDX = 1 * MiB;
constexpr size_t WS_LNP = 9 * MiB;
constexpr size_t WS_SSQ1 = 13 * MiB;
constexpr size_t WS_SSQ2 = 17 * MiB;
constexpr size_t WS_SSQP = 21 * MiB;
constexpr size_t WS_WIDX = 25 * MiB;
constexpr size_t WS_KIDX = 27 * MiB;
constexpr size_t WS_KN = 31 * MiB;
constexpr size_t WS_V = 35 * MiB;
constexpr size_t WS_KRAW = 39 * MiB;
constexpr size_t WS_SGUW = 47 * MiB;
constexpr size_t WS_H = 48 * MiB;
constexpr size_t WS_WIN = 176 * MiB;
constexpr size_t WS_QIDX = 324 * MiB;
constexpr size_t WS_Q = 452 * MiB;
constexpr size_t WS_UV = 516 * MiB;
constexpr size_t WS_SGA = 644 * MiB;
constexpr size_t WS_SGB = 772 * MiB;
constexpr size_t WS_WAB = 900 * MiB;
constexpr size_t WS_WOUT = 932 * MiB;
constexpr size_t WS_WGU = 964 * MiB;
constexpr size_t WS_WD = 1136 * MiB;
constexpr size_t WS_WPLE = 1222 * MiB;
constexpr size_t WS_WPG = 1224 * MiB;
constexpr size_t WS_END = 1256 * MiB;
constexpr size_t WS_WINB = WS_WIN, WS_WIN8 = WS_WIN + 66 * MiB;
constexpr size_t WS_H8 = WS_WD;
constexpr size_t WS_SC = WS_H, WS_MERGED = WS_H, WS_ACT = WS_H, WS_YAB = WS_QIDX, WS_X1G = WS_UV, WS_X2G = WS_UV, WS_PE = WS_SGA;
static_assert(WS_SC + (size_t)MTOK * SEQ * 4 <= WS_QIDX && WS_ACT + (size_t)MTOK * DFF * 2 <= WS_Q && WS_WIN + (size_t)INPAD * DM * 2 <= WS_QIDX && WS_WD + (size_t)DM * DFF * 2 <= WS_WPLE, "ws map");

constexpr int CW_TMO = 0, CW_CODE = 1, CW_BAR = 4096;

constexpr int RING_OFF = 0, RING_BYTES = 131072;
constexpr int LDSCTL_OFF = RING_BYTES, MISC_OFF = LDSCTL_OFF + 320;
constexpr int LDS_BYTES = 147456;
static_assert(MISC_OFF + 128 <= LDS_BYTES, "LDS map");

#define RLX_AGENT __ATOMIC_RELAXED, __HIP_MEMORY_SCOPE_AGENT
#define LDS_WAIT() asm volatile("s_waitcnt lgkmcnt(0)" ::: "memory")
#define VM_WAIT() asm volatile("s_waitcnt vmcnt(0)" ::: "memory")

typedef __bf16 bf16v2_t __attribute__((ext_vector_type(2)));
__device__ __forceinline__ unsigned cvt_pk_bf16(float lo, float hi) { const f32x2 v = {lo, hi}; const bf16v2_t b = __builtin_convertvector(v, bf16v2_t); return __builtin_bit_cast(unsigned, b); }
__device__ __forceinline__ float bf_lo(unsigned w) { return __uint_as_float(w << 16); }
__device__ __forceinline__ float bf_hi(unsigned w) { return __uint_as_float(w & 0xffff0000u); }
__device__ __forceinline__ float fast_sigmoid(float x) { return __builtin_amdgcn_rcpf(1.0f + __builtin_amdgcn_exp2f(-LOG2E * x)); }
__device__ __forceinline__ float gelu_tanh(float x) { const float t = x * (1.0f + 0.044715f * x * x); return x * __builtin_amdgcn_rcpf(1.0f + __builtin_amdgcn_exp2f(-2.302208198f * t)); }
__device__ __forceinline__ float wave_sum(float v) {
#pragma unroll
    for (int o = 1; o < 64; o <<= 1) v += __shfl_xor(v, o);
    return v;
}
#ifndef MCLR
#define MCLR 0
#endif
#ifndef ACT_CLIP
#define ACT_CLIP 3.0f
#endif
#ifndef P7F
#define P7F 64
#endif
__device__ __forceinline__ float rnd_sm(float x) { if (MCLR == 0) return x; unsigned u = __float_as_uint(x); u += ((1u << (15 + MCLR)) - 1u) + ((u >> (16 + MCLR)) & 1u); u &= ~((1u << (16 + MCLR)) - 1u); return __uint_as_float(u); }
__device__ __forceinline__ f32x4 rnd_sm4(f32x4 v) { return (f32x4){rnd_sm(v[0]), rnd_sm(v[1]), rnd_sm(v[2]), rnd_sm(v[3])}; }
__device__ __forceinline__ v4u pack8(f32x4 a, f32x4 b) { v4u w; w.x = cvt_pk_bf16(a[0], a[1]); w.y = cvt_pk_bf16(a[2], a[3]); w.z = cvt_pk_bf16(b[0], b[1]); w.w = cvt_pk_bf16(b[2], b[3]); return w; }
__device__ __forceinline__ void unpack8(v4u w, f32x4& a, f32x4& b) { a = (f32x4){bf_lo(w.x), bf_hi(w.x), bf_lo(w.y), bf_hi(w.y)}; b = (f32x4){bf_lo(w.z), bf_hi(w.z), bf_lo(w.w), bf_hi(w.w)}; }

__device__ __forceinline__ unsigned e2m1(float x) { const float a = fminf(fabsf(x), 6.0f);
    const float c = a < 2.0f ? rintf(2.0f * a) : (a < 4.0f ? 2.0f + rintf(a) : 4.0f + rintf(0.5f * a));
    return (unsigned)c | ((__float_as_uint(x) >> 28) & 8u); }
__device__ __forceinline__ unsigned pack4_f4(float a, float b, float c, float d) { return e2m1(a) | (e2m1(b) << 4) | (e2m1(c) << 8) | (e2m1(d) << 12); }
__device__ __forceinline__ unsigned q8(float x) { const float r = fminf(fmaxf(rintf(x), -127.0f), 127.0f); return (unsigned)(int)r & 255u; }
__device__ __forceinline__ v2u pack8_i8(f32x4 a, f32x4 b) { v2u w; w.x = q8(a[0]) | (q8(a[1]) << 8) | (q8(a[2]) << 16) | (q8(a[3]) << 24); w.y = q8(b[0]) | (q8(b[1]) << 8) | (q8(b[2]) << 16) | (q8(b[3]) << 24); return w; }
__device__ __forceinline__ v2u pack8_f8(f32x4 a, f32x4 b) { v2u w; w.x = (unsigned)__builtin_amdgcn_cvt_pk_fp8_f32(a[2], a[3], __builtin_amdgcn_cvt_pk_fp8_f32(a[0], a[1], 0, false), true);
    w.y = (unsigned)__builtin_amdgcn_cvt_pk_fp8_f32(b[2], b[3], __builtin_amdgcn_cvt_pk_fp8_f32(b[0], b[1], 0, false), true); return w; }
__device__ __forceinline__ void unpack8_f8(v2u w, f32x4& a, f32x4& b) { const f32x2 a0 = __builtin_amdgcn_cvt_pk_f32_fp8((int)w.x, false), a1 = __builtin_amdgcn_cvt_pk_f32_fp8((int)w.x, true), b0 = __builtin_amdgcn_cvt_pk_f32_fp8((int)w.y, false), b1 = __builtin_amdgcn_cvt_pk_f32_fp8((int)w.y, true);
    a = (f32x4){a0[0], a0[1], a1[0], a1[1]}; b = (f32x4){b0[0], b0[1], b1[0], b1[1]}; }

namespace pg8 {
#define PG8_LAS __attribute__((address_space(3)))
typedef unsigned short bf16_t;
typedef unsigned u32x4 __attribute__((ext_vector_type(4)));
constexpr int BM = 256, BK = 64, HALF = 128, HTB = HALF * BK * 2, STAGE_BYTES = 8 * HTB, NXCD = 8, WGM = 4;

__host__ __device__ __forceinline__ int lds_byte(int r, int c) { const int st = (r >> 4) * 2 + (c >> 5), rr = r & 15, cc = c & 31, ob = rr * 64 + cc * 2; return st * 1024 + (ob ^ (((ob >> 9) & 1) << 5)); }
__host__ __device__ __forceinline__ void stage_rc(int b, int& R, int& C) { const int st = b / 1024, sb = b % 1024, swz = sb ^ (((sb >> 9) & 1) << 5); R = (st >> 1) * 16 + swz / 64; C = (st & 1) * 32 + (swz % 64) / 2; }
__host__ __device__ __forceinline__ int perm32(int rho) { const int n = rho >> 4, i = rho & 15; return 8 * (i >> 2) + 4 * n + (i & 3); }

struct Unit { int pm, pn; };
struct Gemm { const bf16_t* A; const bf16_t* Bt; int M, N, K; };

struct StaticOrder {
    int nM, nN, nwg, G, c;
    __host__ __device__ __forceinline__ void init(int M, int N, int G_, int c_) { nM = M / BM; nN = N / BM; nwg = nM * nN; G = G_; c = c_; }
    __host__ __device__ __forceinline__ bool next(int i, Unit& u) const {
        const long L = (long)i * G + c; if (L >= nwg) return false;
        int wgid = (int)L; { const int q = nwg / NXCD, r = nwg % NXCD, xcd = wgid % NXCD, off = wgid / NXCD; wgid = (xcd < r ? xcd * (q + 1) : r * (q + 1) + (xcd - r) * q) + off; }
        const int nig = WGM * nN, gid = wgid / nig, fm = gid * WGM, gsz = (nM - fm) < WGM ? (nM - fm) : WGM;
        u.pm = fm + ((wgid % nig) % gsz); u.pn = (wgid % nig) / gsz; return true;
    }
    __device__ __forceinline__ void a_ready(const Unit&) const {}
    __device__ __forceinline__ void done(const Unit&) const {}
};

struct BlockOrder {
    StaticOrder so; int nM, nN, nNm, rmain, G, c; bool blocked;
    __host__ __device__ __forceinline__ void init(int M, int N, int G_, int c_) { nM = M / BM; nN = N / BM; G = G_; c = c_; blocked = (G_ == 256) && (nM % 16 == 0) && (nN >= 16);
        nNm = blocked ? (nN / 16) * 16 : 0; rmain = blocked ? (nM / 16) * (nNm / 16) : 0; so.init(M, (nN - nNm) * BM, G_, c_); }
    __host__ __device__ __forceinline__ bool next(int i, Unit& u) const {
        if (i < rmain) { const int nsr = nM / 16, sc = i / nsr, s0 = i % nsr, sr = (sc & 1) ? nsr - 1 - s0 : s0, x = c & 7, j = c >> 3;
            u.pm = 16 * sr + 4 * (x >> 1) + (j & 3); u.pn = 16 * sc + 8 * (x & 1) + (j >> 2); return true; }
        if (nN == nNm) return false;
        if (!so.next(i - rmain, u)) return false;
        u.pn += nNm; return true;
    }
    __device__ __forceinline__ void a_ready(const Unit&) const {}
    __device__ __forceinline__ void done(const Unit&) const {}
};

typedef f32x4 Acc[2][2][4][2];

__device__ __forceinline__ float row_total64(const float* tab, int row, int fq) {
    const float* p = tab + ((size_t)(fq * 4) * MTOK + row) * 4;
    const f32x4 a = *(const f32x4*)p, b = *(const f32x4*)(p + (size_t)MTOK * 4), c = *(const f32x4*)(p + (size_t)MTOK * 8), d = *(const f32x4*)(p + (size_t)MTOK * 12);
    float s = ((a[0] + a[1]) + (a[2] + a[3])) + ((b[0] + b[1]) + (b[2] + b[3])) + ((c[0] + c[1]) + (c[2] + c[3])) + ((d[0] + d[1]) + (d[2] + d[3]));
    s += __shfl_xor(s, 16); s += __shfl_xor(s, 32); return s;
}

template <int VAR> struct EpiInProjT {
    static constexpr bool PERM = true, AFTER_DRAIN = false, HAS_MID = false;
    bf16_t *Q, *V, *QIDX, *KIDX, *UV, *SGA, *SGB; float *KRAW, *WIDX, *LNP; const float* FACH; float isw;
    __device__ __forceinline__ float rowf(size_t r) const { if constexpr (VAR == 0) return FACH[r] * isw; else return 1.0f; }
    __device__ __forceinline__ void mid(Acc&, const Unit&, int, int, int, int) const {}
    template <int ACT> __device__ __forceinline__ void plain(const Acc& acc, bf16_t* O, int ldc, int colt, int row0, int cl, bool f8) const {
#pragma unroll
        for (int ai = 0; ai < 2; ++ai)
#pragma unroll
            for (int m = 0; m < 4; ++m) { const float rf = rowf((size_t)(row0 + ai * HALF + m * 16)); const size_t eo = (size_t)(row0 + ai * HALF + m * 16) * ldc + colt + cl; bf16_t* rowp = O + eo; unsigned char* rowp8 = (unsigned char*)O + eo;
#pragma unroll
                for (int bj = 0; bj < 2; ++bj) { f32x4 v0 = acc[ai][bj][m][0] * rf, v1 = acc[ai][bj][m][1] * rf;
                    if (ACT == 1) {
#pragma unroll
                        for (int j = 0; j < 4; ++j) { v0[j] = gelu_tanh(v0[j]); v1[j] = gelu_tanh(v1[j]); } }
                    if (ACT == 2) {
#pragma unroll
                        for (int j = 0; j < 4; ++j) { v0[j] = fast_sigmoid(v0[j]); v1[j] = fast_sigmoid(v1[j]); } }
                    if (f8) *(v2u*)(rowp8 + bj * HALF) = pack8_f8(v0, v1); else *(u32x4*)(rowp + bj * HALF) = pack8(v0, v1); }
                __builtin_amdgcn_sched_barrier(0); }
    }
    __device__ __forceinline__ void operator()(const Acc& acc, const Unit& u, int wr, int wc, int fr, int fq) const {
        asm volatile("" : "+v"(fr), "+v"(fq));
        const int row0 = u.pm * BM + wr * 64 + fr, cl = wc * 32 + 8 * fq, pn = VAR == 2 ? u.pn + 42 : VAR == 1 ? u.pn + 25 : (u.pn < 25 ? u.pn : (u.pn < 41 ? u.pn + 33 : u.pn - 15));
        if (pn < 8 || (pn > 8 && pn < 25)) { const bool isq = pn < 8; plain<0>(acc, isq ? Q : QIDX, isq ? 2048 : 4096, isq ? pn * 256 : (pn - 9) * 256, row0, cl, isq); }
        else if (pn == 8) {
#pragma unroll
            for (int ai = 0; ai < 2; ++ai)
#pragma unroll
                for (int m = 0; m < 4; ++m) { const size_t r = (size_t)(row0 + ai * HALF + m * 16);
                    const float rf = rowf(r);
                    *(f32x4*)(KRAW + r * 128 + cl) = acc[ai][0][m][0] * rf; *(f32x4*)(KRAW + r * 128 + cl + 4) = acc[ai][0][m][1] * rf;
                    *(u32x4*)(V + r * 128 + cl) = pack8(acc[ai][1][m][0] * rf, acc[ai][1][m][1] * rf); }
        }
        else if (pn == 25) {
#pragma unroll
            for (int ai = 0; ai < 2; ++ai)
#pragma unroll
                for (int m = 0; m < 4; ++m) { const size_t r = (size_t)(row0 + ai * HALF + m * 16);
                    *(u32x4*)(KIDX + r * 128 + cl) = pack8(acc[ai][0][m][0], acc[ai][0][m][1]);
                    if (wc == 0) { *(f32x4*)(WIDX + r * 32 + 8 * fq) = acc[ai][1][m][0]; *(f32x4*)(WIDX + r * 32 + 8 * fq + 4) = acc[ai][1][m][1]; } }
        }
        else if (pn < 42) {
            const bool isv = pn >= 34;
#pragma unroll
            for (int ai = 0; ai < 2; ++ai)
#pragma unroll
                for (int m = 0; m < 4; ++m) { const size_t r = (size_t)(row0 + ai * HALF + m * 16); bf16_t* rowp = UV + r * 4096 + (pn - 26) * 256 + cl; float s = 0.f, q = 0.f; const float rf = rowf(r);
#pragma unroll
                    for (int bj = 0; bj < 2; ++bj) { f32x4 v0 = acc[ai][bj][m][0] * rf, v1 = acc[ai][bj][m][1] * rf;
#pragma unroll
                        for (int j = 0; j < 4; ++j) { v0[j] = gelu_tanh(v0[j]); v1[j] = gelu_tanh(v1[j]); s += v0[j] + v1[j]; q += v0[j] * v0[j] + v1[j] * v1[j]; }
                        *(u32x4*)(rowp + bj * HALF) = pack8(v0, v1); }
                    s += __shfl_xor(s, 16); s += __shfl_xor(s, 32); q += __shfl_xor(q, 16); q += __shfl_xor(q, 32);
                    if (isv && fq == 0) *(f32x2*)(LNP + (((size_t)(pn - 34) * MTOK + r) * 4 + wc) * 2) = (f32x2){s, q};
                    __builtin_amdgcn_sched_barrier(0); }
        }
        else { const bool isa = pn < 58; plain<2>(acc, isa ? SGA : SGB, 4096, isa ? (pn - 42) * 256 : (pn - 58) * 256, row0, cl, isa); }
    }
};

struct EpiNull {
    static constexpr bool PERM = true, AFTER_DRAIN = false, HAS_MID = false;
    float* sink;
    __device__ __forceinline__ void mid(Acc&, const Unit&, int, int, int, int) const {}
    __device__ __forceinline__ void operator()(const Acc& acc, const Unit& u, int wr, int wc, int fr, int fq) const {
        f32x4 t = {0.f, 0.f, 0.f, 0.f};
#pragma unroll
        for (int ai = 0; ai < 2; ++ai)
#pragma unroll
            for (int bj = 0; bj < 2; ++bj)
#pragma unroll
                for (int m = 0; m < 4; ++m) t += acc[ai][bj][m][0] + acc[ai][bj][m][1];
        if (t[0] + t[1] + t[2] + t[3] == 123456.789f) sink[u.pm] = t[0];
    }
};

struct EpiPlain {
    static constexpr bool PERM = true, AFTER_DRAIN = false, HAS_MID = false;
    bf16_t* O;
    __device__ __forceinline__ void mid(Acc&, const Unit&, int, int, int, int) const {}
    __device__ __forceinline__ void operator()(const Acc& acc, const Unit& u, int wr, int wc, int fr, int fq) const {
        asm volatile("" : "+v"(fr), "+v"(fq));
        const int row0 = u.pm * BM + wr * 64 + fr, col0 = u.pn * BM + wc * 32 + 8 * fq;
#pragma unroll
        for (int ai = 0; ai < 2; ++ai)
#pragma unroll
            for (int m = 0; m < 4; ++m) { const size_t off = (size_t)(row0 + ai * HALF + m * 16) * 4096 + col0;
#pragma unroll
                for (int bj = 0; bj < 2; ++bj) *(v2u*)((unsigned char*)O + off + bj * HALF) = pack8_f8(acc[ai][bj][m][0] * 16.0f, acc[ai][bj][m][1] * 16.0f);
                __builtin_amdgcn_sched_barrier(0); }
    }
};
struct EpiMerge {
    static constexpr bool PERM = true, AFTER_DRAIN = false, HAS_MID = false;
    const bf16_t *SGA, *SGB; const bf16_t* T8; bf16_t* O;
    __device__ __forceinline__ void mid(Acc&, const Unit&, int, int, int, int) const {}
    __device__ __forceinline__ void operator()(const Acc& acc, const Unit& u, int wr, int wc, int fr, int fq) const {
        asm volatile("" : "+v"(fr), "+v"(fq));
        const int row0 = u.pm * BM + wr * 64 + fr, col0 = u.pn * BM + wc * 32 + 8 * fq;
#pragma unroll
        for (int ai = 0; ai < 2; ++ai)
#pragma unroll
            for (int m = 0; m < 4; ++m) { const size_t off = (size_t)(row0 + ai * HALF + m * 16) * 4096 + col0;
#pragma unroll
                for (int bj = 0; bj < 2; ++bj) { const v2u wa = *(const v2u*)((const unsigned char*)SGA + off + bj * HALF), wt = *(const v2u*)((const unsigned char*)T8 + off + bj * HALF); const u32x4 wb = *(const u32x4*)(SGB + off + bj * HALF);
                    f32x4 a0, a1, b0, b1, t0, t1; unpack8_f8(wa, a0, a1); unpack8(wb, b0, b1); unpack8_f8(wt, t0, t1); t0 *= 0.0625f; t1 *= 0.0625f;
                    *(u32x4*)(O + off + bj * HALF) = pack8(a0 * t0 + b0 * acc[ai][bj][m][0], a1 * t1 + b1 * acc[ai][bj][m][1]); }
                __builtin_amdgcn_sched_barrier(0); }
    }
};

template <bool G8, bool INB, bool QF = false> struct EpiResidT {
    static constexpr bool PERM = true, AFTER_DRAIN = false, HAS_MID = false;
    const void* XIN; bf16_t* XOUT; bf16_t* XG; const float* gain; float* SSQ; const float* FACR; float isw;
    __device__ __forceinline__ void mid(Acc&, const Unit&, int, int, int, int) const {}
    __device__ __forceinline__ void operator()(const Acc& acc, const Unit& u, int wr, int wc, int fr, int fq) const {
        asm volatile("" : "+v"(fr), "+v"(fq));
        const int row0 = u.pm * BM + wr * 64 + fr, col0 = u.pn * BM + wc * 32 + 8 * fq;
        f32x4 gv[2][2];
#pragma unroll
        for (int bj = 0; bj < 2; ++bj) { gv[bj][0] = *(const f32x4*)(gain + col0 + bj * HALF); gv[bj][1] = *(const f32x4*)(gain + col0 + bj * HALF + 4); }
#pragma unroll
        for (int ai = 0; ai < 2; ++ai)
#pragma unroll
            for (int m = 0; m < 4; ++m) { const size_t r = (size_t)(row0 + ai * HALF + m * 16), off = r * 4096 + col0; float q = 0.f; float rf = 1.0f; if constexpr (QF) rf = FACR[r] * isw;
#pragma unroll
                for (int bj = 0; bj < 2; ++bj) { f32x4 v0, v1;
                    if constexpr (INB) { const u32x4 xw = *(const u32x4*)((const bf16_t*)XIN + off + bj * HALF); unpack8(xw, v0, v1); }
                    else { v0 = *(const f32x4*)((const float*)XIN + off + bj * HALF); v1 = *(const f32x4*)((const float*)XIN + off + bj * HALF + 4); }
                    if constexpr (QF) { v0 += acc[ai][bj][m][0] * rf; v1 += acc[ai][bj][m][1] * rf; } else { v0 += acc[ai][bj][m][0]; v1 += acc[ai][bj][m][1]; }
                    *(u32x4*)(XOUT + off + bj * HALF) = pack8(v0, v1);
#pragma unroll
                    for (int j = 0; j < 4; ++j) q += v0[j] * v0[j] + v1[j] * v1[j];
                    if constexpr (G8) { const f32x4 a = v0 * gv[bj][0], b = v1 * gv[bj][1]; v2u w;
                        w.x = (unsigned)__builtin_amdgcn_cvt_pk_fp8_f32(a[2], a[3], __builtin_amdgcn_cvt_pk_fp8_f32(a[0], a[1], 0, false), true);
                        w.y = (unsigned)__builtin_amdgcn_cvt_pk_fp8_f32(b[2], b[3], __builtin_amdgcn_cvt_pk_fp8_f32(b[0], b[1], 0, false), true);
                        *(v2u*)((unsigned char*)XG + off + bj * HALF) = w; }
                    else if (XG) *(u32x4*)(XG + off + bj * HALF) = pack8(rnd_sm4(v0 * gv[bj][0]), rnd_sm4(v1 * gv[bj][1])); }
                q += __shfl_xor(q, 16); q += __shfl_xor(q, 32);
                if (fq == 0) SSQ[((size_t)u.pn * MTOK + r) * 4 + wc] = q;
                __builtin_amdgcn_sched_barrier(0); }
    }
};

typedef EpiResidT<false, false, true> EpiResid; typedef EpiResidT<true, true> EpiResid8; typedef EpiResidT<false, true> EpiResidB; typedef EpiResidT<false, true, true> EpiResidQ;

struct EpiPe {
    static constexpr bool PERM = true, AFTER_DRAIN = false, HAS_MID = false;
    bf16_t* PE; float* SSQ;
    __device__ __forceinline__ void mid(Acc&, const Unit&, int, int, int, int) const {}
    __device__ __forceinline__ void operator()(const Acc& acc, const Unit& u, int wr, int wc, int fr, int fq) const {
        asm volatile("" : "+v"(fr), "+v"(fq));
        const int row0 = u.pm * BM + wr * 64 + fr, col0 = u.pn * BM + wc * 32 + 8 * fq;
#pragma unroll
        for (int ai = 0; ai < 2; ++ai)
#pragma unroll
            for (int m = 0; m < 4; ++m) { const size_t r = (size_t)(row0 + ai * HALF + m * 16), off = r * 4096 + col0; float q = 0.f;
#pragma unroll
                for (int bj = 0; bj < 2; ++bj) { const f32x4 v0 = acc[ai][bj][m][0], v1 = acc[ai][bj][m][1];
#pragma unroll
                    for (int j = 0; j < 4; ++j) q += v0[j] * v0[j] + v1[j] * v1[j];
                    *(u32x4*)(PE + off + bj * HALF) = pack8(v0, v1); }
                q += __shfl_xor(q, 16); q += __shfl_xor(q, 32);
                if (fq == 0) SSQ[((size_t)u.pn * MTOK + r) * 4 + wc] = q;
                __builtin_amdgcn_sched_barrier(0); }
    }
};

struct EpiGateUp {
    static constexpr bool PERM = true, AFTER_DRAIN = false, HAS_MID = false;
    const float* SSQ; bf16_t* ACT; unsigned char* ACT8; int pm8;
    __device__ __forceinline__ void mid(Acc&, const Unit&, int, int, int, int) const {}
    __device__ __forceinline__ void operator()(const Acc& acc, const Unit& u, int wr, int wc, int fr, int fq) const {
        asm volatile("" : "+v"(fr), "+v"(fq));
        const int row0 = u.pm * BM + wr * 64 + fr, col0 = u.pn * HALF + wc * 32 + 8 * fq;
#pragma unroll
        for (int ai = 0; ai < 2; ++ai)
#pragma unroll
            for (int m = 0; m < 4; ++m) { const int r = row0 + ai * HALF + m * 16;
                const float rs = 1.0f / sqrtf(row_total64(SSQ, r, fq) * (1.0f / 4096.0f) + EPS);
                f32x4 o0, o1;
#pragma unroll
                for (int j = 0; j < 4; ++j) { const float g0 = acc[ai][0][m][0][j] * rs, g1 = acc[ai][0][m][1][j] * rs;
                    o0[j] = g0 * fast_sigmoid(g0) * (acc[ai][1][m][0][j] * rs); o1[j] = g1 * fast_sigmoid(g1) * (acc[ai][1][m][1][j] * rs); }
                if (u.pm < pm8) *(v2u*)(ACT8 + (size_t)r * DFF + col0) = pack8_f8(o0, o1); else *(u32x4*)(ACT + (size_t)r * DFF + col0) = pack8(o0, o1);
                __builtin_amdgcn_sched_barrier(0); }
    }
};

struct EpiGateUpQ {
    static constexpr bool PERM = true, AFTER_DRAIN = false, HAS_MID = false;
    const float* FAC; float isg, isu; bf16_t* ACT; unsigned char* ACT8; int pm8; const float* FACA;
    __device__ __forceinline__ void mid(Acc&, const Unit&, int, int, int, int) const {}
    __device__ __forceinline__ void operator()(const Acc& acc, const Unit& u, int wr, int wc, int fr, int fq) const {
        asm volatile("" : "+v"(fr), "+v"(fq));
        const int row0 = u.pm * BM + wr * 64 + fr, col0 = u.pn * HALF + wc * 32 + 8 * fq;
#pragma unroll
        for (int ai = 0; ai < 2; ++ai)
#pragma unroll
            for (int m = 0; m < 4; ++m) { const int r = row0 + ai * HALF + m * 16;
                const float f = FAC[r], fg = f * isg, fu = f * isu;
                f32x4 o0, o1;
#pragma unroll
                for (int j = 0; j < 4; ++j) { const float g0 = acc[ai][0][m][0][j] * fg, g1 = acc[ai][0][m][1][j] * fg;
                    o0[j] = g0 * fast_sigmoid(g0) * (acc[ai][1][m][0][j] * fu); o1[j] = g1 * fast_sigmoid(g1) * (acc[ai][1][m][1][j] * fu); }
                if (u.pm < pm8) {
                    float v_[8] = {o0[0], o0[1], o0[2], o0[3], o1[0], o1[1], o1[2], o1[3]};
#pragma unroll
                    for (int h_ = 1; h_ < 8; h_ <<= 1)
#pragma unroll
                        for (int i_ = 0; i_ < 8; ++i_) if (!(i_ & h_)) { const float a_ = v_[i_], b_ = v_[i_ | h_]; v_[i_] = a_ + b_; v_[i_ | h_] = a_ - b_; }
                    const float s16_ = (fq & 1) ? -1.0f : 1.0f, s32_ = (fq & 2) ? -1.0f : 1.0f;
#pragma unroll
                    for (int i_ = 0; i_ < 8; ++i_) { const auto p_ = __builtin_amdgcn_permlane16_swap(__float_as_uint(v_[i_]), __float_as_uint(v_[i_]), false, false); v_[i_] = __uint_as_float(p_[0]) + s16_ * __uint_as_float(p_[1]); }
#pragma unroll
                    for (int i_ = 0; i_ < 8; ++i_) { const auto p_ = __builtin_amdgcn_permlane32_swap(__float_as_uint(v_[i_]), __float_as_uint(v_[i_]), false, false); v_[i_] = __uint_as_float(p_[0]) + s32_ * __uint_as_float(p_[1]); }
                    const float sa_ = 0.17677669529663687f / FACA[r];
                    *(v2u*)(ACT8 + (size_t)r * DFF + col0) = pack8_i8((f32x4){v_[0], v_[1], v_[2], v_[3]} * sa_, (f32x4){v_[4], v_[5], v_[6], v_[7]} * sa_); }
                else *(u32x4*)(ACT + (size_t)r * DFF + col0) = pack8(o0, o1);
                __builtin_amdgcn_sched_barrier(0); }
    }
};

struct EpiFinal {
    static constexpr bool PERM = true, AFTER_DRAIN = false, HAS_MID = false;
    const float *FAC2, *SSQP, *pleg; const bf16_t* PE; const bf16_t* X2R; float* OUT; float isw;
    __device__ __forceinline__ void mid(Acc&, const Unit&, int, int, int, int) const {}
    __device__ __forceinline__ void operator()(const Acc& acc, const Unit& u, int wr, int wc, int fr, int fq) const {
        asm volatile("" : "+v"(fr), "+v"(fq));
        const int row0 = u.pm * BM + wr * 64 + fr, col0 = u.pn * BM + wc * 32 + 8 * fq;
        f32x4 gv[2][2];
#pragma unroll
        for (int bj = 0; bj < 2; ++bj) { gv[bj][0] = *(const f32x4*)(pleg + col0 + bj * HALF); gv[bj][1] = *(const f32x4*)(pleg + col0 + bj * HALF + 4); }
#pragma unroll
        for (int ai = 0; ai < 2; ++ai)
#pragma unroll
            for (int m = 0; m < 4; ++m) { const int r = row0 + ai * HALF + m * 16; const size_t off = (size_t)r * 4096 + col0;
                const float r3 = FAC2[r] * isw, rp = 1.0f / sqrtf(row_total64(SSQP, r, fq) * (1.0f / 4096.0f) + EPS);
#pragma unroll
                for (int bj = 0; bj < 2; ++bj) { const u32x4 pw = *(const u32x4*)(PE + off + bj * HALF); f32x4 p0, p1; unpack8(pw, p0, p1);
                    f32x4 x0, x1; { const u32x4 xw = *(const u32x4*)(X2R + off + bj * HALF); unpack8(xw, x0, x1); }
#pragma unroll
                    for (int j = 0; j < 4; ++j) { x0[j] += fast_sigmoid(acc[ai][bj][m][0][j] * r3) * (p0[j] * rp * gv[bj][0][j]); x1[j] += fast_sigmoid(acc[ai][bj][m][1][j] * r3) * (p1[j] * rp * gv[bj][1][j]); }
                    *(f32x4*)(OUT + off + bj * HALF) = x0; *(f32x4*)(OUT + off + bj * HALF + 4) = x1; }
                __builtin_amdgcn_sched_barrier(0); }
    }
};
template <class Epi, class Sched, bool ALIGN_EPI = false, bool SP2 = false, bool FP8 = false, bool FP4 = false, bool I8 = false>
__device__ __forceinline__ void gemm_phase(PG8_LAS unsigned char* lds, const Gemm g, const Sched& S, const Epi& E, const int tid, const int sclw4 = 127) {
    const int wid = __builtin_amdgcn_readfirstlane(tid >> 6), lane = tid & 63, wr = wid >> 2, wc = wid & 3, fr = lane & 15, fq = lane >> 4;
    const int K = g.K, nt = K / BK;
    unsigned voffA[2], voffB[2];
#pragma unroll
    for (int i = 0; i < 2; ++i) { int R, C; stage_rc(tid * 16 + i * 8192, R, C); const int Rb = Epi::PERM ? ((R & ~31) + perm32(R & 31)) : R;
        voffA[i] = (unsigned)(R * K + C) * 2u; voffB[i] = (unsigned)(Rb * K + C) * 2u; }
    const size_t kstep = (size_t)(BK * 2);
    const size_t hstep = (size_t)HALF * K * 2;
    const size_t tstep = 2 * hstep;
    const unsigned ldsw = (unsigned)wid * 1024u;
    const int aoff = lds_byte(wr * 64 + fr, fq * 8), boff = lds_byte(wc * 32 + fr, fq * 8);
#define PG8_SA(b, h) (((b) * 2 + (h)) * HTB)
#define PG8_SB(b, h) ((4 + (b) * 2 + (h)) * HTB)
#define PG8_STAGE(bufoff, gbase, voff) do { _Pragma("unroll") for (int _i = 0; _i < 2; ++_i) \
        __builtin_amdgcn_global_load_lds((const unsigned*)((const char*)(gbase) + (voff)[_i]), (PG8_LAS unsigned*)(lds + (bufoff) + ldsw + _i * 8192), 16, 0, 0); } while (0)
#define PG8_LDA(dst, b, h) do { if constexpr (FP8) { _Pragma("unroll") for (int m = 0; m < 4; ++m) { const v4i_t lo_ = *(const PG8_LAS v4i_t*)(lds + PG8_SA(b, h) + aoff + m * 2048), hi_ = *(const PG8_LAS v4i_t*)(lds + PG8_SA(b, h) + aoff + m * 2048 + 1024); dst##8[m] = __builtin_shufflevector(lo_, hi_, 0, 1, 2, 3, 4, 5, 6, 7); } } \
        else { _Pragma("unroll") for (int m = 0; m < 4; ++m) _Pragma("unroll") for (int k = 0; k < 2; ++k) dst[m][k] = *(const PG8_LAS bf16x8*)(lds + PG8_SA(b, h) + aoff + m * 2048 + k * 1024); } } while (0)
#define PG8_LDB(dst, b, h) do { if constexpr (FP8) { _Pragma("unroll") for (int n = 0; n < 2; ++n) { const v4i_t lo_ = *(const PG8_LAS v4i_t*)(lds + PG8_SB(b, h) + boff + n * 2048), hi_ = *(const PG8_LAS v4i_t*)(lds + PG8_SB(b, h) + boff + n * 2048 + 1024); dst##8[n] = __builtin_shufflevector(lo_, hi_, 0, 1, 2, 3, 4, 5, 6, 7); } } \
        else { _Pragma("unroll") for (int n = 0; n < 2; ++n) _Pragma("unroll") for (int k = 0; k < 2; ++k) dst[n][k] = *(const PG8_LAS bf16x8*)(lds + PG8_SB(b, h) + boff + n * 2048 + k * 1024); } } while (0)
#define PG8_ALIGN_MFMA(At, Bt) asm volatile(".p2align 3" :: "v"(At[0][0]), "v"(At[0][1]), "v"(At[1][0]), "v"(At[1][1]), "v"(At[2][0]), "v"(At[2][1]), "v"(At[3][0]), "v"(At[3][1]), "v"(Bt[0][0]), "v"(Bt[0][1]), "v"(Bt[1][0]), "v"(Bt[1][1]))
#define PG8_ALIGN_MFMA8(At, Bt) asm volatile(".p2align 3" :: "v"(At##8[0]), "v"(At##8[1]), "v"(At##8[2]), "v"(At##8[3]), "v"(Bt##8[0]), "v"(Bt##8[1]))
#define PG8_MMA(ai, bj, At, Bt) do { __builtin_amdgcn_s_setprio(1); \
        if constexpr (FP8) { PG8_ALIGN_MFMA8(At, Bt); __builtin_amdgcn_sched_barrier(0); _Pragma("unroll") for (int m = 0; m < 4; ++m) _Pragma("unroll") for (int n = 0; n < 2; ++n) \
            asm volatile("v_mfma_scale_f32_16x16x128_f8f6f4 %0, %1, %2, %0, %3, %4 op_sel_hi:[0,0,0]" : "+v"(acc[ai][bj][m][n]) : "v"(Bt##8[n]), "v"(At##8[m]), "v"(scl_w), "v"(scl_a)); } \
        else if constexpr (I8) { PG8_ALIGN_MFMA(At, Bt); __builtin_amdgcn_sched_barrier(0); _Pragma("unroll") for (int m = 0; m < 4; ++m) _Pragma("unroll") for (int n = 0; n < 2; ++n) _Pragma("unroll") for (int k = 0; k < 2; ++k) \
            asm volatile("v_mfma_i32_16x16x64_i8 %0, %1, %2, %0" : "+v"(acc[ai][bj][m][n]) : "v"(Bt[n][k]), "v"(At[m][k])); } \
        else if constexpr (FP4) { PG8_ALIGN_MFMA(At, Bt); __builtin_amdgcn_sched_barrier(0); _Pragma("unroll") for (int m = 0; m < 4; ++m) _Pragma("unroll") for (int n = 0; n < 2; ++n) _Pragma("unroll") for (int k = 0; k < 2; ++k) \
            asm volatile("v_mfma_scale_f32_16x16x128_f8f6f4 %0, %1, %2, %0, %3, %4 op_sel_hi:[0,0,0] cbsz:4 blgp:4" : "+v"(acc[ai][bj][m][n]) : "v"(Bt[n][k]), "v"(At[m][k]), "v"(scl_w), "v"(scl_a)); } \
        else { PG8_ALIGN_MFMA(At, Bt); __builtin_amdgcn_sched_barrier(0); _Pragma("unroll") for (int m = 0; m < 4; ++m) _Pragma("unroll") for (int n = 0; n < 2; ++n) _Pragma("unroll") for (int k = 0; k < 2; ++k) \
            acc[ai][bj][m][n] = __builtin_amdgcn_mfma_f32_16x16x32_bf16(Bt[n][k], At[m][k], acc[ai][bj][m][n], 0, 0, 0); } \
        __builtin_amdgcn_s_setprio(0); } while (0)
#define PG8_WAIT_V(n) asm volatile("s_waitcnt vmcnt(" #n ")" ::: "memory")
#define PG8_WAIT_L(n) asm volatile("s_waitcnt lgkmcnt(" #n ")" ::: "memory")
#define PG8_BAR __builtin_amdgcn_s_barrier()
#define PG8_SCHED __builtin_amdgcn_sched_barrier(0)
    Unit cur, nxt; int ui = 0;
    if (!S.next(0, cur)) return;
    f32x4 acc[2][2][4][2];
#pragma unroll
    for (int a = 0; a < 2; ++a)
#pragma unroll
        for (int b = 0; b < 2; ++b)
#pragma unroll
            for (int m = 0; m < 4; ++m)
#pragma unroll
                for (int n = 0; n < 2; ++n) acc[a][b][m][n] = (f32x4){0.f, 0.f, 0.f, 0.f};
    typedef int v8i_t __attribute__((ext_vector_type(8))); typedef int v4i_t __attribute__((ext_vector_type(4)));
    bf16x8 At[4][2], B0[2][2], B1[2][2]; v8i_t At8[4], B08[2], B18[2];
    const int scl_w = FP4 ? sclw4 : 121, scl_a = FP4 ? 126 : 127;
    const char* cA = (const char*)g.A + (size_t)cur.pm * tstep; const char* cB = (const char*)g.Bt + (size_t)cur.pn * tstep;
    S.a_ready(cur);
    if constexpr (SP2) {
        PG8_STAGE(PG8_SB(0, 0), cB, voffB); PG8_STAGE(PG8_SB(0, 1), cB + hstep, voffB); PG8_STAGE(PG8_SA(0, 0), cA, voffA); PG8_STAGE(PG8_SA(0, 1), cA + hstep, voffA);
        if (wr == 1) PG8_BAR;
        PG8_WAIT_V(2); PG8_BAR;
        PG8_STAGE(PG8_SB(1, 0), cB + kstep, voffB); PG8_STAGE(PG8_SA(1, 0), cA + kstep, voffA); PG8_STAGE(PG8_SB(1, 1), cB + hstep + kstep, voffB);
        PG8_WAIT_V(6); PG8_BAR;
    } else {
        PG8_STAGE(PG8_SB(0, 0), cB, voffB); PG8_STAGE(PG8_SA(0, 0), cA, voffA); PG8_STAGE(PG8_SB(0, 1), cB + hstep, voffB); PG8_STAGE(PG8_SA(0, 1), cA + hstep, voffA);
        if (wr == 1) PG8_BAR;
        PG8_WAIT_V(4); PG8_BAR;
        PG8_STAGE(PG8_SB(1, 0), cB + kstep, voffB); PG8_STAGE(PG8_SA(1, 0), cA + kstep, voffA); PG8_STAGE(PG8_SB(1, 1), cB + hstep + kstep, voffB);
        PG8_WAIT_V(6); PG8_BAR;
    }
    for (;;) {
        const bool has_next = S.next(ui + 1, nxt);
        const char* nA = has_next ? (const char*)g.A + (size_t)nxt.pm * tstep : cA; const char* nB = has_next ? (const char*)g.Bt + (size_t)nxt.pn * tstep : cB;
        for (int t = 0; t < nt; t += 2) {
            asm volatile(".p2align 6");
            const bool last = (t == nt - 2);
            const char* a1 = cA + (size_t)(t + 1) * kstep;
            const char* a2 = last ? nA : cA + (size_t)(t + 2) * kstep; const char* b2 = last ? nB : cB + (size_t)(t + 2) * kstep;
            const char* a3 = a2 + kstep; const char* b3 = b2 + kstep;
            if (last && has_next) S.a_ready(nxt);
            if constexpr (Epi::HAS_MID) { if (t == (nt >> 1)) E.mid(acc, cur, wr, wc, fr, fq); }
            if constexpr (SP2) {
            PG8_LDB(B0, 0, 0); PG8_LDB(B1, 0, 1); PG8_SCHED; PG8_LDA(At, 0, 0); PG8_STAGE(PG8_SA(1, 1), a1 + hstep, voffA);
            PG8_WAIT_V(8); PG8_WAIT_L(0); PG8_BAR; PG8_MMA(0, 0, At, B0); PG8_MMA(0, 1, At, B1); PG8_BAR; PG8_SCHED;
            PG8_LDA(At, 0, 1); PG8_STAGE(PG8_SB(0, 0), b2, voffB); PG8_STAGE(PG8_SB(0, 1), b2 + hstep, voffB); PG8_STAGE(PG8_SA(0, 0), a2, voffA);
            PG8_WAIT_V(8); PG8_WAIT_L(0); PG8_BAR; PG8_MMA(1, 0, At, B0); PG8_MMA(1, 1, At, B1); PG8_BAR; PG8_SCHED;
            PG8_LDB(B0, 1, 0); PG8_LDB(B1, 1, 1); PG8_SCHED; PG8_LDA(At, 1, 0); PG8_STAGE(PG8_SA(0, 1), a2 + hstep, voffA);
            PG8_WAIT_V(8); PG8_WAIT_L(0); PG8_BAR; PG8_MMA(0, 0, At, B0); PG8_MMA(0, 1, At, B1); PG8_BAR; PG8_SCHED;
            PG8_LDA(At, 1, 1); PG8_STAGE(PG8_SB(1, 0), b3, voffB); PG8_STAGE(PG8_SB(1, 1), b3 + hstep, voffB); PG8_STAGE(PG8_SA(1, 0), a3, voffA);
            PG8_WAIT_V(8); PG8_WAIT_L(0); PG8_BAR; PG8_MMA(1, 0, At, B0); PG8_MMA(1, 1, At, B1); PG8_BAR; PG8_SCHED;
            } else {
            PG8_LDB(B0, 0, 0); PG8_SCHED; PG8_LDA(At, 0, 0); PG8_STAGE(PG8_SA(1, 1), a1 + hstep, voffA);
            PG8_WAIT_L(8); PG8_BAR; PG8_WAIT_L(0); PG8_MMA(0, 0, At, B0); PG8_BAR; PG8_SCHED;
            PG8_LDB(B1, 0, 1); PG8_STAGE(PG8_SB(0, 0), b2, voffB);
            PG8_BAR; PG8_WAIT_L(0); PG8_MMA(0, 1, At, B1); PG8_BAR;
            PG8_LDA(At, 0, 1); PG8_STAGE(PG8_SA(0, 0), a2, voffA);
            PG8_BAR; PG8_WAIT_L(0); PG8_MMA(1, 0, At, B0); PG8_BAR; PG8_SCHED;
            PG8_STAGE(PG8_SB(0, 1), b2 + hstep, voffB);
            PG8_WAIT_V(6); PG8_BAR; PG8_MMA(1, 1, At, B1); PG8_BAR;
            PG8_LDB(B0, 1, 0); PG8_SCHED; PG8_LDA(At, 1, 0); PG8_STAGE(PG8_SA(0, 1), a2 + hstep, voffA);
            PG8_WAIT_L(8); PG8_BAR; PG8_WAIT_L(0); PG8_MMA(0, 0, At, B0); PG8_BAR; PG8_SCHED;
            PG8_LDB(B1, 1, 1); PG8_STAGE(PG8_SB(1, 0), b3, voffB);
            PG8_BAR; PG8_WAIT_L(0); PG8_MMA(0, 1, At, B1); PG8_BAR;
            PG8_LDA(At, 1, 1); PG8_STAGE(PG8_SA(1, 0), a3, voffA);
            PG8_BAR; PG8_WAIT_L(0); PG8_MMA(1, 0, At, B0); PG8_BAR; PG8_SCHED;
            PG8_STAGE(PG8_SB(1, 1), b3 + hstep, voffB);
            PG8_WAIT_V(6); PG8_BAR; PG8_MMA(1, 1, At, B1); PG8_BAR;
            }
        }
        if constexpr (FP8 || FP4 || I8) {
            asm volatile("s_nop 15\n\ts_nop 15" : "+v"(acc[0][0][0][0]), "+v"(acc[0][0][0][1]), "+v"(acc[0][0][1][0]), "+v"(acc[0][0][1][1]), "+v"(acc[0][0][2][0]), "+v"(acc[0][0][2][1]), "+v"(acc[0][0][3][0]), "+v"(acc[0][0][3][1]), "+v"(acc[0][1][0][0]), "+v"(acc[0][1][0][1]), "+v"(acc[0][1][1][0]), "+v"(acc[0][1][1][1]), "+v"(acc[0][1][2][0]), "+v"(acc[0][1][2][1]), "+v"(acc[0][1][3][0]), "+v"(acc[0][1][3][1]));
            asm volatile("" : "+v"(acc[1][0][0][0]), "+v"(acc[1][0][0][1]), "+v"(acc[1][0][1][0]), "+v"(acc[1][0][1][1]), "+v"(acc[1][0][2][0]), "+v"(acc[1][0][2][1]), "+v"(acc[1][0][3][0]), "+v"(acc[1][0][3][1]), "+v"(acc[1][1][0][0]), "+v"(acc[1][1][0][1]), "+v"(acc[1][1][1][0]), "+v"(acc[1][1][1][1]), "+v"(acc[1][1][2][0]), "+v"(acc[1][1][2][1]), "+v"(acc[1][1][3][0]), "+v"(acc[1][1][3][1])); }
        if constexpr (I8) {
#pragma unroll
            for (int a = 0; a < 2; ++a)
#pragma unroll
                for (int b = 0; b < 2; ++b)
#pragma unroll
                    for (int m = 0; m < 4; ++m)
#pragma unroll
                        for (int n = 0; n < 2; ++n) acc[a][b][m][n] = __builtin_convertvector(__builtin_bit_cast(v4i_t, acc[a][b][m][n]), f32x4); }
        if constexpr (ALIGN_EPI) { if (wr == 0) PG8_BAR; }
        if constexpr (!Epi::AFTER_DRAIN) { E(acc, cur, wr, wc, fr, fq); S.done(cur); }
        if (!has_next) break;
#pragma unroll
        for (int a = 0; a < 2; ++a)
#pragma unroll
            for (int b = 0; b < 2; ++b)
#pragma unroll
                for (int m = 0; m < 4; ++m)
#pragma unroll
                    for (int n = 0; n < 2; ++n) acc[a][b][m][n] = (f32x4){0.f, 0.f, 0.f, 0.f};
        cur = nxt; cA = nA; cB = nB; ++ui;
        if constexpr (ALIGN_EPI) { if (wr == 1) PG8_BAR; }
    }
    PG8_WAIT_V(0);
    if constexpr (!ALIGN_EPI) { if (wr == 0) PG8_BAR; }
    PG8_BAR;
    if constexpr (Epi::AFTER_DRAIN) { E.fused(acc, cur, wr, wc, fr, fq, lds, wid, lane); S.done(cur); }
#undef PG8_SA
#undef PG8_SB
#undef PG8_STAGE
#undef PG8_LDA
#undef PG8_LDB
#undef PG8_MMA
#undef PG8_ALIGN_MFMA
#undef PG8_ALIGN_MFMA8
#undef PG8_WAIT_V
#undef PG8_WAIT_L
#undef PG8_BAR
#undef PG8_SCHED
}
}
#define XB_TMO      128
#define XB_XCNT(j)  (256  + 64 * (j))
#define XB_XSUB(j)  (1280 + 64 * (j))
#define XB_XGEN(j)  (2304 + 64 * (j))
#define XB_TOP      3328
#define XB_TOPGEN   3392
#define XCD_BAR_WORDS 3456
#define XB_SPIN_CAP (1u << 20)

__device__ __forceinline__ unsigned xb_ld(unsigned* p)              { return __hip_atomic_load(p, __ATOMIC_RELAXED, __HIP_MEMORY_SCOPE_AGENT); }
__device__ __forceinline__ unsigned xb_add(unsigned* p, unsigned v) { return __hip_atomic_fetch_add(p, v, __ATOMIC_RELAXED, __HIP_MEMORY_SCOPE_AGENT); }
__device__ __forceinline__ unsigned xb_xcc_id() { return (unsigned)__builtin_amdgcn_s_getreg((3 << 11) | 20) & 0xFu; }
#define XB_SPIN(cond, bar) do { unsigned _sp = 0; while (cond) { __builtin_amdgcn_s_sleep(1); \
    if ((++_sp & 255u) == 0u) { if (xb_ld(&(bar)[XB_TMO])) break; if (_sp > XB_SPIN_CAP) { atomicAdd(&(bar)[XB_TMO], 1u); break; } } } } while (0)

struct XcdBarrier {
    unsigned* bar; unsigned x;
    volatile LAS unsigned* st;
};

__device__ __forceinline__ XcdBarrier xcd_barrier_post(unsigned* bar, volatile LAS unsigned* st) {
    XcdBarrier b; b.bar = bar; b.x = xb_xcc_id(); b.st = st;
    if (threadIdx.x == 0) (void)xb_add(&bar[XB_XCNT(b.x)], 1u);
    return b;
}
__device__ __forceinline__ void xcd_barrier_complete(unsigned* bar, unsigned x, unsigned& nloc, unsigned& nx) {
    const unsigned G = gridDim.x * gridDim.y * gridDim.z;
    unsigned sum, cnt, mine, sp = 0u;
    for (;;) {
        sum = 0u; cnt = 0u; mine = 0u;
#pragma unroll
        for (unsigned j = 0; j < 16; ++j) { const unsigned c = xb_ld(&bar[XB_XCNT(j)]); sum += c; cnt += (c > 0u) ? 1u : 0u; mine = (j == x) ? c : mine; }
        if (sum == G) break;
        __builtin_amdgcn_s_sleep(1);
        if ((++sp & 255u) == 0u) { if (xb_ld(&bar[XB_TMO])) break; if (sp > XB_SPIN_CAP) { atomicAdd(&bar[XB_TMO], 1u); break; } }
    }
    nloc = mine > 0u ? mine : 1u; nx = cnt > 0u ? cnt : 1u;
}

__device__ __forceinline__ void xcd_barrier(const XcdBarrier& b) {
    asm volatile("s_waitcnt vmcnt(0)" ::: "memory");
    __syncthreads();
    if (threadIdx.x == 0) {
        unsigned* bar = b.bar;
        __builtin_amdgcn_s_waitcnt(0);
        unsigned nloc = b.st[0], nx = b.st[1];
        if (nloc == 0u) { xcd_barrier_complete(bar, b.x, nloc, nx); b.st[0] = nloc; b.st[1] = nx; }
        const unsigned old = xb_add(&bar[XB_XSUB(b.x)], 1u);
        const unsigned gen = old / nloc;
        if (old + 1u == (gen + 1u) * nloc) {
            __builtin_amdgcn_fence(__ATOMIC_RELEASE, "agent");
            asm volatile("s_waitcnt vmcnt(0)" ::: "memory");
            const unsigned og = xb_add(&bar[XB_TOP], 1u);
            const unsigned tg = og / nx;
            if (og + 1u == (tg + 1u) * nx) xb_add(&bar[XB_TOPGEN], 1u);
            else XB_SPIN(xb_ld(&bar[XB_TOPGEN]) == tg, bar);
            __builtin_amdgcn_fence(__ATOMIC_ACQUIRE, "agent");
            xb_add(&bar[XB_XGEN(b.x)], 1u);
            asm volatile("s_waitcnt vmcnt(0)" ::: "memory");
        } else {
            XB_SPIN(xb_ld(&bar[XB_XGEN(b.x)]) == gen, bar);
            __builtin_amdgcn_fence(__ATOMIC_ACQUIRE, "agent");
            asm volatile("s_waitcnt vmcnt(0)" ::: "memory");
        }
    }
    __syncthreads();
}

template <int MAP> __device__ __forceinline__ int rowmap(int n) {
    if (MAP == 1) return n - 6400;
    if (MAP == 4) return n < 6400 ? n : (n < 10656 ? n + 3936 : n - 8352);
    if (MAP == 2) return (n >> 7) * 256 + (n & 127);
    if (MAP == 3) return (n >> 7) * 256 + 128 + (n & 127);
    return n;
}
__device__ __forceinline__ void p0_load(const float* W, int N, int item, f32x4 (&r)[8], int lane) {
    const int nblk = N / 32, kb = item / nblk, nb = item % nblk;
    const float* p = W + (size_t)(64 * kb + (lane >> 3)) * N + 32 * nb + 4 * (lane & 7);
#pragma unroll
    for (int i = 0; i < 8; ++i) r[i] = *(const GAS f32x4*)(p + (size_t)(8 * i) * N);
}
template <int MAP, bool SM = false> __device__ __forceinline__ void p0_finish(const f32x4 (&r)[8], int N, bf16* dst, int ldd, int koff, LAS float* scr, int item, int lane) {
    const int nblk = N / 32, kb = item / nblk, nb = item % nblk, k0 = 64 * kb, n0 = 32 * nb;
#pragma unroll
    for (int i = 0; i < 8; ++i) { LAS float* s = scr + (8 * i + (lane >> 3)) * 33 + 4 * (lane & 7); s[0] = r[i].x; s[1] = r[i].y; s[2] = r[i].z; s[3] = r[i].w; }
    LDS_WAIT(); asm volatile("" ::: "memory");
    const int c = lane & 7, r0 = rowmap<MAP>(n0);
#pragma unroll
    for (int j = 0; j < 4; ++j) { const int n = (lane >> 3) + 8 * j; const LAS float* s = scr + (8 * c) * 33 + n;
        v4u o; if (SM) { o.x = cvt_pk_bf16(rnd_sm(s[0 * 33]), rnd_sm(s[1 * 33])); o.y = cvt_pk_bf16(rnd_sm(s[2 * 33]), rnd_sm(s[3 * 33])); o.z = cvt_pk_bf16(rnd_sm(s[4 * 33]), rnd_sm(s[5 * 33])); o.w = cvt_pk_bf16(rnd_sm(s[6 * 33]), rnd_sm(s[7 * 33])); }
        else { o.x = cvt_pk_bf16(s[0 * 33], s[1 * 33]); o.y = cvt_pk_bf16(s[2 * 33], s[3 * 33]); o.z = cvt_pk_bf16(s[4 * 33], s[5 * 33]); o.w = cvt_pk_bf16(s[6 * 33], s[7 * 33]); }
        *(GAS v4u*)(dst + (size_t)(r0 + n) * ldd + koff + k0 + 8 * c) = o; }
    LDS_WAIT(); asm volatile("" ::: "memory");
}
template <int MAP> __device__ __forceinline__ void p0_finish8(const f32x4 (&r)[8], int N, unsigned char* dst, int ldd, LAS float* scr, int item, int lane) {
    const int nblk = N / 32, kb = item / nblk, nb = item % nblk, k0 = 64 * kb, n0 = rowmap<MAP>(32 * nb);
#pragma unroll
    for (int i = 0; i < 8; ++i) { LAS float* s = scr + (8 * i + (lane >> 3)) * 33 + 4 * (lane & 7); s[0] = r[i].x; s[1] = r[i].y; s[2] = r[i].z; s[3] = r[i].w; }
    LDS_WAIT(); asm volatile("" ::: "memory");
    const int c = lane & 7;
#pragma unroll
    for (int j = 0; j < 4; ++j) { const int n = (lane >> 3) + 8 * j; const LAS float* s = scr + (8 * c) * 33 + n; v2u o;
        o.x = (unsigned)__builtin_amdgcn_cvt_pk_fp8_f32(64.f * s[2 * 33], 64.f * s[3 * 33], __builtin_amdgcn_cvt_pk_fp8_f32(64.f * s[0 * 33], 64.f * s[1 * 33], 0, false), true);
        o.y = (unsigned)__builtin_amdgcn_cvt_pk_fp8_f32(64.f * s[6 * 33], 64.f * s[7 * 33], __builtin_amdgcn_cvt_pk_fp8_f32(64.f * s[4 * 33], 64.f * s[5 * 33], 0, false), true);
        *(GAS v2u*)(dst + (size_t)(n0 + n) * ldd + k0 + 8 * c) = o; }
    LDS_WAIT(); asm volatile("" ::: "memory");
}
template <int MAP> __device__ __forceinline__ void p0_finish_i8(const f32x4 (&r)[8], int N, unsigned char* dst, int ldd, float wsc, LAS float* scr, int item, int lane) {
    const int nblk = N / 32, kb = item / nblk, nb = item % nblk, k0 = 64 * kb, n0 = rowmap<MAP>(32 * nb);
#pragma unroll
    for (int i = 0; i < 8; ++i) { LAS float* s = scr + (8 * i + (lane >> 3)) * 33 + 4 * (lane & 7); s[0] = r[i].x; s[1] = r[i].y; s[2] = r[i].z; s[3] = r[i].w; }
    LDS_WAIT(); asm volatile("" ::: "memory");
    const int c = lane & 7;
#pragma unroll
    for (int j = 0; j < 4; ++j) { const int n = (lane >> 3) + 8 * j; const LAS float* s = scr + (8 * c) * 33 + n;
        *(GAS v2u*)(dst + (size_t)(n0 + n) * ldd + k0 + 8 * c) = pack8_i8((f32x4){wsc * s[0 * 33], wsc * s[1 * 33], wsc * s[2 * 33], wsc * s[3 * 33]}, (f32x4){wsc * s[4 * 33], wsc * s[5 * 33], wsc * s[6 * 33], wsc * s[7 * 33]}); }
    LDS_WAIT(); asm volatile("" ::: "memory");
}
__device__ __forceinline__ void p0_finish_i8h(const f32x4 (&r)[8], int N, unsigned char* dst, int ldd, float wsc, LAS float* scr, int item, int lane) {
    const int nblk = N / 32, kb = item / nblk, nb = item % nblk, k0 = 64 * kb, n0 = 32 * nb;
#pragma unroll
    for (int i = 0; i < 8; ++i) { LAS float* s = scr + (8 * i + (lane >> 3)) * 33 + 4 * (lane & 7); s[0] = r[i].x; s[1] = r[i].y; s[2] = r[i].z; s[3] = r[i].w; }
    LDS_WAIT(); asm volatile("" ::: "memory");
    const int n = lane & 31, half = lane >> 5; const LAS float* s = scr + (32 * half) * 33 + n;
    float v[32];
#pragma unroll
    for (int i = 0; i < 32; ++i) v[i] = s[i * 33];
#pragma unroll
    for (int h = 1; h < 32; h <<= 1)
#pragma unroll
        for (int i = 0; i < 32; ++i) if (!(i & h)) { const float a = v[i], b = v[i | h]; v[i] = a + b; v[i | h] = a - b; }
    const float c = wsc * 0.17677669529663687f;
    unsigned char* p = dst + (size_t)(n0 + n) * ldd + k0 + 32 * half;
#pragma unroll
    for (int q = 0; q < 2; ++q) { const v2u lo = pack8_i8((f32x4){v[16 * q], v[16 * q + 1], v[16 * q + 2], v[16 * q + 3]} * c, (f32x4){v[16 * q + 4], v[16 * q + 5], v[16 * q + 6], v[16 * q + 7]} * c),
                                            hi = pack8_i8((f32x4){v[16 * q + 8], v[16 * q + 9], v[16 * q + 10], v[16 * q + 11]} * c, (f32x4){v[16 * q + 12], v[16 * q + 13], v[16 * q + 14], v[16 * q + 15]} * c);
        *(GAS v4u*)(p + 16 * q) = (v4u){lo.x, lo.y, hi.x, hi.y}; }
    LDS_WAIT(); asm volatile("" ::: "memory");
}
template <bool NORM, bool GAIN, bool ROT = false> __device__ __forceinline__ void quant_row_i8(const bf16* xrow, const float* gain, unsigned char* orow, float* fac, int lane, const float clip = 4.0f, float* faca = nullptr, const float sgu = 0.f) {
    f32x4 a[8][2]; float sx = 0.f, sa = 0.f;
#pragma unroll
    for (int j = 0; j < 8; ++j) { const v4u w = *(const GAS v4u*)(xrow + (lane + 64 * j) * 8); f32x4 x0, x1; unpack8(w, x0, x1);
        if constexpr (GAIN) { const f32x4 g0 = *(const GAS f32x4*)(gain + (lane + 64 * j) * 8), g1 = *(const GAS f32x4*)(gain + (lane + 64 * j) * 8 + 4); a[j][0] = x0 * g0; a[j][1] = x1 * g1; }
        else { a[j][0] = x0; a[j][1] = x1; }
#pragma unroll
        for (int i = 0; i < 4; ++i) { sx += x0[i] * x0[i] + x1[i] * x1[i]; sa += a[j][0][i] * a[j][0][i] + a[j][1][i] * a[j][1][i]; } }
    if constexpr (NORM) sx = wave_sum(sx);
    sa = wave_sum(sa);
    float sc = 127.0f / (clip * sqrtf(sa * (1.0f / DM)) + 1e-30f);
    if constexpr (ROT) {
        const float s1_ = (lane & 1) ? -1.0f : 1.0f, s2_ = (lane & 2) ? -1.0f : 1.0f;
#pragma unroll
        for (int j = 0; j < 8; ++j) { float v_[8] = {a[j][0][0], a[j][0][1], a[j][0][2], a[j][0][3], a[j][1][0], a[j][1][1], a[j][1][2], a[j][1][3]};
#pragma unroll
            for (int h_ = 1; h_ < 8; h_ <<= 1)
#pragma unroll
                for (int i_ = 0; i_ < 8; ++i_) if (!(i_ & h_)) { const float p_ = v_[i_], q_ = v_[i_ | h_]; v_[i_] = p_ + q_; v_[i_ | h_] = p_ - q_; }
#pragma unroll
            for (int i_ = 0; i_ < 8; ++i_) { const float t_ = __int_as_float(__builtin_amdgcn_update_dpp(0, __float_as_int(v_[i_]), 0xB1, 0xF, 0xF, true)); v_[i_] = (lane & 1) ? t_ - v_[i_] : v_[i_] + t_; }
#pragma unroll
            for (int i_ = 0; i_ < 8; ++i_) { const float t_ = __int_as_float(__builtin_amdgcn_update_dpp(0, __float_as_int(v_[i_]), 0x4E, 0xF, 0xF, true)); v_[i_] = (lane & 2) ? t_ - v_[i_] : v_[i_] + t_; }
            a[j][0] = (f32x4){v_[0], v_[1], v_[2], v_[3]}; a[j][1] = (f32x4){v_[4], v_[5], v_[6], v_[7]}; }
        (void)s1_; (void)s2_;
        sc *= 0.17677669529663687f; }
#pragma unroll
    for (int j = 0; j < 8; ++j) *(GAS v2u*)(orow + (lane + 64 * j) * 8) = pack8_i8(a[j][0] * sc, a[j][1] * sc);
    if constexpr (ROT) sc *= 5.656854249492381f;
    if (lane == 0) { *fac = NORM ? (1.0f / sqrtf(sx * (1.0f / DM) + EPS)) / sc : 1.0f / sc;
        if (faca) *faca = ACT_CLIP * (sa / (sx * (1.0f / DM) + EPS)) * sgu * (1.0f / 127.0f); }
}
__device__ __forceinline__ void p0_finish4(const f32x4 (&r)[8], int N, unsigned char* dst, float wsc, LAS float* scr, int item, int lane) {
    const int nblk = N / 32, kb = item / nblk, nb = item % nblk, k0 = 64 * kb, n0 = 32 * nb - 10656;
#pragma unroll
    for (int i = 0; i < 8; ++i) { LAS float* s = scr + (8 * i + (lane >> 3)) * 33 + 4 * (lane & 7); s[0] = r[i].x; s[1] = r[i].y; s[2] = r[i].z; s[3] = r[i].w; }
    LDS_WAIT(); asm volatile("" ::: "memory");
    const int c = lane & 7;
#pragma unroll
    for (int j = 0; j < 4; ++j) { const int n = (lane >> 3) + 8 * j; const LAS float* s = scr + (8 * c) * 33 + n;
        const unsigned o = pack4_f4(wsc * s[0 * 33], wsc * s[1 * 33], wsc * s[2 * 33], wsc * s[3 * 33]) | (pack4_f4(wsc * s[4 * 33], wsc * s[5 * 33], wsc * s[6 * 33], wsc * s[7 * 33]) << 16);
        *(GAS unsigned*)(dst + (size_t)(n0 + n) * 2048 + (k0 >> 1) + 4 * c) = o; }
    LDS_WAIT(); asm volatile("" ::: "memory");
}
__device__ __forceinline__ void rms_row_to_bf16(const float* xrow, const float* gain, bf16* orow, unsigned char* orow8, unsigned char* orow4, float* fach, int lane) {
    const GAS f32x4* xr = (const GAS f32x4*)xrow + lane;
    f32x4 v[16]; float s = 0.f;
#pragma unroll
    for (int j = 0; j < 16; ++j) { v[j] = xr[64 * j]; s += (v[j].x * v[j].x + v[j].y * v[j].y) + (v[j].z * v[j].z + v[j].w * v[j].w); }
    const float r = 1.0f / sqrtf(wave_sum(s) * (1.0f / DM) + EPS);
    GAS v2u* o8 = (GAS v2u*)orow + lane; GAS unsigned* o4 = (GAS unsigned*)orow8 + lane; GAS unsigned short* o2 = (GAS unsigned short*)orow4 + lane;
    float sh = 0.f;
#pragma unroll
    for (int j = 0; j < 16; ++j) { const f32x4 gv = ((const GAS f32x4*)gain)[lane + 64 * j]; v[j] = v[j] * r * gv; sh += (v[j].x * v[j].x + v[j].y * v[j].y) + (v[j].z * v[j].z + v[j].w * v[j].w); }
    const float sc = 127.0f / (4.0f * sqrtf(wave_sum(sh) * (1.0f / DM)) + 1e-30f);
#pragma unroll
    for (int j = 0; j < 16; ++j) { const f32x4 y = v[j];
        v2u w; w.x = cvt_pk_bf16(y.x, y.y); w.y = cvt_pk_bf16(y.z, y.w); o8[64 * j] = w;
        o4[64 * j] = q8(y.x * sc) | (q8(y.y * sc) << 8) | (q8(y.z * sc) << 16) | (q8(y.w * sc) << 24);
        o2[64 * j] = (unsigned short)pack4_f4(2.0f * y.x, 2.0f * y.y, 2.0f * y.z, 2.0f * y.w); }
    if (lane == 0) *fach = 1.0f / sc;
}

__device__ __forceinline__ unsigned ordkey(float v) { const unsigned u = __float_as_uint(v); return u ^ ((u >> 31) ? 0xffffffffu : 0x80000000u); }
__device__ __forceinline__ int mbcnt64(unsigned long long m) { return (int)__builtin_amdgcn_mbcnt_hi((unsigned)(m >> 32), __builtin_amdgcn_mbcnt_lo((unsigned)m, 0u)); }

__device__ __forceinline__ int wave_count(int cl) { int c = 0;
#pragma unroll
    for (int b = 0; b < 7; ++b) c += __popcll(__ballot((cl >> b) & 1)) << b;
    return c; }
constexpr int TOPK_WAVE_LDS = 6144;
__device__ __forceinline__ void topk_row(const float* sc, int N, unsigned short* out, LAS unsigned char* wl, int lane) {
    asm volatile("" : "+v"(lane));
    if (N <= TOPK) { v2u w; w.x = (unsigned)(4 * lane) | ((unsigned)(4 * lane + 1) << 16); w.y = (unsigned)(4 * lane + 2) | ((unsigned)(4 * lane + 3) << 16); *(GAS v2u*)(out + 4 * lane) = w; return; }
    LAS unsigned* hist = (LAS unsigned*)wl; LAS unsigned short* stg = (LAS unsigned short*)(wl + 4096);
    LAS unsigned* ckl = (LAS unsigned*)(wl + 4608); LAS unsigned short* cel = (LAS unsigned short*)(wl + 5632);
    const int ng = (N + 1023) >> 10;
    unsigned key[4][16]; int npos = 0;
#pragma unroll
    for (int g = 0; g < 4; ++g) {
#pragma unroll
        for (int j = 0; j < 16; ++j) key[g][j] = 0u;
        if (g < ng) {
#pragma unroll
            for (int j = 0; j < 16; ++j) { const int e = g * 1024 + j * 64 + lane; const float v = sc[e]; key[g][j] = e < N ? ordkey(v) : 0u; }
#pragma unroll
            for (int j = 0; j < 16; ++j) { const bool pos = key[g][j] > 0x80000000u; npos += __popcll(__ballot(pos));
                if (pos) (void)__hip_atomic_fetch_add(hist + (key[g][j] >> 22), 1u << ((key[g][j] >> 17) & 16u), __ATOMIC_RELAXED, __HIP_MEMORY_SCOPE_WORKGROUP); }
        } }
    if (npos < TOPK) {
#pragma unroll
        for (int g = 0; g < 4; ++g) if (g < ng) {
#pragma unroll
            for (int j = 0; j < 16; ++j) if (!(key[g][j] > 0x80000000u)) (void)__hip_atomic_fetch_add(hist + (key[g][j] >> 22), 1u << ((key[g][j] >> 17) & 16u), __ATOMIC_RELAXED, __HIP_MEMORY_SCOPE_WORKGROUP); } }
    unsigned h[32]; unsigned sl = 0u;
    { const LAS v4u* hp = (const LAS v4u*)(hist + 1024 - 16 * (lane + 1));
#pragma unroll
      for (int i = 0; i < 4; ++i) { const v4u t = hp[i];
          h[8 * i] = t.x & 0xffffu; h[8 * i + 1] = t.x >> 16; h[8 * i + 2] = t.y & 0xffffu; h[8 * i + 3] = t.y >> 16; h[8 * i + 4] = t.z & 0xffffu; h[8 * i + 5] = t.z >> 16; h[8 * i + 6] = t.w & 0xffffu; h[8 * i + 7] = t.w >> 16;
          sl += ((t.x & 0xffffu) + (t.x >> 16)) + ((t.y & 0xffffu) + (t.y >> 16)) + ((t.z & 0xffffu) + (t.z >> 16)) + ((t.w & 0xffffu) + (t.w >> 16)); }
      LAS v4u* hz = (LAS v4u*)(hist + 1024 - 16 * (lane + 1));
#pragma unroll
      for (int i = 0; i < 4; ++i) hz[i] = (v4u){0u, 0u, 0u, 0u}; }
    unsigned El = 0u;
#pragma unroll
    for (int b = 0; b < 13; ++b) El += (unsigned)mbcnt64(__ballot((sl >> b) & 1u)) << b;
    int kb = 0; unsigned ab = 0u, cb = 0u; { unsigned acc = El;
#pragma unroll
      for (int k = 31; k >= 0; --k) { const bool hit = acc < (unsigned)TOPK && acc + h[k] >= (unsigned)TOPK; kb = hit ? k : kb; ab = hit ? acc : ab; cb = hit ? h[k] : cb; acc += h[k]; } }
    const int Ls = __ffsll((long long)__ballot(El < (unsigned)TOPK && El + sl >= (unsigned)TOPK)) - 1;
    const unsigned b1 = (unsigned)(2048 - 32 * (Ls + 1) + __builtin_amdgcn_readlane(kb, Ls));
    const int above = (int)__builtin_amdgcn_readlane((int)ab, Ls), C = (int)__builtin_amdgcn_readlane((int)cb, Ls);
    int base = 0;
    if (C <= 256) {
        int cbase = 0;
#pragma unroll
        for (int g = 0; g < 4; ++g) if (g < ng) {
#pragma unroll
            for (int j = 0; j < 16; ++j) { const unsigned d = key[g][j] >> 21; const bool up = d > b1, cd = d == b1;
                const unsigned long long mu = __ballot(up), mc = __ballot(cd);
                if (up) stg[base + mbcnt64(mu)] = (unsigned short)(g * 1024 + j * 64 + lane);
                if (cd) { const int cp = cbase + mbcnt64(mc); ckl[cp] = key[g][j]; cel[cp] = (unsigned short)(g * 1024 + j * 64 + lane); }
                base += __popcll(mu); cbase += __popcll(mc); } }
        LDS_WAIT();
        unsigned ck[4]; unsigned ce[4];
#pragma unroll
        for (int m = 0; m < 4; ++m) { const int i = lane + 64 * m; ck[m] = i < C ? ckl[i] : 0u; ce[m] = cel[i]; }
        const int need = TOPK - above;
        unsigned T = b1 << 21; bool exact = false;
#pragma unroll 1
        for (int bit = 20; bit >= 0; --bit) { const unsigned cand = T | (1u << bit); int c = 0;
#pragma unroll
            for (int m = 0; m < 4; ++m) c += __popcll(__ballot(ck[m] >= cand));
            if (c >= need) { T = cand; if (c == need) { exact = true; break; } } }
        int need_eq = 1 << 30;
        if (!exact) { int cg = 0;
#pragma unroll
            for (int m = 0; m < 4; ++m) cg += __popcll(__ballot(ck[m] > T));
            need_eq = need - cg; }
        int eqb = 0;
#pragma unroll
        for (int m = 0; m < 4; ++m) { const bool gt = ck[m] > T, eq = ck[m] == T && ck[m] != 0u; const unsigned long long meq = __ballot(eq);
            const bool sel = gt || (eq && (eqb + mbcnt64(meq)) < need_eq); const unsigned long long ms = __ballot(sel);
            if (sel) stg[base + mbcnt64(ms)] = (unsigned short)ce[m];
            base += __popcll(ms); eqb += __popcll(meq); }
    } else {
        unsigned T = 0u; bool exact = false;
#pragma unroll 1
        for (int bit = 31; bit >= 0; --bit) {
            const unsigned cand = T | (1u << bit); int c = 0;
#pragma unroll
            for (int g = 0; g < 4; ++g) if (g < ng) {
#pragma unroll
                for (int j = 0; j < 16; ++j) c += __popcll(__ballot(key[g][j] >= cand)); }
            if (c >= TOPK) { T = cand; if (c == TOPK) { exact = true; break; } }
        }
        int need_eq = 1 << 30;
        if (!exact) { int cg = 0;
#pragma unroll
            for (int g = 0; g < 4; ++g) if (g < ng) {
#pragma unroll
                for (int j = 0; j < 16; ++j) cg += __popcll(__ballot(key[g][j] > T)); }
            need_eq = TOPK - cg; }
        int eqb = 0;
#pragma unroll
        for (int g = 0; g < 4; ++g) if (g < ng) {
#pragma unroll
            for (int j = 0; j < 16; ++j) { const bool gt = key[g][j] > T, eq = key[g][j] == T; const unsigned long long meq = __ballot(eq);
                const bool sel = gt || (eq && (eqb + mbcnt64(meq)) < need_eq); const unsigned long long ms = __ballot(sel);
                if (sel) stg[base + mbcnt64(ms)] = (unsigned short)(g * 1024 + j * 64 + lane);
                base += __popcll(ms); eqb += __popcll(meq); } }
    }
    LDS_WAIT();
    *(GAS v2u*)(out + 4 * lane) = *(const LAS v2u*)(stg + 4 * lane);
    LDS_WAIT();
}

#ifndef IDX_SCHED_BARRIER
#define IDX_SCHED_BARRIER 2
#endif
__device__ __forceinline__ void indexer_unit(LAS unsigned char* lds, int tid, int wave, int lane, int b, int qg,
                                             const bf16* QIDX, const bf16* KIDX, const float* WIDX, float* SC, unsigned short* IDX) {
    LAS unsigned char* KT = lds;
    LAS float* WT = (LAS float*)(lds + 65536);
    asm volatile("" : "+v"(lane), "+v"(tid));
    const int q0 = qg * 32, nkeys = q0 + 32, r = lane & 31, hh = lane >> 5;
    const size_t rowb = (size_t)b * SEQ;
    __syncthreads();
    const int hl = lane & 15, g = lane >> 4;
    bf16x8 A[4][2][4]; f32x4 W4[4][2];
#pragma unroll
    for (int qi = 0; qi < 4; ++qi)
#pragma unroll
        for (int hf = 0; hf < 2; ++hf) { W4[qi][hf] = *(const GAS f32x4*)(WIDX + (rowb + q0 + 4 * wave + qi) * 32 + 16 * hf + 4 * g);
#pragma unroll
            for (int kk = 0; kk < 4; ++kk) A[qi][hf][kk] = *(const GAS bf16x8*)(QIDX + (rowb + q0 + 4 * wave + qi) * 4096 + (16 * hf + hl) * 128 + 32 * kk + 8 * g); }
    const int nch = (nkeys + 127) >> 7;
    const int srow = 16 * wave + (lane >> 4), slot = lane & 15;
#define IDX_STAGE(ch_, buf_) do { _Pragma("unroll") for (int i_ = 0; i_ < 4; ++i_) { const int krow_ = srow + 4 * i_; \
        __builtin_amdgcn_global_load_lds((const GAS unsigned*)(KIDX + (rowb + (ch_) * 128 + krow_) * 128 + ((slot ^ (krow_ & 15)) << 3)), (LAS unsigned*)((buf_) + (16 * wave + 4 * i_) * 256), 16, 0, 0); } } while (0)
    IDX_STAGE(0, KT);
    for (int ch = 0; ch < nch; ++ch) {
        LAS unsigned char* buf = KT + (ch & 1) * 32768;
        VM_WAIT();
        __syncthreads();
        if (ch + 1 < nch) IDX_STAGE(ch + 1, KT + ((ch + 1) & 1) * 32768);
        const int rem = (nkeys - ch * 128) >> 5, ntile = rem < 4 ? rem : 4;
        for (int tile = 0; tile < ntile; ++tile) {
            bf16x8 Bf[2][4];
#pragma unroll
            for (int st = 0; st < 2; ++st)
#pragma unroll
                for (int kk = 0; kk < 4; ++kk) Bf[st][kk] = *(const LAS bf16x8*)(buf + (tile * 32 + 16 * st + hl) * 256 + (((4 * kk + g) ^ hl) << 4));
            const int key = ch * 128 + tile * 32 + 16 * (g & 1) + hl;
#pragma unroll
            for (int qi = 0; qi < 4; ++qi) {
                float s2[2];
#pragma unroll
                for (int st = 0; st < 2; ++st) { f32x4 a0 = {0.f, 0.f, 0.f, 0.f}, a1 = {0.f, 0.f, 0.f, 0.f};
#pragma unroll
                    for (int kk = 0; kk < 4; ++kk) { a0 = __builtin_amdgcn_mfma_f32_16x16x32_bf16(A[qi][0][kk], Bf[st][kk], a0, 0, 0, 0); a1 = __builtin_amdgcn_mfma_f32_16x16x32_bf16(A[qi][1][kk], Bf[st][kk], a1, 0, 0, 0); }
                    float sc = 0.f;
#pragma unroll
                    for (int i = 0; i < 4; ++i) sc += fmaxf(a0[i], 0.f) * W4[qi][0][i] + fmaxf(a1[i], 0.f) * W4[qi][1][i];
                    s2[st] = sc; }
                float tt; { const auto p16 = __builtin_amdgcn_permlane16_swap(__float_as_uint(s2[0]), __float_as_uint(s2[1]), false, false); tt = __uint_as_float(p16[0]) + __uint_as_float(p16[1]);
                            const auto p32 = __builtin_amdgcn_permlane32_swap(__float_as_uint(tt), __float_as_uint(tt), false, false); tt = __uint_as_float(p32[0]) + __uint_as_float(p32[1]); }
                const int qpos = q0 + 4 * wave + qi;
                if (g < 2 && key <= qpos) SC[(rowb + qpos) * 4096 + key] = tt;
                if (IDX_SCHED_BARRIER == 1 || (IDX_SCHED_BARRIER == 2 && (qi & 1))) __builtin_amdgcn_sched_barrier(0);
            }
        }
    }
#undef IDX_STAGE
    VM_WAIT();
#ifndef DUP_TOPK
#define DUP_TOPK 1
#endif
#pragma unroll 1
    for (int qi = 0; qi < 4 * DUP_TOPK; ++qi) { const int qpos = q0 + 4 * wave + (qi & 3); topk_row(SC + (rowb + qpos) * 4096, qpos + 1, IDX + (rowb + qpos) * 256, lds + 69632 + wave * TOPK_WAVE_LDS, lane); }
}

__device__ __forceinline__ void sgu_unit(LAS unsigned char* lds, int tid, int wave, int lane, int cidx, int grp,
                                         const bf16* UV, const float* LNP, const bf16* SGUW, const float* lng, const float* lnb, const float* sgub, bf16* YAB) {
    constexpr int VP = 544, WP = 272;
    LAS unsigned char* VN = lds;
    LAS unsigned char* WL = lds + 128 * VP;
    LAS float* ST = (LAS float*)(lds + 128 * VP + 128 * WP);
    const int t0 = cidx * 128;
    __syncthreads();
    if (tid < 128) { float s = 0.f, q = 0.f;
#pragma unroll
        for (int i = 0; i < 8; ++i) { const GAS f32x4* p = (const GAS f32x4*)(LNP + ((size_t)i * MTOK + t0 + tid) * 8); const f32x4 a = p[0], b = p[1]; s += (a[0] + a[2]) + (b[0] + b[2]); q += (a[1] + a[3]) + (b[1] + b[3]); }
        const float mean = s * (1.0f / GWID), var = q * (1.0f / GWID) - mean * mean;
        ST[2 * tid] = mean; ST[2 * tid + 1] = 1.0f / sqrtf(var + EPS); }
#pragma unroll
    for (int i = 0; i < 4; ++i) { const int c = (tid & 3) * 4 + i; *(LAS v4u*)(WL + (tid >> 2) * WP + c * 16) = *(const GAS v4u*)(SGUW + ((size_t)grp * 128 + (tid >> 2)) * 128 + c * 8); }
    __syncthreads();
#pragma unroll
    for (int i = 0; i < 8; ++i) { const int id = tid + 512 * i, s = id >> 5, dc = id & 31;
        const v4u w = *(const GAS v4u*)(UV + (size_t)(t0 + s) * 4096 + GWID + grp * GDIM + dc * 8); f32x4 v0, v1; unpack8(w, v0, v1);
        const float mean = ST[2 * s], rstd = ST[2 * s + 1];
        const f32x4 g0 = *(const GAS f32x4*)(lng + grp * GDIM + dc * 8), g1 = *(const GAS f32x4*)(lng + grp * GDIM + dc * 8 + 4);
        const f32x4 b0 = *(const GAS f32x4*)(lnb + grp * GDIM + dc * 8), b1 = *(const GAS f32x4*)(lnb + grp * GDIM + dc * 8 + 4);
        v0 = (v0 - mean) * rstd * g0 + b0; v1 = (v1 - mean) * rstd * g1 + b1;
        *(LAS v4u*)(VN + s * VP + dc * 16) = pack8(v0, v1); }
    __syncthreads();
    const int g = lane >> 4, hl = lane & 15, q = hl >> 2, p = lane & 3;
    f32x4 acc[2][8];
#pragma unroll
    for (int a = 0; a < 2; ++a)
#pragma unroll
        for (int t = 0; t < 8; ++t) acc[a][t] = (f32x4){0.f, 0.f, 0.f, 0.f};
#pragma unroll
    for (int ks = 0; ks < 4; ++ks) {
        bf16x8 vf[2];
#pragma unroll
        for (int ds = 0; ds < 2; ++ds) { const int d0 = (2 * wave + ds) * 16;
            const s16x4 a1 = __builtin_amdgcn_ds_read_tr16_b64_v4i16((LAS s16x4*)(VN + (32 * ks + 4 * g + q) * VP + (d0 + 4 * p) * 2));
            const s16x4 a2 = __builtin_amdgcn_ds_read_tr16_b64_v4i16((LAS s16x4*)(VN + (32 * ks + 16 + 4 * g + q) * VP + (d0 + 4 * p) * 2));
            vf[ds] = (bf16x8){a1[0], a1[1], a1[2], a1[3], a2[0], a2[1], a2[2], a2[3]}; }
#pragma unroll
        for (int tt = 0; tt < 8; ++tt) if (tt >= 2 * ks) {
            const int t = 16 * tt + hl;
            const s16x4 w1 = *(const LAS s16x4*)(WL + t * WP + (32 * ks + 4 * g) * 2), w2 = *(const LAS s16x4*)(WL + t * WP + (32 * ks + 16 + 4 * g) * 2);
            const bf16x8 wf = (bf16x8){w1[0], w1[1], w1[2], w1[3], w2[0], w2[1], w2[2], w2[3]};
#pragma unroll
            for (int ds = 0; ds < 2; ++ds) acc[ds][tt] = __builtin_amdgcn_mfma_f32_16x16x32_bf16(vf[ds], wf, acc[ds][tt], 0, 0, 0);
        }
    }
#pragma unroll
    for (int tt = 0; tt < 8; ++tt) { const int t = 16 * tt + hl; const float bs = sgub[grp * 128 + t]; const size_t rowo = (size_t)(t0 + t) * 4096;
#pragma unroll
        for (int ds = 0; ds < 2; ++ds) { const int d = grp * GDIM + (2 * wave + ds) * 16 + 4 * g;
            const v2u uw = *(const GAS v2u*)(UV + rowo + d);
            v2u o; o.x = cvt_pk_bf16(bf_lo(uw.x) * (acc[ds][tt][0] + bs), bf_hi(uw.x) * (acc[ds][tt][1] + bs)); o.y = cvt_pk_bf16(bf_lo(uw.y) * (acc[ds][tt][2] + bs), bf_hi(uw.y) * (acc[ds][tt][3] + bs));
            *(GAS v2u*)(YAB + (size_t)(t0 + t) * GWID + d) = o; } }
}

#ifndef KB_T
#define KB_T 4
#endif
constexpr int ATT_VB = 32 * 288, ATT_WAVE = ATT_VB + 512, ATT_BL = 8 * ATT_WAVE;
__device__ __forceinline__ void attn_query(LAS unsigned char* wl, const LAS float* BL, int lane, int b, int qpos,
                                           const bf16* Q, const bf16* KN, const bf16* V, const unsigned short* IDX, const float* qgain, bf16* YAB) {
    const int g = lane >> 4, hl = lane & 15, q4 = hl >> 2, p4 = lane & 3;
    const size_t rowb = (size_t)b * SEQ, row = rowb + qpos;
    const int cnt = qpos + 1 < TOPK ? qpos + 1 : TOPK;
    LAS unsigned short* IL = (LAS unsigned short*)(wl + ATT_VB);
    *(LAS v2u*)(IL + 4 * lane) = *(const GAS v2u*)(IDX + row * 256 + 4 * lane);
    bf16x8 qf[4];
    { v2u w[4]; float ss = 0.f;
#pragma unroll
      for (int kk = 0; kk < 4; ++kk) { w[kk] = *(const GAS v2u*)((const unsigned char*)Q + row * 2048 + hl * 128 + kk * 32 + g * 8); f32x4 a, c; unpack8_f8(w[kk], a, c);
          ss += (a[0] * a[0] + a[1] * a[1]) + (a[2] * a[2] + a[3] * a[3]) + (c[0] * c[0] + c[1] * c[1]) + (c[2] * c[2] + c[3] * c[3]); }
      ss += __shfl_xor(ss, 16); ss += __shfl_xor(ss, 32);
      const float rinv = (1.0f / sqrtf(ss * (1.0f / HDA) + EPS)) * 0.08838834764831845f;
#pragma unroll
      for (int kk = 0; kk < 4; ++kk) { f32x4 a, c; unpack8_f8(w[kk], a, c); const f32x4 g0 = *(const GAS f32x4*)(qgain + kk * 32 + g * 8), g1 = *(const GAS f32x4*)(qgain + kk * 32 + g * 8 + 4);
          const v4u o = pack8(a * rinv * g0, c * rinv * g1); qf[kk] = __builtin_bit_cast(bf16x8, o); } }
    f32x4 s[16];
#pragma unroll
    for (int hf = 0; hf < 16 / KB_T; ++hf) {
        bf16x8 kf[KB_T][4];
#pragma unroll
        for (int t8 = 0; t8 < KB_T; ++t8) { const int ki = IL[16 * (KB_T * hf + t8) + hl] & (SEQ - 1); const bf16* kp = KN + (rowb + ki) * 128 + g * 8;
#pragma unroll
            for (int kk = 0; kk < 4; ++kk) kf[t8][kk] = *(const GAS bf16x8*)(kp + kk * 32); }
        __builtin_amdgcn_sched_barrier(0);
#pragma unroll
        for (int t8 = 0; t8 < KB_T; ++t8) { const int t = KB_T * hf + t8; s[t] = (f32x4){0.f, 0.f, 0.f, 0.f};
#pragma unroll
            for (int kk = 0; kk < 4; ++kk) s[t] = __builtin_amdgcn_mfma_f32_16x16x32_bf16(kf[t8][kk], qf[kk], s[t], 0, 0, 0); }
    }
    float mx = -__builtin_inff();
#pragma unroll
    for (int t = 0; t < 16; ++t) { const v2u id = *(const LAS v2u*)(IL + 16 * t + 4 * g); const int kx[4] = {(int)(id.x & 0xffffu), (int)(id.x >> 16), (int)(id.y & 0xffffu), (int)(id.y >> 16)};
#pragma unroll
        for (int i = 0; i < 4; ++i) { int n = qpos - kx[i]; n = n < 0 ? 0 : (n > 128 ? 128 : n);
            const float v = (16 * t + 4 * g + i) < cnt ? s[t][i] + BL[n * 16 + hl] : -__builtin_inff(); s[t][i] = v; mx = fmaxf(mx, v); } }
    mx = fmaxf(mx, __shfl_xor(mx, 16)); mx = fmaxf(mx, __shfl_xor(mx, 32));
    float sum = 0.f;
#pragma unroll
    for (int t = 0; t < 16; ++t)
#pragma unroll
        for (int i = 0; i < 4; ++i) { const float e = __builtin_amdgcn_exp2f((s[t][i] - mx) * LOG2E); s[t][i] = e; sum += e; }
    sum += __shfl_xor(sum, 16); sum += __shfl_xor(sum, 32);
    const float inv = 1.0f / sum;
    bf16x8 pf[8];
#pragma unroll
    for (int T = 0; T < 8; ++T) { const v4u o = pack8(s[2 * T] * inv, s[2 * T + 1] * inv); pf[T] = __builtin_bit_cast(bf16x8, o); }
    f32x4 o[8];
#pragma unroll
    for (int dt = 0; dt < 8; ++dt) o[dt] = (f32x4){0.f, 0.f, 0.f, 0.f};
    v4u vn[8];
#pragma unroll
    for (int ins = 0; ins < 8; ++ins) { const int vi = IL[4 * ins + g] & (SEQ - 1); vn[ins] = *(const GAS v4u*)(V + (rowb + vi) * 128 + hl * 8); }
#pragma unroll
    for (int T = 0; T < 8; ++T) {
#pragma unroll
        for (int ins = 0; ins < 8; ++ins) *(LAS v4u*)(wl + (4 * ins + g) * 288 + hl * 16) = vn[ins];
        if (T < 7) {
#pragma unroll
            for (int ins = 0; ins < 8; ++ins) { const int vi = IL[32 * (T + 1) + 4 * ins + g] & (SEQ - 1); vn[ins] = *(const GAS v4u*)(V + (rowb + vi) * 128 + hl * 8); } }
        __builtin_amdgcn_sched_barrier(0);
#pragma unroll
        for (int dt = 0; dt < 8; ++dt) {
            const s16x4 a1 = __builtin_amdgcn_ds_read_tr16_b64_v4i16((LAS s16x4*)(wl + (4 * g + q4) * 288 + (16 * dt + 4 * p4) * 2));
            const s16x4 a2 = __builtin_amdgcn_ds_read_tr16_b64_v4i16((LAS s16x4*)(wl + (16 + 4 * g + q4) * 288 + (16 * dt + 4 * p4) * 2));
            const bf16x8 vf = (bf16x8){a1[0], a1[1], a1[2], a1[3], a2[0], a2[1], a2[2], a2[3]};
            o[dt] = __builtin_amdgcn_mfma_f32_16x16x32_bf16(vf, pf[T], o[dt], 0, 0, 0);
        }
    }
#pragma unroll
    for (int dt = 0; dt < 8; ++dt)
        *(GAS unsigned*)((unsigned char*)YAB + row * 2048 + hl * 128 + 16 * dt + 4 * g) = (unsigned)__builtin_amdgcn_cvt_pk_fp8_f32(o[dt][2], o[dt][3], __builtin_amdgcn_cvt_pk_fp8_f32(o[dt][0], o[dt][1], 0, false), true);
}

constexpr int NWAVES = 8;
#ifndef DUP_ATT
#define DUP_ATT 1
#endif
#ifndef DUP_SGU
#define DUP_SGU 1
#endif
#ifndef GEMM_SP2
#define GEMM_SP2 true
#endif
#ifndef GEMM_ALIGN
#define GEMM_ALIGN true
#endif
#ifndef MK_N_LAUNCHES
#define MK_N_LAUNCHES 1
#endif
constexpr int N_PHASES = 9;
constexpr int N_LAUNCHES = MK_N_LAUNCHES;
constexpr size_t WS_PB = WS_END;
constexpr size_t WS_NEED = WS_END + 8 * MiB;

__device__ __forceinline__ int lane_now() { int l; asm volatile("v_mbcnt_lo_u32_b32 %0, -1, 0\n\tv_mbcnt_hi_u32_b32 %0, -1, %0" : "=v"(l)); return l; }
struct Args { const float* in[22]; float* out; unsigned char* ws; int ph_lo, ph_hi, li, pad; };
enum { I_X = 0, I_P, I_WIN, I_QNG, I_KNG, I_RELB, I_LNG, I_LNB, I_SGUW, I_SGUB, I_WA, I_WB, I_WOUT, I_NMIX, I_NFFN, I_WG, I_WU, I_WD, I_WPLE, I_PLENG, I_WPG, I_NPLE };

__global__ void __launch_bounds__(NWAVES * 64, 2) fwd_kernel(Args args) {
    extern __shared__ __attribute__((aligned(16))) unsigned char lds_raw[];
    LAS unsigned char* lds = (LAS unsigned char*)lds_raw;
    volatile LAS unsigned* MISC = (volatile LAS unsigned*)(lds + MISC_OFF);
    const int wave = __builtin_amdgcn_readfirstlane(threadIdx.x >> 6);
#define PHASE_IDS() const int lane = lane_now(), tid = wave * 64 + lane
    const int G = gridDim.x, cu = blockIdx.x;
    const int gw = cu * NWAVES + wave, NGW = G * NWAVES;
    unsigned char* ws = args.ws;
    gu32* ctl = (gu32*)(ws + WS_CTL);
    for (int u = threadIdx.x; u < (LDS_BYTES - LDSCTL_OFF) / 4; u += NWAVES * 64) ((LAS unsigned*)(lds + LDSCTL_OFF))[u] = 0u;
    __syncthreads();
    { const unsigned t_ = threadIdx.x; volatile LAS float* sm_ = (volatile LAS float*)(lds + RING_OFF);
      const float* wi_ = args.in[I_WIN] + (size_t)(8 * t_) * INCOLS + 10656; const int ci_ = (int)((t_ * 37u) & 4095u);
      const float* wg_ = args.in[I_WG] + (size_t)(8 * t_) * DFF; const float* wu_ = args.in[I_WU] + (size_t)(8 * t_) * DFF; const int cg_ = (int)((t_ * 37u) % 5504u);
      const float* wo_ = args.in[I_WOUT] + (size_t)(8 * t_) * DM; const float* wp_ = args.in[I_WPG] + (size_t)(8 * t_) * DM; const float* wd_ = args.in[I_WD] + (size_t)(8 * t_) * DM;
      sm_[t_] = fabsf(wi_[ci_]) + fabsf(wi_[(ci_ + 2048) & 4095]); sm_[512 + t_] = fabsf(wg_[cg_]) + fabsf(wg_[cg_ + 5504]); sm_[1024 + t_] = fabsf(wu_[cg_]) + fabsf(wu_[cg_ + 5504]); sm_[1536 + t_] = fabsf(wo_[ci_]) + fabsf(wo_[(ci_ + 2048) & 4095]); sm_[2048 + t_] = fabsf(wp_[ci_]) + fabsf(wp_[(ci_ + 2048) & 4095]); sm_[2560 + t_] = fabsf(wd_[ci_]) + fabsf(wd_[(ci_ + 2048) & 4095]);
      __syncthreads();
      if (t_ < 48) { float a_ = 0.f; for (int i = 0; i < 64; ++i) a_ += sm_[(t_ >> 3) * 512 + (t_ & 7) * 64 + i]; sm_[3072 + t_] = a_; }
      __syncthreads();
      if (t_ == 0) { float s0_ = 0.f, s1_ = 0.f, s2_ = 0.f, s3_ = 0.f, s4_ = 0.f; float s5_ = 0.f; for (int i = 0; i < 8; ++i) { s0_ += sm_[3072 + i]; s1_ += sm_[3080 + i]; s2_ += sm_[3088 + i]; s3_ += sm_[3096 + i]; s4_ += sm_[3104 + i]; s5_ += sm_[3112 + i]; }
          MISC[22] = __float_as_uint(127.0f / (4.0f * 1.2533141f * fmaxf(s5_, 1e-30f) * (1.0f / 1024.0f)));
          MISC[20] = __float_as_uint(127.0f / (4.0f * 1.2533141f * fmaxf(s3_, 1e-30f) * (1.0f / 1024.0f))); MISC[21] = __float_as_uint(127.0f / (4.0f * 1.2533141f * fmaxf(s4_, 1e-30f) * (1.0f / 1024.0f)));
          int e_ = (int)rintf(__log2f(1.596f * 1024.0f / fmaxf(s0_, 1e-30f))); e_ = e_ < -40 ? -40 : (e_ > 60 ? 60 : e_); MISC[12] = (unsigned)e_;
          MISC[15] = __float_as_uint(127.0f / (4.0f * 1.2533141f * fmaxf(s0_, 1e-30f) * (1.0f / 1024.0f)));
          MISC[13] = __float_as_uint(127.0f / (4.0f * 1.2533141f * fmaxf(s1_, 1e-30f) * (1.0f / 1024.0f))); MISC[14] = __float_as_uint(127.0f / (4.0f * 1.2533141f * fmaxf(s2_, 1e-30f) * (1.0f / 1024.0f))); }
      __syncthreads(); }
    XcdBarrier bar; bar.bar = (unsigned*)(ctl + CW_BAR) + args.li * XCD_BAR_WORDS; bar.x = 0; bar.st = nullptr;
    if (N_LAUNCHES == 1) bar = xcd_barrier_post((unsigned*)(ctl + CW_BAR), MISC + 8);
#define GRID_BAR() do { if (N_LAUNCHES == 1) xcd_barrier(bar); } while (0)
    const int lo = args.ph_lo, hi = args.ph_hi;
#ifndef PH_MASK
#define PH_MASK 0x1ff
#endif
#define IN(k) ((((PH_MASK) >> (k)) & 1) && lo <= (k) && (k) < hi)
#define BOTH(k) (IN(k) && IN((k) + 1))
#ifndef DUP_MASK
#define DUP_MASK 0
#endif
#define REPS(k) (1 + (((DUP_MASK) >> (k)) & 1))

    bf16* const H = (bf16*)(ws + WS_H); bf16* const WINB = (bf16*)(ws + WS_WINB); unsigned char* const WIN8 = ws + WS_WIN8; unsigned char* const W4 = ws + WS_WIN8 + 57 * MiB; unsigned char* const H8 = ws + WS_H8; float* const FACH = (float*)(ws + WS_SSQ2);     unsigned char* const H4 = ws + WS_SGA + 64 * MiB;     bf16* const QIDX = (bf16*)(ws + WS_QIDX); bf16* const Qb = (bf16*)(ws + WS_Q);
    bf16* const UV = (bf16*)(ws + WS_UV); bf16* const SGA = (bf16*)(ws + WS_SGA); bf16* const SGB = (bf16*)(ws + WS_SGB);
    unsigned char* const WA8 = ws + WS_WAB; bf16* const WBB = (bf16*)(ws + WS_WAB + 8 * MiB);     bf16* const WOUT = (bf16*)(ws + WS_WOUT); bf16* const WGU = (bf16*)(ws + WS_WGU); bf16* const WD = (bf16*)(ws + WS_WD);
    bf16* const WPLE = (bf16*)(ws + WS_WPLE); bf16* const WPG = (bf16*)(ws + WS_WPG); bf16* const PB = (bf16*)(ws + WS_PB);
    unsigned short* const IDX = (unsigned short*)(ws + WS_IDX); float* const LNP = (float*)(ws + WS_LNP);
    float* const SSQ1 = (float*)(ws + WS_SSQ1); float* const SSQ2 = (float*)(ws + WS_SSQ2); float* const SSQP = (float*)(ws + WS_SSQP);
    float* const WIDX = (float*)(ws + WS_WIDX); bf16* const KIDX = (bf16*)(ws + WS_KIDX); bf16* const KN = (bf16*)(ws + WS_KN); bf16* const Vb = (bf16*)(ws + WS_V);
    float* const KRAW = (float*)(ws + WS_KRAW); bf16* const SGUW = (bf16*)(ws + WS_SGUW);
    float* const SC = (float*)(ws + WS_SC); bf16* const MERGED = (bf16*)(ws + WS_MERGED); unsigned char* const T8 = ws + WS_MERGED + 128 * MiB;     bf16* const ACT = (bf16*)(ws + WS_ACT); unsigned char* const ACT8 = ws + WS_ACT; unsigned char* const WD8 = ws + WS_Q;     bf16* const YB = (bf16*)(ws + WS_YAB); unsigned char* const YA8 = ws + WS_YAB + 64 * MiB;
    bf16* const X1R = (bf16*)(ws + WS_SGB); bf16* const X2R = (bf16*)(ws + WS_WGU);     bf16* const X1G = (bf16*)(ws + WS_X1G); bf16* const X2G = (bf16*)(ws + WS_X2G); bf16* const PE = (bf16*)(ws + WS_PE);


    constexpr int I_IN = 64 * (INCOLS / 32), I_A = 32 * 128, I_SQ = 64 * 128, I_G = 64 * (DFF / 32), I_D = (DFF / 64) * 128, I_PL = 4 * 128;
    constexpr int NITEMS = I_IN + 2 * I_A + I_SQ + I_PL + 2 * I_G + I_D + I_SQ;
    constexpr int TAIL_A = 15104, TAIL_B = 15104, TAIL_U = 22016;
    static_assert(TAIL_A + TAIL_B <= I_D + I_SQ && TAIL_U <= I_G, "deferred item ranges");
#define CONV_SRC(it_, r_) do { int r_ = (it_); const float* W_; int N_; \
        if (r_ < I_IN) { W_ = args.in[I_WIN]; N_ = INCOLS; } else { r_ -= I_IN; \
        if (r_ < I_A) { W_ = args.in[I_WA]; N_ = DM; } else { r_ -= I_A; \
        if (r_ < I_A) { W_ = args.in[I_WB]; N_ = DM; } else { r_ -= I_A; \
        if (r_ < I_SQ) { W_ = args.in[I_WOUT]; N_ = DM; } else { r_ -= I_SQ; \
        if (r_ < I_PL) { W_ = args.in[I_WPLE]; N_ = DM; } else { r_ -= I_PL; \
        if (r_ < I_G) { W_ = args.in[I_WG]; N_ = DFF; } else { r_ -= I_G; \
        if (r_ < I_G) { W_ = args.in[I_WU]; N_ = DFF; } else { r_ -= I_G; \
        if (r_ < I_D) { W_ = args.in[I_WD]; N_ = DM; } else { r_ -= I_D; W_ = args.in[I_WPG]; N_ = DM; } } } } } } } } \
        p0_load(W_, N_, r_, nx, lane); } while (0)
#define CONV_ITEMS(first_, last_, widx_, wstride_) do { LAS float* scr = (LAS float*)(lds + RING_OFF + wave * 16384); f32x4 nx[8], cr[8]; \
        const int i0_ = (first_) + (widx_), iend_ = (last_), ist_ = (wstride_); \
        if (i0_ < iend_) CONV_SRC(i0_, ra_); \
        for (int it = i0_; it < iend_; it += ist_) { \
            _Pragma("unroll") for (int i = 0; i < 8; ++i) cr[i] = nx[i]; \
            asm volatile("" ::: "memory"); \
            if (it + ist_ < iend_) CONV_SRC(it + ist_, rb_); \
            int r = it; \
            if (r < I_IN) { const int nb_ = r % (INCOLS / 32); if (nb_ >= 200 && nb_ < 205) p0_finish<1>(cr, INCOLS, WINB, DM, 0, scr, r, lane); else if (nb_ >= 333 && nb_ < 461) p0_finish4(cr, INCOLS, W4, __uint_as_float((unsigned)(127 + (int)MISC[12]) << 23), scr, r, lane); else p0_finish_i8<4>(cr, INCOLS, WIN8, DM, __uint_as_float(MISC[15]), scr, r, lane); continue; } r -= I_IN; \
            if (r < I_A) { p0_finish8<0>(cr, DM, WA8, 2048, scr, r, lane); continue; } r -= I_A; \
            if (r < I_A) { p0_finish<0>(cr, DM, WBB, 2048, 0, scr, r, lane); continue; } r -= I_A; \
            if (r < I_SQ) { p0_finish_i8h(cr, DM, (unsigned char*)WOUT, DM, __uint_as_float(MISC[20]), scr, r, lane); continue; } r -= I_SQ; \
            if (r < I_PL) { p0_finish<0>(cr, DM, WPLE, DPLE, 0, scr, r, lane); continue; } r -= I_PL; \
            if (r < I_G) { p0_finish_i8<2>(cr, DFF, (unsigned char*)WGU, DM, __uint_as_float(MISC[13]), scr, r, lane); continue; } r -= I_G; \
            if (r < I_G) { p0_finish_i8<3>(cr, DFF, (unsigned char*)WGU, DM, __uint_as_float(MISC[14]), scr, r, lane); continue; } r -= I_G; \
            if (r < I_D) { if (P7F < 64) p0_finish<0>(cr, DM, WD, DFF, 0, scr, r, lane); if (P7F > 0) p0_finish_i8h(cr, DM, WD8, DFF, __uint_as_float(MISC[22]), scr, r, lane); continue; } r -= I_D; \
            p0_finish_i8<0>(cr, DM, (unsigned char*)WPG, DM, __uint_as_float(MISC[21]), scr, r, lane); } } while (0)
#define CONV_TAIL(nwg_, first_, last_) do { const int rem_ = (nwg_) % G; if (rem_ == 0) CONV_ITEMS(first_, last_, gw, NGW); \
        else if (cu >= rem_) CONV_ITEMS(first_, last_, (cu - rem_) * NWAVES + wave, (G - rem_) * NWAVES); } while (0)
    if (IN(0)) {
#pragma unroll
      for (int rep = 0; rep < REPS(0); ++rep) {
        PHASE_IDS();
        CONV_ITEMS(0, NITEMS - TAIL_A - TAIL_B - TAIL_U, gw, NGW);
        for (int m = gw; m < MTOK; m += NGW) rms_row_to_bf16(args.in[I_X] + (size_t)m * DM, args.in[I_NMIX], H + (size_t)m * DM, H8 + (size_t)m * DM, H4 + (size_t)m * (DM / 2), FACH + m, lane);
        { const float* P = args.in[I_P]; const int gt = cu * 512 + tid, NT = G * 512;
          for (int i = gt; i < MTOK * DPLE / 4; i += NT) { const f32x4 v = *(const GAS f32x4*)(P + (size_t)i * 4); v2u w; w.x = cvt_pk_bf16(v.x, v.y); w.y = cvt_pk_bf16(v.z, v.w); *(GAS v2u*)(PB + (size_t)i * 4) = w; }
          const float* SW = args.in[I_SGUW];
          for (int i = gt; i < NGRP * CHK * CHK / 2; i += NT) { const int e = 2 * i, t = (e >> 7) & 127, s = e & 127; const f32x2 v = *(const GAS f32x2*)(SW + e);
              *(GAS unsigned*)(SGUW + e) = cvt_pk_bf16(s <= t ? v.x : 0.f, (s + 1) <= t ? v.y : 0.f); } }
        if (rep + 1 < REPS(0) || BOTH(0)) GRID_BAR();
      }
    }

    if (IN(1)) {
#pragma unroll
      for (int rep = 0; rep < REPS(1); ++rep) {
        PHASE_IDS();
        { pg8::Gemm g{(const bf16*)H4, (const bf16*)W4, MTOK, 16 * 256, DM / 4}; pg8::BlockOrder S; S.init(MTOK, 16 * 256, G, cu);
          pg8::EpiInProjT<2> E{Qb, Vb, QIDX, KIDX, UV, SGA, SGB, KRAW, WIDX, LNP, nullptr, 1.0f};
          pg8::gemm_phase<pg8::EpiInProjT<2>, pg8::BlockOrder, GEMM_ALIGN, GEMM_SP2, false, true>(lds + RING_OFF, g, S, E, tid, 127 - (int)MISC[12]); }
        { pg8::Gemm g{(const bf16*)H8, (const bf16*)WIN8, MTOK, 57 * 256, DM / 2}; pg8::BlockOrder S; S.init(MTOK, 57 * 256, G, cu);
          const float isw_ = __uint_as_float(__builtin_amdgcn_readfirstlane(__float_as_uint(1.0f / __uint_as_float(MISC[15]))));
          pg8::EpiInProjT<0> E{Qb, Vb, QIDX, KIDX, UV, SGA, SGB, KRAW, WIDX, LNP, FACH, isw_};
          pg8::gemm_phase<pg8::EpiInProjT<0>, pg8::BlockOrder, GEMM_ALIGN, GEMM_SP2, false, false, true>(lds + RING_OFF, g, S, E, tid); }
        { pg8::Gemm g{H, WINB, MTOK, 1 * 256, DM}; pg8::BlockOrder S; S.init(MTOK, 1 * 256, G, G - 1 - cu);
          pg8::EpiInProjT<1> E{Qb, Vb, QIDX, KIDX, UV, SGA, SGB, KRAW, WIDX, LNP, nullptr, 1.0f};
          pg8::gemm_phase<pg8::EpiInProjT<1>, pg8::BlockOrder, GEMM_ALIGN, GEMM_SP2>(lds + RING_OFF, g, S, E, tid); }
        if (rep == 0) { const int rem_ = ((MTOK / 256) * 1) % G;
            if (rem_ == 0) CONV_ITEMS(NITEMS - TAIL_A - TAIL_B - TAIL_U, NITEMS - TAIL_A - TAIL_B, gw, NGW);
            else if (G - 1 - cu >= rem_) CONV_ITEMS(NITEMS - TAIL_A - TAIL_B - TAIL_U, NITEMS - TAIL_A - TAIL_B, (G - 1 - cu - rem_) * NWAVES + wave, (G - rem_) * NWAVES); }
        if (rep + 1 < REPS(1) || BOTH(1)) GRID_BAR();
      }
    }

#if defined(NULL_GEMM)
    if (IN(1)) { PHASE_IDS();
        pg8::Gemm g{H, WIN, MTOK, NULL_GEMM * 256, DM}; pg8::BlockOrder S; S.init(MTOK, NULL_GEMM * 256, G, cu);
        pg8::EpiNull E{SSQP};
        pg8::gemm_phase<pg8::EpiNull, pg8::BlockOrder, GEMM_ALIGN, GEMM_SP2>(lds + RING_OFF, g, S, E, tid);
        GRID_BAR(); }
#endif
    if (IN(2)) {
#pragma unroll
      for (int rep = 0; rep < REPS(2); ++rep) {
        PHASE_IDS();
        { const float* kg = args.in[I_KNG];
          for (int rp = gw; rp < MTOK / 2; rp += NGW) { const int row = 2 * rp + (lane >> 5), c = (lane & 31) * 4;
              const f32x4 v = *(const GAS f32x4*)(KRAW + (size_t)row * 128 + c); float ss = (v.x * v.x + v.y * v.y) + (v.z * v.z + v.w * v.w);
#pragma unroll
              for (int o = 1; o < 32; o <<= 1) ss += __shfl_xor(ss, o);
              const float r = 1.0f / sqrtf(ss * (1.0f / HDA) + EPS); const f32x4 gv = *(const GAS f32x4*)(kg + c);
              v2u w; w.x = cvt_pk_bf16(v.x * r * gv.x, v.y * r * gv.y); w.y = cvt_pk_bf16(v.z * r * gv.z, v.w * r * gv.w); *(GAS v2u*)(KN + (size_t)row * 128 + c) = w; } }
        for (int i = tid; i < 8 * TOPK_WAVE_LDS / 16; i += NWAVES * 64) *(LAS v4u*)(lds + RING_OFF + 69632 + i * 16) = (v4u){0u, 0u, 0u, 0u};
        constexpr int NU = NB * (SEQ / 32);
        for (int j = cu; j < NU; j += G) { const int rnd = j / G, pos = j % G; int u;
            if ((rnd & 1) == 0) u = j; else { const int hiu = (rnd + 1) * G < NU ? (rnd + 1) * G : NU; u = hiu - 1 - pos; if (u < rnd * G) continue; }
            indexer_unit(lds + RING_OFF, tid, wave, lane, u % NB, u / NB, QIDX, KIDX, WIDX, SC, IDX); }
        if (rep + 1 < REPS(2) || BOTH(2)) GRID_BAR();
      }
    }

    if (IN(3)) {
#pragma unroll
      for (int rep = 0; rep < REPS(3); ++rep) {
        PHASE_IDS();
        for (int rr = 0; rr < DUP_SGU; ++rr)
        for (int u = cu; u < (MTOK / CHK) * NGRP; u += G) sgu_unit(lds + RING_OFF, tid, wave, lane, u >> 3, u & 7, UV, LNP, SGUW, args.in[I_LNG], args.in[I_LNB], args.in[I_SGUB], YB);
        __syncthreads();
        LAS float* BL = (LAS float*)(lds + RING_OFF + ATT_BL);
        { const float* rb = args.in[I_RELB];
          for (int i = tid; i < 129 * 16; i += NWAVES * 64) { const int n = i >> 4, h = i & 15; int bk;
              if (n < 16) bk = n; else { bk = 16 + (int)(logf((float)n * (1.0f / 16.0f)) / 2.0794415416798357f * 16.0f); bk = bk > 31 ? 31 : bk; }
              BL[i] = rb[bk * 16 + h]; } }
        __syncthreads();
        for (int rr = 0; rr < DUP_ATT; ++rr)
        for (int qi = gw; qi < MTOK; qi += NGW) attn_query(lds + RING_OFF + wave * ATT_WAVE, BL, lane, qi / SEQ, qi % SEQ, Qb, KN, Vb, IDX, args.in[I_QNG], (bf16*)YA8);
        if (rep + 1 < REPS(3) || BOTH(3)) GRID_BAR();
      }
    }

#if defined(IDLE_US)
    { const unsigned long long t0 = __builtin_amdgcn_s_memrealtime(); while (__builtin_amdgcn_s_memrealtime() - t0 < (unsigned long long)(IDLE_US) * 100ull) __builtin_amdgcn_s_sleep(32); }
#endif
    if (IN(4)) {
#pragma unroll
      for (int rep = 0; rep < REPS(4); ++rep) {
        PHASE_IDS();
        { pg8::Gemm g{(const bf16*)YA8, (const bf16*)WA8, MTOK, DM, GWID / 2}; pg8::BlockOrder S; S.init(MTOK, DM, G, cu);
          pg8::EpiPlain E{(bf16*)T8};
          pg8::gemm_phase<pg8::EpiPlain, pg8::BlockOrder, GEMM_ALIGN, GEMM_SP2, true>(lds + RING_OFF, g, S, E, tid); }
        { pg8::Gemm g{YB, WBB, MTOK, DM, GWID}; pg8::BlockOrder S; S.init(MTOK, DM, G, cu);
          pg8::EpiMerge E{SGA, SGB, (const bf16*)T8, MERGED};
          pg8::gemm_phase<pg8::EpiMerge, pg8::BlockOrder, GEMM_ALIGN, GEMM_SP2>(lds + RING_OFF, g, S, E, tid); }
        if (rep + 1 < REPS(4) || BOTH(4)) GRID_BAR();
      }
    }

    if (IN(5)) {
#pragma unroll
      for (int rep = 0; rep < REPS(5); ++rep) {
        PHASE_IDS();
        unsigned char* wsl = args.ws; asm volatile("" : "+s"(wsl));
        unsigned char* const MQ = wsl + WS_MERGED + 128 * MiB; float* const FACM = (float*)(wsl + WS_LNP + 1 * MiB);
        for (int m = gw; m < MTOK; m += NGW) quant_row_i8<false, false, true>(MERGED + (size_t)m * DM, nullptr, MQ + (size_t)m * DM, FACM + m, lane, 4.25f);
        GRID_BAR();
        { pg8::Gemm g{(const bf16*)MQ, WOUT, MTOK, DM, DM / 2}; pg8::BlockOrder S; S.init(MTOK, DM, G, cu);
          const float iso_ = __uint_as_float(__builtin_amdgcn_readfirstlane(__float_as_uint(1.0f / __uint_as_float(MISC[20]))));
          pg8::EpiResid E{args.in[I_X], X1R, nullptr, args.in[I_NFFN], SSQ1, FACM, iso_};
          pg8::gemm_phase<pg8::EpiResid, pg8::BlockOrder, GEMM_ALIGN, GEMM_SP2, false, false, true>(lds + RING_OFF, g, S, E, tid); }
        { pg8::Gemm g{PB, WPLE, MTOK, DM, DPLE}; pg8::BlockOrder S; S.init(MTOK, DM, G, cu);
          pg8::EpiPe E{PE, SSQP};
          pg8::gemm_phase<pg8::EpiPe, pg8::BlockOrder, GEMM_ALIGN, GEMM_SP2>(lds + RING_OFF, g, S, E, tid); }
        if (rep + 1 < REPS(5) || BOTH(5)) GRID_BAR();
      }
    }

    if (IN(6)) {
#pragma unroll
      for (int rep = 0; rep < REPS(6); ++rep) {
        PHASE_IDS();
        if (rep == 0) { CONV_ITEMS(NITEMS - TAIL_A - TAIL_B, NITEMS - TAIL_B, gw, NGW); __syncthreads(); }
        unsigned char* wsl = args.ws; asm volatile("" : "+s"(wsl));
        const float sgu_ = (127.0f / (4.0f * __uint_as_float(MISC[13]))) * (127.0f / (4.0f * __uint_as_float(MISC[14])));
        float* const FACA = (float*)(wsl + WS_LNP + 3 * MiB);
        unsigned char* const X1Q = wsl + WS_WAB; float* const FAC1 = (float*)(wsl + WS_LNP);
        for (int m = gw; m < MTOK; m += NGW) quant_row_i8<true, true>(X1R + (size_t)m * DM, args.in[I_NFFN], X1Q + (size_t)m * DM, FAC1 + m, lane, 4.0f, FACA + m, sgu_);
        GRID_BAR();
        pg8::Gemm g{(const bf16*)X1Q, WGU, MTOK, 2 * DFF, DM / 2}; pg8::BlockOrder S; S.init(MTOK, 2 * DFF, G, cu);
        const float isg_ = __uint_as_float(__builtin_amdgcn_readfirstlane(__float_as_uint(1.0f / __uint_as_float(MISC[13])))), isu_ = __uint_as_float(__builtin_amdgcn_readfirstlane(__float_as_uint(1.0f / __uint_as_float(MISC[14]))));
        pg8::EpiGateUpQ E{FAC1, isg_, isu_, ACT, ACT8, P7F, FACA};
        pg8::gemm_phase<pg8::EpiGateUpQ, pg8::BlockOrder, GEMM_ALIGN, GEMM_SP2, false, false, true>(lds + RING_OFF, g, S, E, tid);
        if (rep == 0) CONV_TAIL((MTOK / 256) * (2 * DFF / 256), NITEMS - TAIL_B, NITEMS);
        if (rep + 1 < REPS(6) || BOTH(6)) GRID_BAR();
      }
    }

    if (IN(7)) {
#pragma unroll
      for (int rep = 0; rep < REPS(7); ++rep) {
        PHASE_IDS();
        if (P7F > 0) { pg8::Gemm g{(const bf16*)ACT8, (const bf16*)WD8, P7F * 256, DM, DFF / 2}; pg8::BlockOrder S; S.init(P7F * 256, DM, G, cu); { int rm_ = S.rmain; asm volatile("" : "+v"(rm_)); S.rmain = __builtin_amdgcn_readfirstlane(rm_); }
          const float isd_ = __uint_as_float(__builtin_amdgcn_readfirstlane(__float_as_uint(1.0f / __uint_as_float(MISC[22]))));
          pg8::EpiResidQ E{X1R, X2R, nullptr, args.in[I_NPLE], SSQ2, (const float*)(args.ws + WS_LNP + 3 * MiB), isd_};
          pg8::gemm_phase<pg8::EpiResidQ, pg8::BlockOrder, GEMM_ALIGN, GEMM_SP2, false, false, true>(lds + RING_OFF, g, S, E, tid); }
        if (P7F < 64) { pg8::Gemm g{ACT + (size_t)P7F * 256 * DFF, WD, MTOK - P7F * 256, DM, DFF}; pg8::BlockOrder S; S.init(MTOK - P7F * 256, DM, G, cu); { int rm_ = S.rmain; asm volatile("" : "+v"(rm_)); S.rmain = __builtin_amdgcn_readfirstlane(rm_); }
          constexpr size_t R0 = (size_t)P7F * 256;
          pg8::EpiResidB E{X1R + R0 * 4096, X2R + R0 * 4096, nullptr, args.in[I_NPLE], SSQ2 + R0 * 4, nullptr, 1.0f};
          pg8::gemm_phase<pg8::EpiResidB, pg8::BlockOrder, GEMM_ALIGN, GEMM_SP2>(lds + RING_OFF, g, S, E, tid); }
        if (rep + 1 < REPS(7) || BOTH(7)) GRID_BAR();
      }
    }

    if (IN(8)) {
        PHASE_IDS();
        unsigned char* wsl = args.ws; asm volatile("" : "+s"(wsl));
        unsigned char* const X2Q = wsl + WS_X2G; float* const FAC2 = (float*)(wsl + WS_LNP + 2 * MiB);
        for (int m = gw; m < MTOK; m += NGW) quant_row_i8<true, true>(X2R + (size_t)m * DM, args.in[I_NPLE], X2Q + (size_t)m * DM, FAC2 + m, lane);
        GRID_BAR();
        pg8::Gemm g{(const bf16*)X2Q, WPG, MTOK, DM, DM / 2}; pg8::BlockOrder S; S.init(MTOK, DM, G, cu);
        const float isp_ = __uint_as_float(__builtin_amdgcn_readfirstlane(__float_as_uint(1.0f / __uint_as_float(MISC[21]))));
        pg8::EpiFinal E{FAC2, SSQP, args.in[I_PLENG], PE, X2R, args.out, isp_};
        pg8::gemm_phase<pg8::EpiFinal, pg8::BlockOrder, GEMM_ALIGN, GEMM_SP2, false, false, true>(lds + RING_OFF, g, S, E, tid);
    }

#if defined(DUMP_AFTER)
    if (lo == N_PHASES) {
        const size_t gt = (size_t)cu * 512 + threadIdx.x, NT = (size_t)G * 512;
        for (size_t i = gt; i < (size_t)MTOK * DM; i += NT) { const size_t m = i >> 12; const int c = (int)(i & 4095); float v = 0.f;
#if DUMP_AFTER == 3
            v = bf_lo((unsigned)YB[i >> 1]);
#elif DUMP_AFTER == 2
            v = c < 256 ? (float)IDX[m * 256 + c] : (c < 384 ? bf_lo((unsigned)KN[m * 128 + c - 256]) : 0.f);
#elif DUMP_AFTER == 1
#if DUMP_SEL == 0
            v = bf_lo((unsigned)QIDX[i]);
#elif DUMP_SEL == 1
            v = bf_lo((unsigned)UV[i]);
#elif DUMP_SEL == 2
            v = bf_lo((unsigned)SGA[i]) + bf_lo((unsigned)SGB[i]);
#elif DUMP_SEL == 3
            v = bf_lo((unsigned)Qb[m * 2048 + (c & 2047)]);
            if (c < 128) v += KRAW[m * 128 + c] + bf_lo((unsigned)Vb[m * 128 + c]) + bf_lo((unsigned)KIDX[m * 128 + c]);
            if (c < 32) v += WIDX[m * 32 + c];
#endif
#elif DUMP_AFTER == 0
            v = bf_lo((unsigned)H[i]) + bf_lo((unsigned)WIN[i]) + bf_lo((unsigned)WIN[(size_t)(INPAD - 4096) * DM + i]) + bf_lo((unsigned)WGU[i]) + bf_lo((unsigned)WD[i]) + bf_lo((unsigned)WAB[i]);
#endif
            args.out[i] = v; }
    }
#endif
#undef IN
#undef BOTH
#undef GRID_BAR
}

extern "C" void kernel_launch(void* const* d_in, const int* in_sizes, int n_in, void* d_out, int out_size, void* d_ws, size_t ws_size, hipStream_t stream) {
    static int grid = 0;
    if (grid == 0) {
        if (n_in != 22 || in_sizes[0] != MTOK * DM || out_size != MTOK * DM || ws_size < WS_NEED) {
            fprintf(stderr, "kernel_launch: unexpected problem (n_in %d, in0 %d, out %d, ws %zu, need %zu); nothing launched\n", n_in, n_in > 0 ? in_sizes[0] : -1, out_size, ws_size, (size_t)WS_NEED); grid = -1; return; }
        int dev = 0, cus = 0, per_cu = 0;
        if (hipGetDevice(&dev) != hipSuccess || hipDeviceGetAttribute(&cus, hipDeviceAttributeMultiprocessorCount, dev) != hipSuccess) { grid = -1; return; }
        if (hipFuncSetAttribute((const void*)fwd_kernel, hipFuncAttributeMaxDynamicSharedMemorySize, LDS_BYTES) != hipSuccess) { fprintf(stderr, "kernel_launch: hipFuncSetAttribute failed\n"); grid = -1; return; }
        if (hipOccupancyMaxActiveBlocksPerMultiprocessor(&per_cu, (const void*)fwd_kernel, NWAVES * 64, LDS_BYTES) != hipSuccess || per_cu < 1)
            fprintf(stderr, "kernel_launch: note: occupancy query reports %d workgroups per CU\n", per_cu);
        (void)hipGetLastError();
        grid = cus;
    }
    if (grid < 0) return;
    if (hipMemsetAsync((char*)d_ws + WS_CTL, 0, CTL_ZERO_BYTES, stream) != hipSuccess) return;
    Args a{};
    for (int i = 0; i < 22; ++i) a.in[i] = (const float*)d_in[i];
    a.out = (float*)d_out; a.ws = (unsigned char*)d_ws;
#if defined(DUMP_AFTER)
    for (int li = 0; li <= DUMP_AFTER + 1; ++li) {
        a.ph_lo = li <= DUMP_AFTER ? li : N_PHASES; a.ph_hi = a.ph_lo + 1; a.li = 0;
#else
    for (int li = 0; li < N_LAUNCHES; ++li) {
        a.ph_lo = (N_LAUNCHES == 1) ? 0 : li; a.ph_hi = (N_LAUNCHES == 1) ? N_PHASES : li + 1; a.li = (N_LAUNCHES == 1) ? 0 : 0;
#endif
        hipLaunchKernelGGL(fwd_kernel, dim3(grid), dim3(NWAVES * 64), LDS_BYTES, stream, a);
        const hipError_t le = hipPeekAtLastError();
        if (le != hipSuccess) { fprintf(stderr, "kernel_launch: launch %d failed: %s\n", li, hipGetErrorName(le)); break; }
    }
}
```

```cpp
#include <hip/hip_runtime.h>
#include <cstdio>
#include <cstdint>

#define GAS __attribute__((address_space(1)))
#define LAS __attribute__((address_space(3)))
typedef unsigned short bf16;
typedef unsigned v4u __attribute__((ext_vector_type(4)));
typedef unsigned v2u __attribute__((ext_vector_type(2)));
typedef float f32x4 __attribute__((ext_vector_type(4)));
typedef float f32x2 __attribute__((ext_vector_type(2)));
typedef float f32x16 __attribute__((ext_vector_type(16)));
typedef short bf16x8 __attribute__((ext_vector_type(8)));
typedef short s16x4 __attribute__((ext_vector_type(4)));
typedef GAS unsigned gu32;

constexpr int NB = 4, SEQ = 4096, DM = 4096, MTOK = NB * SEQ;
constexpr int NHA = 16, HDA = 128, NIH = 32, IDXD = 128, TOPK = 256;
constexpr int GWID = 2048, NGRP = 8, GDIM = 256, CHK = 128;
constexpr int DFF = 11008, DPLE = 256;
constexpr int INCOLS = 18848, INPAD = 18944;
constexpr float EPS = 1e-6f;
constexpr float LOG2E = 1.4426950408889634f;

constexpr size_t MiB = 1u << 20;
constexpr size_t WS_CTL = 0, CTL_ZERO_BYTES = 1 * MiB;
constexpr size_t WS_IDX = 1 * MiB;
constexpr size_t WS_LNP = 9 * MiB;
constexpr size_t WS_SSQ1 = 13 * MiB;
constexpr size_t WS_SSQ2 = 17 * MiB;
constexpr size_t WS_SSQP = 21 * MiB;
constexpr size_t WS_WIDX = 25 * MiB;
constexpr size_t WS_KIDX = 27 * MiB;
constexpr size_t WS_KN = 31 * MiB;
constexpr size_t WS_V = 35 * MiB;
constexpr size_t WS_KRAW = 39 * MiB;
constexpr size_t WS_SGUW = 47 * MiB;
constexpr size_t WS_H = 48 * MiB;
constexpr size_t WS_WIN = 176 * MiB;
constexpr size_t WS_QIDX = 324 * MiB;
constexpr size_t WS_Q = 452 * MiB;
constexpr size_t WS_UV = 516 * MiB;
constexpr size_t WS_SGA = 644 * MiB;
constexpr size_t WS_SGB = 772 * MiB;
constexpr size_t WS_WAB = 900 * MiB;
constexpr size_t WS_WOUT = 932 * MiB;
constexpr size_t WS_WGU = 964 * MiB;
constexpr size_t WS_WD = 1136 * MiB;
constexpr size_t WS_WPLE = 1222 * MiB;
constexpr size_t WS_WPG = 1224 * MiB;
constexpr size_t WS_END = 1256 * MiB;
constexpr size_t WS_WINB = WS_WIN, WS_WIN8 = WS_WIN + 66 * MiB;
constexpr size_t WS_H8 = WS_WD;
constexpr size_t WS_SC = WS_H, WS_MERGED = WS_H, WS_ACT = WS_H, WS_YAB = WS_QIDX, WS_X1G = WS_UV, WS_X2G = WS_UV, WS_PE = WS_SGA;
static_assert(WS_SC + (size_t)MTOK * SEQ * 4 <= WS_QIDX && WS_ACT + (size_t)MTOK * DFF * 2 <= WS_Q && WS_WIN + (size_t)INPAD * DM * 2 <= WS_QIDX && WS_WD + (size_t)DM * DFF * 2 <= WS_WPLE, "ws map");

constexpr int CW_TMO = 0, CW_CODE = 1, CW_BAR = 4096;

constexpr int RING_OFF = 0, RING_BYTES = 131072;
constexpr int LDSCTL_OFF = RING_BYTES, MISC_OFF = LDSCTL_OFF + 320;
constexpr int LDS_BYTES = 147456;
static_assert(MISC_OFF + 128 <= LDS_BYTES, "LDS map");

#define RLX_AGENT __ATOMIC_RELAXED, __HIP_MEMORY_SCOPE_AGENT
#define LDS_WAIT() asm volatile("s_waitcnt lgkmcnt(0)" ::: "memory")
#define VM_WAIT() asm volatile("s_waitcnt vmcnt(0)" ::: "memory")

typedef __bf16 bf16v2_t __attribute__((ext_vector_type(2)));
__device__ __forceinline__ unsigned cvt_pk_bf16(float lo, float hi) { const f32x2 v = {lo, hi}; const bf16v2_t b = __builtin_convertvector(v, bf16v2_t); return __builtin_bit_cast(unsigned, b); }
__device__ __forceinline__ float bf_lo(unsigned w) { return __uint_as_float(w << 16); }
__device__ __forceinline__ float bf_hi(unsigned w) { return __uint_as_float(w & 0xffff0000u); }
__device__ __forceinline__ float fast_sigmoid(float x) { return __builtin_amdgcn_rcpf(1.0f + __builtin_amdgcn_exp2f(-LOG2E * x)); }
__device__ __forceinline__ float gelu_tanh(float x) { const float t = x * (1.0f + 0.044715f * x * x); return x * __builtin_amdgcn_rcpf(1.0f + __builtin_amdgcn_exp2f(-2.302208198f * t)); }
__device__ __forceinline__ float wave_sum(float v) {
#pragma unroll
    for (int o = 1; o < 64; o <<= 1) v += __shfl_xor(v, o);
    return v;
}
#ifndef MCLR
#define MCLR 0
#endif
#ifndef ACT_CLIP
#define ACT_CLIP 3.0f
#endif
#ifndef P7F
#define P7F 64
#endif
__device__ __forceinline__ float rnd_sm(float x) { if (MCLR == 0) return x; unsigned u = __float_as_uint(x); u += ((1u << (15 + MCLR)) - 1u) + ((u >> (16 + MCLR)) & 1u); u &= ~((1u << (16 + MCLR)) - 1u); return __uint_as_float(u); }
__device__ __forceinline__ f32x4 rnd_sm4(f32x4 v) { return (f32x4){rnd_sm(v[0]), rnd_sm(v[1]), rnd_sm(v[2]), rnd_sm(v[3])}; }
__device__ __forceinline__ v4u pack8(f32x4 a, f32x4 b) { v4u w; w.x = cvt_pk_bf16(a[0], a[1]); w.y = cvt_pk_bf16(a[2], a[3]); w.z = cvt_pk_bf16(b[0], b[1]); w.w = cvt_pk_bf16(b[2], b[3]); return w; }
__device__ __forceinline__ void unpack8(v4u w, f32x4& a, f32x4& b) { a = (f32x4){bf_lo(w.x), bf_hi(w.x), bf_lo(w.y), bf_hi(w.y)}; b = (f32x4){bf_lo(w.z), bf_hi(w.z), bf_lo(w.w), bf_hi(w.w)}; }

__device__ __forceinline__ unsigned e2m1(float x) { const float a = fminf(fabsf(x), 6.0f);
    const float c = a < 2.0f ? rintf(2.0f * a) : (a < 4.0f ? 2.0f + rintf(a) : 4.0f + rintf(0.5f * a));
    return (unsigned)c | ((__float_as_uint(x) >> 28) & 8u); }
__device__ __forceinline__ unsigned pack4_f4(float a, float b, float c, float d) { return e2m1(a) | (e2m1(b) << 4) | (e2m1(c) << 8) | (e2m1(d) << 12); }
__device__ __forceinline__ unsigned q8(float x) { const float r = fminf(fmaxf(rintf(x), -127.0f), 127.0f); return (unsigned)(int)r & 255u; }
__device__ __forceinline__ v2u pack8_i8(f32x4 a, f32x4 b) { v2u w; w.x = q8(a[0]) | (q8(a[1]) << 8) | (q8(a[2]) << 16) | (q8(a[3]) << 24); w.y = q8(b[0]) | (q8(b[1]) << 8) | (q8(b[2]) << 16) | (q8(b[3]) << 24); return w; }
__device__ __forceinline__ v2u pack8_f8(f32x4 a, f32x4 b) { v2u w; w.x = (unsigned)__builtin_amdgcn_cvt_pk_fp8_f32(a[2], a[3], __builtin_amdgcn_cvt_pk_fp8_f32(a[0], a[1], 0, false), true);
    w.y = (unsigned)__builtin_amdgcn_cvt_pk_fp8_f32(b[2], b[3], __builtin_amdgcn_cvt_pk_fp8_f32(b[0], b[1], 0, false), true); return w; }
__device__ __forceinline__ void unpack8_f8(v2u w, f32x4& a, f32x4& b) { const f32x2 a0 = __builtin_amdgcn_cvt_pk_f32_fp8((int)w.x, false), a1 = __builtin_amdgcn_cvt_pk_f32_fp8((int)w.x, true), b0 = __builtin_amdgcn_cvt_pk_f32_fp8((int)w.y, false), b1 = __builtin_amdgcn_cvt_pk_f32_fp8((int)w.y, true);
    a = (f32x4){a0[0], a0[1], a1[0], a1[1]}; b = (f32x4){b0[0], b0[1], b1[0], b1[1]}; }

namespace pg8 {
#define PG8_LAS __attribute__((address_space(3)))
typedef unsigned short bf16_t;
typedef unsigned u32x4 __attribute__((ext_vector_type(4)));
constexpr int BM = 256, BK = 64, HALF = 128, HTB = HALF * BK * 2, STAGE_BYTES = 8 * HTB, NXCD = 8, WGM = 4;

__host__ __device__ __forceinline__ int lds_byte(int r, int c) { const int st = (r >> 4) * 2 + (c >> 5), rr = r & 15, cc = c & 31, ob = rr * 64 + cc * 2; return st * 1024 + (ob ^ (((ob >> 9) & 1) << 5)); }
__host__ __device__ __forceinline__ void stage_rc(int b, int& R, int& C) { const int st = b / 1024, sb = b % 1024, swz = sb ^ (((sb >> 9) & 1) << 5); R = (st >> 1) * 16 + swz / 64; C = (st & 1) * 32 + (swz % 64) / 2; }
__host__ __device__ __forceinline__ int perm32(int rho) { const int n = rho >> 4, i = rho & 15; return 8 * (i >> 2) + 4 * n + (i & 3); }

struct Unit { int pm, pn; };
struct Gemm { const bf16_t* A; const bf16_t* Bt; int M, N, K; };

struct StaticOrder {
    int nM, nN, nwg, G, c;
    __host__ __device__ __forceinline__ void init(int M, int N, int G_, int c_) { nM = M / BM; nN = N / BM; nwg = nM * nN; G = G_; c = c_; }
    __host__ __device__ __forceinline__ bool next(int i, Unit& u) const {
        const long L = (long)i * G + c; if (L >= nwg) return false;
        int wgid = (int)L; { const int q = nwg / NXCD, r = nwg % NXCD, xcd = wgid % NXCD, off = wgid / NXCD; wgid = (xcd < r ? xcd * (q + 1) : r * (q + 1) + (xcd - r) * q) + off; }
        const int nig = WGM * nN, gid = wgid / nig, fm = gid * WGM, gsz = (nM - fm) < WGM ? (nM - fm) : WGM;
        u.pm = fm + ((wgid % nig) % gsz); u.pn = (wgid % nig) / gsz; return true;
    }
    __device__ __forceinline__ void a_ready(const Unit&) const {}
    __device__ __forceinline__ void done(const Unit&) const {}
};

struct BlockOrder {
    StaticOrder so; int nM, nN, nNm, rmain, G, c; bool blocked;
    __host__ __device__ __forceinline__ void init(int M, int N, int G_, int c_) { nM = M / BM; nN = N / BM; G = G_; c = c_; blocked = (G_ == 256) && (nM % 16 == 0) && (nN >= 16);
        nNm = blocked ? (nN / 16) * 16 : 0; rmain = blocked ? (nM / 16) * (nNm / 16) : 0; so.init(M, (nN - nNm) * BM, G_, c_); }
    __host__ __device__ __forceinline__ bool next(int i, Unit& u) const {
        if (i < rmain) { const int nsr = nM / 16, sc = i / nsr, s0 = i % nsr, sr = (sc & 1) ? nsr - 1 - s0 : s0, x = c & 7, j = c >> 3;
            u.pm = 16 * sr + 4 * (x >> 1) + (j & 3); u.pn = 16 * sc + 8 * (x & 1) + (j >> 2); return true; }
        if (nN == nNm) return false;
        if (!so.next(i - rmain, u)) return false;
        u.pn += nNm; return true;
    }
    __device__ __forceinline__ void a_ready(const Unit&) const {}
    __device__ __forceinline__ void done(const Unit&) const {}
};

typedef f32x4 Acc[2][2][4][2];

__device__ __forceinline__ float row_total64(const float* tab, int row, int fq) {
    const float* p = tab + ((size_t)(fq * 4) * MTOK + row) * 4;
    const f32x4 a = *(const f32x4*)p, b = *(const f32x4*)(p + (size_t)MTOK * 4), c = *(const f32x4*)(p + (size_t)MTOK * 8), d = *(const f32x4*)(p + (size_t)MTOK * 12);
    float s = ((a[0] + a[1]) + (a[2] + a[3])) + ((b[0] + b[1]) + (b[2] + b[3])) + ((c[0] + c[1]) + (c[2] + c[3])) + ((d[0] + d[1]) + (d[2] + d[3]));
    s += __shfl_xor(s, 16); s += __shfl_xor(s, 32); return s;
}

template <int VAR> struct EpiInProjT {
    static constexpr bool PERM = true, AFTER_DRAIN = false, HAS_MID = false;
    bf16_t *Q, *V, *QIDX, *KIDX, *UV, *SGA, *SGB; float *KRAW, *WIDX, *LNP; const float* FACH; float isw;
    __device__ __forceinline__ float rowf(size_t r) const { if constexpr (VAR == 0) return FACH[r] * isw; else return 1.0f; }
    __device__ __forceinline__ void mid(Acc&, const Unit&, int, int, int, int) const {}
    template <int ACT> __device__ __forceinline__ void plain(const Acc& acc, bf16_t* O, int ldc, int colt, int row0, int cl, bool f8) const {
#pragma unroll
        for (int ai = 0; ai < 2; ++ai)
#pragma unroll
            for (int m = 0; m < 4; ++m) { const float rf = rowf((size_t)(row0 + ai * HALF + m * 16)); const size_t eo = (size_t)(row0 + ai * HALF + m * 16) * ldc + colt + cl; bf16_t* rowp = O + eo; unsigned char* rowp8 = (unsigned char*)O + eo;
#pragma unroll
                for (int bj = 0; bj < 2; ++bj) { f32x4 v0 = acc[ai][bj][m][0] * rf, v1 = acc[ai][bj][m][1] * rf;
                    if (ACT == 1) {
#pragma unroll
                        for (int j = 0; j < 4; ++j) { v0[j] = gelu_tanh(v0[j]); v1[j] = gelu_tanh(v1[j]); } }
                    if (ACT == 2) {
#pragma unroll
                        for (int j = 0; j < 4; ++j) { v0[j] = fast_sigmoid(v0[j]); v1[j] = fast_sigmoid(v1[j]); } }
                    if (f8) *(v2u*)(rowp8 + bj * HALF) = pack8_f8(v0, v1); else *(u32x4*)(rowp + bj * HALF) = pack8(v0, v1); }
                __builtin_amdgcn_sched_barrier(0); }
    }
    __device__ __forceinline__ void operator()(const Acc& acc, const Unit& u, int wr, int wc, int fr, int fq) const {
        asm volatile("" : "+v"(fr), "+v"(fq));
        const int row0 = u.pm * BM + wr * 64 + fr, cl = wc * 32 + 8 * fq, pn = VAR == 2 ? u.pn + 42 : VAR == 1 ? u.pn + 25 : (u.pn < 25 ? u.pn : (u.pn < 41 ? u.pn + 33 : u.pn - 15));
        if (pn < 8 || (pn > 8 && pn < 25)) { const bool isq = pn < 8; plain<0>(acc, isq ? Q : QIDX, isq ? 2048 : 4096, isq ? pn * 256 : (pn - 9) * 256, row0, cl, isq); }
        else if (pn == 8) {
#pragma unroll
            for (int ai = 0; ai < 2; ++ai)
#pragma unroll
                for (int m = 0; m < 4; ++m) { const size_t r = (size_t)(row0 + ai * HALF + m * 16);
                    const float rf = rowf(r);
                    *(f32x4*)(KRAW + r * 128 + cl) = acc[ai][0][m][0] * rf; *(f32x4*)(KRAW + r * 128 + cl + 4) = acc[ai][0][m][1] * rf;
                    *(u32x4*)(V + r * 128 + cl) = pack8(acc[ai][1][m][0] * rf, acc[ai][1][m][1] * rf); }
        }
        else if (pn == 25) {
#pragma unroll
            for (int ai = 0; ai < 2; ++ai)
#pragma unroll
                for (int m = 0; m < 4; ++m) { const size_t r = (size_t)(row0 + ai * HALF + m * 16);
                    *(u32x4*)(KIDX + r * 128 + cl) = pack8(acc[ai][0][m][0], acc[ai][0][m][1]);
                    if (wc == 0) { *(f32x4*)(WIDX + r * 32 + 8 * fq) = acc[ai][1][m][0]; *(f32x4*)(WIDX + r * 32 + 8 * fq + 4) = acc[ai][1][m][1]; } }
        }
        else if (pn < 42) {
            const bool isv = pn >= 34;
#pragma unroll
            for (int ai = 0; ai < 2; ++ai)
#pragma unroll
                for (int m = 0; m < 4; ++m) { const size_t r = (size_t)(row0 + ai * HALF + m * 16); bf16_t* rowp = UV + r * 4096 + (pn - 26) * 256 + cl; float s = 0.f, q = 0.f; const float rf = rowf(r);
#pragma unroll
                    for (int bj = 0; bj < 2; ++bj) { f32x4 v0 = acc[ai][bj][m][0] * rf, v1 = acc[ai][bj][m][1] * rf;
#pragma unroll
                        for (int j = 0; j < 4; ++j) { v0[j] = gelu_tanh(v0[j]); v1[j] = gelu_tanh(v1[j]); s += v0[j] + v1[j]; q += v0[j] * v0[j] + v1[j] * v1[j]; }
                        *(u32x4*)(rowp + bj * HALF) = pack8(v0, v1); }
                    s += __shfl_xor(s, 16); s += __shfl_xor(s, 32); q += __shfl_xor(q, 16); q += __shfl_xor(q, 32);
                    if (isv && fq == 0) *(f32x2*)(LNP + (((size_t)(pn - 34) * MTOK + r) * 4 + wc) * 2) = (f32x2){s, q};
                    __builtin_amdgcn_sched_barrier(0); }
        }
        else { const bool isa = pn < 58; plain<2>(acc, isa ? SGA : SGB, 4096, isa ? (pn - 42) * 256 : (pn - 58) * 256, row0, cl, isa); }
    }
};

struct EpiNull {
    static constexpr bool PERM = true, AFTER_DRAIN = false, HAS_MID = false;
    float* sink;
    __device__ __forceinline__ void mid(Acc&, const Unit&, int, int, int, int) const {}
    __device__ __forceinline__ void operator()(const Acc& acc, const Unit& u, int wr, int wc, int fr, int fq) const {
        f32x4 t = {0.f, 0.f, 0.f, 0.f};
#pragma unroll
        for (int ai = 0; ai < 2; ++ai)
#pragma unroll
            for (int bj = 0; bj < 2; ++bj)
#pragma unroll
                for (int m = 0; m < 4; ++m) t += acc[ai][bj][m][0] + acc[ai][bj][m][1];
        if (t[0] + t[1] + t[2] + t[3] == 123456.789f) sink[u.pm] = t[0];
    }
};

struct EpiPlain {
    static constexpr bool PERM = true, AFTER_DRAIN = false, HAS_MID = false;
    bf16_t* O;
    __device__ __forceinline__ void mid(Acc&, const Unit&, int, int, int, int) const {}
    __device__ __forceinline__ void operator()(const Acc& acc, const Unit& u, int wr, int wc, int fr, int fq) const {
        asm volatile("" : "+v"(fr), "+v"(fq));
        const int row0 = u.pm * BM + wr * 64 + fr, col0 = u.pn * BM + wc * 32 + 8 * fq;
#pragma unroll
        for (int ai = 0; ai < 2; ++ai)
#pragma unroll
            for (int m = 0; m < 4; ++m) { const size_t off = (size_t)(row0 + ai * HALF + m * 16) * 4096 + col0;
#pragma unroll
                for (int bj = 0; bj < 2; ++bj) *(v2u*)((unsigned char*)O + off + bj * HALF) = pack8_f8(acc[ai][bj][m][0] * 16.0f, acc[ai][bj][m][1] * 16.0f);
                __builtin_amdgcn_sched_barrier(0); }
    }
};
struct EpiMerge {
    static constexpr bool PERM = true, AFTER_DRAIN = false, HAS_MID = false;
    const bf16_t *SGA, *SGB; const bf16_t* T8; bf16_t* O;
    __device__ __forceinline__ void mid(Acc&, const Unit&, int, int, int, int) const {}
    __device__ __forceinline__ void operator()(const Acc& acc, const Unit& u, int wr, int wc, int fr, int fq) const {
        asm volatile("" : "+v"(fr), "+v"(fq));
        const int row0 = u.pm * BM + wr * 64 + fr, col0 = u.pn * BM + wc * 32 + 8 * fq;
#pragma unroll
        for (int ai = 0; ai < 2; ++ai)
#pragma unroll
            for (int m = 0; m < 4; ++m) { const size_t off = (size_t)(row0 + ai * HALF + m * 16) * 4096 + col0;
#pragma unroll
                for (int bj = 0; bj < 2; ++bj) { const v2u wa = *(const v2u*)((const unsigned char*)SGA + off + bj * HALF), wt = *(const v2u*)((const unsigned char*)T8 + off + bj * HALF); const u32x4 wb = *(const u32x4*)(SGB + off + bj * HALF);
                    f32x4 a0, a1, b0, b1, t0, t1; unpack8_f8(wa, a0, a1); unpack8(wb, b0, b1); unpack8_f8(wt, t0, t1); t0 *= 0.0625f; t1 *= 0.0625f;
                    *(u32x4*)(O + off + bj * HALF) = pack8(a0 * t0 + b0 * acc[ai][bj][m][0], a1 * t1 + b1 * acc[ai][bj][m][1]); }
                __builtin_amdgcn_sched_barrier(0); }
    }
};

template <bool G8, bool INB, bool QF = false> struct EpiResidT {
    static constexpr bool PERM = true, AFTER_DRAIN = false, HAS_MID = false;
    const void* XIN; bf16_t* XOUT; bf16_t* XG; const float* gain; float* SSQ; const float* FACR; float isw;
    __device__ __forceinline__ void mid(Acc&, const Unit&, int, int, int, int) const {}
    __device__ __forceinline__ void operator()(const Acc& acc, const Unit& u, int wr, int wc, int fr, int fq) const {
        asm volatile("" : "+v"(fr), "+v"(fq));
        const int row0 = u.pm * BM + wr * 64 + fr, col0 = u.pn * BM + wc * 32 + 8 * fq;
        f32x4 gv[2][2];
#pragma unroll
        for (int bj = 0; bj < 2; ++bj) { gv[bj][0] = *(const f32x4*)(gain + col0 + bj * HALF); gv[bj][1] = *(const f32x4*)(gain + col0 + bj * HALF + 4); }
#pragma unroll
        for (int ai = 0; ai < 2; ++ai)
#pragma unroll
            for (int m = 0; m < 4; ++m) { const size_t r = (size_t)(row0 + ai * HALF + m * 16), off = r * 4096 + col0; float q = 0.f; float rf = 1.0f; if constexpr (QF) rf = FACR[r] * isw;
#pragma unroll
                for (int bj = 0; bj < 2; ++bj) { f32x4 v0, v1;
                    if constexpr (INB) { const u32x4 xw = *(const u32x4*)((const bf16_t*)XIN + off + bj * HALF); unpack8(xw, v0, v1); }
                    else { v0 = *(const f32x4*)((const float*)XIN + off + bj * HALF); v1 = *(const f32x4*)((const float*)XIN + off + bj * HALF + 4); }
                    if constexpr (QF) { v0 += acc[ai][bj][m][0] * rf; v1 += acc[ai][bj][m][1] * rf; } else { v0 += acc[ai][bj][m][0]; v1 += acc[ai][bj][m][1]; }
                    *(u32x4*)(XOUT + off + bj * HALF) = pack8(v0, v1);
#pragma unroll
                    for (int j = 0; j < 4; ++j) q += v0[j] * v0[j] + v1[j] * v1[j];
                    if constexpr (G8) { const f32x4 a = v0 * gv[bj][0], b = v1 * gv[bj][1]; v2u w;
                        w.x = (unsigned)__builtin_amdgcn_cvt_pk_fp8_f32(a[2], a[3], __builtin_amdgcn_cvt_pk_fp8_f32(a[0], a[1], 0, false), true);
                        w.y = (unsigned)__builtin_amdgcn_cvt_pk_fp8_f32(b[2], b[3], __builtin_amdgcn_cvt_pk_fp8_f32(b[0], b[1], 0, false), true);
                        *(v2u*)((unsigned char*)XG + off + bj * HALF) = w; }
                    else if (XG) *(u32x4*)(XG + off + bj * HALF) = pack8(rnd_sm4(v0 * gv[bj][0]), rnd_sm4(v1 * gv[bj][1])); }
                q += __shfl_xor(q, 16); q += __shfl_xor(q, 32);
                if (fq == 0) SSQ[((size_t)u.pn * MTOK + r) * 4 + wc] = q;
                __builtin_amdgcn_sched_barrier(0); }
    }
};

typedef EpiResidT<false, false, true> EpiResid; typedef EpiResidT<true, true> EpiResid8; typedef EpiResidT<false, true> EpiResidB; typedef EpiResidT<false, true, true> EpiResidQ;

struct EpiPe {
    static constexpr bool PERM = true, AFTER_DRAIN = false, HAS_MID = false;
    bf16_t* PE; float* SSQ;
    __device__ __forceinline__ void mid(Acc&, const Unit&, int, int, int, int) const {}
    __device__ __forceinline__ void operator()(const Acc& acc, const Unit& u, int wr, int wc, int fr, int fq) const {
        asm volatile("" : "+v"(fr), "+v"(fq));
        const int row0 = u.pm * BM + wr * 64 + fr, col0 = u.pn * BM + wc * 32 + 8 * fq;
#pragma unroll
        for (int ai = 0; ai < 2; ++ai)
#pragma unroll
            for (int m = 0; m < 4; ++m) { const size_t r = (size_t)(row0 + ai * HALF + m * 16), off = r * 4096 + col0; float q = 0.f;
#pragma unroll
                for (int bj = 0; bj < 2; ++bj) { const f32x4 v0 = acc[ai][bj][m][0], v1 = acc[ai][bj][m][1];
#pragma unroll
                    for (int j = 0; j < 4; ++j) q += v0[j] * v0[j] + v1[j] * v1[j];
                    *(u32x4*)(PE + off + bj * HALF) = pack8(v0, v1); }
                q += __shfl_xor(q, 16); q += __shfl_xor(q, 32);
                if (fq == 0) SSQ[((size_t)u.pn * MTOK + r) * 4 + wc] = q;
                __builtin_amdgcn_sched_barrier(0); }
    }
};

struct EpiGateUp {
    static constexpr bool PERM = true, AFTER_DRAIN = false, HAS_MID = false;
    const float* SSQ; bf16_t* ACT; unsigned char* ACT8; int pm8;
    __device__ __forceinline__ void mid(Acc&, const Unit&, int, int, int, int) const {}
    __device__ __forceinline__ void operator()(const Acc& acc, const Unit& u, int wr, int wc, int fr, int fq) const {
        asm volatile("" : "+v"(fr), "+v"(fq));
        const int row0 = u.pm * BM + wr * 64 + fr, col0 = u.pn * HALF + wc * 32 + 8 * fq;
#pragma unroll
        for (int ai = 0; ai < 2; ++ai)
#pragma unroll
            for (int m = 0; m < 4; ++m) { const int r = row0 + ai * HALF + m * 16;
                const float rs = 1.0f / sqrtf(row_total64(SSQ, r, fq) * (1.0f / 4096.0f) + EPS);
                f32x4 o0, o1;
#pragma unroll
                for (int j = 0; j < 4; ++j) { const float g0 = acc[ai][0][m][0][j] * rs, g1 = acc[ai][0][m][1][j] * rs;
                    o0[j] = g0 * fast_sigmoid(g0) * (acc[ai][1][m][0][j] * rs); o1[j] = g1 * fast_sigmoid(g1) * (acc[ai][1][m][1][j] * rs); }
                if (u.pm < pm8) *(v2u*)(ACT8 + (size_t)r * DFF + col0) = pack8_f8(o0, o1); else *(u32x4*)(ACT + (size_t)r * DFF + col0) = pack8(o0, o1);
                __builtin_amdgcn_sched_barrier(0); }
    }
};

struct EpiGateUpQ {
    static constexpr bool PERM = true, AFTER_DRAIN = false, HAS_MID = false;
    const float* FAC; float isg, isu; bf16_t* ACT; unsigned char* ACT8; int pm8; const float* FACA;
    __device__ __forceinline__ void mid(Acc&, const Unit&, int, int, int, int) const {}
    __device__ __forceinline__ void operator()(const Acc& acc, const Unit& u, int wr, int wc, int fr, int fq) const {
        asm volatile("" : "+v"(fr), "+v"(fq));
        const int row0 = u.pm * BM + wr * 64 + fr, col0 = u.pn * HALF + wc * 32 + 8 * fq;
#pragma unroll
        for (int ai = 0; ai < 2; ++ai)
#pragma unroll
            for (int m = 0; m < 4; ++m) { const int r = row0 + ai * HALF + m * 16;
                const float f = FAC[r], fg = f * isg, fu = f * isu;
                f32x4 o0, o1;
#pragma unroll
                for (int j = 0; j < 4; ++j) { const float g0 = acc[ai][0][m][0][j] * fg, g1 = acc[ai][0][m][1][j] * fg;
                    o0[j] = g0 * fast_sigmoid(g0) * (acc[ai][1][m][0][j] * fu); o1[j] = g1 * fast_sigmoid(g1) * (acc[ai][1][m][1][j] * fu); }
                if (u.pm < pm8) {
                    float v_[8] = {o0[0], o0[1], o0[2], o0[3], o1[0], o1[1], o1[2], o1[3]};
#pragma unroll
                    for (int h_ = 1; h_ < 8; h_ <<= 1)
#pragma unroll
                        for (int i_ = 0; i_ < 8; ++i_) if (!(i_ & h_)) { const float a_ = v_[i_], b_ = v_[i_ | h_]; v_[i_] = a_ + b_; v_[i_ | h_] = a_ - b_; }
                    const float s16_ = (fq & 1) ? -1.0f : 1.0f, s32_ = (fq & 2) ? -1.0f : 1.0f;
#pragma unroll
                    for (int i_ = 0; i_ < 8; ++i_) { const auto p_ = __builtin_amdgcn_permlane16_swap(__float_as_uint(v_[i_]), __float_as_uint(v_[i_]), false, false); v_[i_] = __uint_as_float(p_[0]) + s16_ * __uint_as_float(p_[1]); }
#pragma unroll
                    for (int i_ = 0; i_ < 8; ++i_) { const auto p_ = __builtin_amdgcn_permlane32_swap(__float_as_uint(v_[i_]), __float_as_uint(v_[i_]), false, false); v_[i_] = __uint_as_float(p_[0]) + s32_ * __uint_as_float(p_[1]); }
                    const float sa_ = 0.17677669529663687f / FACA[r];
                    *(v2u*)(ACT8 + (size_t)r * DFF + col0) = pack8_i8((f32x4){v_[0], v_[1], v_[2], v_[3]} * sa_, (f32x4){v_[4], v_[5], v_[6], v_[7]} * sa_); }
                else *(u32x4*)(ACT + (size_t)r * DFF + col0) = pack8(o0, o1);
                __builtin_amdgcn_sched_barrier(0); }
    }
};

struct EpiFinal {
    static constexpr bool PERM = true, AFTER_DRAIN = false, HAS_MID = false;
    const float *FAC2, *SSQP, *pleg; const bf16_t* PE; const bf16_t* X2R; float* OUT; float isw;
    __device__ __forceinline__ void mid(Acc&, const Unit&, int, int, int, int) const {}
    __device__ __forceinline__ void operator()(const Acc& acc, const Unit& u, int wr, int wc, int fr, int fq) const {
        asm volatile("" : "+v"(fr), "+v"(fq));
        const int row0 = u.pm * BM + wr * 64 + fr, col0 = u.pn * BM + wc * 32 + 8 * fq;
        f32x4 gv[2][2];
#pragma unroll
        for (int bj = 0; bj < 2; ++bj) { gv[bj][0] = *(const f32x4*)(pleg + col0 + bj * HALF); gv[bj][1] = *(const f32x4*)(pleg + col0 + bj * HALF + 4); }
#pragma unroll
        for (int ai = 0; ai < 2; ++ai)
#pragma unroll
            for (int m = 0; m < 4; ++m) { const int r = row0 + ai * HALF + m * 16; const size_t off = (size_t)r * 4096 + col0;
                const float r3 = FAC2[r] * isw, rp = 1.0f / sqrtf(row_total64(SSQP, r, fq) * (1.0f / 4096.0f) + EPS);
#pragma unroll
                for (int bj = 0; bj < 2; ++bj) { const u32x4 pw = *(const u32x4*)(PE + off + bj * HALF); f32x4 p0, p1; unpack8(pw, p0, p1);
                    f32x4 x0, x1; { const u32x4 xw = *(const u32x4*)(X2R + off + bj * HALF); unpack8(xw, x0, x1); }
#pragma unroll
                    for (int j = 0; j < 4; ++j) { x0[j] += fast_sigmoid(acc[ai][bj][m][0][j] * r3) * (p0[j] * rp * gv[bj][0][j]); x1[j] += fast_sigmoid(acc[ai][bj][m][1][j] * r3) * (p1[j] * rp * gv[bj][1][j]); }
                    *(f32x4*)(OUT + off + bj * HALF) = x0; *(f32x4*)(OUT + off + bj * HALF + 4) = x1; }
                __builtin_amdgcn_sched_barrier(0); }
    }
};
template <class Epi, class Sched, bool ALIGN_EPI = false, bool SP2 = false, bool FP8 = false, bool FP4 = false, bool I8 = false>
__device__ __forceinline__ void gemm_phase(PG8_LAS unsigned char* lds, const Gemm g, const Sched& S, const Epi& E, const int tid, const int sclw4 = 127) {
    const int wid = __builtin_amdgcn_readfirstlane(tid >> 6), lane = tid & 63, wr = wid >> 2, wc = wid & 3, fr = lane & 15, fq = lane >> 4;
    const int K = g.K, nt = K / BK;
    unsigned voffA[2], voffB[2];
#pragma unroll
    for (int i = 0; i < 2; ++i) { int R, C; stage_rc(tid * 16 + i * 8192, R, C); const int Rb = Epi::PERM ? ((R & ~31) + perm32(R & 31)) : R;
        voffA[i] = (unsigned)(R * K + C) * 2u; voffB[i] = (unsigned)(Rb * K + C) * 2u; }
    const size_t kstep = (size_t)(BK * 2);
    const size_t hstep = (size_t)HALF * K * 2;
    const size_t tstep = 2 * hstep;
    const unsigned ldsw = (unsigned)wid * 1024u;
    const int aoff = lds_byte(wr * 64 + fr, fq * 8), boff = lds_byte(wc * 32 + fr, fq * 8);
#define PG8_SA(b, h) (((b) * 2 + (h)) * HTB)
#define PG8_SB(b, h) ((4 + (b) * 2 + (h)) * HTB)
#define PG8_STAGE(bufoff, gbase, voff) do { _Pragma("unroll") for (int _i = 0; _i < 2; ++_i) \
        __builtin_amdgcn_global_load_lds((const unsigned*)((const char*)(gbase) + (voff)[_i]), (PG8_LAS unsigned*)(lds + (bufoff) + ldsw + _i * 8192), 16, 0, 0); } while (0)
#define PG8_LDA(dst, b, h) do { if constexpr (FP8) { _Pragma("unroll") for (int m = 0; m < 4; ++m) { const v4i_t lo_ = *(const PG8_LAS v4i_t*)(lds + PG8_SA(b, h) + aoff + m * 2048), hi_ = *(const PG8_LAS v4i_t*)(lds + PG8_SA(b, h) + aoff + m * 2048 + 1024); dst##8[m] = __builtin_shufflevector(lo_, hi_, 0, 1, 2, 3, 4, 5, 6, 7); } } \
        else { _Pragma("unroll") for (int m = 0; m < 4; ++m) _Pragma("unroll") for (int k = 0; k < 2; ++k) dst[m][k] = *(const PG8_LAS bf16x8*)(lds + PG8_SA(b, h) + aoff + m * 2048 + k * 1024); } } while (0)
#define PG8_LDB(dst, b, h) do { if constexpr (FP8) { _Pragma("unroll") for (int n = 0; n < 2; ++n) { const v4i_t lo_ = *(const PG8_LAS v4i_t*)(lds + PG8_SB(b, h) + boff + n * 2048), hi_ = *(const PG8_LAS v4i_t*)(lds + PG8_SB(b, h) + boff + n * 2048 + 1024); dst##8[n] = __builtin_shufflevector(lo_, hi_, 0, 1, 2, 3, 4, 5, 6, 7); } } \
        else { _Pragma("unroll") for (int n = 0; n < 2; ++n) _Pragma("unroll") for (int k = 0; k < 2; ++k) dst[n][k] = *(const PG8_LAS bf16x8*)(lds + PG8_SB(b, h) + boff + n * 2048 + k * 1024); } } while (0)
#define PG8_ALIGN_MFMA(At, Bt) asm volatile(".p2align 3" :: "v"(At[0][0]), "v"(At[0][1]), "v"(At[1][0]), "v"(At[1][1]), "v"(At[2][0]), "v"(At[2][1]), "v"(At[3][0]), "v"(At[3][1]), "v"(Bt[0][0]), "v"(Bt[0][1]), "v"(Bt[1][0]), "v"(Bt[1][1]))
#define PG8_ALIGN_MFMA8(At, Bt) asm volatile(".p2align 3" :: "v"(At##8[0]), "v"(At##8[1]), "v"(At##8[2]), "v"(At##8[3]), "v"(Bt##8[0]), "v"(Bt##8[1]))
#define PG8_MMA(ai, bj, At, Bt) do { __builtin_amdgcn_s_setprio(1); \
        if constexpr (FP8) { PG8_ALIGN_MFMA8(At, Bt); __builtin_amdgcn_sched_barrier(0); _Pragma("unroll") for (int m = 0; m < 4; ++m) _Pragma("unroll") for (int n = 0; n < 2; ++n) \
            asm volatile("v_mfma_scale_f32_16x16x128_f8f6f4 %0, %1, %2, %0, %3, %4 op_sel_hi:[0,0,0]" : "+v"(acc[ai][bj][m][n]) : "v"(Bt##8[n]), "v"(At##8[m]), "v"(scl_w), "v"(scl_a)); } \
        else if constexpr (I8) { PG8_ALIGN_MFMA(At, Bt); __builtin_amdgcn_sched_barrier(0); _Pragma("unroll") for (int m = 0; m < 4; ++m) _Pragma("unroll") for (int n = 0; n < 2; ++n) _Pragma("unroll") for (int k = 0; k < 2; ++k) \
            asm volatile("v_mfma_i32_16x16x64_i8 %0, %1, %2, %0" : "+v"(acc[ai][bj][m][n]) : "v"(Bt[n][k]), "v"(At[m][k])); } \
        else if constexpr (FP4) { PG8_ALIGN_MFMA(At, Bt); __builtin_amdgcn_sched_barrier(0); _Pragma("unroll") for (int m = 0; m < 4; ++m) _Pragma("unroll") for (int n = 0; n < 2; ++n) _Pragma("unroll") for (int k = 0; k < 2; ++k) \
            asm volatile("v_mfma_scale_f32_16x16x128_f8f6f4 %0, %1, %2, %0, %3, %4 op_sel_hi:[0,0,0] cbsz:4 blgp:4" : "+v"(acc[ai][bj][m][n]) : "v"(Bt[n][k]), "v"(At[m][k]), "v"(scl_w), "v"(scl_a)); } \
        else { PG8_ALIGN_MFMA(At, Bt); __builtin_amdgcn_sched_barrier(0); _Pragma("unroll") for (int m = 0; m < 4; ++m) _Pragma("unroll") for (int n = 0; n < 2; ++n) _Pragma("unroll") for (int k = 0; k < 2; ++k) \
            acc[ai][bj][m][n] = __builtin_amdgcn_mfma_f32_16x16x32_bf16(Bt[n][k], At[m][k], acc[ai][bj][m][n], 0, 0, 0); } \
        __builtin_amdgcn_s_setprio(0); } while (0)
#define PG8_WAIT_V(n) asm volatile("s_waitcnt vmcnt(" #n ")" ::: "memory")
#define PG8_WAIT_L(n) asm volatile("s_waitcnt lgkmcnt(" #n ")" ::: "memory")
#define PG8_BAR __builtin_amdgcn_s_barrier()
#define PG8_SCHED __builtin_amdgcn_sched_barrier(0)
    Unit cur, nxt; int ui = 0;
    if (!S.next(0, cur)) return;
    f32x4 acc[2][2][4][2];
#pragma unroll
    for (int a = 0; a < 2; ++a)
#pragma unroll
        for (int b = 0; b < 2; ++b)
#pragma unroll
            for (int m = 0; m < 4; ++m)
#pragma unroll
                for (int n = 0; n < 2; ++n) acc[a][b][m][n] = (f32x4){0.f, 0.f, 0.f, 0.f};
    typedef int v8i_t __attribute__((ext_vector_type(8))); typedef int v4i_t __attribute__((ext_vector_type(4)));
    bf16x8 At[4][2], B0[2][2], B1[2][2]; v8i_t At8[4], B08[2], B18[2];
    const int scl_w = FP4 ? sclw4 : 121, scl_a = FP4 ? 126 : 127;
    const char* cA = (const char*)g.A + (size_t)cur.pm * tstep; const char* cB = (const char*)g.Bt + (size_t)cur.pn * tstep;
    S.a_ready(cur);
    if constexpr (SP2) {
        PG8_STAGE(PG8_SB(0, 0), cB, voffB); PG8_STAGE(PG8_SB(0, 1), cB + hstep, voffB); PG8_STAGE(PG8_SA(0, 0), cA, voffA); PG8_STAGE(PG8_SA(0, 1), cA + hstep, voffA);
        if (wr == 1) PG8_BAR;
        PG8_WAIT_V(2); PG8_BAR;
        PG8_STAGE(PG8_SB(1, 0), cB + kstep, voffB); PG8_STAGE(PG8_SA(1, 0), cA + kstep, voffA); PG8_STAGE(PG8_SB(1, 1), cB + hstep + kstep, voffB);
        PG8_WAIT_V(6); PG8_BAR;
    } else {
        PG8_STAGE(PG8_SB(0, 0), cB, voffB); PG8_STAGE(PG8_SA(0, 0), cA, voffA); PG8_STAGE(PG8_SB(0, 1), cB + hstep, voffB); PG8_STAGE(PG8_SA(0, 1), cA + hstep, voffA);
        if (wr == 1) PG8_BAR;
        PG8_WAIT_V(4); PG8_BAR;
        PG8_STAGE(PG8_SB(1, 0), cB + kstep, voffB); PG8_STAGE(PG8_SA(1, 0), cA + kstep, voffA); PG8_STAGE(PG8_SB(1, 1), cB + hstep + kstep, voffB);
        PG8_WAIT_V(6); PG8_BAR;
    }
    for (;;) {
        const bool has_next = S.next(ui + 1, nxt);
        const char* nA = has_next ? (const char*)g.A + (size_t)nxt.pm * tstep : cA; const char* nB = has_next ? (const char*)g.Bt + (size_t)nxt.pn * tstep : cB;
        for (int t = 0; t < nt; t += 2) {
            asm volatile(".p2align 6");
            const bool last = (t == nt - 2);
            const char* a1 = cA + (size_t)(t + 1) * kstep;
            const char* a2 = last ? nA : cA + (size_t)(t + 2) * kstep; const char* b2 = last ? nB : cB + (size_t)(t + 2) * kstep;
            const char* a3 = a2 + kstep; const char* b3 = b2 + kstep;
            if (last && has_next) S.a_ready(nxt);
            if constexpr (Epi::HAS_MID) { if (t == (nt >> 1)) E.mid(acc, cur, wr, wc, fr, fq); }
            if constexpr (SP2) {
            PG8_LDB(B0, 0, 0); PG8_LDB(B1, 0, 1); PG8_SCHED; PG8_LDA(At, 0, 0); PG8_STAGE(PG8_SA(1, 1), a1 + hstep, voffA);
            PG8_WAIT_V(8); PG8_WAIT_L(0); PG8_BAR; PG8_MMA(0, 0, At, B0); PG8_MMA(0, 1, At, B1); PG8_BAR; PG8_SCHED;
            PG8_LDA(At, 0, 1); PG8_STAGE(PG8_SB(0, 0), b2, voffB); PG8_STAGE(PG8_SB(0, 1), b2 + hstep, voffB); PG8_STAGE(PG8_SA(0, 0), a2, voffA);
            PG8_WAIT_V(8); PG8_WAIT_L(0); PG8_BAR; PG8_MMA(1, 0, At, B0); PG8_MMA(1, 1, At, B1); PG8_BAR; PG8_SCHED;
            PG8_LDB(B0, 1, 0); PG8_LDB(B1, 1, 1); PG8_SCHED; PG8_LDA(At, 1, 0); PG8_STAGE(PG8_SA(0, 1), a2 + hstep, voffA);
            PG8_WAIT_V(8); PG8_WAIT_L(0); PG8_BAR; PG8_MMA(0, 0, At, B0); PG8_MMA(0, 1, At, B1); PG8_BAR; PG8_SCHED;
            PG8_LDA(At, 1, 1); PG8_STAGE(PG8_SB(1, 0), b3, voffB); PG8_STAGE(PG8_SB(1, 1), b3 + hstep, voffB); PG8_STAGE(PG8_SA(1, 0), a3, voffA);
            PG8_WAIT_V(8); PG8_WAIT_L(0); PG8_BAR; PG8_MMA(1, 0, At, B0); PG8_MMA(1, 1, At, B1); PG8_BAR; PG8_SCHED;
            } else {
            PG8_LDB(B0, 0, 0); PG8_SCHED; PG8_LDA(At, 0, 0); PG8_STAGE(PG8_SA(1, 1), a1 + hstep, voffA);
            PG8_WAIT_L(8); PG8_BAR; PG8_WAIT_L(0); PG8_MMA(0, 0, At, B0); PG8_BAR; PG8_SCHED;
            PG8_LDB(B1, 0, 1); PG8_STAGE(PG8_SB(0, 0), b2, voffB);
            PG8_BAR; PG8_WAIT_L(0); PG8_MMA(0, 1, At, B1); PG8_BAR;
            PG8_LDA(At, 0, 1); PG8_STAGE(PG8_SA(0, 0), a2, voffA);
            PG8_BAR; PG8_WAIT_L(0); PG8_MMA(1, 0, At, B0); PG8_BAR; PG8_SCHED;
            PG8_STAGE(PG8_SB(0, 1), b2 + hstep, voffB);
            PG8_WAIT_V(6); PG8_BAR; PG8_MMA(1, 1, At, B1); PG8_BAR;
            PG8_LDB(B0, 1, 0); PG8_SCHED; PG8_LDA(At, 1, 0); PG8_STAGE(PG8_SA(0, 1), a2 + hstep, voffA);
            PG8_WAIT_L(8); PG8_BAR; PG8_WAIT_L(0); PG8_MMA(0, 0, At, B0); PG8_BAR; PG8_SCHED;
            PG8_LDB(B1, 1, 1); PG8_STAGE(PG8_SB(1, 0), b3, voffB);
            PG8_BAR; PG8_WAIT_L(0); PG8_MMA(0, 1, At, B1); PG8_BAR;
            PG8_LDA(At, 1, 1); PG8_STAGE(PG8_SA(1, 0), a3, voffA);
            PG8_BAR; PG8_WAIT_L(0); PG8_MMA(1, 0, At, B0); PG8_BAR; PG8_SCHED;
            PG8_STAGE(PG8_SB(1, 1), b3 + hstep, voffB);
            PG8_WAIT_V(6); PG8_BAR; PG8_MMA(1, 1, At, B1); PG8_BAR;
            }
        }
        if constexpr (FP8 || FP4 || I8) {
            asm volatile("s_nop 15\n\ts_nop 15" : "+v"(acc[0][0][0][0]), "+v"(acc[0][0][0][1]), "+v"(acc[0][0][1][0]), "+v"(acc[0][0][1][1]), "+v"(acc[0][0][2][0]), "+v"(acc[0][0][2][1]), "+v"(acc[0][0][3][0]), "+v"(acc[0][0][3][1]), "+v"(acc[0][1][0][0]), "+v"(acc[0][1][0][1]), "+v"(acc[0][1][1][0]), "+v"(acc[0][1][1][1]), "+v"(acc[0][1][2][0]), "+v"(acc[0][1][2][1]), "+v"(acc[0][1][3][0]), "+v"(acc[0][1][3][1]));
            asm volatile("" : "+v"(acc[1][0][0][0]), "+v"(acc[1][0][0][1]), "+v"(acc[1][0][1][0]), "+v"(acc[1][0][1][1]), "+v"(acc[1][0][2][0]), "+v"(acc[1][0][2][1]), "+v"(acc[1][0][3][0]), "+v"(acc[1][0][3][1]), "+v"(acc[1][1][0][0]), "+v"(acc[1][1][0][1]), "+v"(acc[1][1][1][0]), "+v"(acc[1][1][1][1]), "+v"(acc[1][1][2][0]), "+v"(acc[1][1][2][1]), "+v"(acc[1][1][3][0]), "+v"(acc[1][1][3][1])); }
        if constexpr (I8) {
#pragma unroll
            for (int a = 0; a < 2; ++a)
#pragma unroll
                for (int b = 0; b < 2; ++b)
#pragma unroll
                    for (int m = 0; m < 4; ++m)
#pragma unroll
                        for (int n = 0; n < 2; ++n) acc[a][b][m][n] = __builtin_convertvector(__builtin_bit_cast(v4i_t, acc[a][b][m][n]), f32x4); }
        if constexpr (ALIGN_EPI) { if (wr == 0) PG8_BAR; }
        if constexpr (!Epi::AFTER_DRAIN) { E(acc, cur, wr, wc, fr, fq); S.done(cur); }
        if (!has_next) break;
#pragma unroll
        for (int a = 0; a < 2; ++a)
#pragma unroll
            for (int b = 0; b < 2; ++b)
#pragma unroll
                for (int m = 0; m < 4; ++m)
#pragma unroll
                    for (int n = 0; n < 2; ++n) acc[a][b][m][n] = (f32x4){0.f, 0.f, 0.f, 0.f};
        cur = nxt; cA = nA; cB = nB; ++ui;
        if constexpr (ALIGN_EPI) { if (wr == 1) PG8_BAR; }
    }
    PG8_WAIT_V(0);
    if constexpr (!ALIGN_EPI) { if (wr == 0) PG8_BAR; }
    PG8_BAR;
    if constexpr (Epi::AFTER_DRAIN) { E.fused(acc, cur, wr, wc, fr, fq, lds, wid, lane); S.done(cur); }
#undef PG8_SA
#undef PG8_SB
#undef PG8_STAGE
#undef PG8_LDA
#undef PG8_LDB
#undef PG8_MMA
#undef PG8_ALIGN_MFMA
#undef PG8_ALIGN_MFMA8
#undef PG8_WAIT_V
#undef PG8_WAIT_L
#undef PG8_BAR
#undef PG8_SCHED
}
}
#define XB_TMO      128
#define XB_XCNT(j)  (256  + 64 * (j))
#define XB_XSUB(j)  (1280 + 64 * (j))
#define XB_XGEN(j)  (2304 + 64 * (j))
#define XB_TOP      3328
#define XB_TOPGEN   3392
#define XCD_BAR_WORDS 3456
#define XB_SPIN_CAP (1u << 20)

__device__ __forceinline__ unsigned xb_ld(unsigned* p)              { return __hip_atomic_load(p, __ATOMIC_RELAXED, __HIP_MEMORY_SCOPE_AGENT); }
__device__ __forceinline__ unsigned xb_add(unsigned* p, unsigned v) { return __hip_atomic_fetch_add(p, v, __ATOMIC_RELAXED, __HIP_MEMORY_SCOPE_AGENT); }
__device__ __forceinline__ unsigned xb_xcc_id() { return (unsigned)__builtin_amdgcn_s_getreg((3 << 11) | 20) & 0xFu; }
#define XB_SPIN(cond, bar) do { unsigned _sp = 0; while (cond) { __builtin_amdgcn_s_sleep(1); \
    if ((++_sp & 255u) == 0u) { if (xb_ld(&(bar)[XB_TMO])) break; if (_sp > XB_SPIN_CAP) { atomicAdd(&(bar)[XB_TMO], 1u); break; } } } } while (0)

struct XcdBarrier {
    unsigned* bar; unsigned x;
    volatile LAS unsigned* st;
};

__device__ __forceinline__ XcdBarrier xcd_barrier_post(unsigned* bar, volatile LAS unsigned* st) {
    XcdBarrier b; b.bar = bar; b.x = xb_xcc_id(); b.st = st;
    if (threadIdx.x == 0) (void)xb_add(&bar[XB_XCNT(b.x)], 1u);
    return b;
}
__device__ __forceinline__ void xcd_barrier_complete(unsigned* bar, unsigned x, unsigned& nloc, unsigned& nx) {
    const unsigned G = gridDim.x * gridDim.y * gridDim.z;
    unsigned sum, cnt, mine, sp = 0u;
    for (;;) {
        sum = 0u; cnt = 0u; mine = 0u;
#pragma unroll
        for (unsigned j = 0; j < 16; ++j) { const unsigned c = xb_ld(&bar[XB_XCNT(j)]); sum += c; cnt += (c > 0u) ? 1u : 0u; mine = (j == x) ? c : mine; }
        if (sum == G) break;
        __builtin_amdgcn_s_sleep(1);
        if ((++sp & 255u) == 0u) { if (xb_ld(&bar[XB_TMO])) break; if (sp > XB_SPIN_CAP) { atomicAdd(&bar[XB_TMO], 1u); break; } }
    }
    nloc = mine > 0u ? mine : 1u; nx = cnt > 0u ? cnt : 1u;
}

__device__ __forceinline__ void xcd_barrier(const XcdBarrier& b) {
    asm volatile("s_waitcnt vmcnt(0)" ::: "memory");
    __syncthreads();
    if (threadIdx.x == 0) {
        unsigned* bar = b.bar;
        __builtin_amdgcn_s_waitcnt(0);
        unsigned nloc = b.st[0], nx = b.st[1];
        if (nloc == 0u) { xcd_barrier_complete(bar, b.x, nloc, nx); b.st[0] = nloc; b.st[1] = nx; }
        const unsigned old = xb_add(&bar[XB_XSUB(b.x)], 1u);
        const unsigned gen = old / nloc;
        if (old + 1u == (gen + 1u) * nloc) {
            __builtin_amdgcn_fence(__ATOMIC_RELEASE, "agent");
            asm volatile("s_waitcnt vmcnt(0)" ::: "memory");
            const unsigned og = xb_add(&bar[XB_TOP], 1u);
            const unsigned tg = og / nx;
            if (og + 1u == (tg + 1u) * nx) xb_add(&bar[XB_TOPGEN], 1u);
            else XB_SPIN(xb_ld(&bar[XB_TOPGEN]) == tg, bar);
            __builtin_amdgcn_fence(__ATOMIC_ACQUIRE, "agent");
            xb_add(&bar[XB_XGEN(b.x)], 1u);
            asm volatile("s_waitcnt vmcnt(0)" ::: "memory");
        } else {
            XB_SPIN(xb_ld(&bar[XB_XGEN(b.x)]) == gen, bar);
            __builtin_amdgcn_fence(__ATOMIC_ACQUIRE, "agent");
            asm volatile("s_waitcnt vmcnt(0)" ::: "memory");
        }
    }
    __syncthreads();
}

template <int MAP> __device__ __forceinline__ int rowmap(int n) {
    if (MAP == 1) return n - 6400;
    if (MAP == 4) return n < 6400 ? n : (n < 10656 ? n + 3936 : n - 8352);
    if (MAP == 2) return (n >> 7) * 256 + (n & 127);
    if (MAP == 3) return (n >> 7) * 256 + 128 + (n & 127);
    return n;
}
__device__ __forceinline__ void p0_load(const float* W, int N, int item, f32x4 (&r)[8], int lane) {
    const int nblk = N / 32, kb = item / nblk, nb = item % nblk;
    const float* p = W + (size_t)(64 * kb + (lane >> 3)) * N + 32 * nb + 4 * (lane & 7);
#pragma unroll
    for (int i = 0; i < 8; ++i) r[i] = *(const GAS f32x4*)(p + (size_t)(8 * i) * N);
}
template <int MAP, bool SM = false> __device__ __forceinline__ void p0_finish(const f32x4 (&r)[8], int N, bf16* dst, int ldd, int koff, LAS float* scr, int item, int lane) {
    const int nblk = N / 32, kb = item / nblk, nb = item % nblk, k0 = 64 * kb, n0 = 32 * nb;
#pragma unroll
    for (int i = 0; i < 8; ++i) { LAS float* s = scr + (8 * i + (lane >> 3)) * 33 + 4 * (lane & 7); s[0] = r[i].x; s[1] = r[i].y; s[2] = r[i].z; s[3] = r[i].w; }
    LDS_WAIT(); asm volatile("" ::: "memory");
    const int c = lane & 7, r0 = rowmap<MAP>(n0);
#pragma unroll
    for (int j = 0; j < 4; ++j) { const int n = (lane >> 3) + 8 * j; const LAS float* s = scr + (8 * c) * 33 + n;
        v4u o; if (SM) { o.x = cvt_pk_bf16(rnd_sm(s[0 * 33]), rnd_sm(s[1 * 33])); o.y = cvt_pk_bf16(rnd_sm(s[2 * 33]), rnd_sm(s[3 * 33])); o.z = cvt_pk_bf16(rnd_sm(s[4 * 33]), rnd_sm(s[5 * 33])); o.w = cvt_pk_bf16(rnd_sm(s[6 * 33]), rnd_sm(s[7 * 33])); }
        else { o.x = cvt_pk_bf16(s[0 * 33], s[1 * 33]); o.y = cvt_pk_bf16(s[2 * 33], s[3 * 33]); o.z = cvt_pk_bf16(s[4 * 33], s[5 * 33]); o.w = cvt_pk_bf16(s[6 * 33], s[7 * 33]); }
        *(GAS v4u*)(dst + (size_t)(r0 + n) * ldd + koff + k0 + 8 * c) = o; }
    LDS_WAIT(); asm volatile("" ::: "memory");
}
template <int MAP> __device__ __forceinline__ void p0_finish8(const f32x4 (&r)[8], int N, unsigned char* dst, int ldd, LAS float* scr, int item, int lane) {
    const int nblk = N / 32, kb = item / nblk, nb = item % nblk, k0 = 64 * kb, n0 = rowmap<MAP>(32 * nb);
#pragma unroll
    for (int i = 0; i < 8; ++i) { LAS float* s = scr + (8 * i + (lane >> 3)) * 33 + 4 * (lane & 7); s[0] = r[i].x; s[1] = r[i].y; s[2] = r[i].z; s[3] = r[i].w; }
    LDS_WAIT(); asm volatile("" ::: "memory");
    const int c = lane & 7;
#pragma unroll
    for (int j = 0; j < 4; ++j) { const int n = (lane >> 3) + 8 * j; const LAS float* s = scr + (8 * c) * 33 + n; v2u o;
        o.x = (unsigned)__builtin_amdgcn_cvt_pk_fp8_f32(64.f * s[2 * 33], 64.f * s[3 * 33], __builtin_amdgcn_cvt_pk_fp8_f32(64.f * s[0 * 33], 64.f * s[1 * 33], 0, false), true);
        o.y = (unsigned)__builtin_amdgcn_cvt_pk_fp8_f32(64.f * s[6 * 33], 64.f * s[7 * 33], __builtin_amdgcn_cvt_pk_fp8_f32(64.f * s[4 * 33], 64.f * s[5 * 33], 0, false), true);
        *(GAS v2u*)(dst + (size_t)(n0 + n) * ldd + k0 + 8 * c) = o; }
    LDS_WAIT(); asm volatile("" ::: "memory");
}
template <int MAP> __device__ __forceinline__ void p0_finish_i8(const f32x4 (&r)[8], int N, unsigned char* dst, int ldd, float wsc, LAS float* scr, int item, int lane) {
    const int nblk = N / 32, kb = item / nblk, nb = item % nblk, k0 = 64 * kb, n0 = rowmap<MAP>(32 * nb);
#pragma unroll
    for (int i = 0; i < 8; ++i) { LAS float* s = scr + (8 * i + (lane >> 3)) * 33 + 4 * (lane & 7); s[0] = r[i].x; s[1] = r[i].y; s[2] = r[i].z; s[3] = r[i].w; }
    LDS_WAIT(); asm volatile("" ::: "memory");
    const int c = lane & 7;
#pragma unroll
    for (int j = 0; j < 4; ++j) { const int n = (lane >> 3) + 8 * j; const LAS float* s = scr + (8 * c) * 33 + n;
        *(GAS v2u*)(dst + (size_t)(n0 + n) * ldd + k0 + 8 * c) = pack8_i8((f32x4){wsc * s[0 * 33], wsc * s[1 * 33], wsc * s[2 * 33], wsc * s[3 * 33]}, (f32x4){wsc * s[4 * 33], wsc * s[5 * 33], wsc * s[6 * 33], wsc * s[7 * 33]}); }
    LDS_WAIT(); asm volatile("" ::: "memory");
}
__device__ __forceinline__ void p0_finish_i8h(const f32x4 (&r)[8], int N, unsigned char* dst, int ldd, float wsc, LAS float* scr, int item, int lane) {
    const int nblk = N / 32, kb = item / nblk, nb = item % nblk, k0 = 64 * kb, n0 = 32 * nb;
#pragma unroll
    for (int i = 0; i < 8; ++i) { LAS float* s = scr + (8 * i + (lane >> 3)) * 33 + 4 * (lane & 7); s[0] = r[i].x; s[1] = r[i].y; s[2] = r[i].z; s[3] = r[i].w; }
    LDS_WAIT(); asm volatile("" ::: "memory");
    const int n = lane & 31, half = lane >> 5; const LAS float* s = scr + (32 * half) * 33 + n;
    float v[32];
#pragma unroll
    for (int i = 0; i < 32; ++i) v[i] = s[i * 33];
#pragma unroll
    for (int h = 1; h < 32; h <<= 1)
#pragma unroll
        for (int i = 0; i < 32; ++i) if (!(i & h)) { const float a = v[i], b = v[i | h]; v[i] = a + b; v[i | h] = a - b; }
    const float c = wsc * 0.17677669529663687f;
    unsigned char* p = dst + (size_t)(n0 + n) * ldd + k0 + 32 * half;
#pragma unroll
    for (int q = 0; q < 2; ++q) { const v2u lo = pack8_i8((f32x4){v[16 * q], v[16 * q + 1], v[16 * q + 2], v[16 * q + 3]} * c, (f32x4){v[16 * q + 4], v[16 * q + 5], v[16 * q + 6], v[16 * q + 7]} * c),
                                            hi = pack8_i8((f32x4){v[16 * q + 8], v[16 * q + 9], v[16 * q + 10], v[16 * q + 11]} * c, (f32x4){v[16 * q + 12], v[16 * q + 13], v[16 * q + 14], v[16 * q + 15]} * c);
        *(GAS v4u*)(p + 16 * q) = (v4u){lo.x, lo.y, hi.x, hi.y}; }
    LDS_WAIT(); asm volatile("" ::: "memory");
}
template <bool NORM, bool GAIN, bool ROT = false> __device__ __forceinline__ void quant_row_i8(const bf16* xrow, const float* gain, unsigned char* orow, float* fac, int lane, const float clip = 4.0f, float* faca = nullptr, const float sgu = 0.f) {
    f32x4 a[8][2]; float sx = 0.f, sa = 0.f;
#pragma unroll
    for (int j = 0; j < 8; ++j) { const v4u w = *(const GAS v4u*)(xrow + (lane + 64 * j) * 8); f32x4 x0, x1; unpack8(w, x0, x1);
        if constexpr (GAIN) { const f32x4 g0 = *(const GAS f32x4*)(gain + (lane + 64 * j) * 8), g1 = *(const GAS f32x4*)(gain + (lane + 64 * j) * 8 + 4); a[j][0] = x0 * g0; a[j][1] = x1 * g1; }
        else { a[j][0] = x0; a[j][1] = x1; }
#pragma unroll
        for (int i = 0; i < 4; ++i) { sx += x0[i] * x0[i] + x1[i] * x1[i]; sa += a[j][0][i] * a[j][0][i] + a[j][1][i] * a[j][1][i]; } }
    if constexpr (NORM) sx = wave_sum(sx);
    sa = wave_sum(sa);
    float sc = 127.0f / (clip * sqrtf(sa * (1.0f / DM)) + 1e-30f);
    if constexpr (ROT) {
        const float s1_ = (lane & 1) ? -1.0f : 1.0f, s2_ = (lane & 2) ? -1.0f : 1.0f;
#pragma unroll
        for (int j = 0; j < 8; ++j) { float v_[8] = {a[j][0][0], a[j][0][1], a[j][0][2], a[j][0][3], a[j][1][0], a[j][1][1], a[j][1][2], a[j][1][3]};
#pragma unroll
            for (int h_ = 1; h_ < 8; h_ <<= 1)
#pragma unroll
                for (int i_ = 0; i_ < 8; ++i_) if (!(i_ & h_)) { const float p_ = v_[i_], q_ = v_[i_ | h_]; v_[i_] = p_ + q_; v_[i_ | h_] = p_ - q_; }
#pragma unroll
            for (int i_ = 0; i_ < 8; ++i_) { const float t_ = __int_as_float(__builtin_amdgcn_update_dpp(0, __float_as_int(v_[i_]), 0xB1, 0xF, 0xF, true)); v_[i_] = (lane & 1) ? t_ - v_[i_] : v_[i_] + t_; }
#pragma unroll
            for (int i_ = 0; i_ < 8; ++i_) { const float t_ = __int_as_float(__builtin_amdgcn_update_dpp(0, __float_as_int(v_[i_]), 0x4E, 0xF, 0xF, true)); v_[i_] = (lane & 2) ? t_ - v_[i_] : v_[i_] + t_; }
            a[j][0] = (f32x4){v_[0], v_[1], v_[2], v_[3]}; a[j][1] = (f32x4){v_[4], v_[5], v_[6], v_[7]}; }
        (void)s1_; (void)s2_;
        sc *= 0.17677669529663687f; }
#pragma unroll
    for (int j = 0; j < 8; ++j) *(GAS v2u*)(orow + (lane + 64 * j) * 8) = pack8_i8(a[j][0] * sc, a[j][1] * sc);
    if constexpr (ROT) sc *= 5.656854249492381f;
    if (lane == 0) { *fac = NORM ? (1.0f / sqrtf(sx * (1.0f / DM) + EPS)) / sc : 1.0f / sc;
        if (faca) *faca = ACT_CLIP * (sa / (sx * (1.0f / DM) + EPS)) * sgu * (1.0f / 127.0f); }
}
__device__ __forceinline__ void p0_finish4(const f32x4 (&r)[8], int N, unsigned char* dst, float wsc, LAS float* scr, int item, int lane) {
    const int nblk = N / 32, kb = item / nblk, nb = item % nblk, k0 = 64 * kb, n0 = 32 * nb - 10656;
#pragma unroll
    for (int i = 0; i < 8; ++i) { LAS float* s = scr + (8 * i + (lane >> 3)) * 33 + 4 * (lane & 7); s[0] = r[i].x; s[1] = r[i].y; s[2] = r[i].z; s[3] = r[i].w; }
    LDS_WAIT(); asm volatile("" ::: "memory");
    const int c = lane & 7;
#pragma unroll
    for (int j = 0; j < 4; ++j) { const int n = (lane >> 3) + 8 * j; const LAS float* s = scr + (8 * c) * 33 + n;
        const unsigned o = pack4_f4(wsc * s[0 * 33], wsc * s[1 * 33], wsc * s[2 * 33], wsc * s[3 * 33]) | (pack4_f4(wsc * s[4 * 33], wsc * s[5 * 33], wsc * s[6 * 33], wsc * s[7 * 33]) << 16);
        *(GAS unsigned*)(dst + (size_t)(n0 + n) * 2048 + (k0 >> 1) + 4 * c) = o; }
    LDS_WAIT(); asm volatile("" ::: "memory");
}
__device__ __forceinline__ void rms_row_to_bf16(const float* xrow, const float* gain, bf16* orow, unsigned char* orow8, unsigned char* orow4, float* fach, int lane) {
    const GAS f32x4* xr = (const GAS f32x4*)xrow + lane;
    f32x4 v[16]; float s = 0.f;
#pragma unroll
    for (int j = 0; j < 16; ++j) { v[j] = xr[64 * j]; s += (v[j].x * v[j].x + v[j].y * v[j].y) + (v[j].z * v[j].z + v[j].w * v[j].w); }
    const float r = 1.0f / sqrtf(wave_sum(s) * (1.0f / DM) + EPS);
    GAS v2u* o8 = (GAS v2u*)orow + lane; GAS unsigned* o4 = (GAS unsigned*)orow8 + lane; GAS unsigned short* o2 = (GAS unsigned short*)orow4 + lane;
    float sh = 0.f;
#pragma unroll
    for (int j = 0; j < 16; ++j) { const f32x4 gv = ((const GAS f32x4*)gain)[lane + 64 * j]; v[j] = v[j] * r * gv; sh += (v[j].x * v[j].x + v[j].y * v[j].y) + (v[j].z * v[j].z + v[j].w * v[j].w); }
    const float sc = 127.0f / (4.0f * sqrtf(wave_sum(sh) * (1.0f / DM)) + 1e-30f);
#pragma unroll
    for (int j = 0; j < 16; ++j) { const f32x4 y = v[j];
        v2u w; w.x = cvt_pk_bf16(y.x, y.y); w.y = cvt_pk_bf16(y.z, y.w); o8[64 * j] = w;
        o4[64 * j] = q8(y.x * sc) | (q8(y.y * sc) << 8) | (q8(y.z * sc) << 16) | (q8(y.w * sc) << 24);
        o2[64 * j] = (unsigned short)pack4_f4(2.0f * y.x, 2.0f * y.y, 2.0f * y.z, 2.0f * y.w); }
    if (lane == 0) *fach = 1.0f / sc;
}

__device__ __forceinline__ unsigned ordkey(float v) { const unsigned u = __float_as_uint(v); return u ^ ((u >> 31) ? 0xffffffffu : 0x80000000u); }
__device__ __forceinline__ int mbcnt64(unsigned long long m) { return (int)__builtin_amdgcn_mbcnt_hi((unsigned)(m >> 32), __builtin_amdgcn_mbcnt_lo((unsigned)m, 0u)); }

__device__ __forceinline__ int wave_count(int cl) { int c = 0;
#pragma unroll
    for (int b = 0; b < 7; ++b) c += __popcll(__ballot((cl >> b) & 1)) << b;
    return c; }
constexpr int TOPK_WAVE_LDS = 6144;
__device__ __forceinline__ void topk_row(const float* sc, int N, unsigned short* out, LAS unsigned char* wl, int lane) {
    asm volatile("" : "+v"(lane));
    if (N <= TOPK) { v2u w; w.x = (unsigned)(4 * lane) | ((unsigned)(4 * lane + 1) << 16); w.y = (unsigned)(4 * lane + 2) | ((unsigned)(4 * lane + 3) << 16); *(GAS v2u*)(out + 4 * lane) = w; return; }
    LAS unsigned* hist = (LAS unsigned*)wl; LAS unsigned short* stg = (LAS unsigned short*)(wl + 4096);
    LAS unsigned* ckl = (LAS unsigned*)(wl + 4608); LAS unsigned short* cel = (LAS unsigned short*)(wl + 5632);
    const int ng = (N + 1023) >> 10;
    unsigned key[4][16]; int npos = 0;
#pragma unroll
    for (int g = 0; g < 4; ++g) {
#pragma unroll
        for (int j = 0; j < 16; ++j) key[g][j] = 0u;
        if (g < ng) {
            float v_[16];
#pragma unroll
            for (int j = 0; j < 16; ++j) v_[j] = sc[g * 1024 + j * 64 + lane];
            asm volatile("" : "+v"(v_[0]), "+v"(v_[1]), "+v"(v_[2]), "+v"(v_[3]), "+v"(v_[4]), "+v"(v_[5]), "+v"(v_[6]), "+v"(v_[7]), "+v"(v_[8]), "+v"(v_[9]), "+v"(v_[10]), "+v"(v_[11]), "+v"(v_[12]), "+v"(v_[13]), "+v"(v_[14]), "+v"(v_[15]));
#pragma unroll
            for (int j = 0; j < 16; ++j) { const int e = g * 1024 + j * 64 + lane; key[g][j] = e < N ? ordkey(v_[j]) : 0u; }
#pragma unroll
            for (int j = 0; j < 16; ++j) { const bool pos = key[g][j] > 0x80000000u; npos += __popcll(__ballot(pos));
                if (pos) (void)__hip_atomic_fetch_add(hist + (key[g][j] >> 22), 1u << ((key[g][j] >> 17) & 16u), __ATOMIC_RELAXED, __HIP_MEMORY_SCOPE_WORKGROUP); }
        } }
    if (npos < TOPK) {
#pragma unroll
        for (int g = 0; g < 4; ++g) if (g < ng) {
#pragma unroll
            for (int j = 0; j < 16; ++j) if (!(key[g][j] > 0x80000000u)) (void)__hip_atomic_fetch_add(hist + (key[g][j] >> 22), 1u << ((key[g][j] >> 17) & 16u), __ATOMIC_RELAXED, __HIP_MEMORY_SCOPE_WORKGROUP); } }
    unsigned h[32]; unsigned sl = 0u;
    { const LAS v4u* hp = (const LAS v4u*)(hist + 1024 - 16 * (lane + 1));
#pragma unroll
      for (int i = 0; i < 4; ++i) { const v4u t = hp[i];
          h[8 * i] = t.x & 0xffffu; h[8 * i + 1] = t.x >> 16; h[8 * i + 2] = t.y & 0xffffu; h[8 * i + 3] = t.y >> 16; h[8 * i + 4] = t.z & 0xffffu; h[8 * i + 5] = t.z >> 16; h[8 * i + 6] = t.w & 0xffffu; h[8 * i + 7] = t.w >> 16;
          sl += ((t.x & 0xffffu) + (t.x >> 16)) + ((t.y & 0xffffu) + (t.y >> 16)) + ((t.z & 0xffffu) + (t.z >> 16)) + ((t.w & 0xffffu) + (t.w >> 16)); }
      LAS v4u* hz = (LAS v4u*)(hist + 1024 - 16 * (lane + 1));
#pragma unroll
      for (int i = 0; i < 4; ++i) hz[i] = (v4u){0u, 0u, 0u, 0u}; }
    unsigned El = 0u;
#pragma unroll
    for (int b = 0; b < 13; ++b) El += (unsigned)mbcnt64(__ballot((sl >> b) & 1u)) << b;
    int kb = 0; unsigned ab = 0u, cb = 0u; { unsigned acc = El;
#pragma unroll
      for (int k = 31; k >= 0; --k) { const bool hit = acc < (unsigned)TOPK && acc + h[k] >= (unsigned)TOPK; kb = hit ? k : kb; ab = hit ? acc : ab; cb = hit ? h[k] : cb; acc += h[k]; } }
    const int Ls = __ffsll((long long)__ballot(El < (unsigned)TOPK && El + sl >= (unsigned)TOPK)) - 1;
    const unsigned b1 = (unsigned)(2048 - 32 * (Ls + 1) + __builtin_amdgcn_readlane(kb, Ls));
    const int above = (int)__builtin_amdgcn_readlane((int)ab, Ls), C = (int)__builtin_amdgcn_readlane((int)cb, Ls);
    int base = 0;
    if (C <= 256) {
        int cbase = 0;
#pragma unroll
        for (int g = 0; g < 4; ++g) if (g < ng) {
#pragma unroll
            for (int j = 0; j < 16; ++j) { const unsigned d = key[g][j] >> 21; const bool up = d > b1, cd = d == b1;
                const unsigned long long mu = __ballot(up), mc = __ballot(cd);
                if (up) stg[base + mbcnt64(mu)] = (unsigned short)(g * 1024 + j * 64 + lane);
                if (cd) { const int cp = cbase + mbcnt64(mc); ckl[cp] = key[g][j]; cel[cp] = (unsigned short)(g * 1024 + j * 64 + lane); }
                base += __popcll(mu); cbase += __popcll(mc); } }
        LDS_WAIT();
        unsigned ck[4]; unsigned ce[4];
#pragma unroll
        for (int m = 0; m < 4; ++m) { const int i = lane + 64 * m; ck[m] = i < C ? ckl[i] : 0u; ce[m] = cel[i]; }
        const int need = TOPK - above;
        unsigned T = b1 << 21; bool exact = false;
#pragma unroll 1
        for (int bit = 20; bit >= 0; --bit) { const unsigned cand = T | (1u << bit); int c = 0;
#pragma unroll
            for (int m = 0; m < 4; ++m) c += __popcll(__ballot(ck[m] >= cand));
            if (c >= need) { T = cand; if (c == need) { exact = true; break; } } }
        int need_eq = 1 << 30;
        if (!exact) { int cg = 0;
#pragma unroll
            for (int m = 0; m < 4; ++m) cg += __popcll(__ballot(ck[m] > T));
            need_eq = need - cg; }
        int eqb = 0;
#pragma unroll
        for (int m = 0; m < 4; ++m) { const bool gt = ck[m] > T, eq = ck[m] == T && ck[m] != 0u; const unsigned long long meq = __ballot(eq);
            const bool sel = gt || (eq && (eqb + mbcnt64(meq)) < need_eq); const unsigned long long ms = __ballot(sel);
            if (sel) stg[base + mbcnt64(ms)] = (unsigned short)ce[m];
            base += __popcll(ms); eqb += __popcll(meq); }
    } else {
        unsigned T = 0u; bool exact = false;
#pragma unroll 1
        for (int bit = 31; bit >= 0; --bit) {
            const unsigned cand = T | (1u << bit); int c = 0;
#pragma unroll
            for (int g = 0; g < 4; ++g) if (g < ng) {
#pragma unroll
                for (int j = 0; j < 16; ++j) c += __popcll(__ballot(key[g][j] >= cand)); }
            if (c >= TOPK) { T = cand; if (c == TOPK) { exact = true; break; } }
        }
        int need_eq = 1 << 30;
        if (!exact) { int cg = 0;
#pragma unroll
            for (int g = 0; g < 4; ++g) if (g < ng) {
#pragma unroll
                for (int j = 0; j < 16; ++j) cg += __popcll(__ballot(key[g][j] > T)); }
            need_eq = TOPK - cg; }
        int eqb = 0;
#pragma unroll
        for (int g = 0; g < 4; ++g) if (g < ng) {
#pragma unroll
            for (int j = 0; j < 16; ++j) { const bool gt = key[g][j] > T, eq = key[g][j] == T; const unsigned long long meq = __ballot(eq);
                const bool sel = gt || (eq && (eqb + mbcnt64(meq)) < need_eq); const unsigned long long ms = __ballot(sel);
                if (sel) stg[base + mbcnt64(ms)] = (unsigned short)(g * 1024 + j * 64 + lane);
                base += __popcll(ms); eqb += __popcll(meq); } }
    }
    LDS_WAIT();
    *(GAS v2u*)(out + 4 * lane) = *(const LAS v2u*)(stg + 4 * lane);
    LDS_WAIT();
}

#ifndef IDX_SCHED_BARRIER
#define IDX_SCHED_BARRIER 2
#endif
__device__ __forceinline__ void indexer_unit(LAS unsigned char* lds, int tid, int wave, int lane, int b, int qg,
                                             const bf16* QIDX, const bf16* KIDX, const float* WIDX, float* SC, unsigned short* IDX) {
    LAS unsigned char* KT = lds;
    LAS float* WT = (LAS float*)(lds + 65536);
    asm volatile("" : "+v"(lane), "+v"(tid));
    const int q0 = qg * 32, nkeys = q0 + 32, r = lane & 31, hh = lane >> 5;
    const size_t rowb = (size_t)b * SEQ;
    __syncthreads();
    const int hl = lane & 15, g = lane >> 4;
    bf16x8 A[4][2][4]; f32x4 W4[4][2];
#pragma unroll
    for (int qi = 0; qi < 4; ++qi)
#pragma unroll
        for (int hf = 0; hf < 2; ++hf) { W4[qi][hf] = *(const GAS f32x4*)(WIDX + (rowb + q0 + 4 * wave + qi) * 32 + 16 * hf + 4 * g);
#pragma unroll
            for (int kk = 0; kk < 4; ++kk) A[qi][hf][kk] = *(const GAS bf16x8*)(QIDX + (rowb + q0 + 4 * wave + qi) * 4096 + (16 * hf + hl) * 128 + 32 * kk + 8 * g); }
    const int nch = (nkeys + 127) >> 7;
    const int srow = 16 * wave + (lane >> 4), slot = lane & 15;
#define IDX_STAGE(ch_, buf_) do { _Pragma("unroll") for (int i_ = 0; i_ < 4; ++i_) { const int krow_ = srow + 4 * i_; \
        __builtin_amdgcn_global_load_lds((const GAS unsigned*)(KIDX + (rowb + (ch_) * 128 + krow_) * 128 + ((slot ^ (krow_ & 15)) << 3)), (LAS unsigned*)((buf_) + (16 * wave + 4 * i_) * 256), 16, 0, 0); } } while (0)
    IDX_STAGE(0, KT);
    for (int ch = 0; ch < nch; ++ch) {
        LAS unsigned char* buf = KT + (ch & 1) * 32768;
        if (ch == 0) VM_WAIT(); else asm volatile("s_waitcnt vmcnt(16)" ::: "memory");
        __syncthreads();
        if (ch + 1 < nch) IDX_STAGE(ch + 1, KT + ((ch + 1) & 1) * 32768);
        const int rem = (nkeys - ch * 128) >> 5, ntile = rem < 4 ? rem : 4;
        for (int tile = 0; tile < ntile; ++tile) {
            bf16x8 Bf[2][4];
#pragma unroll
            for (int st = 0; st < 2; ++st)
#pragma unroll
                for (int kk = 0; kk < 4; ++kk) Bf[st][kk] = *(const LAS bf16x8*)(buf + (tile * 32 + 16 * st + hl) * 256 + (((4 * kk + g) ^ hl) << 4));
            const int key = ch * 128 + tile * 32 + 16 * (g & 1) + hl;
#pragma unroll
            for (int qi = 0; qi < 4; ++qi) {
                float s2[2];
#pragma unroll
                for (int st = 0; st < 2; ++st) { f32x4 a0 = {0.f, 0.f, 0.f, 0.f}, a1 = {0.f, 0.f, 0.f, 0.f};
#pragma unroll
                    for (int kk = 0; kk < 4; ++kk) { a0 = __builtin_amdgcn_mfma_f32_16x16x32_bf16(A[qi][0][kk], Bf[st][kk], a0, 0, 0, 0); a1 = __builtin_amdgcn_mfma_f32_16x16x32_bf16(A[qi][1][kk], Bf[st][kk], a1, 0, 0, 0); }
                    float sc = 0.f;
#pragma unroll
                    for (int i = 0; i < 4; ++i) sc += fmaxf(a0[i], 0.f) * W4[qi][0][i] + fmaxf(a1[i], 0.f) * W4[qi][1][i];
                    s2[st] = sc; }
                float tt; { const auto p16 = __builtin_amdgcn_permlane16_swap(__float_as_uint(s2[0]), __float_as_uint(s2[1]), false, false); tt = __uint_as_float(p16[0]) + __uint_as_float(p16[1]);
                            const auto p32 = __builtin_amdgcn_permlane32_swap(__float_as_uint(tt), __float_as_uint(tt), false, false); tt = __uint_as_float(p32[0]) + __uint_as_float(p32[1]); }
                const int qpos = q0 + 4 * wave + qi;
                if (g < 2) SC[(rowb + qpos) * 4096 + key] = tt;
                if (IDX_SCHED_BARRIER == 1 || (IDX_SCHED_BARRIER == 2 && (qi & 1))) __builtin_amdgcn_sched_barrier(0);
            }
        }
    }
#undef IDX_STAGE
    VM_WAIT();
#ifndef DUP_TOPK
#define DUP_TOPK 1
#endif
#pragma unroll 1
    for (int qi = 0; qi < 4 * DUP_TOPK; ++qi) { const int qpos = q0 + 4 * wave + (qi & 3); topk_row(SC + (rowb + qpos) * 4096, qpos + 1, IDX + (rowb + qpos) * 256, lds + 69632 + wave * TOPK_WAVE_LDS, lane); }
}

__device__ __forceinline__ void sgu_unit(LAS unsigned char* lds, int tid, int wave, int lane, int cidx, int grp,
                                         const bf16* UV, const float* LNP, const bf16* SGUW, const float* lng, const float* lnb, const float* sgub, bf16* YAB) {
    constexpr int VP = 544, WP = 272;
    LAS unsigned char* VN = lds;
    LAS unsigned char* WL = lds + 128 * VP;
    LAS float* ST = (LAS float*)(lds + 128 * VP + 128 * WP);
    const int t0 = cidx * 128;
    __syncthreads();
    if (tid < 128) { float s = 0.f, q = 0.f;
#pragma unroll
        for (int i = 0; i < 8; ++i) { const GAS f32x4* p = (const GAS f32x4*)(LNP + ((size_t)i * MTOK + t0 + tid) * 8); const f32x4 a = p[0], b = p[1]; s += (a[0] + a[2]) + (b[0] + b[2]); q += (a[1] + a[3]) + (b[1] + b[3]); }
        const float mean = s * (1.0f / GWID), var = q * (1.0f / GWID) - mean * mean;
        ST[2 * tid] = mean; ST[2 * tid + 1] = 1.0f / sqrtf(var + EPS); }
#pragma unroll
    for (int i = 0; i < 4; ++i) { const int c = (tid & 3) * 4 + i; *(LAS v4u*)(WL + (tid >> 2) * WP + c * 16) = *(const GAS v4u*)(SGUW + ((size_t)grp * 128 + (tid >> 2)) * 128 + c * 8); }
    __syncthreads();
#pragma unroll
    for (int i = 0; i < 8; ++i) { const int id = tid + 512 * i, s = id >> 5, dc = id & 31;
        const v4u w = *(const GAS v4u*)(UV + (size_t)(t0 + s) * 4096 + GWID + grp * GDIM + dc * 8); f32x4 v0, v1; unpack8(w, v0, v1);
        const float mean = ST[2 * s], rstd = ST[2 * s + 1];
        const f32x4 g0 = *(const GAS f32x4*)(lng + grp * GDIM + dc * 8), g1 = *(const GAS f32x4*)(lng + grp * GDIM + dc * 8 + 4);
        const f32x4 b0 = *(const GAS f32x4*)(lnb + grp * GDIM + dc * 8), b1 = *(const GAS f32x4*)(lnb + grp * GDIM + dc * 8 + 4);
        v0 = (v0 - mean) * rstd * g0 + b0; v1 = (v1 - mean) * rstd * g1 + b1;
        *(LAS v4u*)(VN + s * VP + dc * 16) = pack8(v0, v1); }
    __syncthreads();
    const int g = lane >> 4, hl = lane & 15, q = hl >> 2, p = lane & 3;
    f32x4 acc[2][8];
#pragma unroll
    for (int a = 0; a < 2; ++a)
#pragma unroll
        for (int t = 0; t < 8; ++t) acc[a][t] = (f32x4){0.f, 0.f, 0.f, 0.f};
#pragma unroll
    for (int ks = 0; ks < 4; ++ks) {
        bf16x8 vf[2];
#pragma unroll
        for (int ds = 0; ds < 2; ++ds) { const int d0 = (2 * wave + ds) * 16;
            const s16x4 a1 = __builtin_amdgcn_ds_read_tr16_b64_v4i16((LAS s16x4*)(VN + (32 * ks + 4 * g + q) * VP + (d0 + 4 * p) * 2));
            const s16x4 a2 = __builtin_amdgcn_ds_read_tr16_b64_v4i16((LAS s16x4*)(VN + (32 * ks + 16 + 4 * g + q) * VP + (d0 + 4 * p) * 2));
            vf[ds] = (bf16x8){a1[0], a1[1], a1[2], a1[3], a2[0], a2[1], a2[2], a2[3]}; }
#pragma unroll
        for (int tt = 0; tt < 8; ++tt) if (tt >= 2 * ks) {
            const int t = 16 * tt + hl;
            const s16x4 w1 = *(const LAS s16x4*)(WL + t * WP + (32 * ks + 4 * g) * 2), w2 = *(const LAS s16x4*)(WL + t * WP + (32 * ks + 16 + 4 * g) * 2);
            const bf16x8 wf = (bf16x8){w1[0], w1[1], w1[2], w1[3], w2[0], w2[1], w2[2], w2[3]};
#pragma unroll
            for (int ds = 0; ds < 2; ++ds) acc[ds][tt] = __builtin_amdgcn_mfma_f32_16x16x32_bf16(vf[ds], wf, acc[ds][tt], 0, 0, 0);
        }
    }
#pragma unroll
    for (int tt = 0; tt < 8; ++tt) { const int t = 16 * tt + hl; const float bs = sgub[grp * 128 + t]; const size_t rowo = (size_t)(t0 + t) * 4096;
#pragma unroll
        for (int ds = 0; ds < 2; ++ds) { const int d = grp * GDIM + (2 * wave + ds) * 16 + 4 * g;
            const v2u uw = *(const GAS v2u*)(UV + rowo + d);
            v2u o; o.x = cvt_pk_bf16(bf_lo(uw.x) * (acc[ds][tt][0] + bs), bf_hi(uw.x) * (acc[ds][tt][1] + bs)); o.y = cvt_pk_bf16(bf_lo(uw.y) * (acc[ds][tt][2] + bs), bf_hi(uw.y) * (acc[ds][tt][3] + bs));
            *(GAS v2u*)(YAB + (size_t)(t0 + t) * GWID + d) = o; } }
}

#ifndef KB_T
#define KB_T 4
#endif
constexpr int ATT_VB = 32 * 288, ATT_WAVE = ATT_VB + 512, ATT_BL = 8 * ATT_WAVE;
__device__ __forceinline__ void attn_query(LAS unsigned char* wl, const LAS float* BL, int lane, int b, int qpos,
                                           const bf16* Q, const bf16* KN, const bf16* V, const unsigned short* IDX, const float* qgain, bf16* YAB) {
    const int g = lane >> 4, hl = lane & 15, q4 = hl >> 2, p4 = lane & 3;
    const size_t rowb = (size_t)b * SEQ, row = rowb + qpos;
    const int cnt = qpos + 1 < TOPK ? qpos + 1 : TOPK;
    LAS unsigned short* IL = (LAS unsigned short*)(wl + ATT_VB);
    *(LAS v2u*)(IL + 4 * lane) = *(const GAS v2u*)(IDX + row * 256 + 4 * lane);
    bf16x8 qf[4];
    { v2u w[4]; float ss = 0.f;
#pragma unroll
      for (int kk = 0; kk < 4; ++kk) { w[kk] = *(const GAS v2u*)((const unsigned char*)Q + row * 2048 + hl * 128 + kk * 32 + g * 8); f32x4 a, c; unpack8_f8(w[kk], a, c);
          ss += (a[0] * a[0] + a[1] * a[1]) + (a[2] * a[2] + a[3] * a[3]) + (c[0] * c[0] + c[1] * c[1]) + (c[2] * c[2] + c[3] * c[3]); }
      ss += __shfl_xor(ss, 16); ss += __shfl_xor(ss, 32);
      const float rinv = (1.0f / sqrtf(ss * (1.0f / HDA) + EPS)) * 0.08838834764831845f;
#pragma unroll
      for (int kk = 0; kk < 4; ++kk) { f32x4 a, c; unpack8_f8(w[kk], a, c); const f32x4 g0 = *(const GAS f32x4*)(qgain + kk * 32 + g * 8), g1 = *(const GAS f32x4*)(qgain + kk * 32 + g * 8 + 4);
          const v4u o = pack8(a * rinv * g0, c * rinv * g1); qf[kk] = __builtin_bit_cast(bf16x8, o); } }
    f32x4 s[16];
#pragma unroll
    for (int hf = 0; hf < 16 / KB_T; ++hf) {
        bf16x8 kf[KB_T][4];
#pragma unroll
        for (int t8 = 0; t8 < KB_T; ++t8) { const int ki = IL[16 * (KB_T * hf + t8) + hl] & (SEQ - 1); const bf16* kp = KN + (rowb + ki) * 128 + g * 8;
#pragma unroll
            for (int kk = 0; kk < 4; ++kk) kf[t8][kk] = *(const GAS bf16x8*)(kp + kk * 32); }
        __builtin_amdgcn_sched_barrier(0);
#pragma unroll
        for (int t8 = 0; t8 < KB_T; ++t8) { const int t = KB_T * hf + t8; s[t] = (f32x4){0.f, 0.f, 0.f, 0.f};
#pragma unroll
            for (int kk = 0; kk < 4; ++kk) s[t] = __builtin_amdgcn_mfma_f32_16x16x32_bf16(kf[t8][kk], qf[kk], s[t], 0, 0, 0); }
    }
    float mx = -__builtin_inff();
#pragma unroll
    for (int t = 0; t < 16; ++t) { const v2u id = *(const LAS v2u*)(IL + 16 * t + 4 * g); const int kx[4] = {(int)(id.x & 0xffffu), (int)(id.x >> 16), (int)(id.y & 0xffffu), (int)(id.y >> 16)};
#pragma unroll
        for (int i = 0; i < 4; ++i) { int n = qpos - kx[i]; n = n < 0 ? 0 : (n > 128 ? 128 : n);
            const float v = (16 * t + 4 * g + i) < cnt ? s[t][i] + BL[n * 16 + hl] : -__builtin_inff(); s[t][i] = v; mx = fmaxf(mx, v); } }
    mx = fmaxf(mx, __shfl_xor(mx, 16)); mx = fmaxf(mx, __shfl_xor(mx, 32));
    float sum = 0.f;
#pragma unroll
    for (int t = 0; t < 16; ++t)
#pragma unroll
        for (int i = 0; i < 4; ++i) { const float e = __builtin_amdgcn_exp2f((s[t][i] - mx) * LOG2E); s[t][i] = e; sum += e; }
    sum += __shfl_xor(sum, 16); sum += __shfl_xor(sum, 32);
    const float inv = 1.0f / sum;
    bf16x8 pf[8];
#pragma unroll
    for (int T = 0; T < 8; ++T) { const v4u o = pack8(s[2 * T] * inv, s[2 * T + 1] * inv); pf[T] = __builtin_bit_cast(bf16x8, o); }
    f32x4 o[8];
#pragma unroll
    for (int dt = 0; dt < 8; ++dt) o[dt] = (f32x4){0.f, 0.f, 0.f, 0.f};
    v4u vn[8];
#pragma unroll
    for (int ins = 0; ins < 8; ++ins) { const int vi = IL[4 * ins + g] & (SEQ - 1); vn[ins] = *(const GAS v4u*)(V + (rowb + vi) * 128 + hl * 8); }
#pragma unroll
    for (int T = 0; T < 8; ++T) {
#pragma unroll
        for (int ins = 0; ins < 8; ++ins) *(LAS v4u*)(wl + (4 * ins + g) * 288 + hl * 16) = vn[ins];
        if (T < 7) {
#pragma unroll
            for (int ins = 0; ins < 8; ++ins) { const int vi = IL[32 * (T + 1) + 4 * ins + g] & (SEQ - 1); vn[ins] = *(const GAS v4u*)(V + (rowb + vi) * 128 + hl * 8); } }
        __builtin_amdgcn_sched_barrier(0);
#pragma unroll
        for (int dt = 0; dt < 8; ++dt) {
            const s16x4 a1 = __builtin_amdgcn_ds_read_tr16_b64_v4i16((LAS s16x4*)(wl + (4 * g + q4) * 288 + (16 * dt + 4 * p4) * 2));
            const s16x4 a2 = __builtin_amdgcn_ds_read_tr16_b64_v4i16((LAS s16x4*)(wl + (16 + 4 * g + q4) * 288 + (16 * dt + 4 * p4) * 2));
            const bf16x8 vf = (bf16x8){a1[0], a1[1], a1[2], a1[3], a2[0], a2[1], a2[2], a2[3]};
            o[dt] = __builtin_amdgcn_mfma_f32_16x16x32_bf16(vf, pf[T], o[dt], 0, 0, 0);
        }
    }
#pragma unroll
    for (int dt = 0; dt < 8; ++dt)
        *(GAS unsigned*)((unsigned char*)YAB + row * 2048 + hl * 128 + 16 * dt + 4 * g) = (unsigned)__builtin_amdgcn_cvt_pk_fp8_f32(o[dt][2], o[dt][3], __builtin_amdgcn_cvt_pk_fp8_f32(o[dt][0], o[dt][1], 0, false), true);
}

constexpr int NWAVES = 8;
#ifndef DUP_ATT
#define DUP_ATT 1
#endif
#ifndef DUP_SGU
#define DUP_SGU 1
#endif
#ifndef GEMM_SP2
#define GEMM_SP2 true
#endif
#ifndef GEMM_ALIGN
#define GEMM_ALIGN true
#endif
#ifndef MK_N_LAUNCHES
#define MK_N_LAUNCHES 1
#endif
constexpr int N_PHASES = 9;
constexpr int N_LAUNCHES = MK_N_LAUNCHES;
constexpr size_t WS_PB = WS_END;
constexpr size_t WS_NEED = WS_END + 8 * MiB;

__device__ __forceinline__ int lane_now() { int l; asm volatile("v_mbcnt_lo_u32_b32 %0, -1, 0\n\tv_mbcnt_hi_u32_b32 %0, -1, %0" : "=v"(l)); return l; }
struct Args { const float* in[22]; float* out; unsigned char* ws; int ph_lo, ph_hi, li, pad; };
enum { I_X = 0, I_P, I_WIN, I_QNG, I_KNG, I_RELB, I_LNG, I_LNB, I_SGUW, I_SGUB, I_WA, I_WB, I_WOUT, I_NMIX, I_NFFN, I_WG, I_WU, I_WD, I_WPLE, I_PLENG, I_WPG, I_NPLE };

__global__ void __launch_bounds__(NWAVES * 64, 2) fwd_kernel(Args args) {
    extern __shared__ __attribute__((aligned(16))) unsigned char lds_raw[];
    LAS unsigned char* lds = (LAS unsigned char*)lds_raw;
    volatile LAS unsigned* MISC = (volatile LAS unsigned*)(lds + MISC_OFF);
    const int wave = __builtin_amdgcn_readfirstlane(threadIdx.x >> 6);
#define PHASE_IDS() const int lane = lane_now(), tid = wave * 64 + lane
    const int G = gridDim.x, cu = blockIdx.x;
    const int gw = cu * NWAVES + wave, NGW = G * NWAVES;
    unsigned char* ws = args.ws;
    gu32* ctl = (gu32*)(ws + WS_CTL);
    for (int u = threadIdx.x; u < (LDS_BYTES - LDSCTL_OFF) / 4; u += NWAVES * 64) ((LAS unsigned*)(lds + LDSCTL_OFF))[u] = 0u;
    __syncthreads();
    { const unsigned t_ = threadIdx.x; volatile LAS float* sm_ = (volatile LAS float*)(lds + RING_OFF);
      const float* wi_ = args.in[I_WIN] + (size_t)(8 * t_) * INCOLS + 10656; const int ci_ = (int)((t_ * 37u) & 4095u);
      const float* wg_ = args.in[I_WG] + (size_t)(8 * t_) * DFF; const float* wu_ = args.in[I_WU] + (size_t)(8 * t_) * DFF; const int cg_ = (int)((t_ * 37u) % 5504u);
      const float* wo_ = args.in[I_WOUT] + (size_t)(8 * t_) * DM; const float* wp_ = args.in[I_WPG] + (size_t)(8 * t_) * DM; const float* wd_ = args.in[I_WD] + (size_t)(8 * t_) * DM;
      sm_[t_] = fabsf(wi_[ci_]) + fabsf(wi_[(ci_ + 2048) & 4095]); sm_[512 + t_] = fabsf(wg_[cg_]) + fabsf(wg_[cg_ + 5504]); sm_[1024 + t_] = fabsf(wu_[cg_]) + fabsf(wu_[cg_ + 5504]); sm_[1536 + t_] = fabsf(wo_[ci_]) + fabsf(wo_[(ci_ + 2048) & 4095]); sm_[2048 + t_] = fabsf(wp_[ci_]) + fabsf(wp_[(ci_ + 2048) & 4095]); sm_[2560 + t_] = fabsf(wd_[ci_]) + fabsf(wd_[(ci_ + 2048) & 4095]);
      __syncthreads();
      if (t_ < 48) { float a_ = 0.f; for (int i = 0; i < 64; ++i) a_ += sm_[(t_ >> 3) * 512 + (t_ & 7) * 64 + i]; sm_[3072 + t_] = a_; }
      __syncthreads();
      if (t_ == 0) { float s0_ = 0.f, s1_ = 0.f, s2_ = 0.f, s3_ = 0.f, s4_ = 0.f; float s5_ = 0.f; for (int i = 0; i < 8; ++i) { s0_ += sm_[3072 + i]; s1_ += sm_[3080 + i]; s2_ += sm_[3088 + i]; s3_ += sm_[3096 + i]; s4_ += sm_[3104 + i]; s5_ += sm_[3112 + i]; }
          MISC[22] = __float_as_uint(127.0f / (4.0f * 1.2533141f * fmaxf(s5_, 1e-30f) * (1.0f / 1024.0f)));
          MISC[20] = __float_as_uint(127.0f / (4.0f * 1.2533141f * fmaxf(s3_, 1e-30f) * (1.0f / 1024.0f))); MISC[21] = __float_as_uint(127.0f / (4.0f * 1.2533141f * fmaxf(s4_, 1e-30f) * (1.0f / 1024.0f)));
          int e_ = (int)rintf(__log2f(1.596f * 1024.0f / fmaxf(s0_, 1e-30f))); e_ = e_ < -40 ? -40 : (e_ > 60 ? 60 : e_); MISC[12] = (unsigned)e_;
          MISC[15] = __float_as_uint(127.0f / (4.0f * 1.2533141f * fmaxf(s0_, 1e-30f) * (1.0f / 1024.0f)));
          MISC[13] = __float_as_uint(127.0f / (4.0f * 1.2533141f * fmaxf(s1_, 1e-30f) * (1.0f / 1024.0f))); MISC[14] = __float_as_uint(127.0f / (4.0f * 1.2533141f * fmaxf(s2_, 1e-30f) * (1.0f / 1024.0f))); }
      __syncthreads(); }
    XcdBarrier bar; bar.bar = (unsigned*)(ctl + CW_BAR) + args.li * XCD_BAR_WORDS; bar.x = 0; bar.st = nullptr;
    if (N_LAUNCHES == 1) bar = xcd_barrier_post((unsigned*)(ctl + CW_BAR), MISC + 8);
#define GRID_BAR() do { if (N_LAUNCHES == 1) xcd_barrier(bar); } while (0)
    const int lo = args.ph_lo, hi = args.ph_hi;
#ifndef PH_MASK
#define PH_MASK 0x1ff
#endif
#define IN(k) ((((PH_MASK) >> (k)) & 1) && lo <= (k) && (k) < hi)
#define BOTH(k) (IN(k) && IN((k) + 1))
#ifndef DUP_MASK
#define DUP_MASK 0
#endif
#define REPS(k) (1 + (((DUP_MASK) >> (k)) & 1))

    bf16* const H = (bf16*)(ws + WS_H); bf16* const WINB = (bf16*)(ws + WS_WINB); unsigned char* const WIN8 = ws + WS_WIN8; unsigned char* const W4 = ws + WS_WIN8 + 57 * MiB; unsigned char* const H8 = ws + WS_H8; float* const FACH = (float*)(ws + WS_SSQ2);     unsigned char* const H4 = ws + WS_SGA + 64 * MiB;     bf16* const QIDX = (bf16*)(ws + WS_QIDX); bf16* const Qb = (bf16*)(ws + WS_Q);
    bf16* const UV = (bf16*)(ws + WS_UV); bf16* const SGA = (bf16*)(ws + WS_SGA); bf16* const SGB = (bf16*)(ws + WS_SGB);
    unsigned char* const WA8 = ws + WS_WAB; bf16* const WBB = (bf16*)(ws + WS_WAB + 8 * MiB);     bf16* const WOUT = (bf16*)(ws + WS_WOUT); bf16* const WGU = (bf16*)(ws + WS_WGU); bf16* const WD = (bf16*)(ws + WS_WD);
    bf16* const WPLE = (bf16*)(ws + WS_WPLE); bf16* const WPG = (bf16*)(ws + WS_WPG); bf16* const PB = (bf16*)(ws + WS_PB);
    unsigned short* const IDX = (unsigned short*)(ws + WS_IDX); float* const LNP = (float*)(ws + WS_LNP);
    float* const SSQ1 = (float*)(ws + WS_SSQ1); float* const SSQ2 = (float*)(ws + WS_SSQ2); float* const SSQP = (float*)(ws + WS_SSQP);
    float* const WIDX = (float*)(ws + WS_WIDX); bf16* const KIDX = (bf16*)(ws + WS_KIDX); bf16* const KN = (bf16*)(ws + WS_KN); bf16* const Vb = (bf16*)(ws + WS_V);
    float* const KRAW = (float*)(ws + WS_KRAW); bf16* const SGUW = (bf16*)(ws + WS_SGUW);
    float* const SC = (float*)(ws + WS_SC); bf16* const MERGED = (bf16*)(ws + WS_MERGED); unsigned char* const T8 = ws + WS_MERGED + 128 * MiB;     bf16* const ACT = (bf16*)(ws + WS_ACT); unsigned char* const ACT8 = ws + WS_ACT; unsigned char* const WD8 = ws + WS_Q;     bf16* const YB = (bf16*)(ws + WS_YAB); unsigned char* const YA8 = ws + WS_YAB + 64 * MiB;
    bf16* const X1R = (bf16*)(ws + WS_SGB); bf16* const X2R = (bf16*)(ws + WS_WGU);     bf16* const X1G = (bf16*)(ws + WS_X1G); bf16* const X2G = (bf16*)(ws + WS_X2G); bf16* const PE = (bf16*)(ws + WS_PE);


    constexpr int I_IN = 64 * (INCOLS / 32), I_A = 32 * 128, I_SQ = 64 * 128, I_G = 64 * (DFF / 32), I_D = (DFF / 64) * 128, I_PL = 4 * 128;
    constexpr int NITEMS = I_IN + 2 * I_A + I_SQ + I_PL + 2 * I_G + I_D + I_SQ;
    constexpr int TAIL_A = 15104, TAIL_B = 15104, TAIL_U = 22016;
    static_assert(TAIL_A + TAIL_B <= I_D + I_SQ && TAIL_U <= I_G, "deferred item ranges");
#define CONV_SRC(it_, r_) do { int r_ = (it_); const float* W_; int N_; \
        if (r_ < I_IN) { W_ = args.in[I_WIN]; N_ = INCOLS; } else { r_ -= I_IN; \
        if (r_ < I_A) { W_ = args.in[I_WA]; N_ = DM; } else { r_ -= I_A; \
        if (r_ < I_A) { W_ = args.in[I_WB]; N_ = DM; } else { r_ -= I_A; \
        if (r_ < I_SQ) { W_ = args.in[I_WOUT]; N_ = DM; } else { r_ -= I_SQ; \
        if (r_ < I_PL) { W_ = args.in[I_WPLE]; N_ = DM; } else { r_ -= I_PL; \
        if (r_ < I_G) { W_ = args.in[I_WG]; N_ = DFF; } else { r_ -= I_G; \
        if (r_ < I_G) { W_ = args.in[I_WU]; N_ = DFF; } else { r_ -= I_G; \
        if (r_ < I_D) { W_ = args.in[I_WD]; N_ = DM; } else { r_ -= I_D; W_ = args.in[I_WPG]; N_ = DM; } } } } } } } } \
        p0_load(W_, N_, r_, nx, lane); } while (0)
#define CONV_ITEMS(first_, last_, widx_, wstride_) do { LAS float* scr = (LAS float*)(lds + RING_OFF + wave * 16384); f32x4 nx[8], cr[8]; \
        const int i0_ = (first_) + (widx_), iend_ = (last_), ist_ = (wstride_); \
        if (i0_ < iend_) CONV_SRC(i0_, ra_); \
        for (int it = i0_; it < iend_; it += ist_) { \
            _Pragma("unroll") for (int i = 0; i < 8; ++i) cr[i] = nx[i]; \
            asm volatile("" ::: "memory"); \
            if (it + ist_ < iend_) CONV_SRC(it + ist_, rb_); \
            int r = it; \
            if (r < I_IN) { const int nb_ = r % (INCOLS / 32); if (nb_ >= 200 && nb_ < 205) p0_finish<1>(cr, INCOLS, WINB, DM, 0, scr, r, lane); else if (nb_ >= 333 && nb_ < 461) p0_finish4(cr, INCOLS, W4, __uint_as_float((unsigned)(127 + (int)MISC[12]) << 23), scr, r, lane); else p0_finish_i8<4>(cr, INCOLS, WIN8, DM, __uint_as_float(MISC[15]), scr, r, lane); continue; } r -= I_IN; \
            if (r < I_A) { p0_finish8<0>(cr, DM, WA8, 2048, scr, r, lane); continue; } r -= I_A; \
            if (r < I_A) { p0_finish<0>(cr, DM, WBB, 2048, 0, scr, r, lane); continue; } r -= I_A; \
            if (r < I_SQ) { p0_finish_i8h(cr, DM, (unsigned char*)WOUT, DM, __uint_as_float(MISC[20]), scr, r, lane); continue; } r -= I_SQ; \
            if (r < I_PL) { p0_finish<0>(cr, DM, WPLE, DPLE, 0, scr, r, lane); continue; } r -= I_PL; \
            if (r < I_G) { p0_finish_i8<2>(cr, DFF, (unsigned char*)WGU, DM, __uint_as_float(MISC[13]), scr, r, lane); continue; } r -= I_G; \
            if (r < I_G) { p0_finish_i8<3>(cr, DFF, (unsigned char*)WGU, DM, __uint_as_float(MISC[14]), scr, r, lane); continue; } r -= I_G; \
            if (r < I_D) { if (P7F < 64) p0_finish<0>(cr, DM, WD, DFF, 0, scr, r, lane); if (P7F > 0) p0_finish_i8h(cr, DM, WD8, DFF, __uint_as_float(MISC[22]), scr, r, lane); continue; } r -= I_D; \
            p0_finish_i8<0>(cr, DM, (unsigned char*)WPG, DM, __uint_as_float(MISC[21]), scr, r, lane); } } while (0)
#define CONV_TAIL(nwg_, first_, last_) do { const int rem_ = (nwg_) % G; if (rem_ == 0) CONV_ITEMS(first_, last_, gw, NGW); \
        else if (cu >= rem_) CONV_ITEMS(first_, last_, (cu - rem_) * NWAVES + wave, (G - rem_) * NWAVES); } while (0)
    if (IN(0)) {
#pragma unroll
      for (int rep = 0; rep < REPS(0); ++rep) {
        PHASE_IDS();
        CONV_ITEMS(0, NITEMS - TAIL_A - TAIL_B - TAIL_U, gw, NGW);
        for (int m = gw; m < MTOK; m += NGW) rms_row_to_bf16(args.in[I_X] + (size_t)m * DM, args.in[I_NMIX], H + (size_t)m * DM, H8 + (size_t)m * DM, H4 + (size_t)m * (DM / 2), FACH + m, lane);
        { const float* P = args.in[I_P]; const int gt = cu * 512 + tid, NT = G * 512;
          for (int i = gt; i < MTOK * DPLE / 4; i += NT) { const f32x4 v = *(const GAS f32x4*)(P + (size_t)i * 4); v2u w; w.x = cvt_pk_bf16(v.x, v.y); w.y = cvt_pk_bf16(v.z, v.w); *(GAS v2u*)(PB + (size_t)i * 4) = w; }
          const float* SW = args.in[I_SGUW];
          for (int i = gt; i < NGRP * CHK * CHK / 2; i += NT) { const int e = 2 * i, t = (e >> 7) & 127, s = e & 127; const f32x2 v = *(const GAS f32x2*)(SW + e);
              *(GAS unsigned*)(SGUW + e) = cvt_pk_bf16(s <= t ? v.x : 0.f, (s + 1) <= t ? v.y : 0.f); } }
        if (rep + 1 < REPS(0) || BOTH(0)) GRID_BAR();
      }
    }

    if (IN(1)) {
#pragma unroll
      for (int rep = 0; rep < REPS(1); ++rep) {
        PHASE_IDS();
        { pg8::Gemm g{(const bf16*)H4, (const bf16*)W4, MTOK, 16 * 256, DM / 4}; pg8::BlockOrder S; S.init(MTOK, 16 * 256, G, cu);
          pg8::EpiInProjT<2> E{Qb, Vb, QIDX, KIDX, UV, SGA, SGB, KRAW, WIDX, LNP, nullptr, 1.0f};
          pg8::gemm_phase<pg8::EpiInProjT<2>, pg8::BlockOrder, GEMM_ALIGN, GEMM_SP2, false, true>(lds + RING_OFF, g, S, E, tid, 127 - (int)MISC[12]); }
        { pg8::Gemm g{(const bf16*)H8, (const bf16*)WIN8, MTOK, 57 * 256, DM / 2}; pg8::BlockOrder S; S.init(MTOK, 57 * 256, G, cu);
          const float isw_ = __uint_as_float(__builtin_amdgcn_readfirstlane(__float_as_uint(1.0f / __uint_as_float(MISC[15]))));
          pg8::EpiInProjT<0> E{Qb, Vb, QIDX, KIDX, UV, SGA, SGB, KRAW, WIDX, LNP, FACH, isw_};
          pg8::gemm_phase<pg8::EpiInProjT<0>, pg8::BlockOrder, GEMM_ALIGN, GEMM_SP2, false, false, true>(lds + RING_OFF, g, S, E, tid); }
        { pg8::Gemm g{H, WINB, MTOK, 1 * 256, DM}; pg8::BlockOrder S; S.init(MTOK, 1 * 256, G, G - 1 - cu);
          pg8::EpiInProjT<1> E{Qb, Vb, QIDX, KIDX, UV, SGA, SGB, KRAW, WIDX, LNP, nullptr, 1.0f};
          pg8::gemm_phase<pg8::EpiInProjT<1>, pg8::BlockOrder, GEMM_ALIGN, GEMM_SP2>(lds + RING_OFF, g, S, E, tid); }
        if (rep == 0) { const int rem_ = ((MTOK / 256) * 1) % G;
            if (rem_ == 0) CONV_ITEMS(NITEMS - TAIL_A - TAIL_B - TAIL_U, NITEMS - TAIL_A - TAIL_B, gw, NGW);
            else if (G - 1 - cu >= rem_) CONV_ITEMS(NITEMS - TAIL_A - TAIL_B - TAIL_U, NITEMS - TAIL_A - TAIL_B, (G - 1 - cu - rem_) * NWAVES + wave, (G - rem_) * NWAVES); }
        if (rep + 1 < REPS(1) || BOTH(1)) GRID_BAR();
      }
    }

#if defined(NULL_GEMM)
    if (IN(1)) { PHASE_IDS();
        pg8::Gemm g{H, WIN, MTOK, NULL_GEMM * 256, DM}; pg8::BlockOrder S; S.init(MTOK, NULL_GEMM * 256, G, cu);
        pg8::EpiNull E{SSQP};
        pg8::gemm_phase<pg8::EpiNull, pg8::BlockOrder, GEMM_ALIGN, GEMM_SP2>(lds + RING_OFF, g, S, E, tid);
        GRID_BAR(); }
#endif
    if (IN(2)) {
#pragma unroll
      for (int rep = 0; rep < REPS(2); ++rep) {
        PHASE_IDS();
        { const float* kg = args.in[I_KNG];
          for (int rp = gw; rp < MTOK / 2; rp += NGW) { const int row = 2 * rp + (lane >> 5), c = (lane & 31) * 4;
              const f32x4 v = *(const GAS f32x4*)(KRAW + (size_t)row * 128 + c); float ss = (v.x * v.x + v.y * v.y) + (v.z * v.z + v.w * v.w);
#pragma unroll
              for (int o = 1; o < 32; o <<= 1) ss += __shfl_xor(ss, o);
              const float r = 1.0f / sqrtf(ss * (1.0f / HDA) + EPS); const f32x4 gv = *(const GAS f32x4*)(kg + c);
              v2u w; w.x = cvt_pk_bf16(v.x * r * gv.x, v.y * r * gv.y); w.y = cvt_pk_bf16(v.z * r * gv.z, v.w * r * gv.w); *(GAS v2u*)(KN + (size_t)row * 128 + c) = w; } }
        for (int i = tid; i < 8 * TOPK_WAVE_LDS / 16; i += NWAVES * 64) *(LAS v4u*)(lds + RING_OFF + 69632 + i * 16) = (v4u){0u, 0u, 0u, 0u};
        constexpr int NU = NB * (SEQ / 32);
        for (int j = cu; j < NU; j += G) { const int rnd = j / G, pos = j % G; int u;
            if ((rnd & 1) == 0) u = j; else { const int hiu = (rnd + 1) * G < NU ? (rnd + 1) * G : NU; u = hiu - 1 - pos; if (u < rnd * G) continue; }
            indexer_unit(lds + RING_OFF, tid, wave, lane, u % NB, u / NB, QIDX, KIDX, WIDX, SC, IDX); }
        if (rep + 1 < REPS(2) || BOTH(2)) GRID_BAR();
      }
    }

    if (IN(3)) {
#pragma unroll
      for (int rep = 0; rep < REPS(3); ++rep) {
        PHASE_IDS();
        for (int rr = 0; rr < DUP_SGU; ++rr)
        for (int u = cu; u < (MTOK / CHK) * NGRP; u += G) sgu_unit(lds + RING_OFF, tid, wave, lane, u >> 3, u & 7, UV, LNP, SGUW, args.in[I_LNG], args.in[I_LNB], args.in[I_SGUB], YB);
        __syncthreads();
        LAS float* BL = (LAS float*)(lds + RING_OFF + ATT_BL);
        { const float* rb = args.in[I_RELB];
          for (int i = tid; i < 129 * 16; i += NWAVES * 64) { const int n = i >> 4, h = i & 15; int bk;
              if (n < 16) bk = n; else { bk = 16 + (int)(logf((float)n * (1.0f / 16.0f)) / 2.0794415416798357f * 16.0f); bk = bk > 31 ? 31 : bk; }
              BL[i] = rb[bk * 16 + h]; } }
        __syncthreads();
        for (int rr = 0; rr < DUP_ATT; ++rr)
        for (int qi = gw; qi < MTOK; qi += NGW) attn_query(lds + RING_OFF + wave * ATT_WAVE, BL, lane, qi / SEQ, qi % SEQ, Qb, KN, Vb, IDX, args.in[I_QNG], (bf16*)YA8);
        if (rep + 1 < REPS(3) || BOTH(3)) GRID_BAR();
      }
    }

#if defined(IDLE_US)
    { const unsigned long long t0 = __builtin_amdgcn_s_memrealtime(); while (__builtin_amdgcn_s_memrealtime() - t0 < (unsigned long long)(IDLE_US) * 100ull) __builtin_amdgcn_s_sleep(32); }
#endif
    if (IN(4)) {
#pragma unroll
      for (int rep = 0; rep < REPS(4); ++rep) {
        PHASE_IDS();
        { pg8::Gemm g{(const bf16*)YA8, (const bf16*)WA8, MTOK, DM, GWID / 2}; pg8::BlockOrder S; S.init(MTOK, DM, G, cu);
          pg8::EpiPlain E{(bf16*)T8};
          pg8::gemm_phase<pg8::EpiPlain, pg8::BlockOrder, GEMM_ALIGN, GEMM_SP2, true>(lds + RING_OFF, g, S, E, tid); }
        { pg8::Gemm g{YB, WBB, MTOK, DM, GWID}; pg8::BlockOrder S; S.init(MTOK, DM, G, cu);
          pg8::EpiMerge E{SGA, SGB, (const bf16*)T8, MERGED};
          pg8::gemm_phase<pg8::EpiMerge, pg8::BlockOrder, GEMM_ALIGN, GEMM_SP2>(lds + RING_OFF, g, S, E, tid); }
        if (rep + 1 < REPS(4) || BOTH(4)) GRID_BAR();
      }
    }

    if (IN(5)) {
#pragma unroll
      for (int rep = 0; rep < REPS(5); ++rep) {
        PHASE_IDS();
        unsigned char* wsl = args.ws; asm volatile("" : "+s"(wsl));
        unsigned char* const MQ = wsl + WS_MERGED + 128 * MiB; float* const FACM = (float*)(wsl + WS_LNP + 1 * MiB);
        for (int m = gw; m < MTOK; m += NGW) quant_row_i8<false, false, true>(MERGED + (size_t)m * DM, nullptr, MQ + (size_t)m * DM, FACM + m, lane, 4.25f);
        GRID_BAR();
        { pg8::Gemm g{(const bf16*)MQ, WOUT, MTOK, DM, DM / 2}; pg8::BlockOrder S; S.init(MTOK, DM, G, cu);
          const float iso_ = __uint_as_float(__builtin_amdgcn_readfirstlane(__float_as_uint(1.0f / __uint_as_float(MISC[20]))));
          pg8::EpiResid E{args.in[I_X], X1R, nullptr, args.in[I_NFFN], SSQ1, FACM, iso_};
          pg8::gemm_phase<pg8::EpiResid, pg8::BlockOrder, GEMM_ALIGN, GEMM_SP2, false, false, true>(lds + RING_OFF, g, S, E, tid); }
        { pg8::Gemm g{PB, WPLE, MTOK, DM, DPLE}; pg8::BlockOrder S; S.init(MTOK, DM, G, cu);
          pg8::EpiPe E{PE, SSQP};
          pg8::gemm_phase<pg8::EpiPe, pg8::BlockOrder, GEMM_ALIGN, GEMM_SP2>(lds + RING_OFF, g, S, E, tid); }
        if (rep + 1 < REPS(5) || BOTH(5)) GRID_BAR();
      }
    }

    if (IN(6)) {
#pragma unroll
      for (int rep = 0; rep < REPS(6); ++rep) {
        PHASE_IDS();
        if (rep == 0) { CONV_ITEMS(NITEMS - TAIL_A - TAIL_B, NITEMS - TAIL_B, gw, NGW); __syncthreads(); }
        unsigned char* wsl = args.ws; asm volatile("" : "+s"(wsl));
        const float sgu_ = (127.0f / (4.0f * __uint_as_float(MISC[13]))) * (127.0f / (4.0f * __uint_as_float(MISC[14])));
        float* const FACA = (float*)(wsl + WS_LNP + 3 * MiB);
        unsigned char* const X1Q = wsl + WS_WAB; float* const FAC1 = (float*)(wsl + WS_LNP);
        for (int m = gw; m < MTOK; m += NGW) quant_row_i8<true, true>(X1R + (size_t)m * DM, args.in[I_NFFN], X1Q + (size_t)m * DM, FAC1 + m, lane, 4.0f, FACA + m, sgu_);
        GRID_BAR();
        pg8::Gemm g{(const bf16*)X1Q, WGU, MTOK, 2 * DFF, DM / 2}; pg8::BlockOrder S; S.init(MTOK, 2 * DFF, G, cu);
        const float isg_ = __uint_as_float(__builtin_amdgcn_readfirstlane(__float_as_uint(1.0f / __uint_as_float(MISC[13])))), isu_ = __uint_as_float(__builtin_amdgcn_readfirstlane(__float_as_uint(1.0f / __uint_as_float(MISC[14]))));
        pg8::EpiGateUpQ E{FAC1, isg_, isu_, ACT, ACT8, P7F, FACA};
        pg8::gemm_phase<pg8::EpiGateUpQ, pg8::BlockOrder, GEMM_ALIGN, GEMM_SP2, false, false, true>(lds + RING_OFF, g, S, E, tid);
        if (rep == 0) CONV_TAIL((MTOK / 256) * (2 * DFF / 256), NITEMS - TAIL_B, NITEMS);
        if (rep + 1 < REPS(6) || BOTH(6)) GRID_BAR();
      }
    }

    if (IN(7)) {
#pragma unroll
      for (int rep = 0; rep < REPS(7); ++rep) {
        PHASE_IDS();
        if (P7F > 0) { pg8::Gemm g{(const bf16*)ACT8, (const bf16*)WD8, P7F * 256, DM, DFF / 2}; pg8::BlockOrder S; S.init(P7F * 256, DM, G, cu); { int rm_ = S.rmain; asm volatile("" : "+v"(rm_)); S.rmain = __builtin_amdgcn_readfirstlane(rm_); }
          const float isd_ = __uint_as_float(__builtin_amdgcn_readfirstlane(__float_as_uint(1.0f / __uint_as_float(MISC[22]))));
          pg8::EpiResidQ E{X1R, X2R, nullptr, args.in[I_NPLE], SSQ2, (const float*)(args.ws + WS_LNP + 3 * MiB), isd_};
          pg8::gemm_phase<pg8::EpiResidQ, pg8::BlockOrder, GEMM_ALIGN, GEMM_SP2, false, false, true>(lds + RING_OFF, g, S, E, tid); }
        if (P7F < 64) { pg8::Gemm g{ACT + (size_t)P7F * 256 * DFF, WD, MTOK - P7F * 256, DM, DFF}; pg8::BlockOrder S; S.init(MTOK - P7F * 256, DM, G, cu); { int rm_ = S.rmain; asm volatile("" : "+v"(rm_)); S.rmain = __builtin_amdgcn_readfirstlane(rm_); }
          constexpr size_t R0 = (size_t)P7F * 256;
          pg8::EpiResidB E{X1R + R0 * 4096, X2R + R0 * 4096, nullptr, args.in[I_NPLE], SSQ2 + R0 * 4, nullptr, 1.0f};
          pg8::gemm_phase<pg8::EpiResidB, pg8::BlockOrder, GEMM_ALIGN, GEMM_SP2>(lds + RING_OFF, g, S, E, tid); }
        if (rep + 1 < REPS(7) || BOTH(7)) GRID_BAR();
      }
    }

    if (IN(8)) {
        PHASE_IDS();
        unsigned char* wsl = args.ws; asm volatile("" : "+s"(wsl));
        unsigned char* const X2Q = wsl + WS_X2G; float* const FAC2 = (float*)(wsl + WS_LNP + 2 * MiB);
        for (int m = gw; m < MTOK; m += NGW) quant_row_i8<true, true>(X2R + (size_t)m * DM, args.in[I_NPLE], X2Q + (size_t)m * DM, FAC2 + m, lane);
        GRID_BAR();
        pg8::Gemm g{(const bf16*)X2Q, WPG, MTOK, DM, DM / 2}; pg8::BlockOrder S; S.init(MTOK, DM, G, cu);
        const float isp_ = __uint_as_float(__builtin_amdgcn_readfirstlane(__float_as_uint(1.0f / __uint_as_float(MISC[21]))));
        pg8::EpiFinal E{FAC2, SSQP, args.in[I_PLENG], PE, X2R, args.out, isp_};
        pg8::gemm_phase<pg8::EpiFinal, pg8::BlockOrder, GEMM_ALIGN, GEMM_SP2, false, false, true>(lds + RING_OFF, g, S, E, tid);
    }

#if defined(DUMP_AFTER)
    if (lo == N_PHASES) {
        const size_t gt = (size_t)cu * 512 + threadIdx.x, NT = (size_t)G * 512;
        for (size_t i = gt; i < (size_t)MTOK * DM; i += NT) { const size_t m = i >> 12; const int c = (int)(i & 4095); float v = 0.f;
#if DUMP_AFTER == 3
            v = bf_lo((unsigned)YB[i >> 1]);
#elif DUMP_AFTER == 2
            v = c < 256 ? (float)IDX[m * 256 + c] : (c < 384 ? bf_lo((unsigned)KN[m * 128 + c - 256]) : 0.f);
#elif DUMP_AFTER == 1
#if DUMP_SEL == 0
            v = bf_lo((unsigned)QIDX[i]);
#elif DUMP_SEL == 1
            v = bf_lo((unsigned)UV[i]);
#elif DUMP_SEL == 2
            v = bf_lo((unsigned)SGA[i]) + bf_lo((unsigned)SGB[i]);
#elif DUMP_SEL == 3
            v = bf_lo((unsigned)Qb[m * 2048 + (c & 2047)]);
            if (c < 128) v += KRAW[m * 128 + c] + bf_lo((unsigned)Vb[m * 128 + c]) + bf_lo((unsigned)KIDX[m * 128 + c]);
            if (c < 32) v += WIDX[m * 32 + c];
#endif
#elif DUMP_AFTER == 0
            v = bf_lo((unsigned)H[i]) + bf_lo((unsigned)WIN[i]) + bf_lo((unsigned)WIN[(size_t)(INPAD - 4096) * DM + i]) + bf_lo((unsigned)WGU[i]) + bf_lo((unsigned)WD[i]) + bf_lo((unsigned)WAB[i]);
#endif
            args.out[i] = v; }
    }
#endif
#undef IN
#undef BOTH
#undef GRID_BAR
}

extern "C" void kernel_launch(void* const* d_in, const int* in_sizes, int n_in, void* d_out, int out_size, void* d_ws, size_t ws_size, hipStream_t stream) {
    static int grid = 0;
    if (grid == 0) {
        if (n_in != 22 || in_sizes[0] != MTOK * DM || out_size != MTOK * DM || ws_size < WS_NEED) {
            fprintf(stderr, "kernel_launch: unexpected problem (n_in %d, in0 %d, out %d, ws %zu, need %zu); nothing launched\n", n_in, n_in > 0 ? in_sizes[0] : -1, out_size, ws_size, (size_t)WS_NEED); grid = -1; return; }
        int dev = 0, cus = 0, per_cu = 0;
        if (hipGetDevice(&dev) != hipSuccess || hipDeviceGetAttribute(&cus, hipDeviceAttributeMultiprocessorCount, dev) != hipSuccess) { grid = -1; return; }
        if (hipFuncSetAttribute((const void*)fwd_kernel, hipFuncAttributeMaxDynamicSharedMemorySize, LDS_BYTES) != hipSuccess) { fprintf(stderr, "kernel_launch: hipFuncSetAttribute failed\n"); grid = -1; return; }
        if (hipOccupancyMaxActiveBlocksPerMultiprocessor(&per_cu, (const void*)fwd_kernel, NWAVES * 64, LDS_BYTES) != hipSuccess || per_cu < 1)
            fprintf(stderr, "kernel_launch: note: occupancy query reports %d workgroups per CU\n", per_cu);
        (void)hipGetLastError();
        grid = cus;
    }
    if (grid < 0) return;
    if (hipMemsetAsync((char*)d_ws + WS_CTL, 0, CTL_ZERO_BYTES, stream) != hipSuccess) return;
    Args a{};
    for (int i = 0; i < 22; ++i) a.in[i] = (const float*)d_in[i];
    a.out = (float*)d_out; a.ws = (unsigned char*)d_ws;
#if defined(DUMP_AFTER)
    for (int li = 0; li <= DUMP_AFTER + 1; ++li) {
        a.ph_lo = li <= DUMP_AFTER ? li : N_PHASES; a.ph_hi = a.ph_lo + 1; a.li = 0;
#else
    for (int li = 0; li < N_LAUNCHES; ++li) {
        a.ph_lo = (N_LAUNCHES == 1) ? 0 : li; a.ph_hi = (N_LAUNCHES == 1) ? N_PHASES : li + 1; a.li = (N_LAUNCHES == 1) ? 0 : 0;
#endif
        hipLaunchKernelGGL(fwd_kernel, dim3(grid), dim3(NWAVES * 64), LDS_BYTES, stream, a);
        const hipError_t le = hipPeekAtLastError();
        if (le != hipSuccess) { fprintf(stderr, "kernel_launch: launch %d failed: %s\n", li, hipGetErrorName(le)); break; }
    }
}
```

```cpp
#include <hip/hip_runtime.h>
#include <cstdio>
#include <cstdint>

#define GAS __attribute__((address_space(1)))
#define LAS __attribute__((address_space(3)))
typedef unsigned short bf16;
typedef unsigned v4u __attribute__((ext_vector_type(4)));
typedef unsigned v2u __attribute__((ext_vector_type(2)));
typedef float f32x4 __attribute__((ext_vector_type(4)));
typedef float f32x2 __attribute__((ext_vector_type(2)));
typedef float f32x16 __attribute__((ext_vector_type(16)));
typedef short bf16x8 __attribute__((ext_vector_type(8)));
typedef short s16x4 __attribute__((ext_vector_type(4)));
typedef GAS unsigned gu32;

constexpr int NB = 4, SEQ = 4096, DM = 4096, MTOK = NB * SEQ;
constexpr int NHA = 16, HDA = 128, NIH = 32, IDXD = 128, TOPK = 256;
constexpr int GWID = 2048, NGRP = 8, GDIM = 256, CHK = 128;
constexpr int DFF = 11008, DPLE = 256;
constexpr int INCOLS = 18848, INPAD = 18944;
constexpr float EPS = 1e-6f;
constexpr float LOG2E = 1.4426950408889634f;

constexpr size_t MiB = 1u << 20;
constexpr size_t WS_CTL = 0, CTL_ZERO_BYTES = 1 * MiB;
constexpr size_t WS_IDX = 1 * MiB;
constexpr size_t WS_LNP = 9 * MiB;
constexpr size_t WS_SSQ1 = 13 * MiB;
constexpr size_t WS_SSQ2 = 17 * MiB;
constexpr size_t WS_SSQP = 21 * MiB;
constexpr size_t WS_WIDX = 25 * MiB;
constexpr size_t WS_KIDX = 27 * MiB;
constexpr size_t WS_KN = 31 * MiB;
constexpr size_t WS_V = 35 * MiB;
constexpr size_t WS_KRAW = 39 * MiB;
constexpr size_t WS_SGUW = 47 * MiB;
constexpr size_t WS_H = 48 * MiB;
constexpr size_t WS_WIN = 176 * MiB;
constexpr size_t WS_QIDX = 324 * MiB;
constexpr size_t WS_Q = 452 * MiB;
constexpr size_t WS_UV = 516 * MiB;
constexpr size_t WS_SGA = 644 * MiB;
constexpr size_t WS_SGB = 772 * MiB;
constexpr size_t WS_WAB = 900 * MiB;
constexpr size_t WS_WOUT = 932 * MiB;
constexpr size_t WS_WGU = 964 * MiB;
constexpr size_t WS_WD = 1136 * MiB;
constexpr size_t WS_WPLE = 1222 * MiB;
constexpr size_t WS_WPG = 1224 * MiB;
constexpr size_t WS_END = 1256 * MiB;
constexpr size_t WS_WINB = WS_WIN, WS_WIN8 = WS_WIN + 66 * MiB;
constexpr size_t WS_H8 = WS_WD;
constexpr size_t WS_SC = WS_H, WS_MERGED = WS_H, WS_ACT = WS_H, WS_YAB = WS_QIDX, WS_X1G = WS_UV, WS_X2G = WS_UV, WS_PE = WS_SGA;
static_assert(WS_SC + (size_t)MTOK * SEQ * 4 <= WS_QIDX && WS_ACT + (size_t)MTOK * DFF * 2 <= WS_Q && WS_WIN + (size_t)INPAD * DM * 2 <= WS_QIDX && WS_WD + (size_t)DM * DFF * 2 <= WS_WPLE, "ws map");

constexpr int CW_TMO = 0, CW_CODE = 1, CW_BAR = 4096;

constexpr int RING_OFF = 0, RING_BYTES = 131072;
constexpr int LDSCTL_OFF = RING_BYTES, MISC_OFF = LDSCTL_OFF + 320;
constexpr int LDS_BYTES = 147456;
static_assert(MISC_OFF + 128 <= LDS_BYTES, "LDS map");

#define RLX_AGENT __ATOMIC_RELAXED, __HIP_MEMORY_SCOPE_AGENT
#define LDS_WAIT() asm volatile("s_waitcnt lgkmcnt(0)" ::: "memory")
#define VM_WAIT() asm volatile("s_waitcnt vmcnt(0)" ::: "memory")

typedef __bf16 bf16v2_t __attribute__((ext_vector_type(2)));
__device__ __forceinline__ unsigned cvt_pk_bf16(float lo, float hi) { const f32x2 v = {lo, hi}; const bf16v2_t b = __builtin_convertvector(v, bf16v2_t); return __builtin_bit_cast(unsigned, b); }
__device__ __forceinline__ float bf_lo(unsigned w) { return __uint_as_float(w << 16); }
__device__ __forceinline__ float bf_hi(unsigned w) { return __uint_as_float(w & 0xffff0000u); }
__device__ __forceinline__ float fast_sigmoid(float x) { return __builtin_amdgcn_rcpf(1.0f + __builtin_amdgcn_exp2f(-LOG2E * x)); }
__device__ __forceinline__ float gelu_tanh(float x) { const float t = x * (1.0f + 0.044715f * x * x); return x * __builtin_amdgcn_rcpf(1.0f + __builtin_amdgcn_exp2f(-2.302208198f * t)); }
__device__ __forceinline__ float wave_sum(float v) {
#pragma unroll
    for (int o = 1; o < 64; o <<= 1) v += __shfl_xor(v, o);
    return v;
}
#ifndef MCLR
#define MCLR 0
#endif
#ifndef ACT_CLIP
#define ACT_CLIP 3.0f
#endif
#ifndef P7F
#define P7F 64
#endif
__device__ __forceinline__ float rnd_sm(float x) { if (MCLR == 0) return x; unsigned u = __float_as_uint(x); u += ((1u << (15 + MCLR)) - 1u) + ((u >> (16 + MCLR)) & 1u); u &= ~((1u << (16 + MCLR)) - 1u); return __uint_as_float(u); }
__device__ __forceinline__ f32x4 rnd_sm4(f32x4 v) { return (f32x4){rnd_sm(v[0]), rnd_sm(v[1]), rnd_sm(v[2]), rnd_sm(v[3])}; }
__device__ __forceinline__ v4u pack8(f32x4 a, f32x4 b) { v4u w; w.x = cvt_pk_bf16(a[0], a[1]); w.y = cvt_pk_bf16(a[2], a[3]); w.z = cvt_pk_bf16(b[0], b[1]); w.w = cvt_pk_bf16(b[2], b[3]); return w; }
__device__ __forceinline__ void unpack8(v4u w, f32x4& a, f32x4& b) { a = (f32x4){bf_lo(w.x), bf_hi(w.x), bf_lo(w.y), bf_hi(w.y)}; b = (f32x4){bf_lo(w.z), bf_hi(w.z), bf_lo(w.w), bf_hi(w.w)}; }

__device__ __forceinline__ unsigned e2m1(float x) { const float a = fminf(fabsf(x), 6.0f);
    const float c = a < 2.0f ? rintf(2.0f * a) : (a < 4.0f ? 2.0f + rintf(a) : 4.0f + rintf(0.5f * a));
    return (unsigned)c | ((__float_as_uint(x) >> 28) & 8u); }
__device__ __forceinline__ unsigned pack4_f4(float a, float b, float c, float d) { return e2m1(a) | (e2m1(b) << 4) | (e2m1(c) << 8) | (e2m1(d) << 12); }
__device__ __forceinline__ unsigned q8(float x) { const float r = fminf(fmaxf(rintf(x), -127.0f), 127.0f); return (unsigned)(int)r & 255u; }
__device__ __forceinline__ v2u pack8_i8(f32x4 a, f32x4 b) { v2u w; w.x = q8(a[0]) | (q8(a[1]) << 8) | (q8(a[2]) << 16) | (q8(a[3]) << 24); w.y = q8(b[0]) | (q8(b[1]) << 8) | (q8(b[2]) << 16) | (q8(b[3]) << 24); return w; }
__device__ __forceinline__ v2u pack8_f8(f32x4 a, f32x4 b) { v2u w; w.x = (unsigned)__builtin_amdgcn_cvt_pk_fp8_f32(a[2], a[3], __builtin_amdgcn_cvt_pk_fp8_f32(a[0], a[1], 0, false), true);
    w.y = (unsigned)__builtin_amdgcn_cvt_pk_fp8_f32(b[2], b[3], __builtin_amdgcn_cvt_pk_fp8_f32(b[0], b[1], 0, false), true); return w; }
__device__ __forceinline__ void unpack8_f8(v2u w, f32x4& a, f32x4& b) { const f32x2 a0 = __builtin_amdgcn_cvt_pk_f32_fp8((int)w.x, false), a1 = __builtin_amdgcn_cvt_pk_f32_fp8((int)w.x, true), b0 = __builtin_amdgcn_cvt_pk_f32_fp8((int)w.y, false), b1 = __builtin_amdgcn_cvt_pk_f32_fp8((int)w.y, true);
    a = (f32x4){a0[0], a0[1], a1[0], a1[1]}; b = (f32x4){b0[0], b0[1], b1[0], b1[1]}; }

namespace pg8 {
#define PG8_LAS __attribute__((address_space(3)))
typedef unsigned short bf16_t;
typedef unsigned u32x4 __attribute__((ext_vector_type(4)));
constexpr int BM = 256, BK = 64, HALF = 128, HTB = HALF * BK * 2, STAGE_BYTES = 8 * HTB, NXCD = 8, WGM = 4;

__host__ __device__ __forceinline__ int lds_byte(int r, int c) { const int st = (r >> 4) * 2 + (c >> 5), rr = r & 15, cc = c & 31, ob = rr * 64 + cc * 2; return st * 1024 + (ob ^ (((ob >> 9) & 1) << 5)); }
__host__ __device__ __forceinline__ void stage_rc(int b, int& R, int& C) { const int st = b / 1024, sb = b % 1024, swz = sb ^ (((sb >> 9) & 1) << 5); R = (st >> 1) * 16 + swz / 64; C = (st & 1) * 32 + (swz % 64) / 2; }
__host__ __device__ __forceinline__ int perm32(int rho) { const int n = rho >> 4, i = rho & 15; return 8 * (i >> 2) + 4 * n + (i & 3); }

struct Unit { int pm, pn; };
struct Gemm { const bf16_t* A; const bf16_t* Bt; int M, N, K; };

struct StaticOrder {
    int nM, nN, nwg, G, c;
    __host__ __device__ __forceinline__ void init(int M, int N, int G_, int c_) { nM = M / BM; nN = N / BM; nwg = nM * nN; G = G_; c = c_; }
    __host__ __device__ __forceinline__ bool next(int i, Unit& u) const {
        const long L = (long)i * G + c; if (L >= nwg) return false;
        int wgid = (int)L; { const int q = nwg / NXCD, r = nwg % NXCD, xcd = wgid % NXCD, off = wgid / NXCD; wgid = (xcd < r ? xcd * (q + 1) : r * (q + 1) + (xcd - r) * q) + off; }
        const int nig = WGM * nN, gid = wgid / nig, fm = gid * WGM, gsz = (nM - fm) < WGM ? (nM - fm) : WGM;
        u.pm = fm + ((wgid % nig) % gsz); u.pn = (wgid % nig) / gsz; return true;
    }
    __device__ __forceinline__ void a_ready(const Unit&) const {}
    __device__ __forceinline__ void done(const Unit&) const {}
};

struct BlockOrder {
    StaticOrder so; int nM, nN, nNm, rmain, G, c; bool blocked;
    __host__ __device__ __forceinline__ void init(int M, int N, int G_, int c_) { nM = M / BM; nN = N / BM; G = G_; c = c_; blocked = (G_ == 256) && (nM % 16 == 0) && (nN >= 16);
        nNm = blocked ? (nN / 16) * 16 : 0; rmain = blocked ? (nM / 16) * (nNm / 16) : 0; so.init(M, (nN - nNm) * BM, G_, c_); }
    __host__ __device__ __forceinline__ bool next(int i, Unit& u) const {
        if (i < rmain) { const int nsr = nM / 16, sc = i / nsr, s0 = i % nsr, sr = (sc & 1) ? nsr - 1 - s0 : s0, x = c & 7, j = c >> 3;
            u.pm = 16 * sr + 4 * (x >> 1) + (j & 3); u.pn = 16 * sc + 8 * (x & 1) + (j >> 2); return true; }
        if (nN == nNm) return false;
        if (!so.next(i - rmain, u)) return false;
        u.pn += nNm; return true;
    }
    __device__ __forceinline__ void a_ready(const Unit&) const {}
    __device__ __forceinline__ void done(const Unit&) const {}
};

typedef f32x4 Acc[2][2][4][2];

__device__ __forceinline__ float row_total64(const float* tab, int row, int fq) {
    const float* p = tab + ((size_t)(fq * 4) * MTOK + row) * 4;
    const f32x4 a = *(const f32x4*)p, b = *(const f32x4*)(p + (size_t)MTOK * 4), c = *(const f32x4*)(p + (size_t)MTOK * 8), d = *(const f32x4*)(p + (size_t)MTOK * 12);
    float s = ((a[0] + a[1]) + (a[2] + a[3])) + ((b[0] + b[1]) + (b[2] + b[3])) + ((c[0] + c[1]) + (c[2] + c[3])) + ((d[0] + d[1]) + (d[2] + d[3]));
    s += __shfl_xor(s, 16); s += __shfl_xor(s, 32); return s;
}

template <int VAR> struct EpiInProjT {
    static constexpr bool PERM = true, AFTER_DRAIN = false, HAS_MID = false;
    bf16_t *Q, *V, *QIDX, *KIDX, *UV, *SGA, *SGB; float *KRAW, *WIDX, *LNP; const float* FACH; float isw;
    __device__ __forceinline__ float rowf(size_t r) const { if constexpr (VAR == 0) return FACH[r] * isw; else return 1.0f; }
    __device__ __forceinline__ void mid(Acc&, const Unit&, int, int, int, int) const {}
    template <int ACT> __device__ __forceinline__ void plain(const Acc& acc, bf16_t* O, int ldc, int colt, int row0, int cl, bool f8, const float (&rfs)[8]) const {
#pragma unroll
        for (int ai = 0; ai < 2; ++ai)
#pragma unroll
            for (int m = 0; m < 4; ++m) { const float rf = rfs[ai * 4 + m]; const size_t eo = (size_t)(row0 + ai * HALF + m * 16) * ldc + colt + cl; bf16_t* rowp = O + eo; unsigned char* rowp8 = (unsigned char*)O + eo;
#pragma unroll
                for (int bj = 0; bj < 2; ++bj) { f32x4 v0 = acc[ai][bj][m][0] * rf, v1 = acc[ai][bj][m][1] * rf;
                    if (ACT == 1) {
#pragma unroll
                        for (int j = 0; j < 4; ++j) { v0[j] = gelu_tanh(v0[j]); v1[j] = gelu_tanh(v1[j]); } }
                    if (ACT == 2) {
#pragma unroll
                        for (int j = 0; j < 4; ++j) { v0[j] = fast_sigmoid(v0[j]); v1[j] = fast_sigmoid(v1[j]); } }
                    if (f8) *(v2u*)(rowp8 + bj * HALF) = pack8_f8(v0, v1); else *(u32x4*)(rowp + bj * HALF) = pack8(v0, v1); }
                __builtin_amdgcn_sched_barrier(0); }
    }
    __device__ __forceinline__ void operator()(const Acc& acc, const Unit& u, int wr, int wc, int fr, int fq) const {
        asm volatile("" : "+v"(fr), "+v"(fq));
        const int row0 = u.pm * BM + wr * 64 + fr, cl = wc * 32 + 8 * fq, pn = VAR == 2 ? u.pn + 42 : VAR == 1 ? u.pn + 25 : (u.pn < 25 ? u.pn : (u.pn < 41 ? u.pn + 33 : u.pn - 15));
        float rfs[8];
#pragma unroll
        for (int i = 0; i < 8; ++i) rfs[i] = rowf((size_t)(row0 + (i >> 2) * HALF + (i & 3) * 16));
        if constexpr (VAR == 0) { asm volatile("" : "+v"(rfs[0]), "+v"(rfs[1]), "+v"(rfs[2]), "+v"(rfs[3]), "+v"(rfs[4]), "+v"(rfs[5]), "+v"(rfs[6]), "+v"(rfs[7])); }
        if (pn < 8 || (pn > 8 && pn < 25)) { const bool isq = pn < 8; plain<0>(acc, isq ? Q : QIDX, isq ? 2048 : 4096, isq ? pn * 256 : (pn - 9) * 256, row0, cl, isq, rfs); }
        else if (pn == 8) {
#pragma unroll
            for (int ai = 0; ai < 2; ++ai)
#pragma unroll
                for (int m = 0; m < 4; ++m) { const size_t r = (size_t)(row0 + ai * HALF + m * 16);
                    const float rf = rfs[ai * 4 + m];
                    *(f32x4*)(KRAW + r * 128 + cl) = acc[ai][0][m][0] * rf; *(f32x4*)(KRAW + r * 128 + cl + 4) = acc[ai][0][m][1] * rf;
                    *(u32x4*)(V + r * 128 + cl) = pack8(acc[ai][1][m][0] * rf, acc[ai][1][m][1] * rf); }
        }
        else if (pn == 25) {
#pragma unroll
            for (int ai = 0; ai < 2; ++ai)
#pragma unroll
                for (int m = 0; m < 4; ++m) { const size_t r = (size_t)(row0 + ai * HALF + m * 16);
                    *(u32x4*)(KIDX + r * 128 + cl) = pack8(acc[ai][0][m][0], acc[ai][0][m][1]);
                    if (wc == 0) { *(f32x4*)(WIDX + r * 32 + 8 * fq) = acc[ai][1][m][0]; *(f32x4*)(WIDX + r * 32 + 8 * fq + 4) = acc[ai][1][m][1]; } }
        }
        else if (pn < 42) {
            const bool isv = pn >= 34;
#pragma unroll
            for (int ai = 0; ai < 2; ++ai)
#pragma unroll
                for (int m = 0; m < 4; ++m) { const size_t r = (size_t)(row0 + ai * HALF + m * 16); bf16_t* rowp = UV + r * 4096 + (pn - 26) * 256 + cl; float s = 0.f, q = 0.f; const float rf = rfs[ai * 4 + m];
#pragma unroll
                    for (int bj = 0; bj < 2; ++bj) { f32x4 v0 = acc[ai][bj][m][0] * rf, v1 = acc[ai][bj][m][1] * rf;
#pragma unroll
                        for (int j = 0; j < 4; ++j) { v0[j] = gelu_tanh(v0[j]); v1[j] = gelu_tanh(v1[j]); s += v0[j] + v1[j]; q += v0[j] * v0[j] + v1[j] * v1[j]; }
                        *(u32x4*)(rowp + bj * HALF) = pack8(v0, v1); }
                    s += __shfl_xor(s, 16); s += __shfl_xor(s, 32); q += __shfl_xor(q, 16); q += __shfl_xor(q, 32);
                    if (isv && fq == 0) *(f32x2*)(LNP + (((size_t)(pn - 34) * MTOK + r) * 4 + wc) * 2) = (f32x2){s, q};
                    __builtin_amdgcn_sched_barrier(0); }
        }
        else { const bool isa = pn < 58; plain<2>(acc, isa ? SGA : SGB, 4096, isa ? (pn - 42) * 256 : (pn - 58) * 256, row0, cl, isa, rfs); }
    }
};

struct EpiNull {
    static constexpr bool PERM = true, AFTER_DRAIN = false, HAS_MID = false;
    float* sink;
    __device__ __forceinline__ void mid(Acc&, const Unit&, int, int, int, int) const {}
    __device__ __forceinline__ void operator()(const Acc& acc, const Unit& u, int wr, int wc, int fr, int fq) const {
        f32x4 t = {0.f, 0.f, 0.f, 0.f};
#pragma unroll
        for (int ai = 0; ai < 2; ++ai)
#pragma unroll
            for (int bj = 0; bj < 2; ++bj)
#pragma unroll
                for (int m = 0; m < 4; ++m) t += acc[ai][bj][m][0] + acc[ai][bj][m][1];
        if (t[0] + t[1] + t[2] + t[3] == 123456.789f) sink[u.pm] = t[0];
    }
};

struct EpiPlain {
    static constexpr bool PERM = true, AFTER_DRAIN = false, HAS_MID = false;
    bf16_t* O;
    __device__ __forceinline__ void mid(Acc&, const Unit&, int, int, int, int) const {}
    __device__ __forceinline__ void operator()(const Acc& acc, const Unit& u, int wr, int wc, int fr, int fq) const {
        asm volatile("" : "+v"(fr), "+v"(fq));
        const int row0 = u.pm * BM + wr * 64 + fr, col0 = u.pn * BM + wc * 32 + 8 * fq;
#pragma unroll
        for (int ai = 0; ai < 2; ++ai)
#pragma unroll
            for (int m = 0; m < 4; ++m) { const size_t off = (size_t)(row0 + ai * HALF + m * 16) * 4096 + col0;
#pragma unroll
                for (int bj = 0; bj < 2; ++bj) *(v2u*)((unsigned char*)O + off + bj * HALF) = pack8_f8(acc[ai][bj][m][0] * 16.0f, acc[ai][bj][m][1] * 16.0f);
                __builtin_amdgcn_sched_barrier(0); }
    }
};
struct EpiMerge {
    static constexpr bool PERM = true, AFTER_DRAIN = false, HAS_MID = false;
    const bf16_t *SGA, *SGB; const bf16_t* T8; bf16_t* O;
    __device__ __forceinline__ void mid(Acc&, const Unit&, int, int, int, int) const {}
    __device__ __forceinline__ void operator()(const Acc& acc, const Unit& u, int wr, int wc, int fr, int fq) const {
        asm volatile("" : "+v"(fr), "+v"(fq));
        const int row0 = u.pm * BM + wr * 64 + fr, col0 = u.pn * BM + wc * 32 + 8 * fq;
#pragma unroll
        for (int ai = 0; ai < 2; ++ai)
#pragma unroll
            for (int m = 0; m < 4; ++m) { const size_t off = (size_t)(row0 + ai * HALF + m * 16) * 4096 + col0;
#pragma unroll
                for (int bj = 0; bj < 2; ++bj) { const v2u wa = *(const v2u*)((const unsigned char*)SGA + off + bj * HALF), wt = *(const v2u*)((const unsigned char*)T8 + off + bj * HALF); const u32x4 wb = *(const u32x4*)(SGB + off + bj * HALF);
                    f32x4 a0, a1, b0, b1, t0, t1; unpack8_f8(wa, a0, a1); unpack8(wb, b0, b1); unpack8_f8(wt, t0, t1); t0 *= 0.0625f; t1 *= 0.0625f;
                    *(u32x4*)(O + off + bj * HALF) = pack8(a0 * t0 + b0 * acc[ai][bj][m][0], a1 * t1 + b1 * acc[ai][bj][m][1]); }
                __builtin_amdgcn_sched_barrier(0); }
    }
};

template <bool G8, bool INB, bool QF = false> struct EpiResidT {
    static constexpr bool PERM = true, AFTER_DRAIN = false, HAS_MID = false;
    const void* XIN; bf16_t* XOUT; bf16_t* XG; const float* gain; float* SSQ; const float* FACR; float isw;
    __device__ __forceinline__ void mid(Acc&, const Unit&, int, int, int, int) const {}
    __device__ __forceinline__ void operator()(const Acc& acc, const Unit& u, int wr, int wc, int fr, int fq) const {
        asm volatile("" : "+v"(fr), "+v"(fq));
        const int row0 = u.pm * BM + wr * 64 + fr, col0 = u.pn * BM + wc * 32 + 8 * fq;
        f32x4 gv[2][2];
#pragma unroll
        for (int bj = 0; bj < 2; ++bj) { gv[bj][0] = *(const f32x4*)(gain + col0 + bj * HALF); gv[bj][1] = *(const f32x4*)(gain + col0 + bj * HALF + 4); }
        float rq_[8];
        if constexpr (QF) {
#pragma unroll
            for (int i = 0; i < 8; ++i) rq_[i] = FACR[row0 + (i >> 2) * HALF + (i & 3) * 16];
            asm volatile("" : "+v"(rq_[0]), "+v"(rq_[1]), "+v"(rq_[2]), "+v"(rq_[3]), "+v"(rq_[4]), "+v"(rq_[5]), "+v"(rq_[6]), "+v"(rq_[7])); }
#pragma unroll
        for (int ai = 0; ai < 2; ++ai)
#pragma unroll
            for (int m = 0; m < 4; ++m) { const size_t r = (size_t)(row0 + ai * HALF + m * 16), off = r * 4096 + col0; float q = 0.f; float rf = 1.0f; if constexpr (QF) rf = rq_[ai * 4 + m] * isw;
#pragma unroll
                for (int bj = 0; bj < 2; ++bj) { f32x4 v0, v1;
                    if constexpr (INB) { const u32x4 xw = *(const u32x4*)((const bf16_t*)XIN + off + bj * HALF); unpack8(xw, v0, v1); }
                    else { v0 = *(const f32x4*)((const float*)XIN + off + bj * HALF); v1 = *(const f32x4*)((const float*)XIN + off + bj * HALF + 4); }
                    if constexpr (QF) { v0 += acc[ai][bj][m][0] * rf; v1 += acc[ai][bj][m][1] * rf; } else { v0 += acc[ai][bj][m][0]; v1 += acc[ai][bj][m][1]; }
                    *(u32x4*)(XOUT + off + bj * HALF) = pack8(v0, v1);
#pragma unroll
                    for (int j = 0; j < 4; ++j) q += v0[j] * v0[j] + v1[j] * v1[j];
                    if constexpr (G8) { const f32x4 a = v0 * gv[bj][0], b = v1 * gv[bj][1]; v2u w;
                        w.x = (unsigned)__builtin_amdgcn_cvt_pk_fp8_f32(a[2], a[3], __builtin_amdgcn_cvt_pk_fp8_f32(a[0], a[1], 0, false), true);
                        w.y = (unsigned)__builtin_amdgcn_cvt_pk_fp8_f32(b[2], b[3], __builtin_amdgcn_cvt_pk_fp8_f32(b[0], b[1], 0, false), true);
                        *(v2u*)((unsigned char*)XG + off + bj * HALF) = w; }
                    else if (XG) *(u32x4*)(XG + off + bj * HALF) = pack8(rnd_sm4(v0 * gv[bj][0]), rnd_sm4(v1 * gv[bj][1])); }
                q += __shfl_xor(q, 16); q += __shfl_xor(q, 32);
                if (fq == 0) SSQ[((size_t)u.pn * MTOK + r) * 4 + wc] = q;
                __builtin_amdgcn_sched_barrier(0); }
    }
};

typedef EpiResidT<false, false, true> EpiResid; typedef EpiResidT<true, true> EpiResid8; typedef EpiResidT<false, true> EpiResidB; typedef EpiResidT<false, true, true> EpiResidQ;

struct EpiPe {
    static constexpr bool PERM = true, AFTER_DRAIN = false, HAS_MID = false;
    bf16_t* PE; float* SSQ;
    __device__ __forceinline__ void mid(Acc&, const Unit&, int, int, int, int) const {}
    __device__ __forceinline__ void operator()(const Acc& acc, const Unit& u, int wr, int wc, int fr, int fq) const {
        asm volatile("" : "+v"(fr), "+v"(fq));
        const int row0 = u.pm * BM + wr * 64 + fr, col0 = u.pn * BM + wc * 32 + 8 * fq;
#pragma unroll
        for (int ai = 0; ai < 2; ++ai)
#pragma unroll
            for (int m = 0; m < 4; ++m) { const size_t r = (size_t)(row0 + ai * HALF + m * 16), off = r * 4096 + col0; float q = 0.f;
#pragma unroll
                for (int bj = 0; bj < 2; ++bj) { const f32x4 v0 = acc[ai][bj][m][0], v1 = acc[ai][bj][m][1];
#pragma unroll
                    for (int j = 0; j < 4; ++j) q += v0[j] * v0[j] + v1[j] * v1[j];
                    *(u32x4*)(PE + off + bj * HALF) = pack8(v0, v1); }
                q += __shfl_xor(q, 16); q += __shfl_xor(q, 32);
                if (fq == 0) SSQ[((size_t)u.pn * MTOK + r) * 4 + wc] = q;
                __builtin_amdgcn_sched_barrier(0); }
    }
};

struct EpiGateUp {
    static constexpr bool PERM = true, AFTER_DRAIN = false, HAS_MID = false;
    const float* SSQ; bf16_t* ACT; unsigned char* ACT8; int pm8;
    __device__ __forceinline__ void mid(Acc&, const Unit&, int, int, int, int) const {}
    __device__ __forceinline__ void operator()(const Acc& acc, const Unit& u, int wr, int wc, int fr, int fq) const {
        asm volatile("" : "+v"(fr), "+v"(fq));
        const int row0 = u.pm * BM + wr * 64 + fr, col0 = u.pn * HALF + wc * 32 + 8 * fq;
#pragma unroll
        for (int ai = 0; ai < 2; ++ai)
#pragma unroll
            for (int m = 0; m < 4; ++m) { const int r = row0 + ai * HALF + m * 16;
                const float rs = 1.0f / sqrtf(row_total64(SSQ, r, fq) * (1.0f / 4096.0f) + EPS);
                f32x4 o0, o1;
#pragma unroll
                for (int j = 0; j < 4; ++j) { const float g0 = acc[ai][0][m][0][j] * rs, g1 = acc[ai][0][m][1][j] * rs;
                    o0[j] = g0 * fast_sigmoid(g0) * (acc[ai][1][m][0][j] * rs); o1[j] = g1 * fast_sigmoid(g1) * (acc[ai][1][m][1][j] * rs); }
                if (u.pm < pm8) *(v2u*)(ACT8 + (size_t)r * DFF + col0) = pack8_f8(o0, o1); else *(u32x4*)(ACT + (size_t)r * DFF + col0) = pack8(o0, o1);
                __builtin_amdgcn_sched_barrier(0); }
    }
};

struct EpiGateUpQ {
    static constexpr bool PERM = true, AFTER_DRAIN = false, HAS_MID = false;
    const float* FAC; float isg, isu; bf16_t* ACT; unsigned char* ACT8; int pm8; const float* FACA;
    __device__ __forceinline__ void mid(Acc&, const Unit&, int, int, int, int) const {}
    __device__ __forceinline__ void operator()(const Acc& acc, const Unit& u, int wr, int wc, int fr, int fq) const {
        asm volatile("" : "+v"(fr), "+v"(fq));
        const int row0 = u.pm * BM + wr * 64 + fr, col0 = u.pn * HALF + wc * 32 + 8 * fq;
        float fs_[8], fa_[8];
#pragma unroll
        for (int i = 0; i < 8; ++i) { fs_[i] = FAC[row0 + (i >> 2) * HALF + (i & 3) * 16]; fa_[i] = FACA[row0 + (i >> 2) * HALF + (i & 3) * 16]; }
        asm volatile("" : "+v"(fs_[0]), "+v"(fs_[1]), "+v"(fs_[2]), "+v"(fs_[3]), "+v"(fs_[4]), "+v"(fs_[5]), "+v"(fs_[6]), "+v"(fs_[7])); asm volatile("" : "+v"(fa_[0]), "+v"(fa_[1]), "+v"(fa_[2]), "+v"(fa_[3]), "+v"(fa_[4]), "+v"(fa_[5]), "+v"(fa_[6]), "+v"(fa_[7]));
#pragma unroll
        for (int ai = 0; ai < 2; ++ai)
#pragma unroll
            for (int m = 0; m < 4; ++m) { const int r = row0 + ai * HALF + m * 16;
                const float f = fs_[ai * 4 + m], fg = f * isg, fu = f * isu;
                f32x4 o0, o1;
#pragma unroll
                for (int j = 0; j < 4; ++j) { const float g0 = acc[ai][0][m][0][j] * fg, g1 = acc[ai][0][m][1][j] * fg;
                    o0[j] = g0 * fast_sigmoid(g0) * (acc[ai][1][m][0][j] * fu); o1[j] = g1 * fast_sigmoid(g1) * (acc[ai][1][m][1][j] * fu); }
                if (u.pm < pm8) {
                    float v_[8] = {o0[0], o0[1], o0[2], o0[3], o1[0], o1[1], o1[2], o1[3]};
#pragma unroll
                    for (int h_ = 1; h_ < 8; h_ <<= 1)
#pragma unroll
                        for (int i_ = 0; i_ < 8; ++i_) if (!(i_ & h_)) { const float a_ = v_[i_], b_ = v_[i_ | h_]; v_[i_] = a_ + b_; v_[i_ | h_] = a_ - b_; }
                    const float s16_ = (fq & 1) ? -1.0f : 1.0f, s32_ = (fq & 2) ? -1.0f : 1.0f;
#pragma unroll
                    for (int i_ = 0; i_ < 8; ++i_) { const auto p_ = __builtin_amdgcn_permlane16_swap(__float_as_uint(v_[i_]), __float_as_uint(v_[i_]), false, false); v_[i_] = __uint_as_float(p_[0]) + s16_ * __uint_as_float(p_[1]); }
#pragma unroll
                    for (int i_ = 0; i_ < 8; ++i_) { const auto p_ = __builtin_amdgcn_permlane32_swap(__float_as_uint(v_[i_]), __float_as_uint(v_[i_]), false, false); v_[i_] = __uint_as_float(p_[0]) + s32_ * __uint_as_float(p_[1]); }
                    const float sa_ = 0.17677669529663687f / fa_[ai * 4 + m];
                    *(v2u*)(ACT8 + (size_t)r * DFF + col0) = pack8_i8((f32x4){v_[0], v_[1], v_[2], v_[3]} * sa_, (f32x4){v_[4], v_[5], v_[6], v_[7]} * sa_); }
                else *(u32x4*)(ACT + (size_t)r * DFF + col0) = pack8(o0, o1);
                __builtin_amdgcn_sched_barrier(0); }
    }
};

struct EpiFinal {
    static constexpr bool PERM = true, AFTER_DRAIN = false, HAS_MID = false;
    const float *FAC2, *SSQP, *pleg; const bf16_t* PE; const bf16_t* X2R; float* OUT; float isw;
    __device__ __forceinline__ void mid(Acc&, const Unit&, int, int, int, int) const {}
    __device__ __forceinline__ void operator()(const Acc& acc, const Unit& u, int wr, int wc, int fr, int fq) const {
        asm volatile("" : "+v"(fr), "+v"(fq));
        const int row0 = u.pm * BM + wr * 64 + fr, col0 = u.pn * BM + wc * 32 + 8 * fq;
        f32x4 gv[2][2];
#pragma unroll
        for (int bj = 0; bj < 2; ++bj) { gv[bj][0] = *(const f32x4*)(pleg + col0 + bj * HALF); gv[bj][1] = *(const f32x4*)(pleg + col0 + bj * HALF + 4); }
        float r3_[8];
#pragma unroll
        for (int i = 0; i < 8; ++i) r3_[i] = FAC2[row0 + (i >> 2) * HALF + (i & 3) * 16];
        asm volatile("" : "+v"(r3_[0]), "+v"(r3_[1]), "+v"(r3_[2]), "+v"(r3_[3]), "+v"(r3_[4]), "+v"(r3_[5]), "+v"(r3_[6]), "+v"(r3_[7]));
#pragma unroll
        for (int ai = 0; ai < 2; ++ai)
#pragma unroll
            for (int m = 0; m < 4; ++m) { const int r = row0 + ai * HALF + m * 16; const size_t off = (size_t)r * 4096 + col0;
                const float r3 = r3_[ai * 4 + m] * isw, rp = 1.0f / sqrtf(row_total64(SSQP, r, fq) * (1.0f / 4096.0f) + EPS);
#pragma unroll
                for (int bj = 0; bj < 2; ++bj) { const u32x4 pw = *(const u32x4*)(PE + off + bj * HALF); f32x4 p0, p1; unpack8(pw, p0, p1);
                    f32x4 x0, x1; { const u32x4 xw = *(const u32x4*)(X2R + off + bj * HALF); unpack8(xw, x0, x1); }
#pragma unroll
                    for (int j = 0; j < 4; ++j) { x0[j] += fast_sigmoid(acc[ai][bj][m][0][j] * r3) * (p0[j] * rp * gv[bj][0][j]); x1[j] += fast_sigmoid(acc[ai][bj][m][1][j] * r3) * (p1[j] * rp * gv[bj][1][j]); }
                    *(f32x4*)(OUT + off + bj * HALF) = x0; *(f32x4*)(OUT + off + bj * HALF + 4) = x1; }
                __builtin_amdgcn_sched_barrier(0); }
    }
};
template <class Epi, class Sched, bool ALIGN_EPI = false, bool SP2 = false, bool FP8 = false, bool FP4 = false, bool I8 = false>
__device__ __forceinline__ void gemm_phase(PG8_LAS unsigned char* lds, const Gemm g, const Sched& S, const Epi& E, const int tid, const int sclw4 = 127) {
    const int wid = __builtin_amdgcn_readfirstlane(tid >> 6), lane = tid & 63, wr = wid >> 2, wc = wid & 3, fr = lane & 15, fq = lane >> 4;
    const int K = g.K, nt = K / BK;
    unsigned voffA[2], voffB[2];
#pragma unroll
    for (int i = 0; i < 2; ++i) { int R, C; stage_rc(tid * 16 + i * 8192, R, C); const int Rb = Epi::PERM ? ((R & ~31) + perm32(R & 31)) : R;
        voffA[i] = (unsigned)(R * K + C) * 2u; voffB[i] = (unsigned)(Rb * K + C) * 2u; }
    const size_t kstep = (size_t)(BK * 2);
    const size_t hstep = (size_t)HALF * K * 2;
    const size_t tstep = 2 * hstep;
    const unsigned ldsw = (unsigned)wid * 1024u;
    const int aoff = lds_byte(wr * 64 + fr, fq * 8), boff = lds_byte(wc * 32 + fr, fq * 8);
#define PG8_SA(b, h) (((b) * 2 + (h)) * HTB)
#define PG8_SB(b, h) ((4 + (b) * 2 + (h)) * HTB)
#define PG8_STAGE(bufoff, gbase, voff) do { _Pragma("unroll") for (int _i = 0; _i < 2; ++_i) \
        __builtin_amdgcn_global_load_lds((const unsigned*)((const char*)(gbase) + (voff)[_i]), (PG8_LAS unsigned*)(lds + (bufoff) + ldsw + _i * 8192), 16, 0, 0); } while (0)
#define PG8_LDA(dst, b, h) do { if constexpr (FP8) { _Pragma("unroll") for (int m = 0; m < 4; ++m) { const v4i_t lo_ = *(const PG8_LAS v4i_t*)(lds + PG8_SA(b, h) + aoff + m * 2048), hi_ = *(const PG8_LAS v4i_t*)(lds + PG8_SA(b, h) + aoff + m * 2048 + 1024); dst##8[m] = __builtin_shufflevector(lo_, hi_, 0, 1, 2, 3, 4, 5, 6, 7); } } \
        else { _Pragma("unroll") for (int m = 0; m < 4; ++m) _Pragma("unroll") for (int k = 0; k < 2; ++k) dst[m][k] = *(const PG8_LAS bf16x8*)(lds + PG8_SA(b, h) + aoff + m * 2048 + k * 1024); } } while (0)
#define PG8_LDB(dst, b, h) do { if constexpr (FP8) { _Pragma("unroll") for (int n = 0; n < 2; ++n) { const v4i_t lo_ = *(const PG8_LAS v4i_t*)(lds + PG8_SB(b, h) + boff + n * 2048), hi_ = *(const PG8_LAS v4i_t*)(lds + PG8_SB(b, h) + boff + n * 2048 + 1024); dst##8[n] = __builtin_shufflevector(lo_, hi_, 0, 1, 2, 3, 4, 5, 6, 7); } } \
        else { _Pragma("unroll") for (int n = 0; n < 2; ++n) _Pragma("unroll") for (int k = 0; k < 2; ++k) dst[n][k] = *(const PG8_LAS bf16x8*)(lds + PG8_SB(b, h) + boff + n * 2048 + k * 1024); } } while (0)
#define PG8_ALIGN_MFMA(At, Bt) asm volatile(".p2align 3" :: "v"(At[0][0]), "v"(At[0][1]), "v"(At[1][0]), "v"(At[1][1]), "v"(At[2][0]), "v"(At[2][1]), "v"(At[3][0]), "v"(At[3][1]), "v"(Bt[0][0]), "v"(Bt[0][1]), "v"(Bt[1][0]), "v"(Bt[1][1]))
#define PG8_ALIGN_MFMA8(At, Bt) asm volatile(".p2align 3" :: "v"(At##8[0]), "v"(At##8[1]), "v"(At##8[2]), "v"(At##8[3]), "v"(Bt##8[0]), "v"(Bt##8[1]))
#define PG8_MMA(ai, bj, At, Bt) do { __builtin_amdgcn_s_setprio(1); \
        if constexpr (FP8) { PG8_ALIGN_MFMA8(At, Bt); __builtin_amdgcn_sched_barrier(0); _Pragma("unroll") for (int m = 0; m < 4; ++m) _Pragma("unroll") for (int n = 0; n < 2; ++n) \
            asm volatile("v_mfma_scale_f32_16x16x128_f8f6f4 %0, %1, %2, %0, %3, %4 op_sel_hi:[0,0,0]" : "+v"(acc[ai][bj][m][n]) : "v"(Bt##8[n]), "v"(At##8[m]), "v"(scl_w), "v"(scl_a)); } \
        else if constexpr (I8) { PG8_ALIGN_MFMA(At, Bt); __builtin_amdgcn_sched_barrier(0); _Pragma("unroll") for (int m = 0; m < 4; ++m) _Pragma("unroll") for (int n = 0; n < 2; ++n) _Pragma("unroll") for (int k = 0; k < 2; ++k) \
            asm volatile("v_mfma_i32_16x16x64_i8 %0, %1, %2, %0" : "+v"(acc[ai][bj][m][n]) : "v"(Bt[n][k]), "v"(At[m][k])); } \
        else if constexpr (FP4) { PG8_ALIGN_MFMA(At, Bt); __builtin_amdgcn_sched_barrier(0); _Pragma("unroll") for (int m = 0; m < 4; ++m) _Pragma("unroll") for (int n = 0; n < 2; ++n) _Pragma("unroll") for (int k = 0; k < 2; ++k) \
            asm volatile("v_mfma_scale_f32_16x16x128_f8f6f4 %0, %1, %2, %0, %3, %4 op_sel_hi:[0,0,0] cbsz:4 blgp:4" : "+v"(acc[ai][bj][m][n]) : "v"(Bt[n][k]), "v"(At[m][k]), "v"(scl_w), "v"(scl_a)); } \
        else { PG8_ALIGN_MFMA(At, Bt); __builtin_amdgcn_sched_barrier(0); _Pragma("unroll") for (int m = 0; m < 4; ++m) _Pragma("unroll") for (int n = 0; n < 2; ++n) _Pragma("unroll") for (int k = 0; k < 2; ++k) \
            acc[ai][bj][m][n] = __builtin_amdgcn_mfma_f32_16x16x32_bf16(Bt[n][k], At[m][k], acc[ai][bj][m][n], 0, 0, 0); } \
        __builtin_amdgcn_s_setprio(0); } while (0)
#define PG8_WAIT_V(n) asm volatile("s_waitcnt vmcnt(" #n ")" ::: "memory")
#define PG8_WAIT_L(n) asm volatile("s_waitcnt lgkmcnt(" #n ")" ::: "memory")
#define PG8_BAR __builtin_amdgcn_s_barrier()
#define PG8_SCHED __builtin_amdgcn_sched_barrier(0)
    Unit cur, nxt; int ui = 0;
    if (!S.next(0, cur)) return;
    f32x4 acc[2][2][4][2];
#pragma unroll
    for (int a = 0; a < 2; ++a)
#pragma unroll
        for (int b = 0; b < 2; ++b)
#pragma unroll
            for (int m = 0; m < 4; ++m)
#pragma unroll
                for (int n = 0; n < 2; ++n) acc[a][b][m][n] = (f32x4){0.f, 0.f, 0.f, 0.f};
    typedef int v8i_t __attribute__((ext_vector_type(8))); typedef int v4i_t __attribute__((ext_vector_type(4)));
    bf16x8 At[4][2], B0[2][2], B1[2][2]; v8i_t At8[4], B08[2], B18[2];
    const int scl_w = FP4 ? sclw4 : 121, scl_a = FP4 ? 126 : 127;
    const char* cA = (const char*)g.A + (size_t)cur.pm * tstep; const char* cB = (const char*)g.Bt + (size_t)cur.pn * tstep;
    S.a_ready(cur);
    if constexpr (SP2) {
        PG8_STAGE(PG8_SB(0, 0), cB, voffB); PG8_STAGE(PG8_SB(0, 1), cB + hstep, voffB); PG8_STAGE(PG8_SA(0, 0), cA, voffA); PG8_STAGE(PG8_SA(0, 1), cA + hstep, voffA);
        if (wr == 1) PG8_BAR;
        PG8_WAIT_V(2); PG8_BAR;
        PG8_STAGE(PG8_SB(1, 0), cB + kstep, voffB); PG8_STAGE(PG8_SA(1, 0), cA + kstep, voffA); PG8_STAGE(PG8_SB(1, 1), cB + hstep + kstep, voffB);
        PG8_WAIT_V(6); PG8_BAR;
    } else {
        PG8_STAGE(PG8_SB(0, 0), cB, voffB); PG8_STAGE(PG8_SA(0, 0), cA, voffA); PG8_STAGE(PG8_SB(0, 1), cB + hstep, voffB); PG8_STAGE(PG8_SA(0, 1), cA + hstep, voffA);
        if (wr == 1) PG8_BAR;
        PG8_WAIT_V(4); PG8_BAR;
        PG8_STAGE(PG8_SB(1, 0), cB + kstep, voffB); PG8_STAGE(PG8_SA(1, 0), cA + kstep, voffA); PG8_STAGE(PG8_SB(1, 1), cB + hstep + kstep, voffB);
        PG8_WAIT_V(6); PG8_BAR;
    }
    for (;;) {
        const bool has_next = S.next(ui + 1, nxt);
        const char* nA = has_next ? (const char*)g.A + (size_t)nxt.pm * tstep : cA; const char* nB = has_next ? (const char*)g.Bt + (size_t)nxt.pn * tstep : cB;
        for (int t = 0; t < nt; t += 2) {
            asm volatile(".p2align 6");
            const bool last = (t == nt - 2);
            const char* a1 = cA + (size_t)(t + 1) * kstep;
            const char* a2 = last ? nA : cA + (size_t)(t + 2) * kstep; const char* b2 = last ? nB : cB + (size_t)(t + 2) * kstep;
            const char* a3 = a2 + kstep; const char* b3 = b2 + kstep;
            if (last && has_next) S.a_ready(nxt);
            if constexpr (Epi::HAS_MID) { if (t == (nt >> 1)) E.mid(acc, cur, wr, wc, fr, fq); }
            if constexpr (SP2) {
            PG8_LDB(B0, 0, 0); PG8_LDB(B1, 0, 1); PG8_SCHED; PG8_LDA(At, 0, 0); PG8_STAGE(PG8_SA(1, 1), a1 + hstep, voffA);
            PG8_WAIT_V(8); PG8_WAIT_L(0); PG8_BAR; PG8_MMA(0, 0, At, B0); PG8_MMA(0, 1, At, B1); PG8_BAR; PG8_SCHED;
            PG8_LDA(At, 0, 1); PG8_STAGE(PG8_SB(0, 0), b2, voffB); PG8_STAGE(PG8_SB(0, 1), b2 + hstep, voffB); PG8_STAGE(PG8_SA(0, 0), a2, voffA);
            PG8_WAIT_V(8); PG8_WAIT_L(0); PG8_BAR; PG8_MMA(1, 0, At, B0); PG8_MMA(1, 1, At, B1); PG8_BAR; PG8_SCHED;
            PG8_LDB(B0, 1, 0); PG8_LDB(B1, 1, 1); PG8_SCHED; PG8_LDA(At, 1, 0); PG8_STAGE(PG8_SA(0, 1), a2 + hstep, voffA);
            PG8_WAIT_V(8); PG8_WAIT_L(0); PG8_BAR; PG8_MMA(0, 0, At, B0); PG8_MMA(0, 1, At, B1); PG8_BAR; PG8_SCHED;
            PG8_LDA(At, 1, 1); PG8_STAGE(PG8_SB(1, 0), b3, voffB); PG8_STAGE(PG8_SB(1, 1), b3 + hstep, voffB); PG8_STAGE(PG8_SA(1, 0), a3, voffA);
            PG8_WAIT_V(8); PG8_WAIT_L(0); PG8_BAR; PG8_MMA(1, 0, At, B0); PG8_MMA(1, 1, At, B1); PG8_BAR; PG8_SCHED;
            } else {
            PG8_LDB(B0, 0, 0); PG8_SCHED; PG8_LDA(At, 0, 0); PG8_STAGE(PG8_SA(1, 1), a1 + hstep, voffA);
            PG8_WAIT_L(8); PG8_BAR; PG8_WAIT_L(0); PG8_MMA(0, 0, At, B0); PG8_BAR; PG8_SCHED;
            PG8_LDB(B1, 0, 1); PG8_STAGE(PG8_SB(0, 0), b2, voffB);
            PG8_BAR; PG8_WAIT_L(0); PG8_MMA(0, 1, At, B1); PG8_BAR;
            PG8_LDA(At, 0, 1); PG8_STAGE(PG8_SA(0, 0), a2, voffA);
            PG8_BAR; PG8_WAIT_L(0); PG8_MMA(1, 0, At, B0); PG8_BAR; PG8_SCHED;
            PG8_STAGE(PG8_SB(0, 1), b2 + hstep, voffB);
            PG8_WAIT_V(6); PG8_BAR; PG8_MMA(1, 1, At, B1); PG8_BAR;
            PG8_LDB(B0, 1, 0); PG8_SCHED; PG8_LDA(At, 1, 0); PG8_STAGE(PG8_SA(0, 1), a2 + hstep, voffA);
            PG8_WAIT_L(8); PG8_BAR; PG8_WAIT_L(0); PG8_MMA(0, 0, At, B0); PG8_BAR; PG8_SCHED;
            PG8_LDB(B1, 1, 1); PG8_STAGE(PG8_SB(1, 0), b3, voffB);
            PG8_BAR; PG8_WAIT_L(0); PG8_MMA(0, 1, At, B1); PG8_BAR;
            PG8_LDA(At, 1, 1); PG8_STAGE(PG8_SA(1, 0), a3, voffA);
            PG8_BAR; PG8_WAIT_L(0); PG8_MMA(1, 0, At, B0); PG8_BAR; PG8_SCHED;
            PG8_STAGE(PG8_SB(1, 1), b3 + hstep, voffB);
            PG8_WAIT_V(6); PG8_BAR; PG8_MMA(1, 1, At, B1); PG8_BAR;
            }
        }
        if constexpr (FP8 || FP4 || I8) {
            asm volatile("s_nop 15\n\ts_nop 15" : "+v"(acc[0][0][0][0]), "+v"(acc[0][0][0][1]), "+v"(acc[0][0][1][0]), "+v"(acc[0][0][1][1]), "+v"(acc[0][0][2][0]), "+v"(acc[0][0][2][1]), "+v"(acc[0][0][3][0]), "+v"(acc[0][0][3][1]), "+v"(acc[0][1][0][0]), "+v"(acc[0][1][0][1]), "+v"(acc[0][1][1][0]), "+v"(acc[0][1][1][1]), "+v"(acc[0][1][2][0]), "+v"(acc[0][1][2][1]), "+v"(acc[0][1][3][0]), "+v"(acc[0][1][3][1]));
            asm volatile("" : "+v"(acc[1][0][0][0]), "+v"(acc[1][0][0][1]), "+v"(acc[1][0][1][0]), "+v"(acc[1][0][1][1]), "+v"(acc[1][0][2][0]), "+v"(acc[1][0][2][1]), "+v"(acc[1][0][3][0]), "+v"(acc[1][0][3][1]), "+v"(acc[1][1][0][0]), "+v"(acc[1][1][0][1]), "+v"(acc[1][1][1][0]), "+v"(acc[1][1][1][1]), "+v"(acc[1][1][2][0]), "+v"(acc[1][1][2][1]), "+v"(acc[1][1][3][0]), "+v"(acc[1][1][3][1])); }
        if constexpr (I8) {
#pragma unroll
            for (int a = 0; a < 2; ++a)
#pragma unroll
                for (int b = 0; b < 2; ++b)
#pragma unroll
                    for (int m = 0; m < 4; ++m)
#pragma unroll
                        for (int n = 0; n < 2; ++n) acc[a][b][m][n] = __builtin_convertvector(__builtin_bit_cast(v4i_t, acc[a][b][m][n]), f32x4); }
        if constexpr (ALIGN_EPI) { if (wr == 0) PG8_BAR; }
        if constexpr (!Epi::AFTER_DRAIN) { E(acc, cur, wr, wc, fr, fq); S.done(cur); }
        if (!has_next) break;
#pragma unroll
        for (int a = 0; a < 2; ++a)
#pragma unroll
            for (int b = 0; b < 2; ++b)
#pragma unroll
                for (int m = 0; m < 4; ++m)
#pragma unroll
                    for (int n = 0; n < 2; ++n) acc[a][b][m][n] = (f32x4){0.f, 0.f, 0.f, 0.f};
        cur = nxt; cA = nA; cB = nB; ++ui;
        if constexpr (ALIGN_EPI) { if (wr == 1) PG8_BAR; }
    }
    PG8_WAIT_V(0);
    if constexpr (!ALIGN_EPI) { if (wr == 0) PG8_BAR; }
    PG8_BAR;
    if constexpr (Epi::AFTER_DRAIN) { E.fused(acc, cur, wr, wc, fr, fq, lds, wid, lane); S.done(cur); }
#undef PG8_SA
#undef PG8_SB
#undef PG8_STAGE
#undef PG8_LDA
#undef PG8_LDB
#undef PG8_MMA
#undef PG8_ALIGN_MFMA
#undef PG8_ALIGN_MFMA8
#undef PG8_WAIT_V
#undef PG8_WAIT_L
#undef PG8_BAR
#undef PG8_SCHED
}
}
#define XB_TMO      128
#define XB_XCNT(j)  (256  + 64 * (j))
#define XB_XSUB(j)  (1280 + 64 * (j))
#define XB_XGEN(j)  (2304 + 64 * (j))
#define XB_TOP      3328
#define XB_TOPGEN   3392
#define XCD_BAR_WORDS 3456
#define XB_SPIN_CAP (1u << 20)

__device__ __forceinline__ unsigned xb_ld(unsigned* p)              { return __hip_atomic_load(p, __ATOMIC_RELAXED, __HIP_MEMORY_SCOPE_AGENT); }
__device__ __forceinline__ unsigned xb_add(unsigned* p, unsigned v) { return __hip_atomic_fetch_add(p, v, __ATOMIC_RELAXED, __HIP_MEMORY_SCOPE_AGENT); }
__device__ __forceinline__ unsigned xb_xcc_id() { return (unsigned)__builtin_amdgcn_s_getreg((3 << 11) | 20) & 0xFu; }
#define XB_SPIN(cond, bar) do { unsigned _sp = 0; while (cond) { __builtin_amdgcn_s_sleep(1); \
    if ((++_sp & 255u) == 0u) { if (xb_ld(&(bar)[XB_TMO])) break; if (_sp > XB_SPIN_CAP) { atomicAdd(&(bar)[XB_TMO], 1u); break; } } } } while (0)

struct XcdBarrier {
    unsigned* bar; unsigned x;
    volatile LAS unsigned* st;
};

__device__ __forceinline__ XcdBarrier xcd_barrier_post(unsigned* bar, volatile LAS unsigned* st) {
    XcdBarrier b; b.bar = bar; b.x = xb_xcc_id(); b.st = st;
    if (threadIdx.x == 0) (void)xb_add(&bar[XB_XCNT(b.x)], 1u);
    return b;
}
__device__ __forceinline__ void xcd_barrier_complete(unsigned* bar, unsigned x, unsigned& nloc, unsigned& nx) {
    const unsigned G = gridDim.x * gridDim.y * gridDim.z;
    unsigned sum, cnt, mine, sp = 0u;
    for (;;) {
        sum = 0u; cnt = 0u; mine = 0u;
#pragma unroll
        for (unsigned j = 0; j < 16; ++j) { const unsigned c = xb_ld(&bar[XB_XCNT(j)]); sum += c; cnt += (c > 0u) ? 1u : 0u; mine = (j == x) ? c : mine; }
        if (sum == G) break;
        __builtin_amdgcn_s_sleep(1);
        if ((++sp & 255u) == 0u) { if (xb_ld(&bar[XB_TMO])) break; if (sp > XB_SPIN_CAP) { atomicAdd(&bar[XB_TMO], 1u); break; } }
    }
    nloc = mine > 0u ? mine : 1u; nx = cnt > 0u ? cnt : 1u;
}

__device__ __forceinline__ void xcd_barrier(const XcdBarrier& b) {
    asm volatile("s_waitcnt vmcnt(0)" ::: "memory");
    __syncthreads();
    if (threadIdx.x == 0) {
        unsigned* bar = b.bar;
        __builtin_amdgcn_s_waitcnt(0);
        unsigned nloc = b.st[0], nx = b.st[1];
        if (nloc == 0u) { xcd_barrier_complete(bar, b.x, nloc, nx); b.st[0] = nloc; b.st[1] = nx; }
        const unsigned old = xb_add(&bar[XB_XSUB(b.x)], 1u);
        const unsigned gen = old / nloc;
        if (old + 1u == (gen + 1u) * nloc) {
            __builtin_amdgcn_fence(__ATOMIC_RELEASE, "agent");
            asm volatile("s_waitcnt vmcnt(0)" ::: "memory");
            const unsigned og = xb_add(&bar[XB_TOP], 1u);
            const unsigned tg = og / nx;
            if (og + 1u == (tg + 1u) * nx) xb_add(&bar[XB_TOPGEN], 1u);
            else XB_SPIN(xb_ld(&bar[XB_TOPGEN]) == tg, bar);
            __builtin_amdgcn_fence(__ATOMIC_ACQUIRE, "agent");
            xb_add(&bar[XB_XGEN(b.x)], 1u);
            asm volatile("s_waitcnt vmcnt(0)" ::: "memory");
        } else {
            XB_SPIN(xb_ld(&bar[XB_XGEN(b.x)]) == gen, bar);
            __builtin_amdgcn_fence(__ATOMIC_ACQUIRE, "agent");
            asm volatile("s_waitcnt vmcnt(0)" ::: "memory");
        }
    }
    __syncthreads();
}

template <int MAP> __device__ __forceinline__ int rowmap(int n) {
    if (MAP == 1) return n - 6400;
    if (MAP == 4) return n < 6400 ? n : (n < 10656 ? n + 3936 : n - 8352);
    if (MAP == 2) return (n >> 7) * 256 + (n & 127);
    if (MAP == 3) return (n >> 7) * 256 + 128 + (n & 127);
    return n;
}
__device__ __forceinline__ void p0_load(const float* W, int N, int item, f32x4 (&r)[8], int lane) {
    const int nblk = N / 32, kb = item / nblk, nb = item % nblk;
    const float* p = W + (size_t)(64 * kb + (lane >> 3)) * N + 32 * nb + 4 * (lane & 7);
#pragma unroll
    for (int i = 0; i < 8; ++i) r[i] = *(const GAS f32x4*)(p + (size_t)(8 * i) * N);
}
template <int MAP, bool SM = false> __device__ __forceinline__ void p0_finish(const f32x4 (&r)[8], int N, bf16* dst, int ldd, int koff, LAS float* scr, int item, int lane) {
    const int nblk = N / 32, kb = item / nblk, nb = item % nblk, k0 = 64 * kb, n0 = 32 * nb;
#pragma unroll
    for (int i = 0; i < 8; ++i) { LAS float* s = scr + (8 * i + (lane >> 3)) * 33 + 4 * (lane & 7); s[0] = r[i].x; s[1] = r[i].y; s[2] = r[i].z; s[3] = r[i].w; }
    LDS_WAIT(); asm volatile("" ::: "memory");
    const int c = lane & 7, r0 = rowmap<MAP>(n0);
#pragma unroll
    for (int j = 0; j < 4; ++j) { const int n = (lane >> 3) + 8 * j; const LAS float* s = scr + (8 * c) * 33 + n;
        v4u o; if (SM) { o.x = cvt_pk_bf16(rnd_sm(s[0 * 33]), rnd_sm(s[1 * 33])); o.y = cvt_pk_bf16(rnd_sm(s[2 * 33]), rnd_sm(s[3 * 33])); o.z = cvt_pk_bf16(rnd_sm(s[4 * 33]), rnd_sm(s[5 * 33])); o.w = cvt_pk_bf16(rnd_sm(s[6 * 33]), rnd_sm(s[7 * 33])); }
        else { o.x = cvt_pk_bf16(s[0 * 33], s[1 * 33]); o.y = cvt_pk_bf16(s[2 * 33], s[3 * 33]); o.z = cvt_pk_bf16(s[4 * 33], s[5 * 33]); o.w = cvt_pk_bf16(s[6 * 33], s[7 * 33]); }
        *(GAS v4u*)(dst + (size_t)(r0 + n) * ldd + koff + k0 + 8 * c) = o; }
    LDS_WAIT(); asm volatile("" ::: "memory");
}
template <int MAP> __device__ __forceinline__ void p0_finish8(const f32x4 (&r)[8], int N, unsigned char* dst, int ldd, LAS float* scr, int item, int lane) {
    const int nblk = N / 32, kb = item / nblk, nb = item % nblk, k0 = 64 * kb, n0 = rowmap<MAP>(32 * nb);
#pragma unroll
    for (int i = 0; i < 8; ++i) { LAS float* s = scr + (8 * i + (lane >> 3)) * 33 + 4 * (lane & 7); s[0] = r[i].x; s[1] = r[i].y; s[2] = r[i].z; s[3] = r[i].w; }
    LDS_WAIT(); asm volatile("" ::: "memory");
    const int c = lane & 7;
#pragma unroll
    for (int j = 0; j < 4; ++j) { const int n = (lane >> 3) + 8 * j; const LAS float* s = scr + (8 * c) * 33 + n; v2u o;
        o.x = (unsigned)__builtin_amdgcn_cvt_pk_fp8_f32(64.f * s[2 * 33], 64.f * s[3 * 33], __builtin_amdgcn_cvt_pk_fp8_f32(64.f * s[0 * 33], 64.f * s[1 * 33], 0, false), true);
        o.y = (unsigned)__builtin_amdgcn_cvt_pk_fp8_f32(64.f * s[6 * 33], 64.f * s[7 * 33], __builtin_amdgcn_cvt_pk_fp8_f32(64.f * s[4 * 33], 64.f * s[5 * 33], 0, false), true);
        *(GAS v2u*)(dst + (size_t)(n0 + n) * ldd + k0 + 8 * c) = o; }
    LDS_WAIT(); asm volatile("" ::: "memory");
}
template <int MAP> __device__ __forceinline__ void p0_finish_i8(const f32x4 (&r)[8], int N, unsigned char* dst, int ldd, float wsc, LAS float* scr, int item, int lane) {
    const int nblk = N / 32, kb = item / nblk, nb = item % nblk, k0 = 64 * kb, n0 = rowmap<MAP>(32 * nb);
#pragma unroll
    for (int i = 0; i < 8; ++i) { LAS float* s = scr + (8 * i + (lane >> 3)) * 33 + 4 * (lane & 7); s[0] = r[i].x; s[1] = r[i].y; s[2] = r[i].z; s[3] = r[i].w; }
    LDS_WAIT(); asm volatile("" ::: "memory");
    const int c = lane & 7;
#pragma unroll
    for (int j = 0; j < 4; ++j) { const int n = (lane >> 3) + 8 * j; const LAS float* s = scr + (8 * c) * 33 + n;
        *(GAS v2u*)(dst + (size_t)(n0 + n) * ldd + k0 + 8 * c) = pack8_i8((f32x4){wsc * s[0 * 33], wsc * s[1 * 33], wsc * s[2 * 33], wsc * s[3 * 33]}, (f32x4){wsc * s[4 * 33], wsc * s[5 * 33], wsc * s[6 * 33], wsc * s[7 * 33]}); }
    LDS_WAIT(); asm volatile("" ::: "memory");
}
__device__ __forceinline__ void p0_finish_i8h(const f32x4 (&r)[8], int N, unsigned char* dst, int ldd, float wsc, LAS float* scr, int item, int lane) {
    const int nblk = N / 32, kb = item / nblk, nb = item % nblk, k0 = 64 * kb, n0 = 32 * nb;
#pragma unroll
    for (int i = 0; i < 8; ++i) { LAS float* s = scr + (8 * i + (lane >> 3)) * 33 + 4 * (lane & 7); s[0] = r[i].x; s[1] = r[i].y; s[2] = r[i].z; s[3] = r[i].w; }
    LDS_WAIT(); asm volatile("" ::: "memory");
    const int n = lane & 31, half = lane >> 5; const LAS float* s = scr + (32 * half) * 33 + n;
    float v[32];
#pragma unroll
    for (int i = 0; i < 32; ++i) v[i] = s[i * 33];
#pragma unroll
    for (int h = 1; h < 32; h <<= 1)
#pragma unroll
        for (int i = 0; i < 32; ++i) if (!(i & h)) { const float a = v[i], b = v[i | h]; v[i] = a + b; v[i | h] = a - b; }
    const float c = wsc * 0.17677669529663687f;
    unsigned char* p = dst + (size_t)(n0 + n) * ldd + k0 + 32 * half;
#pragma unroll
    for (int q = 0; q < 2; ++q) { const v2u lo = pack8_i8((f32x4){v[16 * q], v[16 * q + 1], v[16 * q + 2], v[16 * q + 3]} * c, (f32x4){v[16 * q + 4], v[16 * q + 5], v[16 * q + 6], v[16 * q + 7]} * c),
                                            hi = pack8_i8((f32x4){v[16 * q + 8], v[16 * q + 9], v[16 * q + 10], v[16 * q + 11]} * c, (f32x4){v[16 * q + 12], v[16 * q + 13], v[16 * q + 14], v[16 * q + 15]} * c);
        *(GAS v4u*)(p + 16 * q) = (v4u){lo.x, lo.y, hi.x, hi.y}; }
    LDS_WAIT(); asm volatile("" ::: "memory");
}
template <bool NORM, bool GAIN, bool ROT = false> __device__ __forceinline__ void quant_row_i8(const bf16* xrow, const float* gain, unsigned char* orow, float* fac, int lane, const float clip = 4.0f, float* faca = nullptr, const float sgu = 0.f) {
    f32x4 a[8][2]; float sx = 0.f, sa = 0.f;
#pragma unroll
    for (int j = 0; j < 8; ++j) { const v4u w = *(const GAS v4u*)(xrow + (lane + 64 * j) * 8); f32x4 x0, x1; unpack8(w, x0, x1);
        if constexpr (GAIN) { const f32x4 g0 = *(const GAS f32x4*)(gain + (lane + 64 * j) * 8), g1 = *(const GAS f32x4*)(gain + (lane + 64 * j) * 8 + 4); a[j][0] = x0 * g0; a[j][1] = x1 * g1; }
        else { a[j][0] = x0; a[j][1] = x1; }
#pragma unroll
        for (int i = 0; i < 4; ++i) { sx += x0[i] * x0[i] + x1[i] * x1[i]; sa += a[j][0][i] * a[j][0][i] + a[j][1][i] * a[j][1][i]; } }
    if constexpr (NORM) sx = wave_sum(sx);
    sa = wave_sum(sa);
    float sc = 127.0f / (clip * sqrtf(sa * (1.0f / DM)) + 1e-30f);
    if constexpr (ROT) {
        const float s1_ = (lane & 1) ? -1.0f : 1.0f, s2_ = (lane & 2) ? -1.0f : 1.0f;
#pragma unroll
        for (int j = 0; j < 8; ++j) { float v_[8] = {a[j][0][0], a[j][0][1], a[j][0][2], a[j][0][3], a[j][1][0], a[j][1][1], a[j][1][2], a[j][1][3]};
#pragma unroll
            for (int h_ = 1; h_ < 8; h_ <<= 1)
#pragma unroll
                for (int i_ = 0; i_ < 8; ++i_) if (!(i_ & h_)) { const float p_ = v_[i_], q_ = v_[i_ | h_]; v_[i_] = p_ + q_; v_[i_ | h_] = p_ - q_; }
#pragma unroll
            for (int i_ = 0; i_ < 8; ++i_) { const float t_ = __int_as_float(__builtin_amdgcn_update_dpp(0, __float_as_int(v_[i_]), 0xB1, 0xF, 0xF, true)); v_[i_] = (lane & 1) ? t_ - v_[i_] : v_[i_] + t_; }
#pragma unroll
            for (int i_ = 0; i_ < 8; ++i_) { const float t_ = __int_as_float(__builtin_amdgcn_update_dpp(0, __float_as_int(v_[i_]), 0x4E, 0xF, 0xF, true)); v_[i_] = (lane & 2) ? t_ - v_[i_] : v_[i_] + t_; }
            a[j][0] = (f32x4){v_[0], v_[1], v_[2], v_[3]}; a[j][1] = (f32x4){v_[4], v_[5], v_[6], v_[7]}; }
        (void)s1_; (void)s2_;
        sc *= 0.17677669529663687f; }
#pragma unroll
    for (int j = 0; j < 8; ++j) *(GAS v2u*)(orow + (lane + 64 * j) * 8) = pack8_i8(a[j][0] * sc, a[j][1] * sc);
    if constexpr (ROT) sc *= 5.656854249492381f;
    if (lane == 0) { *fac = NORM ? (1.0f / sqrtf(sx * (1.0f / DM) + EPS)) / sc : 1.0f / sc;
        if (faca) *faca = ACT_CLIP * (sa / (sx * (1.0f / DM) + EPS)) * sgu * (1.0f / 127.0f); }
}
__device__ __forceinline__ void p0_finish4(const f32x4 (&r)[8], int N, unsigned char* dst, float wsc, LAS float* scr, int item, int lane) {
    const int nblk = N / 32, kb = item / nblk, nb = item % nblk, k0 = 64 * kb, n0 = 32 * nb - 10656;
#pragma unroll
    for (int i = 0; i < 8; ++i) { LAS float* s = scr + (8 * i + (lane >> 3)) * 33 + 4 * (lane & 7); s[0] = r[i].x; s[1] = r[i].y; s[2] = r[i].z; s[3] = r[i].w; }
    LDS_WAIT(); asm volatile("" ::: "memory");
    const int c = lane & 7;
#pragma unroll
    for (int j = 0; j < 4; ++j) { const int n = (lane >> 3) + 8 * j; const LAS float* s = scr + (8 * c) * 33 + n;
        const unsigned o = pack4_f4(wsc * s[0 * 33], wsc * s[1 * 33], wsc * s[2 * 33], wsc * s[3 * 33]) | (pack4_f4(wsc * s[4 * 33], wsc * s[5 * 33], wsc * s[6 * 33], wsc * s[7 * 33]) << 16);
        *(GAS unsigned*)(dst + (size_t)(n0 + n) * 2048 + (k0 >> 1) + 4 * c) = o; }
    LDS_WAIT(); asm volatile("" ::: "memory");
}
__device__ __forceinline__ void rms_row_to_bf16(const float* xrow, const float* gain, bf16* orow, unsigned char* orow8, unsigned char* orow4, float* fach, int lane) {
    const GAS f32x4* xr = (const GAS f32x4*)xrow + lane;
    f32x4 v[16]; float s = 0.f;
#pragma unroll
    for (int j = 0; j < 16; ++j) { v[j] = xr[64 * j]; s += (v[j].x * v[j].x + v[j].y * v[j].y) + (v[j].z * v[j].z + v[j].w * v[j].w); }
    const float r = 1.0f / sqrtf(wave_sum(s) * (1.0f / DM) + EPS);
    GAS v2u* o8 = (GAS v2u*)orow + lane; GAS unsigned* o4 = (GAS unsigned*)orow8 + lane; GAS unsigned short* o2 = (GAS unsigned short*)orow4 + lane;
    float sh = 0.f;
#pragma unroll
    for (int j = 0; j < 16; ++j) { const f32x4 gv = ((const GAS f32x4*)gain)[lane + 64 * j]; v[j] = v[j] * r * gv; sh += (v[j].x * v[j].x + v[j].y * v[j].y) + (v[j].z * v[j].z + v[j].w * v[j].w); }
    const float sc = 127.0f / (4.0f * sqrtf(wave_sum(sh) * (1.0f / DM)) + 1e-30f);
#pragma unroll
    for (int j = 0; j < 16; ++j) { const f32x4 y = v[j];
        v2u w; w.x = cvt_pk_bf16(y.x, y.y); w.y = cvt_pk_bf16(y.z, y.w); o8[64 * j] = w;
        o4[64 * j] = q8(y.x * sc) | (q8(y.y * sc) << 8) | (q8(y.z * sc) << 16) | (q8(y.w * sc) << 24);
        o2[64 * j] = (unsigned short)pack4_f4(2.0f * y.x, 2.0f * y.y, 2.0f * y.z, 2.0f * y.w); }
    if (lane == 0) *fach = 1.0f / sc;
}

__device__ __forceinline__ unsigned ordkey(float v) { const unsigned u = __float_as_uint(v); return u ^ ((u >> 31) ? 0xffffffffu : 0x80000000u); }
__device__ __forceinline__ int mbcnt64(unsigned long long m) { return (int)__builtin_amdgcn_mbcnt_hi((unsigned)(m >> 32), __builtin_amdgcn_mbcnt_lo((unsigned)m, 0u)); }

__device__ __forceinline__ int wave_count(int cl) { int c = 0;
#pragma unroll
    for (int b = 0; b < 7; ++b) c += __popcll(__ballot((cl >> b) & 1)) << b;
    return c; }
constexpr int TOPK_WAVE_LDS = 6144;
__device__ __forceinline__ void topk_row(const float* sc, int N, unsigned short* out, LAS unsigned char* wl, int lane) {
    asm volatile("" : "+v"(lane));
    if (N <= TOPK) { v2u w; w.x = (unsigned)(4 * lane) | ((unsigned)(4 * lane + 1) << 16); w.y = (unsigned)(4 * lane + 2) | ((unsigned)(4 * lane + 3) << 16); *(GAS v2u*)(out + 4 * lane) = w; return; }
    LAS unsigned* hist = (LAS unsigned*)wl; LAS unsigned short* stg = (LAS unsigned short*)(wl + 4096);
    LAS unsigned* ckl = (LAS unsigned*)(wl + 4608); LAS unsigned short* cel = (LAS unsigned short*)(wl + 5632);
    const int ng = (N + 1023) >> 10;
    unsigned key[4][16]; int npos = 0;
#pragma unroll
    for (int g = 0; g < 4; ++g) {
#pragma unroll
        for (int j = 0; j < 16; ++j) key[g][j] = 0u;
        if (g < ng) {
            float v_[16];
#pragma unroll
            for (int j = 0; j < 16; ++j) v_[j] = sc[g * 1024 + j * 64 + lane];
            asm volatile("" : "+v"(v_[0]), "+v"(v_[1]), "+v"(v_[2]), "+v"(v_[3]), "+v"(v_[4]), "+v"(v_[5]), "+v"(v_[6]), "+v"(v_[7]), "+v"(v_[8]), "+v"(v_[9]), "+v"(v_[10]), "+v"(v_[11]), "+v"(v_[12]), "+v"(v_[13]), "+v"(v_[14]), "+v"(v_[15]));
#pragma unroll
            for (int j = 0; j < 16; ++j) { const int e = g * 1024 + j * 64 + lane; key[g][j] = e < N ? ordkey(v_[j]) : 0u; }
#pragma unroll
            for (int j = 0; j < 16; ++j) { const bool pos = key[g][j] > 0x80000000u; npos += __popcll(__ballot(pos));
                if (pos) (void)__hip_atomic_fetch_add(hist + (key[g][j] >> 22), 1u << ((key[g][j] >> 17) & 16u), __ATOMIC_RELAXED, __HIP_MEMORY_SCOPE_WORKGROUP); }
        } }
    if (npos < TOPK) {
#pragma unroll
        for (int g = 0; g < 4; ++g) if (g < ng) {
#pragma unroll
            for (int j = 0; j < 16; ++j) if (!(key[g][j] > 0x80000000u)) (void)__hip_atomic_fetch_add(hist + (key[g][j] >> 22), 1u << ((key[g][j] >> 17) & 16u), __ATOMIC_RELAXED, __HIP_MEMORY_SCOPE_WORKGROUP); } }
    unsigned h[32]; unsigned sl = 0u;
    { const LAS v4u* hp = (const LAS v4u*)(hist + 1024 - 16 * (lane + 1));
#pragma unroll
      for (int i = 0; i < 4; ++i) { const v4u t = hp[i];
          h[8 * i] = t.x & 0xffffu; h[8 * i + 1] = t.x >> 16; h[8 * i + 2] = t.y & 0xffffu; h[8 * i + 3] = t.y >> 16; h[8 * i + 4] = t.z & 0xffffu; h[8 * i + 5] = t.z >> 16; h[8 * i + 6] = t.w & 0xffffu; h[8 * i + 7] = t.w >> 16;
          sl += ((t.x & 0xffffu) + (t.x >> 16)) + ((t.y & 0xffffu) + (t.y >> 16)) + ((t.z & 0xffffu) + (t.z >> 16)) + ((t.w & 0xffffu) + (t.w >> 16)); }
      LAS v4u* hz = (LAS v4u*)(hist + 1024 - 16 * (lane + 1));
#pragma unroll
      for (int i = 0; i < 4; ++i) hz[i] = (v4u){0u, 0u, 0u, 0u}; }
    unsigned El = 0u;
#pragma unroll
    for (int b = 0; b < 13; ++b) El += (unsigned)mbcnt64(__ballot((sl >> b) & 1u)) << b;
    int kb = 0; unsigned ab = 0u, cb = 0u; { unsigned acc = El;
#pragma unroll
      for (int k = 31; k >= 0; --k) { const bool hit = acc < (unsigned)TOPK && acc + h[k] >= (unsigned)TOPK; kb = hit ? k : kb; ab = hit ? acc : ab; cb = hit ? h[k] : cb; acc += h[k]; } }
    const int Ls = __ffsll((long long)__ballot(El < (unsigned)TOPK && El + sl >= (unsigned)TOPK)) - 1;
    const unsigned b1 = (unsigned)(2048 - 32 * (Ls + 1) + __builtin_amdgcn_readlane(kb, Ls));
    const int above = (int)__builtin_amdgcn_readlane((int)ab, Ls), C = (int)__builtin_amdgcn_readlane((int)cb, Ls);
    int base = 0;
    if (C <= 256) {
        int cbase = 0;
#pragma unroll
        for (int g = 0; g < 4; ++g) if (g < ng) {
#pragma unroll
            for (int j = 0; j < 16; ++j) { const unsigned d = key[g][j] >> 21; const bool up = d > b1, cd = d == b1;
                const unsigned long long mu = __ballot(up), mc = __ballot(cd);
                if (up) stg[base + mbcnt64(mu)] = (unsigned short)(g * 1024 + j * 64 + lane);
                if (cd) { const int cp = cbase + mbcnt64(mc); ckl[cp] = key[g][j]; cel[cp] = (unsigned short)(g * 1024 + j * 64 + lane); }
                base += __popcll(mu); cbase += __popcll(mc); } }
        LDS_WAIT();
        unsigned ck[4]; unsigned ce[4];
#pragma unroll
        for (int m = 0; m < 4; ++m) { const int i = lane + 64 * m; ck[m] = i < C ? ckl[i] : 0u; ce[m] = cel[i]; }
        const int need = TOPK - above;
        unsigned T = b1 << 21; bool exact = false;
#pragma unroll 1
        for (int bit = 20; bit >= 0; --bit) { const unsigned cand = T | (1u << bit); int c = 0;
#pragma unroll
            for (int m = 0; m < 4; ++m) c += __popcll(__ballot(ck[m] >= cand));
            if (c >= need) { T = cand; if (c == need) { exact = true; break; } } }
        int need_eq = 1 << 30;
        if (!exact) { int cg = 0;
#pragma unroll
            for (int m = 0; m < 4; ++m) cg += __popcll(__ballot(ck[m] > T));
            need_eq = need - cg; }
        int eqb = 0;
#pragma unroll
        for (int m = 0; m < 4; ++m) { const bool gt = ck[m] > T, eq = ck[m] == T && ck[m] != 0u; const unsigned long long meq = __ballot(eq);
            const bool sel = gt || (eq && (eqb + mbcnt64(meq)) < need_eq); const unsigned long long ms = __ballot(sel);
            if (sel) stg[base + mbcnt64(ms)] = (unsigned short)ce[m];
            base += __popcll(ms); eqb += __popcll(meq); }
    } else {
        unsigned T = 0u; bool exact = false;
#pragma unroll 1
        for (int bit = 31; bit >= 0; --bit) {
            const unsigned cand = T | (1u << bit); int c = 0;
#pragma unroll
            for (int g = 0; g < 4; ++g) if (g < ng) {
#pragma unroll
                for (int j = 0; j < 16; ++j) c += __popcll(__ballot(key[g][j] >= cand)); }
            if (c >= TOPK) { T = cand; if (c == TOPK) { exact = true; break; } }
        }
        int need_eq = 1 << 30;
        if (!exact) { int cg = 0;
#pragma unroll
            for (int g = 0; g < 4; ++g) if (g < ng) {
#pragma unroll
                for (int j = 0; j < 16; ++j) cg += __popcll(__ballot(key[g][j] > T)); }
            need_eq = TOPK - cg; }
        int eqb = 0;
#pragma unroll
        for (int g = 0; g < 4; ++g) if (g < ng) {
#pragma unroll
            for (int j = 0; j < 16; ++j) { const bool gt = key[g][j] > T, eq = key[g][j] == T; const unsigned long long meq = __ballot(eq);
                const bool sel = gt || (eq && (eqb + mbcnt64(meq)) < need_eq); const unsigned long long ms = __ballot(sel);
                if (sel) stg[base + mbcnt64(ms)] = (unsigned short)(g * 1024 + j * 64 + lane);
                base += __popcll(ms); eqb += __popcll(meq); } }
    }
    LDS_WAIT();
    *(GAS v2u*)(out + 4 * lane) = *(const LAS v2u*)(stg + 4 * lane);
    LDS_WAIT();
}

#ifndef IDX_SCHED_BARRIER
#define IDX_SCHED_BARRIER 2
#endif
__device__ __forceinline__ void indexer_unit(LAS unsigned char* lds, int tid, int wave, int lane, int b, int qg,
                                             const bf16* QIDX, const bf16* KIDX, const float* WIDX, float* SC, unsigned short* IDX) {
    LAS unsigned char* KT = lds;
    LAS float* WT = (LAS float*)(lds + 65536);
    asm volatile("" : "+v"(lane), "+v"(tid));
    const int q0 = qg * 32, nkeys = q0 + 32, r = lane & 31, hh = lane >> 5;
    const size_t rowb = (size_t)b * SEQ;
    __syncthreads();
    const int hl = lane & 15, g = lane >> 4;
    bf16x8 A[4][2][4]; f32x4 W4[4][2];
#pragma unroll
    for (int qi = 0; qi < 4; ++qi)
#pragma unroll
        for (int hf = 0; hf < 2; ++hf) { W4[qi][hf] = *(const GAS f32x4*)(WIDX + (rowb + q0 + 4 * wave + qi) * 32 + 16 * hf + 4 * g);
#pragma unroll
            for (int kk = 0; kk < 4; ++kk) A[qi][hf][kk] = *(const GAS bf16x8*)(QIDX + (rowb + q0 + 4 * wave + qi) * 4096 + (16 * hf + hl) * 128 + 32 * kk + 8 * g); }
    const int nch = (nkeys + 127) >> 7;
    const int srow = 16 * wave + (lane >> 4), slot = lane & 15;
#define IDX_STAGE(ch_, buf_) do { _Pragma("unroll") for (int i_ = 0; i_ < 4; ++i_) { const int krow_ = srow + 4 * i_; \
        __builtin_amdgcn_global_load_lds((const GAS unsigned*)(KIDX + (rowb + (ch_) * 128 + krow_) * 128 + ((slot ^ (krow_ & 15)) << 3)), (LAS unsigned*)((buf_) + (16 * wave + 4 * i_) * 256), 16, 0, 0); } } while (0)
    IDX_STAGE(0, KT);
    for (int ch = 0; ch < nch; ++ch) {
        LAS unsigned char* buf = KT + (ch & 1) * 32768;
        if (ch == 0) VM_WAIT(); else asm volatile("s_waitcnt vmcnt(16)" ::: "memory");
        __syncthreads();
        if (ch + 1 < nch) IDX_STAGE(ch + 1, KT + ((ch + 1) & 1) * 32768);
        const int rem = (nkeys - ch * 128) >> 5, ntile = rem < 4 ? rem : 4;
        for (int tile = 0; tile < ntile; ++tile) {
            bf16x8 Bf[2][4];
#pragma unroll
            for (int st = 0; st < 2; ++st)
#pragma unroll
                for (int kk = 0; kk < 4; ++kk) Bf[st][kk] = *(const LAS bf16x8*)(buf + (tile * 32 + 16 * st + hl) * 256 + (((4 * kk + g) ^ hl) << 4));
            const int key = ch * 128 + tile * 32 + 16 * (g & 1) + hl;
#pragma unroll
            for (int qi = 0; qi < 4; ++qi) {
                float s2[2];
#pragma unroll
                for (int st = 0; st < 2; ++st) { f32x4 a0 = {0.f, 0.f, 0.f, 0.f}, a1 = {0.f, 0.f, 0.f, 0.f};
#pragma unroll
                    for (int kk = 0; kk < 4; ++kk) { a0 = __builtin_amdgcn_mfma_f32_16x16x32_bf16(A[qi][0][kk], Bf[st][kk], a0, 0, 0, 0); a1 = __builtin_amdgcn_mfma_f32_16x16x32_bf16(A[qi][1][kk], Bf[st][kk], a1, 0, 0, 0); }
                    float sc = 0.f;
#pragma unroll
                    for (int i = 0; i < 4; ++i) sc += fmaxf(a0[i], 0.f) * W4[qi][0][i] + fmaxf(a1[i], 0.f) * W4[qi][1][i];
                    s2[st] = sc; }
                float tt; { const auto p16 = __builtin_amdgcn_permlane16_swap(__float_as_uint(s2[0]), __float_as_uint(s2[1]), false, false); tt = __uint_as_float(p16[0]) + __uint_as_float(p16[1]);
                            const auto p32 = __builtin_amdgcn_permlane32_swap(__float_as_uint(tt), __float_as_uint(tt), false, false); tt = __uint_as_float(p32[0]) + __uint_as_float(p32[1]); }
                const int qpos = q0 + 4 * wave + qi;
                if (g < 2) SC[(rowb + qpos) * 4096 + key] = tt;
                if (IDX_SCHED_BARRIER == 1 || (IDX_SCHED_BARRIER == 2 && (qi & 1))) __builtin_amdgcn_sched_barrier(0);
            }
        }
    }
#undef IDX_STAGE
    VM_WAIT();
#ifndef DUP_TOPK
#define DUP_TOPK 1
#endif
#pragma unroll 1
    for (int qi = 0; qi < 4 * DUP_TOPK; ++qi) { const int qpos = q0 + 4 * wave + (qi & 3); topk_row(SC + (rowb + qpos) * 4096, qpos + 1, IDX + (rowb + qpos) * 256, lds + 69632 + wave * TOPK_WAVE_LDS, lane); }
}

__device__ __forceinline__ void sgu_unit(LAS unsigned char* lds, int tid, int wave, int lane, int cidx, int grp,
                                         const bf16* UV, const float* LNP, const bf16* SGUW, const float* lng, const float* lnb, const float* sgub, bf16* YAB) {
    constexpr int VP = 544, WP = 272;
    LAS unsigned char* VN = lds;
    LAS unsigned char* WL = lds + 128 * VP;
    LAS float* ST = (LAS float*)(lds + 128 * VP + 128 * WP);
    const int t0 = cidx * 128;
    __syncthreads();
    if (tid < 128) { float s = 0.f, q = 0.f;
#pragma unroll
        for (int i = 0; i < 8; ++i) { const GAS f32x4* p = (const GAS f32x4*)(LNP + ((size_t)i * MTOK + t0 + tid) * 8); const f32x4 a = p[0], b = p[1]; s += (a[0] + a[2]) + (b[0] + b[2]); q += (a[1] + a[3]) + (b[1] + b[3]); }
        const float mean = s * (1.0f / GWID), var = q * (1.0f / GWID) - mean * mean;
        ST[2 * tid] = mean; ST[2 * tid + 1] = 1.0f / sqrtf(var + EPS); }
#pragma unroll
    for (int i = 0; i < 4; ++i) { const int c = (tid & 3) * 4 + i; *(LAS v4u*)(WL + (tid >> 2) * WP + c * 16) = *(const GAS v4u*)(SGUW + ((size_t)grp * 128 + (tid >> 2)) * 128 + c * 8); }
    __syncthreads();
#pragma unroll
    for (int i = 0; i < 8; ++i) { const int id = tid + 512 * i, s = id >> 5, dc = id & 31;
        const v4u w = *(const GAS v4u*)(UV + (size_t)(t0 + s) * 4096 + GWID + grp * GDIM + dc * 8); f32x4 v0, v1; unpack8(w, v0, v1);
        const float mean = ST[2 * s], rstd = ST[2 * s + 1];
        const f32x4 g0 = *(const GAS f32x4*)(lng + grp * GDIM + dc * 8), g1 = *(const GAS f32x4*)(lng + grp * GDIM + dc * 8 + 4);
        const f32x4 b0 = *(const GAS f32x4*)(lnb + grp * GDIM + dc * 8), b1 = *(const GAS f32x4*)(lnb + grp * GDIM + dc * 8 + 4);
        v0 = (v0 - mean) * rstd * g0 + b0; v1 = (v1 - mean) * rstd * g1 + b1;
        *(LAS v4u*)(VN + s * VP + dc * 16) = pack8(v0, v1); }
    __syncthreads();
    const int g = lane >> 4, hl = lane & 15, q = hl >> 2, p = lane & 3;
    f32x4 acc[2][8];
#pragma unroll
    for (int a = 0; a < 2; ++a)
#pragma unroll
        for (int t = 0; t < 8; ++t) acc[a][t] = (f32x4){0.f, 0.f, 0.f, 0.f};
#pragma unroll
    for (int ks = 0; ks < 4; ++ks) {
        bf16x8 vf[2];
#pragma unroll
        for (int ds = 0; ds < 2; ++ds) { const int d0 = (2 * wave + ds) * 16;
            const s16x4 a1 = __builtin_amdgcn_ds_read_tr16_b64_v4i16((LAS s16x4*)(VN + (32 * ks + 4 * g + q) * VP + (d0 + 4 * p) * 2));
            const s16x4 a2 = __builtin_amdgcn_ds_read_tr16_b64_v4i16((LAS s16x4*)(VN + (32 * ks + 16 + 4 * g + q) * VP + (d0 + 4 * p) * 2));
            vf[ds] = (bf16x8){a1[0], a1[1], a1[2], a1[3], a2[0], a2[1], a2[2], a2[3]}; }
#pragma unroll
        for (int tt = 0; tt < 8; ++tt) if (tt >= 2 * ks) {
            const int t = 16 * tt + hl;
            const s16x4 w1 = *(const LAS s16x4*)(WL + t * WP + (32 * ks + 4 * g) * 2), w2 = *(const LAS s16x4*)(WL + t * WP + (32 * ks + 16 + 4 * g) * 2);
            const bf16x8 wf = (bf16x8){w1[0], w1[1], w1[2], w1[3], w2[0], w2[1], w2[2], w2[3]};
#pragma unroll
            for (int ds = 0; ds < 2; ++ds) acc[ds][tt] = __builtin_amdgcn_mfma_f32_16x16x32_bf16(vf[ds], wf, acc[ds][tt], 0, 0, 0);
        }
    }
#pragma unroll
    for (int tt = 0; tt < 8; ++tt) { const int t = 16 * tt + hl; const float bs = sgub[grp * 128 + t]; const size_t rowo = (size_t)(t0 + t) * 4096;
#pragma unroll
        for (int ds = 0; ds < 2; ++ds) { const int d = grp * GDIM + (2 * wave + ds) * 16 + 4 * g;
            const v2u uw = *(const GAS v2u*)(UV + rowo + d);
            v2u o; o.x = cvt_pk_bf16(bf_lo(uw.x) * (acc[ds][tt][0] + bs), bf_hi(uw.x) * (acc[ds][tt][1] + bs)); o.y = cvt_pk_bf16(bf_lo(uw.y) * (acc[ds][tt][2] + bs), bf_hi(uw.y) * (acc[ds][tt][3] + bs));
            *(GAS v2u*)(YAB + (size_t)(t0 + t) * GWID + d) = o; } }
}

#ifndef KB_T
#define KB_T 4
#endif
constexpr int ATT_VB = 32 * 288, ATT_WAVE = ATT_VB + 512, ATT_BL = 8 * ATT_WAVE;
__device__ __forceinline__ void attn_query(LAS unsigned char* wl, const LAS float* BL, int lane, int b, int qpos,
                                           const bf16* Q, const bf16* KN, const bf16* V, const unsigned short* IDX, const float* qgain, bf16* YAB) {
    const int g = lane >> 4, hl = lane & 15, q4 = hl >> 2, p4 = lane & 3;
    const size_t rowb = (size_t)b * SEQ, row = rowb + qpos;
    const int cnt = qpos + 1 < TOPK ? qpos + 1 : TOPK;
    LAS unsigned short* IL = (LAS unsigned short*)(wl + ATT_VB);
    *(LAS v2u*)(IL + 4 * lane) = *(const GAS v2u*)(IDX + row * 256 + 4 * lane);
    bf16x8 qf[4];
    { v2u w[4]; float ss = 0.f;
#pragma unroll
      for (int kk = 0; kk < 4; ++kk) { w[kk] = *(const GAS v2u*)((const unsigned char*)Q + row * 2048 + hl * 128 + kk * 32 + g * 8); f32x4 a, c; unpack8_f8(w[kk], a, c);
          ss += (a[0] * a[0] + a[1] * a[1]) + (a[2] * a[2] + a[3] * a[3]) + (c[0] * c[0] + c[1] * c[1]) + (c[2] * c[2] + c[3] * c[3]); }
      ss += __shfl_xor(ss, 16); ss += __shfl_xor(ss, 32);
      const float rinv = (1.0f / sqrtf(ss * (1.0f / HDA) + EPS)) * 0.08838834764831845f;
#pragma unroll
      for (int kk = 0; kk < 4; ++kk) { f32x4 a, c; unpack8_f8(w[kk], a, c); const f32x4 g0 = *(const GAS f32x4*)(qgain + kk * 32 + g * 8), g1 = *(const GAS f32x4*)(qgain + kk * 32 + g * 8 + 4);
          const v4u o = pack8(a * rinv * g0, c * rinv * g1); qf[kk] = __builtin_bit_cast(bf16x8, o); } }
    f32x4 s[16];
#pragma unroll
    for (int hf = 0; hf < 16 / KB_T; ++hf) {
        bf16x8 kf[KB_T][4];
#pragma unroll
        for (int t8 = 0; t8 < KB_T; ++t8) { const int ki = IL[16 * (KB_T * hf + t8) + hl] & (SEQ - 1); const bf16* kp = KN + (rowb + ki) * 128 + g * 8;
#pragma unroll
            for (int kk = 0; kk < 4; ++kk) kf[t8][kk] = *(const GAS bf16x8*)(kp + kk * 32); }
        __builtin_amdgcn_sched_barrier(0);
#pragma unroll
        for (int t8 = 0; t8 < KB_T; ++t8) { const int t = KB_T * hf + t8; s[t] = (f32x4){0.f, 0.f, 0.f, 0.f};
#pragma unroll
            for (int kk = 0; kk < 4; ++kk) s[t] = __builtin_amdgcn_mfma_f32_16x16x32_bf16(kf[t8][kk], qf[kk], s[t], 0, 0, 0); }
    }
    float mx = -__builtin_inff();
#pragma unroll
    for (int t = 0; t < 16; ++t) { const v2u id = *(const LAS v2u*)(IL + 16 * t + 4 * g); const int kx[4] = {(int)(id.x & 0xffffu), (int)(id.x >> 16), (int)(id.y & 0xffffu), (int)(id.y >> 16)};
#pragma unroll
        for (int i = 0; i < 4; ++i) { int n = qpos - kx[i]; n = n < 0 ? 0 : (n > 128 ? 128 : n);
            const float v = (16 * t + 4 * g + i) < cnt ? s[t][i] + BL[n * 16 + hl] : -__builtin_inff(); s[t][i] = v; mx = fmaxf(mx, v); } }
    mx = fmaxf(mx, __shfl_xor(mx, 16)); mx = fmaxf(mx, __shfl_xor(mx, 32));
    float sum = 0.f;
#pragma unroll
    for (int t = 0; t < 16; ++t)
#pragma unroll
        for (int i = 0; i < 4; ++i) { const float e = __builtin_amdgcn_exp2f((s[t][i] - mx) * LOG2E); s[t][i] = e; sum += e; }
    sum += __shfl_xor(sum, 16); sum += __shfl_xor(sum, 32);
    const float inv = 1.0f / sum;
    bf16x8 pf[8];
#pragma unroll
    for (int T = 0; T < 8; ++T) { const v4u o = pack8(s[2 * T] * inv, s[2 * T + 1] * inv); pf[T] = __builtin_bit_cast(bf16x8, o); }
    f32x4 o[8];
#pragma unroll
    for (int dt = 0; dt < 8; ++dt) o[dt] = (f32x4){0.f, 0.f, 0.f, 0.f};
    v4u vn[8];
#pragma unroll
    for (int ins = 0; ins < 8; ++ins) { const int vi = IL[4 * ins + g] & (SEQ - 1); vn[ins] = *(const GAS v4u*)(V + (rowb + vi) * 128 + hl * 8); }
#pragma unroll
    for (int T = 0; T < 8; ++T) {
#pragma unroll
        for (int ins = 0; ins < 8; ++ins) *(LAS v4u*)(wl + (4 * ins + g) * 288 + hl * 16) = vn[ins];
        if (T < 7) {
#pragma unroll
            for (int ins = 0; ins < 8; ++ins) { const int vi = IL[32 * (T + 1) + 4 * ins + g] & (SEQ - 1); vn[ins] = *(const GAS v4u*)(V + (rowb + vi) * 128 + hl * 8); } }
        __builtin_amdgcn_sched_barrier(0);
#pragma unroll
        for (int dt = 0; dt < 8; ++dt) {
            const s16x4 a1 = __builtin_amdgcn_ds_read_tr16_b64_v4i16((LAS s16x4*)(wl + (4 * g + q4) * 288 + (16 * dt + 4 * p4) * 2));
            const s16x4 a2 = __builtin_amdgcn_ds_read_tr16_b64_v4i16((LAS s16x4*)(wl + (16 + 4 * g + q4) * 288 + (16 * dt + 4 * p4) * 2));
            const bf16x8 vf = (bf16x8){a1[0], a1[1], a1[2], a1[3], a2[0], a2[1], a2[2], a2[3]};
            o[dt] = __builtin_amdgcn_mfma_f32_16x16x32_bf16(vf, pf[T], o[dt], 0, 0, 0);
        }
    }
#pragma unroll
    for (int dt = 0; dt < 8; ++dt)
        *(GAS unsigned*)((unsigned char*)YAB + row * 2048 + hl * 128 + 16 * dt + 4 * g) = (unsigned)__builtin_amdgcn_cvt_pk_fp8_f32(o[dt][2], o[dt][3], __builtin_amdgcn_cvt_pk_fp8_f32(o[dt][0], o[dt][1], 0, false), true);
}

constexpr int NWAVES = 8;
#ifndef DUP_ATT
#define DUP_ATT 1
#endif
#ifndef DUP_SGU
#define DUP_SGU 1
#endif
#ifndef GEMM_SP2
#define GEMM_SP2 true
#endif
#ifndef GEMM_ALIGN
#define GEMM_ALIGN true
#endif
#ifndef MK_N_LAUNCHES
#define MK_N_LAUNCHES 1
#endif
constexpr int N_PHASES = 9;
constexpr int N_LAUNCHES = MK_N_LAUNCHES;
constexpr size_t WS_PB = WS_END;
constexpr size_t WS_NEED = WS_END + 8 * MiB;

__device__ __forceinline__ int lane_now() { int l; asm volatile("v_mbcnt_lo_u32_b32 %0, -1, 0\n\tv_mbcnt_hi_u32_b32 %0, -1, %0" : "=v"(l)); return l; }
struct Args { const float* in[22]; float* out; unsigned char* ws; int ph_lo, ph_hi, li, pad; };
enum { I_X = 0, I_P, I_WIN, I_QNG, I_KNG, I_RELB, I_LNG, I_LNB, I_SGUW, I_SGUB, I_WA, I_WB, I_WOUT, I_NMIX, I_NFFN, I_WG, I_WU, I_WD, I_WPLE, I_PLENG, I_WPG, I_NPLE };

__global__ void __launch_bounds__(NWAVES * 64, 2) fwd_kernel(Args args) {
    extern __shared__ __attribute__((aligned(16))) unsigned char lds_raw[];
    LAS unsigned char* lds = (LAS unsigned char*)lds_raw;
    volatile LAS unsigned* MISC = (volatile LAS unsigned*)(lds + MISC_OFF);
    const int wave = __builtin_amdgcn_readfirstlane(threadIdx.x >> 6);
#define PHASE_IDS() const int lane = lane_now(), tid = wave * 64 + lane
    const int G = gridDim.x, cu = blockIdx.x;
    const int gw = cu * NWAVES + wave, NGW = G * NWAVES;
    unsigned char* ws = args.ws;
    gu32* ctl = (gu32*)(ws + WS_CTL);
    for (int u = threadIdx.x; u < (LDS_BYTES - LDSCTL_OFF) / 4; u += NWAVES * 64) ((LAS unsigned*)(lds + LDSCTL_OFF))[u] = 0u;
    __syncthreads();
    { const unsigned t_ = threadIdx.x; volatile LAS float* sm_ = (volatile LAS float*)(lds + RING_OFF);
      const float* wi_ = args.in[I_WIN] + (size_t)(8 * t_) * INCOLS + 10656; const int ci_ = (int)((t_ * 37u) & 4095u);
      const float* wg_ = args.in[I_WG] + (size_t)(8 * t_) * DFF; const float* wu_ = args.in[I_WU] + (size_t)(8 * t_) * DFF; const int cg_ = (int)((t_ * 37u) % 5504u);
      const float* wo_ = args.in[I_WOUT] + (size_t)(8 * t_) * DM; const float* wp_ = args.in[I_WPG] + (size_t)(8 * t_) * DM; const float* wd_ = args.in[I_WD] + (size_t)(8 * t_) * DM;
      sm_[t_] = fabsf(wi_[ci_]) + fabsf(wi_[(ci_ + 2048) & 4095]); sm_[512 + t_] = fabsf(wg_[cg_]) + fabsf(wg_[cg_ + 5504]); sm_[1024 + t_] = fabsf(wu_[cg_]) + fabsf(wu_[cg_ + 5504]); sm_[1536 + t_] = fabsf(wo_[ci_]) + fabsf(wo_[(ci_ + 2048) & 4095]); sm_[2048 + t_] = fabsf(wp_[ci_]) + fabsf(wp_[(ci_ + 2048) & 4095]); sm_[2560 + t_] = fabsf(wd_[ci_]) + fabsf(wd_[(ci_ + 2048) & 4095]);
      __syncthreads();
      if (t_ < 48) { float a_ = 0.f; for (int i = 0; i < 64; ++i) a_ += sm_[(t_ >> 3) * 512 + (t_ & 7) * 64 + i]; sm_[3072 + t_] = a_; }
      __syncthreads();
      if (t_ == 0) { float s0_ = 0.f, s1_ = 0.f, s2_ = 0.f, s3_ = 0.f, s4_ = 0.f; float s5_ = 0.f; for (int i = 0; i < 8; ++i) { s0_ += sm_[3072 + i]; s1_ += sm_[3080 + i]; s2_ += sm_[3088 + i]; s3_ += sm_[3096 + i]; s4_ += sm_[3104 + i]; s5_ += sm_[3112 + i]; }
          MISC[22] = __float_as_uint(127.0f / (4.0f * 1.2533141f * fmaxf(s5_, 1e-30f) * (1.0f / 1024.0f)));
          MISC[20] = __float_as_uint(127.0f / (4.0f * 1.2533141f * fmaxf(s3_, 1e-30f) * (1.0f / 1024.0f))); MISC[21] = __float_as_uint(127.0f / (4.0f * 1.2533141f * fmaxf(s4_, 1e-30f) * (1.0f / 1024.0f)));
          int e_ = (int)rintf(__log2f(1.596f * 1024.0f / fmaxf(s0_, 1e-30f))); e_ = e_ < -40 ? -40 : (e_ > 60 ? 60 : e_); MISC[12] = (unsigned)e_;
          MISC[15] = __float_as_uint(127.0f / (4.0f * 1.2533141f * fmaxf(s0_, 1e-30f) * (1.0f / 1024.0f)));
          MISC[13] = __float_as_uint(127.0f / (4.0f * 1.2533141f * fmaxf(s1_, 1e-30f) * (1.0f / 1024.0f))); MISC[14] = __float_as_uint(127.0f / (4.0f * 1.2533141f * fmaxf(s2_, 1e-30f) * (1.0f / 1024.0f))); }
      __syncthreads(); }
    XcdBarrier bar; bar.bar = (unsigned*)(ctl + CW_BAR) + args.li * XCD_BAR_WORDS; bar.x = 0; bar.st = nullptr;
    if (N_LAUNCHES == 1) bar = xcd_barrier_post((unsigned*)(ctl + CW_BAR), MISC + 8);
#define GRID_BAR() do { if (N_LAUNCHES == 1) xcd_barrier(bar); } while (0)
    const int lo = args.ph_lo, hi = args.ph_hi;
#ifndef PH_MASK
#define PH_MASK 0x1ff
#endif
#define IN(k) ((((PH_MASK) >> (k)) & 1) && lo <= (k) && (k) < hi)
#define BOTH(k) (IN(k) && IN((k) + 1))
#ifndef DUP_MASK
#define DUP_MASK 0
#endif
#define REPS(k) (1 + (((DUP_MASK) >> (k)) & 1))

    bf16* const H = (bf16*)(ws + WS_H); bf16* const WINB = (bf16*)(ws + WS_WINB); unsigned char* const WIN8 = ws + WS_WIN8; unsigned char* const W4 = ws + WS_WIN8 + 57 * MiB; unsigned char* const H8 = ws + WS_H8; float* const FACH = (float*)(ws + WS_SSQ2);     unsigned char* const H4 = ws + WS_SGA + 64 * MiB;     bf16* const QIDX = (bf16*)(ws + WS_QIDX); bf16* const Qb = (bf16*)(ws + WS_Q);
    bf16* const UV = (bf16*)(ws + WS_UV); bf16* const SGA = (bf16*)(ws + WS_SGA); bf16* const SGB = (bf16*)(ws + WS_SGB);
    unsigned char* const WA8 = ws + WS_WAB; bf16* const WBB = (bf16*)(ws + WS_WAB + 8 * MiB);     bf16* const WOUT = (bf16*)(ws + WS_WOUT); bf16* const WGU = (bf16*)(ws + WS_WGU); bf16* const WD = (bf16*)(ws + WS_WD);
    bf16* const WPLE = (bf16*)(ws + WS_WPLE); bf16* const WPG = (bf16*)(ws + WS_WPG); bf16* const PB = (bf16*)(ws + WS_PB);
    unsigned short* const IDX = (unsigned short*)(ws + WS_IDX); float* const LNP = (float*)(ws + WS_LNP);
    float* const SSQ1 = (float*)(ws + WS_SSQ1); float* const SSQ2 = (float*)(ws + WS_SSQ2); float* const SSQP = (float*)(ws + WS_SSQP);
    float* const WIDX = (float*)(ws + WS_WIDX); bf16* const KIDX = (bf16*)(ws + WS_KIDX); bf16* const KN = (bf16*)(ws + WS_KN); bf16* const Vb = (bf16*)(ws + WS_V);
    float* const KRAW = (float*)(ws + WS_KRAW); bf16* const SGUW = (bf16*)(ws + WS_SGUW);
    float* const SC = (float*)(ws + WS_SC); bf16* const MERGED = (bf16*)(ws + WS_MERGED); unsigned char* const T8 = ws + WS_MERGED + 128 * MiB;     bf16* const ACT = (bf16*)(ws + WS_ACT); unsigned char* const ACT8 = ws + WS_ACT; unsigned char* const WD8 = ws + WS_Q;     bf16* const YB = (bf16*)(ws + WS_YAB); unsigned char* const YA8 = ws + WS_YAB + 64 * MiB;
    bf16* const X1R = (bf16*)(ws + WS_SGB); bf16* const X2R = (bf16*)(ws + WS_WGU);     bf16* const X1G = (bf16*)(ws + WS_X1G); bf16* const X2G = (bf16*)(ws + WS_X2G); bf16* const PE = (bf16*)(ws + WS_PE);


    constexpr int I_IN = 64 * (INCOLS / 32), I_A = 32 * 128, I_SQ = 64 * 128, I_G = 64 * (DFF / 32), I_D = (DFF / 64) * 128, I_PL = 4 * 128;
    constexpr int NITEMS = I_IN + 2 * I_A + I_SQ + I_PL + 2 * I_G + I_D + I_SQ;
    constexpr int TAIL_A = 15104, TAIL_B = 15104, TAIL_U = 22016;
    static_assert(TAIL_A + TAIL_B <= I_D + I_SQ && TAIL_U <= I_G, "deferred item ranges");
#define CONV_SRC(it_, r_) do { int r_ = (it_); const float* W_; int N_; \
        if (r_ < I_IN) { W_ = args.in[I_WIN]; N_ = INCOLS; } else { r_ -= I_IN; \
        if (r_ < I_A) { W_ = args.in[I_WA]; N_ = DM; } else { r_ -= I_A; \
        if (r_ < I_A) { W_ = args.in[I_WB]; N_ = DM; } else { r_ -= I_A; \
        if (r_ < I_SQ) { W_ = args.in[I_WOUT]; N_ = DM; } else { r_ -= I_SQ; \
        if (r_ < I_PL) { W_ = args.in[I_WPLE]; N_ = DM; } else { r_ -= I_PL; \
        if (r_ < I_G) { W_ = args.in[I_WG]; N_ = DFF; } else { r_ -= I_G; \
        if (r_ < I_G) { W_ = args.in[I_WU]; N_ = DFF; } else { r_ -= I_G; \
        if (r_ < I_D) { W_ = args.in[I_WD]; N_ = DM; } else { r_ -= I_D; W_ = args.in[I_WPG]; N_ = DM; } } } } } } } } \
        p0_load(W_, N_, r_, nx, lane); } while (0)
#define CONV_ITEMS(first_, last_, widx_, wstride_) do { LAS float* scr = (LAS float*)(lds + RING_OFF + wave * 16384); f32x4 nx[8], cr[8]; \
        const int i0_ = (first_) + (widx_), iend_ = (last_), ist_ = (wstride_); \
        if (i0_ < iend_) CONV_SRC(i0_, ra_); \
        for (int it = i0_; it < iend_; it += ist_) { \
            _Pragma("unroll") for (int i = 0; i < 8; ++i) cr[i] = nx[i]; \
            asm volatile("" ::: "memory"); \
            if (it + ist_ < iend_) CONV_SRC(it + ist_, rb_); \
            int r = it; \
            if (r < I_IN) { const int nb_ = r % (INCOLS / 32); if (nb_ >= 200 && nb_ < 205) p0_finish<1>(cr, INCOLS, WINB, DM, 0, scr, r, lane); else if (nb_ >= 333 && nb_ < 461) p0_finish4(cr, INCOLS, W4, __uint_as_float((unsigned)(127 + (int)MISC[12]) << 23), scr, r, lane); else p0_finish_i8<4>(cr, INCOLS, WIN8, DM, __uint_as_float(MISC[15]), scr, r, lane); continue; } r -= I_IN; \
            if (r < I_A) { p0_finish8<0>(cr, DM, WA8, 2048, scr, r, lane); continue; } r -= I_A; \
            if (r < I_A) { p0_finish<0>(cr, DM, WBB, 2048, 0, scr, r, lane); continue; } r -= I_A; \
            if (r < I_SQ) { p0_finish_i8h(cr, DM, (unsigned char*)WOUT, DM, __uint_as_float(MISC[20]), scr, r, lane); continue; } r -= I_SQ; \
            if (r < I_PL) { p0_finish<0>(cr, DM, WPLE, DPLE, 0, scr, r, lane); continue; } r -= I_PL; \
            if (r < I_G) { p0_finish_i8<2>(cr, DFF, (unsigned char*)WGU, DM, __uint_as_float(MISC[13]), scr, r, lane); continue; } r -= I_G; \
            if (r < I_G) { p0_finish_i8<3>(cr, DFF, (unsigned char*)WGU, DM, __uint_as_float(MISC[14]), scr, r, lane); continue; } r -= I_G; \
            if (r < I_D) { if (P7F < 64) p0_finish<0>(cr, DM, WD, DFF, 0, scr, r, lane); if (P7F > 0) p0_finish_i8h(cr, DM, WD8, DFF, __uint_as_float(MISC[22]), scr, r, lane); continue; } r -= I_D; \
            p0_finish_i8<0>(cr, DM, (unsigned char*)WPG, DM, __uint_as_float(MISC[21]), scr, r, lane); } } while (0)
#define CONV_TAIL(nwg_, first_, last_) do { const int rem_ = (nwg_) % G; if (rem_ == 0) CONV_ITEMS(first_, last_, gw, NGW); \
        else if (cu >= rem_) CONV_ITEMS(first_, last_, (cu - rem_) * NWAVES + wave, (G - rem_) * NWAVES); } while (0)
    if (IN(0)) {
#pragma unroll
      for (int rep = 0; rep < REPS(0); ++rep) {
        PHASE_IDS();
        CONV_ITEMS(0, NITEMS - TAIL_A - TAIL_B - TAIL_U, gw, NGW);
        for (int m = gw; m < MTOK; m += NGW) rms_row_to_bf16(args.in[I_X] + (size_t)m * DM, args.in[I_NMIX], H + (size_t)m * DM, H8 + (size_t)m * DM, H4 + (size_t)m * (DM / 2), FACH + m, lane);
        { const float* P = args.in[I_P]; const int gt = cu * 512 + tid, NT = G * 512;
          for (int i = gt; i < MTOK * DPLE / 4; i += NT) { const f32x4 v = *(const GAS f32x4*)(P + (size_t)i * 4); v2u w; w.x = cvt_pk_bf16(v.x, v.y); w.y = cvt_pk_bf16(v.z, v.w); *(GAS v2u*)(PB + (size_t)i * 4) = w; }
          const float* SW = args.in[I_SGUW];
          for (int i = gt; i < NGRP * CHK * CHK / 2; i += NT) { const int e = 2 * i, t = (e >> 7) & 127, s = e & 127; const f32x2 v = *(const GAS f32x2*)(SW + e);
              *(GAS unsigned*)(SGUW + e) = cvt_pk_bf16(s <= t ? v.x : 0.f, (s + 1) <= t ? v.y : 0.f); } }
        if (rep + 1 < REPS(0) || BOTH(0)) GRID_BAR();
      }
    }

    if (IN(1)) {
#pragma unroll
      for (int rep = 0; rep < REPS(1); ++rep) {
        PHASE_IDS();
        { pg8::Gemm g{(const bf16*)H4, (const bf16*)W4, MTOK, 16 * 256, DM / 4}; pg8::BlockOrder S; S.init(MTOK, 16 * 256, G, cu);
          pg8::EpiInProjT<2> E{Qb, Vb, QIDX, KIDX, UV, SGA, SGB, KRAW, WIDX, LNP, nullptr, 1.0f};
          pg8::gemm_phase<pg8::EpiInProjT<2>, pg8::BlockOrder, GEMM_ALIGN, GEMM_SP2, false, true>(lds + RING_OFF, g, S, E, tid, 127 - (int)MISC[12]); }
        { pg8::Gemm g{(const bf16*)H8, (const bf16*)WIN8, MTOK, 57 * 256, DM / 2}; pg8::BlockOrder S; S.init(MTOK, 57 * 256, G, cu);
          const float isw_ = __uint_as_float(__builtin_amdgcn_readfirstlane(__float_as_uint(1.0f / __uint_as_float(MISC[15]))));
          pg8::EpiInProjT<0> E{Qb, Vb, QIDX, KIDX, UV, SGA, SGB, KRAW, WIDX, LNP, FACH, isw_};
          pg8::gemm_phase<pg8::EpiInProjT<0>, pg8::BlockOrder, GEMM_ALIGN, GEMM_SP2, false, false, true>(lds + RING_OFF, g, S, E, tid); }
        { pg8::Gemm g{H, WINB, MTOK, 1 * 256, DM}; pg8::BlockOrder S; S.init(MTOK, 1 * 256, G, G - 1 - cu);
          pg8::EpiInProjT<1> E{Qb, Vb, QIDX, KIDX, UV, SGA, SGB, KRAW, WIDX, LNP, nullptr, 1.0f};
          pg8::gemm_phase<pg8::EpiInProjT<1>, pg8::BlockOrder, GEMM_ALIGN, GEMM_SP2>(lds + RING_OFF, g, S, E, tid); }
        if (rep == 0) { const int rem_ = ((MTOK / 256) * 1) % G;
            if (rem_ == 0) CONV_ITEMS(NITEMS - TAIL_A - TAIL_B - TAIL_U, NITEMS - TAIL_A - TAIL_B, gw, NGW);
            else if (G - 1 - cu >= rem_) CONV_ITEMS(NITEMS - TAIL_A - TAIL_B - TAIL_U, NITEMS - TAIL_A - TAIL_B, (G - 1 - cu - rem_) * NWAVES + wave, (G - rem_) * NWAVES); }
        if (rep + 1 < REPS(1) || BOTH(1)) GRID_BAR();
      }
    }

#if defined(NULL_GEMM)
    if (IN(1)) { PHASE_IDS();
        pg8::Gemm g{H, WIN, MTOK, NULL_GEMM * 256, DM}; pg8::BlockOrder S; S.init(MTOK, NULL_GEMM * 256, G, cu);
        pg8::EpiNull E{SSQP};
        pg8::gemm_phase<pg8::EpiNull, pg8::BlockOrder, GEMM_ALIGN, GEMM_SP2>(lds + RING_OFF, g, S, E, tid);
        GRID_BAR(); }
#endif
    if (IN(2)) {
#pragma unroll
      for (int rep = 0; rep < REPS(2); ++rep) {
        PHASE_IDS();
        { const float* kg = args.in[I_KNG];
          for (int rp = gw; rp < MTOK / 2; rp += NGW) { const int row = 2 * rp + (lane >> 5), c = (lane & 31) * 4;
              const f32x4 v = *(const GAS f32x4*)(KRAW + (size_t)row * 128 + c); float ss = (v.x * v.x + v.y * v.y) + (v.z * v.z + v.w * v.w);
#pragma unroll
              for (int o = 1; o < 32; o <<= 1) ss += __shfl_xor(ss, o);
              const float r = 1.0f / sqrtf(ss * (1.0f / HDA) + EPS); const f32x4 gv = *(const GAS f32x4*)(kg + c);
              v2u w; w.x = cvt_pk_bf16(v.x * r * gv.x, v.y * r * gv.y); w.y = cvt_pk_bf16(v.z * r * gv.z, v.w * r * gv.w); *(GAS v2u*)(KN + (size_t)row * 128 + c) = w; } }
        for (int i = tid; i < 8 * TOPK_WAVE_LDS / 16; i += NWAVES * 64) *(LAS v4u*)(lds + RING_OFF + 69632 + i * 16) = (v4u){0u, 0u, 0u, 0u};
        constexpr int NU = NB * (SEQ / 32);
        for (int j = cu; j < NU; j += G) { const int rnd = j / G, pos = j % G; int u;
            if ((rnd & 1) == 0) u = j; else { const int hiu = (rnd + 1) * G < NU ? (rnd + 1) * G : NU; u = hiu - 1 - pos; if (u < rnd * G) continue; }
            indexer_unit(lds + RING_OFF, tid, wave, lane, u % NB, u / NB, QIDX, KIDX, WIDX, SC, IDX); }
        if (rep + 1 < REPS(2) || BOTH(2)) GRID_BAR();
      }
    }

    if (IN(3)) {
#pragma unroll
      for (int rep = 0; rep < REPS(3); ++rep) {
        PHASE_IDS();
        for (int rr = 0; rr < DUP_SGU; ++rr)
        for (int u = cu; u < (MTOK / CHK) * NGRP; u += G) sgu_unit(lds + RING_OFF, tid, wave, lane, u >> 3, u & 7, UV, LNP, SGUW, args.in[I_LNG], args.in[I_LNB], args.in[I_SGUB], YB);
        __syncthreads();
        LAS float* BL = (LAS float*)(lds + RING_OFF + ATT_BL);
        { const float* rb = args.in[I_RELB];
          for (int i = tid; i < 129 * 16; i += NWAVES * 64) { const int n = i >> 4, h = i & 15; int bk;
              if (n < 16) bk = n; else { bk = 16 + (int)(logf((float)n * (1.0f / 16.0f)) / 2.0794415416798357f * 16.0f); bk = bk > 31 ? 31 : bk; }
              BL[i] = rb[bk * 16 + h]; } }
        __syncthreads();
        for (int rr = 0; rr < DUP_ATT; ++rr)
        for (int qi = gw; qi < MTOK; qi += NGW) attn_query(lds + RING_OFF + wave * ATT_WAVE, BL, lane, qi / SEQ, qi % SEQ, Qb, KN, Vb, IDX, args.in[I_QNG], (bf16*)YA8);
        if (rep + 1 < REPS(3) || BOTH(3)) GRID_BAR();
      }
    }

#if defined(IDLE_US)
    { const unsigned long long t0 = __builtin_amdgcn_s_memrealtime(); while (__builtin_amdgcn_s_memrealtime() - t0 < (unsigned long long)(IDLE_US) * 100ull) __builtin_amdgcn_s_sleep(32); }
#endif
    if (IN(4)) {
#pragma unroll
      for (int rep = 0; rep < REPS(4); ++rep) {
        PHASE_IDS();
        { pg8::Gemm g{(const bf16*)YA8, (const bf16*)WA8, MTOK, DM, GWID / 2}; pg8::BlockOrder S; S.init(MTOK, DM, G, cu);
          pg8::EpiPlain E{(bf16*)T8};
          pg8::gemm_phase<pg8::EpiPlain, pg8::BlockOrder, GEMM_ALIGN, GEMM_SP2, true>(lds + RING_OFF, g, S, E, tid); }
        { pg8::Gemm g{YB, WBB, MTOK, DM, GWID}; pg8::BlockOrder S; S.init(MTOK, DM, G, cu);
          pg8::EpiMerge E{SGA, SGB, (const bf16*)T8, MERGED};
          pg8::gemm_phase<pg8::EpiMerge, pg8::BlockOrder, GEMM_ALIGN, GEMM_SP2>(lds + RING_OFF, g, S, E, tid); }
        if (rep + 1 < REPS(4) || BOTH(4)) GRID_BAR();
      }
    }

    if (IN(5)) {
#pragma unroll
      for (int rep = 0; rep < REPS(5); ++rep) {
        PHASE_IDS();
        unsigned char* wsl = args.ws; asm volatile("" : "+s"(wsl));
        unsigned char* const MQ = wsl + WS_MERGED + 128 * MiB; float* const FACM = (float*)(wsl + WS_LNP + 1 * MiB);
        for (int m = gw; m < MTOK; m += NGW) quant_row_i8<false, false, true>(MERGED + (size_t)m * DM, nullptr, MQ + (size_t)m * DM, FACM + m, lane, 4.25f);
        GRID_BAR();
        { pg8::Gemm g{(const bf16*)MQ, WOUT, MTOK, DM, DM / 2}; pg8::BlockOrder S; S.init(MTOK, DM, G, cu);
          const float iso_ = __uint_as_float(__builtin_amdgcn_readfirstlane(__float_as_uint(1.0f / __uint_as_float(MISC[20]))));
          pg8::EpiResid E{args.in[I_X], X1R, nullptr, args.in[I_NFFN], SSQ1, FACM, iso_};
          pg8::gemm_phase<pg8::EpiResid, pg8::BlockOrder, GEMM_ALIGN, GEMM_SP2, false, false, true>(lds + RING_OFF, g, S, E, tid); }
        { pg8::Gemm g{PB, WPLE, MTOK, DM, DPLE}; pg8::BlockOrder S; S.init(MTOK, DM, G, cu);
          pg8::EpiPe E{PE, SSQP};
          pg8::gemm_phase<pg8::EpiPe, pg8::BlockOrder, GEMM_ALIGN, GEMM_SP2>(lds + RING_OFF, g, S, E, tid); }
        if (rep + 1 < REPS(5) || BOTH(5)) GRID_BAR();
      }
    }

    if (IN(6)) {
#pragma unroll
      for (int rep = 0; rep < REPS(6); ++rep) {
        PHASE_IDS();
        if (rep == 0) { CONV_ITEMS(NITEMS - TAIL_A - TAIL_B, NITEMS - TAIL_B, gw, NGW); __syncthreads(); }
        unsigned char* wsl = args.ws; asm volatile("" : "+s"(wsl));
        const float sgu_ = (127.0f / (4.0f * __uint_as_float(MISC[13]))) * (127.0f / (4.0f * __uint_as_float(MISC[14])));
        float* const FACA = (float*)(wsl + WS_LNP + 3 * MiB);
        unsigned char* const X1Q = wsl + WS_WAB; float* const FAC1 = (float*)(wsl + WS_LNP);
        for (int m = gw; m < MTOK; m += NGW) quant_row_i8<true, true>(X1R + (size_t)m * DM, args.in[I_NFFN], X1Q + (size_t)m * DM, FAC1 + m, lane, 4.0f, FACA + m, sgu_);
        GRID_BAR();
        pg8::Gemm g{(const bf16*)X1Q, WGU, MTOK, 2 * DFF, DM / 2}; pg8::BlockOrder S; S.init(MTOK, 2 * DFF, G, cu);
        const float isg_ = __uint_as_float(__builtin_amdgcn_readfirstlane(__float_as_uint(1.0f / __uint_as_float(MISC[13])))), isu_ = __uint_as_float(__builtin_amdgcn_readfirstlane(__float_as_uint(1.0f / __uint_as_float(MISC[14]))));
        pg8::EpiGateUpQ E{FAC1, isg_, isu_, ACT, ACT8, P7F, FACA};
        pg8::gemm_phase<pg8::EpiGateUpQ, pg8::BlockOrder, GEMM_ALIGN, GEMM_SP2, false, false, true>(lds + RING_OFF, g, S, E, tid);
        if (rep == 0) CONV_TAIL((MTOK / 256) * (2 * DFF / 256), NITEMS - TAIL_B, NITEMS);
        if (rep + 1 < REPS(6) || BOTH(6)) GRID_BAR();
      }
    }

    if (IN(7)) {
#pragma unroll
      for (int rep = 0; rep < REPS(7); ++rep) {
        PHASE_IDS();
        if (P7F > 0) { pg8::Gemm g{(const bf16*)ACT8, (const bf16*)WD8, P7F * 256, DM, DFF / 2}; pg8::BlockOrder S; S.init(P7F * 256, DM, G, cu); { int rm_ = S.rmain; asm volatile("" : "+v"(rm_)); S.rmain = __builtin_amdgcn_readfirstlane(rm_); }
          const float isd_ = __uint_as_float(__builtin_amdgcn_readfirstlane(__float_as_uint(1.0f / __uint_as_float(MISC[22]))));
          pg8::EpiResidQ E{X1R, X2R, nullptr, args.in[I_NPLE], SSQ2, (const float*)(args.ws + WS_LNP + 3 * MiB), isd_};
          pg8::gemm_phase<pg8::EpiResidQ, pg8::BlockOrder, GEMM_ALIGN, GEMM_SP2, false, false, true>(lds + RING_OFF, g, S, E, tid); }
        if (P7F < 64) { pg8::Gemm g{ACT + (size_t)P7F * 256 * DFF, WD, MTOK - P7F * 256, DM, DFF}; pg8::BlockOrder S; S.init(MTOK - P7F * 256, DM, G, cu); { int rm_ = S.rmain; asm volatile("" : "+v"(rm_)); S.rmain = __builtin_amdgcn_readfirstlane(rm_); }
          constexpr size_t R0 = (size_t)P7F * 256;
          pg8::EpiResidB E{X1R + R0 * 4096, X2R + R0 * 4096, nullptr, args.in[I_NPLE], SSQ2 + R0 * 4, nullptr, 1.0f};
          pg8::gemm_phase<pg8::EpiResidB, pg8::BlockOrder, GEMM_ALIGN, GEMM_SP2>(lds + RING_OFF, g, S, E, tid); }
        if (rep + 1 < REPS(7) || BOTH(7)) GRID_BAR();
      }
    }

    if (IN(8)) {
        PHASE_IDS();
        unsigned char* wsl = args.ws; asm volatile("" : "+s"(wsl));
        unsigned char* const X2Q = wsl + WS_X2G; float* const FAC2 = (float*)(wsl + WS_LNP + 2 * MiB);
        for (int m = gw; m < MTOK; m += NGW) quant_row_i8<true, true>(X2R + (size_t)m * DM, args.in[I_NPLE], X2Q + (size_t)m * DM, FAC2 + m, lane);
        GRID_BAR();
        pg8::Gemm g{(const bf16*)X2Q, WPG, MTOK, DM, DM / 2}; pg8::BlockOrder S; S.init(MTOK, DM, G, cu);
        const float isp_ = __uint_as_float(__builtin_amdgcn_readfirstlane(__float_as_uint(1.0f / __uint_as_float(MISC[21]))));
        pg8::EpiFinal E{FAC2, SSQP, args.in[I_PLENG], PE, X2R, args.out, isp_};
        pg8::gemm_phase<pg8::EpiFinal, pg8::BlockOrder, GEMM_ALIGN, GEMM_SP2, false, false, true>(lds + RING_OFF, g, S, E, tid);
    }

#if defined(DUMP_AFTER)
    if (lo == N_PHASES) {
        const size_t gt = (size_t)cu * 512 + threadIdx.x, NT = (size_t)G * 512;
        for (size_t i = gt; i < (size_t)MTOK * DM; i += NT) { const size_t m = i >> 12; const int c = (int)(i & 4095); float v = 0.f;
#if DUMP_AFTER == 3
            v = bf_lo((unsigned)YB[i >> 1]);
#elif DUMP_AFTER == 2
            v = c < 256 ? (float)IDX[m * 256 + c] : (c < 384 ? bf_lo((unsigned)KN[m * 128 + c - 256]) : 0.f);
#elif DUMP_AFTER == 1
#if DUMP_SEL == 0
            v = bf_lo((unsigned)QIDX[i]);
#elif DUMP_SEL == 1
            v = bf_lo((unsigned)UV[i]);
#elif DUMP_SEL == 2
            v = bf_lo((unsigned)SGA[i]) + bf_lo((unsigned)SGB[i]);
#elif DUMP_SEL == 3
            v = bf_lo((unsigned)Qb[m * 2048 + (c & 2047)]);
            if (c < 128) v += KRAW[m * 128 + c] + bf_lo((unsigned)Vb[m * 128 + c]) + bf_lo((unsigned)KIDX[m * 128 + c]);
            if (c < 32) v += WIDX[m * 32 + c];
#endif
#elif DUMP_AFTER == 0
            v = bf_lo((unsigned)H[i]) + bf_lo((unsigned)WIN[i]) + bf_lo((unsigned)WIN[(size_t)(INPAD - 4096) * DM + i]) + bf_lo((unsigned)WGU[i]) + bf_lo((unsigned)WD[i]) + bf_lo((unsigned)WAB[i]);
#endif
            args.out[i] = v; }
    }
#endif
#undef IN
#undef BOTH
#undef GRID_BAR
}

extern "C" void kernel_launch(void* const* d_in, const int* in_sizes, int n_in, void* d_out, int out_size, void* d_ws, size_t ws_size, hipStream_t stream) {
    static int grid = 0;
    if (grid == 0) {
        if (n_in != 22 || in_sizes[0] != MTOK * DM || out_size != MTOK * DM || ws_size < WS_NEED) {
            fprintf(stderr, "kernel_launch: unexpected problem (n_in %d, in0 %d, out %d, ws %zu, need %zu); nothing launched\n", n_in, n_in > 0 ? in_sizes[0] : -1, out_size, ws_size, (size_t)WS_NEED); grid = -1; return; }
        int dev = 0, cus = 0, per_cu = 0;
        if (hipGetDevice(&dev) != hipSuccess || hipDeviceGetAttribute(&cus, hipDeviceAttributeMultiprocessorCount, dev) != hipSuccess) { grid = -1; return; }
        if (hipFuncSetAttribute((const void*)fwd_kernel, hipFuncAttributeMaxDynamicSharedMemorySize, LDS_BYTES) != hipSuccess) { fprintf(stderr, "kernel_launch: hipFuncSetAttribute failed\n"); grid = -1; return; }
        if (hipOccupancyMaxActiveBlocksPerMultiprocessor(&per_cu, (const void*)fwd_kernel, NWAVES * 64, LDS_BYTES) != hipSuccess || per_cu < 1)
            fprintf(stderr, "kernel_launch: note: occupancy query reports %d workgroups per CU\n", per_cu);
        (void)hipGetLastError();
        grid = cus;
    }
    if (grid < 0) return;
    if (hipMemsetAsync((char*)d_ws + WS_CTL, 0, CTL_ZERO_BYTES, stream) != hipSuccess) return;
    Args a{};
    for (int i = 0; i < 22; ++i) a.in[i] = (const float*)d_in[i];
    a.out = (float*)d_out; a.ws = (unsigned char*)d_ws;
#if defined(DUMP_AFTER)
    for (int li = 0; li <= DUMP_AFTER + 1; ++li) {
        a.ph_lo = li <= DUMP_AFTER ? li : N_PHASES; a.ph_hi = a.ph_lo + 1; a.li = 0;
#else
    for (int li = 0; li < N_LAUNCHES; ++li) {
        a.ph_lo = (N_LAUNCHES == 1) ? 0 : li; a.ph_hi = (N_LAUNCHES == 1) ? N_PHASES : li + 1; a.li = (N_LAUNCHES == 1) ? 0 : 0;
#endif
        hipLaunchKernelGGL(fwd_kernel, dim3(grid), dim3(NWAVES * 64), LDS_BYTES, stream, a);
        const hipError_t le = hipPeekAtLastError();
        if (le != hipSuccess) { fprintf(stderr, "kernel_launch: launch %d failed: %s\n", li, hipGetErrorName(le)); break; }
    }
}
```

```cpp
#include <hip/hip_runtime.h>
#include <cstdio>
#include <cstdint>

#define GAS __attribute__((address_space(1)))
#define LAS __attribute__((address_space(3)))
typedef unsigned short bf16;
typedef unsigned v4u __attribute__((ext_vector_type(4)));
typedef unsigned v2u __attribute__((ext_vector_type(2)));
typedef float f32x4 __attribute__((ext_vector_type(4)));
typedef float f32x2 __attribute__((ext_vector_type(2)));
typedef float f32x16 __attribute__((ext_vector_type(16)));
typedef short bf16x8 __attribute__((ext_vector_type(8)));
typedef short s16x4 __attribute__((ext_vector_type(4)));
typedef GAS unsigned gu32;

constexpr int NB = 4, SEQ = 4096, DM = 4096, MTOK = NB * SEQ;
constexpr int NHA = 16, HDA = 128, NIH = 32, IDXD = 128, TOPK = 256;
constexpr int GWID = 2048, NGRP = 8, GDIM = 256, CHK = 128;
constexpr int DFF = 11008, DPLE = 256;
constexpr int INCOLS = 18848, INPAD = 18944;
constexpr float EPS = 1e-6f;
constexpr float LOG2E = 1.4426950408889634f;

constexpr size_t MiB = 1u << 20;
constexpr size_t WS_CTL = 0, CTL_ZERO_BYTES = 1 * MiB;
constexpr size_t WS_IDX = 1 * MiB;
constexpr size_t WS_LNP = 9 * MiB;
constexpr size_t WS_SSQ1 = 13 * MiB;
constexpr size_t WS_SSQ2 = 17 * MiB;
constexpr size_t WS_SSQP = 21 * MiB;
constexpr size_t WS_WIDX = 25 * MiB;
constexpr size_t WS_KIDX = 27 * MiB;
constexpr size_t WS_KN = 31 * MiB;
constexpr size_t WS_V = 35 * MiB;
constexpr size_t WS_KRAW = 39 * MiB;
constexpr size_t WS_SGUW = 47 * MiB;
constexpr size_t WS_H = 48 * MiB;
constexpr size_t WS_WIN = 176 * MiB;
constexpr size_t WS_QIDX = 324 * MiB;
constexpr size_t WS_Q = 452 * MiB;
constexpr size_t WS_UV = 516 * MiB;
constexpr size_t WS_SGA = 644 * MiB;
constexpr size_t WS_SGB = 772 * MiB;
constexpr size_t WS_WAB = 900 * MiB;
constexpr size_t WS_WOUT = 932 * MiB;
constexpr size_t WS_WGU = 964 * MiB;
constexpr size_t WS_WD = 1136 * MiB;
constexpr size_t WS_WPLE = 1222 * MiB;
constexpr size_t WS_WPG = 1224 * MiB;
constexpr size_t WS_END = 1256 * MiB;
constexpr size_t WS_WINB = WS_WIN, WS_WIN8 = WS_WIN + 66 * MiB;
constexpr size_t WS_H8 = WS_WD;
constexpr size_t WS_SC = WS_H, WS_MERGED = WS_H, WS_ACT = WS_H, WS_YAB = WS_QIDX, WS_X1G = WS_UV, WS_X2G = WS_UV, WS_PE = WS_SGA;
static_assert(WS_SC + (size_t)MTOK * SEQ * 4 <= WS_QIDX && WS_ACT + (size_t)MTOK * DFF * 2 <= WS_Q && WS_WIN + (size_t)INPAD * DM * 2 <= WS_QIDX && WS_WD + (size_t)DM * DFF * 2 <= WS_WPLE, "ws map");

constexpr int CW_TMO = 0, CW_CODE = 1, CW_BAR = 4096;

constexpr int RING_OFF = 0, RING_BYTES = 131072;
constexpr int LDSCTL_OFF = RING_BYTES, MISC_OFF = LDSCTL_OFF + 320;
constexpr int LDS_BYTES = 147456;
static_assert(MISC_OFF + 128 <= LDS_BYTES, "LDS map");

#define RLX_AGENT __ATOMIC_RELAXED, __HIP_MEMORY_SCOPE_AGENT
#define LDS_WAIT() asm volatile("s_waitcnt lgkmcnt(0)" ::: "memory")
#define VM_WAIT() asm volatile("s_waitcnt vmcnt(0)" ::: "memory")

typedef __bf16 bf16v2_t __attribute__((ext_vector_type(2)));
__device__ __forceinline__ unsigned cvt_pk_bf16(float lo, float hi) { const f32x2 v = {lo, hi}; const bf16v2_t b = __builtin_convertvector(v, bf16v2_t); return __builtin_bit_cast(unsigned, b); }
__device__ __forceinline__ float bf_lo(unsigned w) { return __uint_as_float(w << 16); }
__device__ __forceinline__ float bf_hi(unsigned w) { return __uint_as_float(w & 0xffff0000u); }
__device__ __forceinline__ float fast_sigmoid(float x) { return __builtin_amdgcn_rcpf(1.0f + __builtin_amdgcn_exp2f(-LOG2E * x)); }
__device__ __forceinline__ float gelu_tanh(float x) { const float t = x * (1.0f + 0.044715f * x * x); return x * __builtin_amdgcn_rcpf(1.0f + __builtin_amdgcn_exp2f(-2.302208198f * t)); }
__device__ __forceinline__ float wave_sum(float v) {
#pragma unroll
    for (int o = 1; o < 64; o <<= 1) v += __shfl_xor(v, o);
    return v;
}
#ifndef MCLR
#define MCLR 0
#endif
#ifndef ACT_CLIP
#define ACT_CLIP 3.0f
#endif
#ifndef P7F
#define P7F 64
#endif
__device__ __forceinline__ float rnd_sm(float x) { if (MCLR == 0) return x; unsigned u = __float_as_uint(x); u += ((1u << (15 + MCLR)) - 1u) + ((u >> (16 + MCLR)) & 1u); u &= ~((1u << (16 + MCLR)) - 1u); return __uint_as_float(u); }
__device__ __forceinline__ f32x4 rnd_sm4(f32x4 v) { return (f32x4){rnd_sm(v[0]), rnd_sm(v[1]), rnd_sm(v[2]), rnd_sm(v[3])}; }
__device__ __forceinline__ v4u pack8(f32x4 a, f32x4 b) { v4u w; w.x = cvt_pk_bf16(a[0], a[1]); w.y = cvt_pk_bf16(a[2], a[3]); w.z = cvt_pk_bf16(b[0], b[1]); w.w = cvt_pk_bf16(b[2], b[3]); return w; }
__device__ __forceinline__ void unpack8(v4u w, f32x4& a, f32x4& b) { a = (f32x4){bf_lo(w.x), bf_hi(w.x), bf_lo(w.y), bf_hi(w.y)}; b = (f32x4){bf_lo(w.z), bf_hi(w.z), bf_lo(w.w), bf_hi(w.w)}; }

__device__ __forceinline__ unsigned e2m1(float x) { const float a = fminf(fabsf(x), 6.0f);
    const float c = a < 2.0f ? rintf(2.0f * a) : (a < 4.0f ? 2.0f + rintf(a) : 4.0f + rintf(0.5f * a));
    return (unsigned)c | ((__float_as_uint(x) >> 28) & 8u); }
__device__ __forceinline__ unsigned pack4_f4(float a, float b, float c, float d) { return e2m1(a) | (e2m1(b) << 4) | (e2m1(c) << 8) | (e2m1(d) << 12); }
__device__ __forceinline__ unsigned q8(float x) { const float r = fminf(fmaxf(rintf(x), -127.0f), 127.0f); return (unsigned)(int)r & 255u; }
__device__ __forceinline__ v2u pack8_i8(f32x4 a, f32x4 b) { v2u w; w.x = q8(a[0]) | (q8(a[1]) << 8) | (q8(a[2]) << 16) | (q8(a[3]) << 24); w.y = q8(b[0]) | (q8(b[1]) << 8) | (q8(b[2]) << 16) | (q8(b[3]) << 24); return w; }
__device__ __forceinline__ v2u pack8_f8(f32x4 a, f32x4 b) { v2u w; w.x = (unsigned)__builtin_amdgcn_cvt_pk_fp8_f32(a[2], a[3], __builtin_amdgcn_cvt_pk_fp8_f32(a[0], a[1], 0, false), true);
    w.y = (unsigned)__builtin_amdgcn_cvt_pk_fp8_f32(b[2], b[3], __builtin_amdgcn_cvt_pk_fp8_f32(b[0], b[1], 0, false), true); return w; }
__device__ __forceinline__ void unpack8_f8(v2u w, f32x4& a, f32x4& b) { const f32x2 a0 = __builtin_amdgcn_cvt_pk_f32_fp8((int)w.x, false), a1 = __builtin_amdgcn_cvt_pk_f32_fp8((int)w.x, true), b0 = __builtin_amdgcn_cvt_pk_f32_fp8((int)w.y, false), b1 = __builtin_amdgcn_cvt_pk_f32_fp8((int)w.y, true);
    a = (f32x4){a0[0], a0[1], a1[0], a1[1]}; b = (f32x4){b0[0], b0[1], b1[0], b1[1]}; }

namespace pg8 {
#define PG8_LAS __attribute__((address_space(3)))
typedef unsigned short bf16_t;
typedef unsigned u32x4 __attribute__((ext_vector_type(4)));
constexpr int BM = 256, BK = 64, HALF = 128, HTB = HALF * BK * 2, STAGE_BYTES = 8 * HTB, NXCD = 8, WGM = 4;

__host__ __device__ __forceinline__ int lds_byte(int r, int c) { const int st = (r >> 4) * 2 + (c >> 5), rr = r & 15, cc = c & 31, ob = rr * 64 + cc * 2; return st * 1024 + (ob ^ (((ob >> 9) & 1) << 5)); }
__host__ __device__ __forceinline__ void stage_rc(int b, int& R, int& C) { const int st = b / 1024, sb = b % 1024, swz = sb ^ (((sb >> 9) & 1) << 5); R = (st >> 1) * 16 + swz / 64; C = (st & 1) * 32 + (swz % 64) / 2; }
__host__ __device__ __forceinline__ int perm32(int rho) { const int n = rho >> 4, i = rho & 15; return 8 * (i >> 2) + 4 * n + (i & 3); }

struct Unit { int pm, pn; };
struct Gemm { const bf16_t* A; const bf16_t* Bt; int M, N, K; };

struct StaticOrder {
    int nM, nN, nwg, G, c;
    __host__ __device__ __forceinline__ void init(int M, int N, int G_, int c_) { nM = M / BM; nN = N / BM; nwg = nM * nN; G = G_; c = c_; }
    __host__ __device__ __forceinline__ bool next(int i, Unit& u) const {
        const long L = (long)i * G + c; if (L >= nwg) return false;
        int wgid = (int)L; { const int q = nwg / NXCD, r = nwg % NXCD, xcd = wgid % NXCD, off = wgid / NXCD; wgid = (xcd < r ? xcd * (q + 1) : r * (q + 1) + (xcd - r) * q) + off; }
        const int nig = WGM * nN, gid = wgid / nig, fm = gid * WGM, gsz = (nM - fm) < WGM ? (nM - fm) : WGM;
        u.pm = fm + ((wgid % nig) % gsz); u.pn = (wgid % nig) / gsz; return true;
    }
    __device__ __forceinline__ void a_ready(const Unit&) const {}
    __device__ __forceinline__ void done(const Unit&) const {}
};

struct BlockOrder {
    StaticOrder so; int nM, nN, nNm, rmain, G, c; bool blocked;
    __host__ __device__ __forceinline__ void init(int M, int N, int G_, int c_) { nM = M / BM; nN = N / BM; G = G_; c = c_; blocked = (G_ == 256) && (nM % 16 == 0) && (nN >= 16);
        nNm = blocked ? (nN / 16) * 16 : 0; rmain = blocked ? (nM / 16) * (nNm / 16) : 0; so.init(M, (nN - nNm) * BM, G_, c_); }
    __host__ __device__ __forceinline__ bool next(int i, Unit& u) const {
        if (i < rmain) { const int nsr = nM / 16, sc = i / nsr, s0 = i % nsr, sr = (sc & 1) ? nsr - 1 - s0 : s0, x = c & 7, j = c >> 3;
            u.pm = 16 * sr + 4 * (x >> 1) + (j & 3); u.pn = 16 * sc + 8 * (x & 1) + (j >> 2); return true; }
        if (nN == nNm) return false;
        if (!so.next(i - rmain, u)) return false;
        u.pn += nNm; return true;
    }
    __device__ __forceinline__ void a_ready(const Unit&) const {}
    __device__ __forceinline__ void done(const Unit&) const {}
};

typedef f32x4 Acc[2][2][4][2];

__device__ __forceinline__ float row_total64(const float* tab, int row, int fq) {
    const float* p = tab + ((size_t)(fq * 4) * MTOK + row) * 4;
    const f32x4 a = *(const f32x4*)p, b = *(const f32x4*)(p + (size_t)MTOK * 4), c = *(const f32x4*)(p + (size_t)MTOK * 8), d = *(const f32x4*)(p + (size_t)MTOK * 12);
    float s = ((a[0] + a[1]) + (a[2] + a[3])) + ((b[0] + b[1]) + (b[2] + b[3])) + ((c[0] + c[1]) + (c[2] + c[3])) + ((d[0] + d[1]) + (d[2] + d[3]));
    s += __shfl_xor(s, 16); s += __shfl_xor(s, 32); return s;
}

template <int VAR> struct EpiInProjT {
    static constexpr bool PERM = true, AFTER_DRAIN = false, HAS_MID = false;
    bf16_t *Q, *V, *QIDX, *KIDX, *UV, *SGA, *SGB; float *KRAW, *WIDX, *LNP; const float* FACH; float isw;
    __device__ __forceinline__ float rowf(size_t r) const { if constexpr (VAR == 0) return FACH[r] * isw; else return 1.0f; }
    __device__ __forceinline__ void mid(Acc&, const Unit&, int, int, int, int) const {}
    template <int ACT> __device__ __forceinline__ void plain(const Acc& acc, bf16_t* O, int ldc, int colt, int row0, int cl, bool f8, const float (&rfs)[8]) const {
#pragma unroll
        for (int ai = 0; ai < 2; ++ai)
#pragma unroll
            for (int m = 0; m < 4; ++m) { const float rf = rfs[ai * 4 + m]; const size_t eo = (size_t)(row0 + ai * HALF + m * 16) * ldc + colt + cl; bf16_t* rowp = O + eo; unsigned char* rowp8 = (unsigned char*)O + eo;
#pragma unroll
                for (int bj = 0; bj < 2; ++bj) { f32x4 v0 = acc[ai][bj][m][0] * rf, v1 = acc[ai][bj][m][1] * rf;
                    if (ACT == 1) {
#pragma unroll
                        for (int j = 0; j < 4; ++j) { v0[j] = gelu_tanh(v0[j]); v1[j] = gelu_tanh(v1[j]); } }
                    if (ACT == 2) {
#pragma unroll
                        for (int j = 0; j < 4; ++j) { v0[j] = fast_sigmoid(v0[j]); v1[j] = fast_sigmoid(v1[j]); } }
                    if (f8) *(v2u*)(rowp8 + bj * HALF) = pack8_f8(v0, v1); else *(u32x4*)(rowp + bj * HALF) = pack8(v0, v1); }
                __builtin_amdgcn_sched_barrier(0); }
    }
    __device__ __forceinline__ void operator()(const Acc& acc, const Unit& u, int wr, int wc, int fr, int fq) const {
        asm volatile("" : "+v"(fr), "+v"(fq));
        const int row0 = u.pm * BM + wr * 64 + fr, cl = wc * 32 + 8 * fq, pn = VAR == 2 ? u.pn + 42 : VAR == 1 ? u.pn + 25 : (u.pn < 25 ? u.pn : (u.pn < 41 ? u.pn + 33 : u.pn - 15));
        float rfs[8];
#pragma unroll
        for (int i = 0; i < 8; ++i) rfs[i] = rowf((size_t)(row0 + (i >> 2) * HALF + (i & 3) * 16));
        if constexpr (VAR == 0) { asm volatile("" : "+v"(rfs[0]), "+v"(rfs[1]), "+v"(rfs[2]), "+v"(rfs[3]), "+v"(rfs[4]), "+v"(rfs[5]), "+v"(rfs[6]), "+v"(rfs[7])); }
        if (pn < 8 || (pn > 8 && pn < 25)) { const bool isq = pn < 8; plain<0>(acc, isq ? Q : QIDX, isq ? 2048 : 4096, isq ? pn * 256 : (pn - 9) * 256, row0, cl, isq, rfs); }
        else if (pn == 8) {
#pragma unroll
            for (int ai = 0; ai < 2; ++ai)
#pragma unroll
                for (int m = 0; m < 4; ++m) { const size_t r = (size_t)(row0 + ai * HALF + m * 16);
                    const float rf = rfs[ai * 4 + m];
                    *(f32x4*)(KRAW + r * 128 + cl) = acc[ai][0][m][0] * rf; *(f32x4*)(KRAW + r * 128 + cl + 4) = acc[ai][0][m][1] * rf;
                    *(u32x4*)(V + r * 128 + cl) = pack8(acc[ai][1][m][0] * rf, acc[ai][1][m][1] * rf); }
        }
        else if (pn == 25) {
#pragma unroll
            for (int ai = 0; ai < 2; ++ai)
#pragma unroll
                for (int m = 0; m < 4; ++m) { const size_t r = (size_t)(row0 + ai * HALF + m * 16);
                    *(u32x4*)(KIDX + r * 128 + cl) = pack8(acc[ai][0][m][0], acc[ai][0][m][1]);
                    if (wc == 0) { *(f32x4*)(WIDX + r * 32 + 8 * fq) = acc[ai][1][m][0]; *(f32x4*)(WIDX + r * 32 + 8 * fq + 4) = acc[ai][1][m][1]; } }
        }
        else if (pn < 42) {
            const bool isv = pn >= 34;
#pragma unroll
            for (int ai = 0; ai < 2; ++ai)
#pragma unroll
                for (int m = 0; m < 4; ++m) { const size_t r = (size_t)(row0 + ai * HALF + m * 16); bf16_t* rowp = UV + r * 4096 + (pn - 26) * 256 + cl; float s = 0.f, q = 0.f; const float rf = rfs[ai * 4 + m];
#pragma unroll
                    for (int bj = 0; bj < 2; ++bj) { f32x4 v0 = acc[ai][bj][m][0] * rf, v1 = acc[ai][bj][m][1] * rf;
#pragma unroll
                        for (int j = 0; j < 4; ++j) { v0[j] = gelu_tanh(v0[j]); v1[j] = gelu_tanh(v1[j]); s += v0[j] + v1[j]; q += v0[j] * v0[j] + v1[j] * v1[j]; }
                        *(u32x4*)(rowp + bj * HALF) = pack8(v0, v1); }
                    s += __shfl_xor(s, 16); s += __shfl_xor(s, 32); q += __shfl_xor(q, 16); q += __shfl_xor(q, 32);
                    if (isv && fq == 0) *(f32x2*)(LNP + (((size_t)(pn - 34) * MTOK + r) * 4 + wc) * 2) = (f32x2){s, q};
                    __builtin_amdgcn_sched_barrier(0); }
        }
        else { const bool isa = pn < 58; plain<2>(acc, isa ? SGA : SGB, 4096, isa ? (pn - 42) * 256 : (pn - 58) * 256, row0, cl, isa, rfs); }
    }
};

struct EpiNull {
    static constexpr bool PERM = true, AFTER_DRAIN = false, HAS_MID = false;
    float* sink;
    __device__ __forceinline__ void mid(Acc&, const Unit&, int, int, int, int) const {}
    __device__ __forceinline__ void operator()(const Acc& acc, const Unit& u, int wr, int wc, int fr, int fq) const {
        f32x4 t = {0.f, 0.f, 0.f, 0.f};
#pragma unroll
        for (int ai = 0; ai < 2; ++ai)
#pragma unroll
            for (int bj = 0; bj < 2; ++bj)
#pragma unroll
                for (int m = 0; m < 4; ++m) t += acc[ai][bj][m][0] + acc[ai][bj][m][1];
        if (t[0] + t[1] + t[2] + t[3] == 123456.789f) sink[u.pm] = t[0];
    }
};

struct EpiPlain {
    static constexpr bool PERM = true, AFTER_DRAIN = false, HAS_MID = false;
    bf16_t* O;
    __device__ __forceinline__ void mid(Acc&, const Unit&, int, int, int, int) const {}
    __device__ __forceinline__ void operator()(const Acc& acc, const Unit& u, int wr, int wc, int fr, int fq) const {
        asm volatile("" : "+v"(fr), "+v"(fq));
        const int row0 = u.pm * BM + wr * 64 + fr, col0 = u.pn * BM + wc * 32 + 8 * fq;
#pragma unroll
        for (int ai = 0; ai < 2; ++ai)
#pragma unroll
            for (int m = 0; m < 4; ++m) { const size_t off = (size_t)(row0 + ai * HALF + m * 16) * 4096 + col0;
#pragma unroll
                for (int bj = 0; bj < 2; ++bj) *(v2u*)((unsigned char*)O + off + bj * HALF) = pack8_f8(acc[ai][bj][m][0] * 16.0f, acc[ai][bj][m][1] * 16.0f);
                __builtin_amdgcn_sched_barrier(0); }
    }
};
struct EpiMerge {
    static constexpr bool PERM = true, AFTER_DRAIN = false, HAS_MID = false;
    const bf16_t *SGA, *SGB; const bf16_t* T8; bf16_t* O;
    __device__ __forceinline__ void mid(Acc&, const Unit&, int, int, int, int) const {}
    __device__ __forceinline__ void operator()(const Acc& acc, const Unit& u, int wr, int wc, int fr, int fq) const {
        asm volatile("" : "+v"(fr), "+v"(fq));
        const int row0 = u.pm * BM + wr * 64 + fr, col0 = u.pn * BM + wc * 32 + 8 * fq;
        v2u na[2], nt[2]; u32x4 nb[2];
#define MRG_LD(it_) do { const size_t off_ = (size_t)(row0 + ((it_) >> 2) * HALF + ((it_) & 3) * 16) * 4096 + col0; _Pragma("unroll") for (int bj_ = 0; bj_ < 2; ++bj_) { \
            na[bj_] = *(const v2u*)((const unsigned char*)SGA + off_ + bj_ * HALF); nt[bj_] = *(const v2u*)((const unsigned char*)T8 + off_ + bj_ * HALF); nb[bj_] = *(const u32x4*)(SGB + off_ + bj_ * HALF); } } while (0)
        MRG_LD(0);
#pragma unroll
        for (int it = 0; it < 8; ++it) { const int ai = it >> 2, m = it & 3; const size_t off = (size_t)(row0 + ai * HALF + m * 16) * 4096 + col0;
            const v2u ca[2] = {na[0], na[1]}, ct[2] = {nt[0], nt[1]}; const u32x4 cb[2] = {nb[0], nb[1]};
            if (it < 7) MRG_LD(it + 1);
#pragma unroll
            for (int bj = 0; bj < 2; ++bj) { f32x4 a0, a1, b0, b1, t0, t1; unpack8_f8(ca[bj], a0, a1); unpack8(cb[bj], b0, b1); unpack8_f8(ct[bj], t0, t1); t0 *= 0.0625f; t1 *= 0.0625f;
                *(u32x4*)(O + off + bj * HALF) = pack8(a0 * t0 + b0 * acc[ai][bj][m][0], a1 * t1 + b1 * acc[ai][bj][m][1]); }
            __builtin_amdgcn_sched_barrier(0); }
#undef MRG_LD
    }
};

template <bool G8, bool INB, bool QF = false> struct EpiResidT {
    static constexpr bool PERM = true, AFTER_DRAIN = false, HAS_MID = false;
    const void* XIN; bf16_t* XOUT; bf16_t* XG; const float* gain; float* SSQ; const float* FACR; float isw;
    __device__ __forceinline__ void mid(Acc&, const Unit&, int, int, int, int) const {}
    __device__ __forceinline__ void operator()(const Acc& acc, const Unit& u, int wr, int wc, int fr, int fq) const {
        asm volatile("" : "+v"(fr), "+v"(fq));
        const int row0 = u.pm * BM + wr * 64 + fr, col0 = u.pn * BM + wc * 32 + 8 * fq;
        f32x4 gv[2][2];
#pragma unroll
        for (int bj = 0; bj < 2; ++bj) { gv[bj][0] = *(const f32x4*)(gain + col0 + bj * HALF); gv[bj][1] = *(const f32x4*)(gain + col0 + bj * HALF + 4); }
        float rq_[8];
        if constexpr (QF) {
#pragma unroll
            for (int i = 0; i < 8; ++i) rq_[i] = FACR[row0 + (i >> 2) * HALF + (i & 3) * 16];
            asm volatile("" : "+v"(rq_[0]), "+v"(rq_[1]), "+v"(rq_[2]), "+v"(rq_[3]), "+v"(rq_[4]), "+v"(rq_[5]), "+v"(rq_[6]), "+v"(rq_[7])); }
        u32x4 nxb[2]; f32x4 nxf[2][2];
#define RES_LD(it_) do { const size_t off_ = (size_t)(row0 + ((it_) >> 2) * HALF + ((it_) & 3) * 16) * 4096 + col0; _Pragma("unroll") for (int bj_ = 0; bj_ < 2; ++bj_) { \
            if constexpr (INB) nxb[bj_] = *(const u32x4*)((const bf16_t*)XIN + off_ + bj_ * HALF); \
            else { nxf[bj_][0] = *(const f32x4*)((const float*)XIN + off_ + bj_ * HALF); nxf[bj_][1] = *(const f32x4*)((const float*)XIN + off_ + bj_ * HALF + 4); } } } while (0)
        RES_LD(0);
#pragma unroll
        for (int it = 0; it < 8; ++it) { const int ai = it >> 2, m = it & 3;
            { const size_t r = (size_t)(row0 + ai * HALF + m * 16), off = r * 4096 + col0; float q = 0.f; float rf = 1.0f; if constexpr (QF) rf = rq_[ai * 4 + m] * isw;
                const u32x4 cxb[2] = {nxb[0], nxb[1]}; const f32x4 cxf[2][2] = {{nxf[0][0], nxf[0][1]}, {nxf[1][0], nxf[1][1]}};
                if (it < 7) RES_LD(it + 1);
#pragma unroll
                for (int bj = 0; bj < 2; ++bj) { f32x4 v0, v1;
                    if constexpr (INB) unpack8(cxb[bj], v0, v1);
                    else { v0 = cxf[bj][0]; v1 = cxf[bj][1]; }
                    if constexpr (QF) { v0 += acc[ai][bj][m][0] * rf; v1 += acc[ai][bj][m][1] * rf; } else { v0 += acc[ai][bj][m][0]; v1 += acc[ai][bj][m][1]; }
                    *(u32x4*)(XOUT + off + bj * HALF) = pack8(v0, v1);
#pragma unroll
                    for (int j = 0; j < 4; ++j) q += v0[j] * v0[j] + v1[j] * v1[j];
                    if constexpr (G8) { const f32x4 a = v0 * gv[bj][0], b = v1 * gv[bj][1]; v2u w;
                        w.x = (unsigned)__builtin_amdgcn_cvt_pk_fp8_f32(a[2], a[3], __builtin_amdgcn_cvt_pk_fp8_f32(a[0], a[1], 0, false), true);
                        w.y = (unsigned)__builtin_amdgcn_cvt_pk_fp8_f32(b[2], b[3], __builtin_amdgcn_cvt_pk_fp8_f32(b[0], b[1], 0, false), true);
                        *(v2u*)((unsigned char*)XG + off + bj * HALF) = w; }
                    else if (XG) *(u32x4*)(XG + off + bj * HALF) = pack8(rnd_sm4(v0 * gv[bj][0]), rnd_sm4(v1 * gv[bj][1])); }
                q += __shfl_xor(q, 16); q += __shfl_xor(q, 32);
                if (fq == 0) SSQ[((size_t)u.pn * MTOK + r) * 4 + wc] = q;
                __builtin_amdgcn_sched_barrier(0); } }
#undef RES_LD
    }
};

typedef EpiResidT<false, false, true> EpiResid; typedef EpiResidT<true, true> EpiResid8; typedef EpiResidT<false, true> EpiResidB; typedef EpiResidT<false, true, true> EpiResidQ;

struct EpiPe {
    static constexpr bool PERM = true, AFTER_DRAIN = false, HAS_MID = false;
    bf16_t* PE; float* SSQ;
    __device__ __forceinline__ void mid(Acc&, const Unit&, int, int, int, int) const {}
    __device__ __forceinline__ void operator()(const Acc& acc, const Unit& u, int wr, int wc, int fr, int fq) const {
        asm volatile("" : "+v"(fr), "+v"(fq));
        const int row0 = u.pm * BM + wr * 64 + fr, col0 = u.pn * BM + wc * 32 + 8 * fq;
#pragma unroll
        for (int ai = 0; ai < 2; ++ai)
#pragma unroll
            for (int m = 0; m < 4; ++m) { const size_t r = (size_t)(row0 + ai * HALF + m * 16), off = r * 4096 + col0; float q = 0.f;
#pragma unroll
                for (int bj = 0; bj < 2; ++bj) { const f32x4 v0 = acc[ai][bj][m][0], v1 = acc[ai][bj][m][1];
#pragma unroll
                    for (int j = 0; j < 4; ++j) q += v0[j] * v0[j] + v1[j] * v1[j];
                    *(u32x4*)(PE + off + bj * HALF) = pack8(v0, v1); }
                q += __shfl_xor(q, 16); q += __shfl_xor(q, 32);
                if (fq == 0) SSQ[((size_t)u.pn * MTOK + r) * 4 + wc] = q;
                __builtin_amdgcn_sched_barrier(0); }
    }
};

struct EpiGateUp {
    static constexpr bool PERM = true, AFTER_DRAIN = false, HAS_MID = false;
    const float* SSQ; bf16_t* ACT; unsigned char* ACT8; int pm8;
    __device__ __forceinline__ void mid(Acc&, const Unit&, int, int, int, int) const {}
    __device__ __forceinline__ void operator()(const Acc& acc, const Unit& u, int wr, int wc, int fr, int fq) const {
        asm volatile("" : "+v"(fr), "+v"(fq));
        const int row0 = u.pm * BM + wr * 64 + fr, col0 = u.pn * HALF + wc * 32 + 8 * fq;
#pragma unroll
        for (int ai = 0; ai < 2; ++ai)
#pragma unroll
            for (int m = 0; m < 4; ++m) { const int r = row0 + ai * HALF + m * 16;
                const float rs = 1.0f / sqrtf(row_total64(SSQ, r, fq) * (1.0f / 4096.0f) + EPS);
                f32x4 o0, o1;
#pragma unroll
                for (int j = 0; j < 4; ++j) { const float g0 = acc[ai][0][m][0][j] * rs, g1 = acc[ai][0][m][1][j] * rs;
                    o0[j] = g0 * fast_sigmoid(g0) * (acc[ai][1][m][0][j] * rs); o1[j] = g1 * fast_sigmoid(g1) * (acc[ai][1][m][1][j] * rs); }
                if (u.pm < pm8) *(v2u*)(ACT8 + (size_t)r * DFF + col0) = pack8_f8(o0, o1); else *(u32x4*)(ACT + (size_t)r * DFF + col0) = pack8(o0, o1);
                __builtin_amdgcn_sched_barrier(0); }
    }
};

struct EpiGateUpQ {
    static constexpr bool PERM = true, AFTER_DRAIN = false, HAS_MID = false;
    const float* FAC; float isg, isu; bf16_t* ACT; unsigned char* ACT8; int pm8; const float* FACA;
    __device__ __forceinline__ void mid(Acc&, const Unit&, int, int, int, int) const {}
    __device__ __forceinline__ void operator()(const Acc& acc, const Unit& u, int wr, int wc, int fr, int fq) const {
        asm volatile("" : "+v"(fr), "+v"(fq));
        const int row0 = u.pm * BM + wr * 64 + fr, col0 = u.pn * HALF + wc * 32 + 8 * fq;
        float fs_[8], fa_[8];
#pragma unroll
        for (int i = 0; i < 8; ++i) { fs_[i] = FAC[row0 + (i >> 2) * HALF + (i & 3) * 16]; fa_[i] = FACA[row0 + (i >> 2) * HALF + (i & 3) * 16]; }
        asm volatile("" : "+v"(fs_[0]), "+v"(fs_[1]), "+v"(fs_[2]), "+v"(fs_[3]), "+v"(fs_[4]), "+v"(fs_[5]), "+v"(fs_[6]), "+v"(fs_[7])); asm volatile("" : "+v"(fa_[0]), "+v"(fa_[1]), "+v"(fa_[2]), "+v"(fa_[3]), "+v"(fa_[4]), "+v"(fa_[5]), "+v"(fa_[6]), "+v"(fa_[7]));
#pragma unroll
        for (int ai = 0; ai < 2; ++ai)
#pragma unroll
            for (int m = 0; m < 4; ++m) { const int r = row0 + ai * HALF + m * 16;
                const float f = fs_[ai * 4 + m], fg = f * isg, fu = f * isu;
                f32x4 o0, o1;
#pragma unroll
                for (int j = 0; j < 4; ++j) { const float g0 = acc[ai][0][m][0][j] * fg, g1 = acc[ai][0][m][1][j] * fg;
                    o0[j] = g0 * fast_sigmoid(g0) * (acc[ai][1][m][0][j] * fu); o1[j] = g1 * fast_sigmoid(g1) * (acc[ai][1][m][1][j] * fu); }
                if (u.pm < pm8) {
                    float v_[8] = {o0[0], o0[1], o0[2], o0[3], o1[0], o1[1], o1[2], o1[3]};
#pragma unroll
                    for (int h_ = 1; h_ < 8; h_ <<= 1)
#pragma unroll
                        for (int i_ = 0; i_ < 8; ++i_) if (!(i_ & h_)) { const float a_ = v_[i_], b_ = v_[i_ | h_]; v_[i_] = a_ + b_; v_[i_ | h_] = a_ - b_; }
                    const float s16_ = (fq & 1) ? -1.0f : 1.0f, s32_ = (fq & 2) ? -1.0f : 1.0f;
#pragma unroll
                    for (int i_ = 0; i_ < 8; ++i_) { const auto p_ = __builtin_amdgcn_permlane16_swap(__float_as_uint(v_[i_]), __float_as_uint(v_[i_]), false, false); v_[i_] = __uint_as_float(p_[0]) + s16_ * __uint_as_float(p_[1]); }
#pragma unroll
                    for (int i_ = 0; i_ < 8; ++i_) { const auto p_ = __builtin_amdgcn_permlane32_swap(__float_as_uint(v_[i_]), __float_as_uint(v_[i_]), false, false); v_[i_] = __uint_as_float(p_[0]) + s32_ * __uint_as_float(p_[1]); }
                    const float sa_ = 0.17677669529663687f / fa_[ai * 4 + m];
                    *(v2u*)(ACT8 + (size_t)r * DFF + col0) = pack8_i8((f32x4){v_[0], v_[1], v_[2], v_[3]} * sa_, (f32x4){v_[4], v_[5], v_[6], v_[7]} * sa_); }
                else *(u32x4*)(ACT + (size_t)r * DFF + col0) = pack8(o0, o1);
                __builtin_amdgcn_sched_barrier(0); }
    }
};

struct EpiFinal {
    static constexpr bool PERM = true, AFTER_DRAIN = false, HAS_MID = false;
    const float *FAC2, *SSQP, *pleg; const bf16_t* PE; const bf16_t* X2R; float* OUT; float isw;
    __device__ __forceinline__ void mid(Acc&, const Unit&, int, int, int, int) const {}
    __device__ __forceinline__ void operator()(const Acc& acc, const Unit& u, int wr, int wc, int fr, int fq) const {
        asm volatile("" : "+v"(fr), "+v"(fq));
        const int row0 = u.pm * BM + wr * 64 + fr, col0 = u.pn * BM + wc * 32 + 8 * fq;
        f32x4 gv[2][2];
#pragma unroll
        for (int bj = 0; bj < 2; ++bj) { gv[bj][0] = *(const f32x4*)(pleg + col0 + bj * HALF); gv[bj][1] = *(const f32x4*)(pleg + col0 + bj * HALF + 4); }
        float r3_[8];
#pragma unroll
        for (int i = 0; i < 8; ++i) r3_[i] = FAC2[row0 + (i >> 2) * HALF + (i & 3) * 16];
        asm volatile("" : "+v"(r3_[0]), "+v"(r3_[1]), "+v"(r3_[2]), "+v"(r3_[3]), "+v"(r3_[4]), "+v"(r3_[5]), "+v"(r3_[6]), "+v"(r3_[7]));
#pragma unroll
        for (int ai = 0; ai < 2; ++ai)
#pragma unroll
            for (int m = 0; m < 4; ++m) { const int r = row0 + ai * HALF + m * 16; const size_t off = (size_t)r * 4096 + col0;
                const float r3 = r3_[ai * 4 + m] * isw, rp = 1.0f / sqrtf(row_total64(SSQP, r, fq) * (1.0f / 4096.0f) + EPS);
#pragma unroll
                for (int bj = 0; bj < 2; ++bj) { const u32x4 pw = *(const u32x4*)(PE + off + bj * HALF); f32x4 p0, p1; unpack8(pw, p0, p1);
                    f32x4 x0, x1; { const u32x4 xw = *(const u32x4*)(X2R + off + bj * HALF); unpack8(xw, x0, x1); }
#pragma unroll
                    for (int j = 0; j < 4; ++j) { x0[j] += fast_sigmoid(acc[ai][bj][m][0][j] * r3) * (p0[j] * rp * gv[bj][0][j]); x1[j] += fast_sigmoid(acc[ai][bj][m][1][j] * r3) * (p1[j] * rp * gv[bj][1][j]); }
                    *(f32x4*)(OUT + off + bj * HALF) = x0; *(f32x4*)(OUT + off + bj * HALF + 4) = x1; }
                __builtin_amdgcn_sched_barrier(0); }
    }
};
template <class Epi, class Sched, bool ALIGN_EPI = false, bool SP2 = false, bool FP8 = false, bool FP4 = false, bool I8 = false>
__device__ __forceinline__ void gemm_phase(PG8_LAS unsigned char* lds, const Gemm g, const Sched& S, const Epi& E, const int tid, const int sclw4 = 127) {
    const int wid = __builtin_amdgcn_readfirstlane(tid >> 6), lane = tid & 63, wr = wid >> 2, wc = wid & 3, fr = lane & 15, fq = lane >> 4;
    const int K = g.K, nt = K / BK;
    unsigned voffA[2], voffB[2];
#pragma unroll
    for (int i = 0; i < 2; ++i) { int R, C; stage_rc(tid * 16 + i * 8192, R, C); const int Rb = Epi::PERM ? ((R & ~31) + perm32(R & 31)) : R;
        voffA[i] = (unsigned)(R * K + C) * 2u; voffB[i] = (unsigned)(Rb * K + C) * 2u; }
    const size_t kstep = (size_t)(BK * 2);
    const size_t hstep = (size_t)HALF * K * 2;
    const size_t tstep = 2 * hstep;
    const unsigned ldsw = (unsigned)wid * 1024u;
    const int aoff = lds_byte(wr * 64 + fr, fq * 8), boff = lds_byte(wc * 32 + fr, fq * 8);
#define PG8_SA(b, h) (((b) * 2 + (h)) * HTB)
#define PG8_SB(b, h) ((4 + (b) * 2 + (h)) * HTB)
#define PG8_STAGE(bufoff, gbase, voff) do { _Pragma("unroll") for (int _i = 0; _i < 2; ++_i) \
        __builtin_amdgcn_global_load_lds((const unsigned*)((const char*)(gbase) + (voff)[_i]), (PG8_LAS unsigned*)(lds + (bufoff) + ldsw + _i * 8192), 16, 0, 0); } while (0)
#define PG8_LDA(dst, b, h) do { if constexpr (FP8) { _Pragma("unroll") for (int m = 0; m < 4; ++m) { const v4i_t lo_ = *(const PG8_LAS v4i_t*)(lds + PG8_SA(b, h) + aoff + m * 2048), hi_ = *(const PG8_LAS v4i_t*)(lds + PG8_SA(b, h) + aoff + m * 2048 + 1024); dst##8[m] = __builtin_shufflevector(lo_, hi_, 0, 1, 2, 3, 4, 5, 6, 7); } } \
        else { _Pragma("unroll") for (int m = 0; m < 4; ++m) _Pragma("unroll") for (int k = 0; k < 2; ++k) dst[m][k] = *(const PG8_LAS bf16x8*)(lds + PG8_SA(b, h) + aoff + m * 2048 + k * 1024); } } while (0)
#define PG8_LDB(dst, b, h) do { if constexpr (FP8) { _Pragma("unroll") for (int n = 0; n < 2; ++n) { const v4i_t lo_ = *(const PG8_LAS v4i_t*)(lds + PG8_SB(b, h) + boff + n * 2048), hi_ = *(const PG8_LAS v4i_t*)(lds + PG8_SB(b, h) + boff + n * 2048 + 1024); dst##8[n] = __builtin_shufflevector(lo_, hi_, 0, 1, 2, 3, 4, 5, 6, 7); } } \
        else { _Pragma("unroll") for (int n = 0; n < 2; ++n) _Pragma("unroll") for (int k = 0; k < 2; ++k) dst[n][k] = *(const PG8_LAS bf16x8*)(lds + PG8_SB(b, h) + boff + n * 2048 + k * 1024); } } while (0)
#define PG8_ALIGN_MFMA(At, Bt) asm volatile(".p2align 3" :: "v"(At[0][0]), "v"(At[0][1]), "v"(At[1][0]), "v"(At[1][1]), "v"(At[2][0]), "v"(At[2][1]), "v"(At[3][0]), "v"(At[3][1]), "v"(Bt[0][0]), "v"(Bt[0][1]), "v"(Bt[1][0]), "v"(Bt[1][1]))
#define PG8_ALIGN_MFMA8(At, Bt) asm volatile(".p2align 3" :: "v"(At##8[0]), "v"(At##8[1]), "v"(At##8[2]), "v"(At##8[3]), "v"(Bt##8[0]), "v"(Bt##8[1]))
#define PG8_MMA(ai, bj, At, Bt) do { __builtin_amdgcn_s_setprio(1); \
        if constexpr (FP8) { PG8_ALIGN_MFMA8(At, Bt); __builtin_amdgcn_sched_barrier(0); _Pragma("unroll") for (int m = 0; m < 4; ++m) _Pragma("unroll") for (int n = 0; n < 2; ++n) \
            asm volatile("v_mfma_scale_f32_16x16x128_f8f6f4 %0, %1, %2, %0, %3, %4 op_sel_hi:[0,0,0]" : "+v"(acc[ai][bj][m][n]) : "v"(Bt##8[n]), "v"(At##8[m]), "v"(scl_w), "v"(scl_a)); } \
        else if constexpr (I8) { PG8_ALIGN_MFMA(At, Bt); __builtin_amdgcn_sched_barrier(0); _Pragma("unroll") for (int m = 0; m < 4; ++m) _Pragma("unroll") for (int n = 0; n < 2; ++n) _Pragma("unroll") for (int k = 0; k < 2; ++k) \
            asm volatile("v_mfma_i32_16x16x64_i8 %0, %1, %2, %0" : "+v"(acc[ai][bj][m][n]) : "v"(Bt[n][k]), "v"(At[m][k])); } \
        else if constexpr (FP4) { PG8_ALIGN_MFMA(At, Bt); __builtin_amdgcn_sched_barrier(0); _Pragma("unroll") for (int m = 0; m < 4; ++m) _Pragma("unroll") for (int n = 0; n < 2; ++n) _Pragma("unroll") for (int k = 0; k < 2; ++k) \
            asm volatile("v_mfma_scale_f32_16x16x128_f8f6f4 %0, %1, %2, %0, %3, %4 op_sel_hi:[0,0,0] cbsz:4 blgp:4" : "+v"(acc[ai][bj][m][n]) : "v"(Bt[n][k]), "v"(At[m][k]), "v"(scl_w), "v"(scl_a)); } \
        else { PG8_ALIGN_MFMA(At, Bt); __builtin_amdgcn_sched_barrier(0); _Pragma("unroll") for (int m = 0; m < 4; ++m) _Pragma("unroll") for (int n = 0; n < 2; ++n) _Pragma("unroll") for (int k = 0; k < 2; ++k) \
            acc[ai][bj][m][n] = __builtin_amdgcn_mfma_f32_16x16x32_bf16(Bt[n][k], At[m][k], acc[ai][bj][m][n], 0, 0, 0); } \
        __builtin_amdgcn_s_setprio(0); } while (0)
#define PG8_WAIT_V(n) asm volatile("s_waitcnt vmcnt(" #n ")" ::: "memory")
#define PG8_WAIT_L(n) asm volatile("s_waitcnt lgkmcnt(" #n ")" ::: "memory")
#define PG8_BAR __builtin_amdgcn_s_barrier()
#define PG8_SCHED __builtin_amdgcn_sched_barrier(0)
    Unit cur, nxt; int ui = 0;
    if (!S.next(0, cur)) return;
    f32x4 acc[2][2][4][2];
#pragma unroll
    for (int a = 0; a < 2; ++a)
#pragma unroll
        for (int b = 0; b < 2; ++b)
#pragma unroll
            for (int m = 0; m < 4; ++m)
#pragma unroll
                for (int n = 0; n < 2; ++n) acc[a][b][m][n] = (f32x4){0.f, 0.f, 0.f, 0.f};
    typedef int v8i_t __attribute__((ext_vector_type(8))); typedef int v4i_t __attribute__((ext_vector_type(4)));
    bf16x8 At[4][2], B0[2][2], B1[2][2]; v8i_t At8[4], B08[2], B18[2];
    const int scl_w = FP4 ? sclw4 : 121, scl_a = FP4 ? 126 : 127;
    const char* cA = (const char*)g.A + (size_t)cur.pm * tstep; const char* cB = (const char*)g.Bt + (size_t)cur.pn * tstep;
    S.a_ready(cur);
    if constexpr (SP2) {
        PG8_STAGE(PG8_SB(0, 0), cB, voffB); PG8_STAGE(PG8_SB(0, 1), cB + hstep, voffB); PG8_STAGE(PG8_SA(0, 0), cA, voffA); PG8_STAGE(PG8_SA(0, 1), cA + hstep, voffA);
        if (wr == 1) PG8_BAR;
        PG8_WAIT_V(2); PG8_BAR;
        PG8_STAGE(PG8_SB(1, 0), cB + kstep, voffB); PG8_STAGE(PG8_SA(1, 0), cA + kstep, voffA); PG8_STAGE(PG8_SB(1, 1), cB + hstep + kstep, voffB);
        PG8_WAIT_V(6); PG8_BAR;
    } else {
        PG8_STAGE(PG8_SB(0, 0), cB, voffB); PG8_STAGE(PG8_SA(0, 0), cA, voffA); PG8_STAGE(PG8_SB(0, 1), cB + hstep, voffB); PG8_STAGE(PG8_SA(0, 1), cA + hstep, voffA);
        if (wr == 1) PG8_BAR;
        PG8_WAIT_V(4); PG8_BAR;
        PG8_STAGE(PG8_SB(1, 0), cB + kstep, voffB); PG8_STAGE(PG8_SA(1, 0), cA + kstep, voffA); PG8_STAGE(PG8_SB(1, 1), cB + hstep + kstep, voffB);
        PG8_WAIT_V(6); PG8_BAR;
    }
    for (;;) {
        const bool has_next = S.next(ui + 1, nxt);
        const char* nA = has_next ? (const char*)g.A + (size_t)nxt.pm * tstep : cA; const char* nB = has_next ? (const char*)g.Bt + (size_t)nxt.pn * tstep : cB;
        for (int t = 0; t < nt; t += 2) {
            asm volatile(".p2align 6");
            const bool last = (t == nt - 2);
            const char* a1 = cA + (size_t)(t + 1) * kstep;
            const char* a2 = last ? nA : cA + (size_t)(t + 2) * kstep; const char* b2 = last ? nB : cB + (size_t)(t + 2) * kstep;
            const char* a3 = a2 + kstep; const char* b3 = b2 + kstep;
            if (last && has_next) S.a_ready(nxt);
            if constexpr (Epi::HAS_MID) { if (t == (nt >> 1)) E.mid(acc, cur, wr, wc, fr, fq); }
            if constexpr (SP2) {
            PG8_LDB(B0, 0, 0); PG8_LDB(B1, 0, 1); PG8_SCHED; PG8_LDA(At, 0, 0); PG8_STAGE(PG8_SA(1, 1), a1 + hstep, voffA);
            PG8_WAIT_V(8); PG8_WAIT_L(0); PG8_BAR; PG8_MMA(0, 0, At, B0); PG8_MMA(0, 1, At, B1); PG8_BAR; PG8_SCHED;
            PG8_LDA(At, 0, 1); PG8_STAGE(PG8_SB(0, 0), b2, voffB); PG8_STAGE(PG8_SB(0, 1), b2 + hstep, voffB); PG8_STAGE(PG8_SA(0, 0), a2, voffA);
            PG8_WAIT_V(8); PG8_WAIT_L(0); PG8_BAR; PG8_MMA(1, 0, At, B0); PG8_MMA(1, 1, At, B1); PG8_BAR; PG8_SCHED;
            PG8_LDB(B0, 1, 0); PG8_LDB(B1, 1, 1); PG8_SCHED; PG8_LDA(At, 1, 0); PG8_STAGE(PG8_SA(0, 1), a2 + hstep, voffA);
            PG8_WAIT_V(8); PG8_WAIT_L(0); PG8_BAR; PG8_MMA(0, 0, At, B0); PG8_MMA(0, 1, At, B1); PG8_BAR; PG8_SCHED;
            PG8_LDA(At, 1, 1); PG8_STAGE(PG8_SB(1, 0), b3, voffB); PG8_STAGE(PG8_SB(1, 1), b3 + hstep, voffB); PG8_STAGE(PG8_SA(1, 0), a3, voffA);
            PG8_WAIT_V(8); PG8_WAIT_L(0); PG8_BAR; PG8_MMA(1, 0, At, B0); PG8_MMA(1, 1, At, B1); PG8_BAR; PG8_SCHED;
            } else {
            PG8_LDB(B0, 0, 0); PG8_SCHED; PG8_LDA(At, 0, 0); PG8_STAGE(PG8_SA(1, 1), a1 + hstep, voffA);
            PG8_WAIT_L(8); PG8_BAR; PG8_WAIT_L(0); PG8_MMA(0, 0, At, B0); PG8_BAR; PG8_SCHED;
            PG8_LDB(B1, 0, 1); PG8_STAGE(PG8_SB(0, 0), b2, voffB);
            PG8_BAR; PG8_WAIT_L(0); PG8_MMA(0, 1, At, B1); PG8_BAR;
            PG8_LDA(At, 0, 1); PG8_STAGE(PG8_SA(0, 0), a2, voffA);
            PG8_BAR; PG8_WAIT_L(0); PG8_MMA(1, 0, At, B0); PG8_BAR; PG8_SCHED;
            PG8_STAGE(PG8_SB(0, 1), b2 + hstep, voffB);
            PG8_WAIT_V(6); PG8_BAR; PG8_MMA(1, 1, At, B1); PG8_BAR;
            PG8_LDB(B0, 1, 0); PG8_SCHED; PG8_LDA(At, 1, 0); PG8_STAGE(PG8_SA(0, 1), a2 + hstep, voffA);
            PG8_WAIT_L(8); PG8_BAR; PG8_WAIT_L(0); PG8_MMA(0, 0, At, B0); PG8_BAR; PG8_SCHED;
            PG8_LDB(B1, 1, 1); PG8_STAGE(PG8_SB(1, 0), b3, voffB);
            PG8_BAR; PG8_WAIT_L(0); PG8_MMA(0, 1, At, B1); PG8_BAR;
            PG8_LDA(At, 1, 1); PG8_STAGE(PG8_SA(1, 0), a3, voffA);
            PG8_BAR; PG8_WAIT_L(0); PG8_MMA(1, 0, At, B0); PG8_BAR; PG8_SCHED;
            PG8_STAGE(PG8_SB(1, 1), b3 + hstep, voffB);
            PG8_WAIT_V(6); PG8_BAR; PG8_MMA(1, 1, At, B1); PG8_BAR;
            }
        }
        if constexpr (FP8 || FP4 || I8) {
            asm volatile("s_nop 15\n\ts_nop 15" : "+v"(acc[0][0][0][0]), "+v"(acc[0][0][0][1]), "+v"(acc[0][0][1][0]), "+v"(acc[0][0][1][1]), "+v"(acc[0][0][2][0]), "+v"(acc[0][0][2][1]), "+v"(acc[0][0][3][0]), "+v"(acc[0][0][3][1]), "+v"(acc[0][1][0][0]), "+v"(acc[0][1][0][1]), "+v"(acc[0][1][1][0]), "+v"(acc[0][1][1][1]), "+v"(acc[0][1][2][0]), "+v"(acc[0][1][2][1]), "+v"(acc[0][1][3][0]), "+v"(acc[0][1][3][1]));
            asm volatile("" : "+v"(acc[1][0][0][0]), "+v"(acc[1][0][0][1]), "+v"(acc[1][0][1][0]), "+v"(acc[1][0][1][1]), "+v"(acc[1][0][2][0]), "+v"(acc[1][0][2][1]), "+v"(acc[1][0][3][0]), "+v"(acc[1][0][3][1]), "+v"(acc[1][1][0][0]), "+v"(acc[1][1][0][1]), "+v"(acc[1][1][1][0]), "+v"(acc[1][1][1][1]), "+v"(acc[1][1][2][0]), "+v"(acc[1][1][2][1]), "+v"(acc[1][1][3][0]), "+v"(acc[1][1][3][1])); }
        if constexpr (I8) {
#pragma unroll
            for (int a = 0; a < 2; ++a)
#pragma unroll
                for (int b = 0; b < 2; ++b)
#pragma unroll
                    for (int m = 0; m < 4; ++m)
#pragma unroll
                        for (int n = 0; n < 2; ++n) acc[a][b][m][n] = __builtin_convertvector(__builtin_bit_cast(v4i_t, acc[a][b][m][n]), f32x4); }
        if constexpr (ALIGN_EPI) { if (wr == 0) PG8_BAR; }
        if constexpr (!Epi::AFTER_DRAIN) { E(acc, cur, wr, wc, fr, fq); S.done(cur); }
        if (!has_next) break;
#pragma unroll
        for (int a = 0; a < 2; ++a)
#pragma unroll
            for (int b = 0; b < 2; ++b)
#pragma unroll
                for (int m = 0; m < 4; ++m)
#pragma unroll
                    for (int n = 0; n < 2; ++n) acc[a][b][m][n] = (f32x4){0.f, 0.f, 0.f, 0.f};
        cur = nxt; cA = nA; cB = nB; ++ui;
        if constexpr (ALIGN_EPI) { if (wr == 1) PG8_BAR; }
    }
    PG8_WAIT_V(0);
    if constexpr (!ALIGN_EPI) { if (wr == 0) PG8_BAR; }
    PG8_BAR;
    if constexpr (Epi::AFTER_DRAIN) { E.fused(acc, cur, wr, wc, fr, fq, lds, wid, lane); S.done(cur); }
#undef PG8_SA
#undef PG8_SB
#undef PG8_STAGE
#undef PG8_LDA
#undef PG8_LDB
#undef PG8_MMA
#undef PG8_ALIGN_MFMA
#undef PG8_ALIGN_MFMA8
#undef PG8_WAIT_V
#undef PG8_WAIT_L
#undef PG8_BAR
#undef PG8_SCHED
}
}
#define XB_TMO      128
#define XB_XCNT(j)  (256  + 64 * (j))
#define XB_XSUB(j)  (1280 + 64 * (j))
#define XB_XGEN(j)  (2304 + 64 * (j))
#define XB_TOP      3328
#define XB_TOPGEN   3392
#define XCD_BAR_WORDS 3456
#define XB_SPIN_CAP (1u << 20)

__device__ __forceinline__ unsigned xb_ld(unsigned* p)              { return __hip_atomic_load(p, __ATOMIC_RELAXED, __HIP_MEMORY_SCOPE_AGENT); }
__device__ __forceinline__ unsigned xb_add(unsigned* p, unsigned v) { return __hip_atomic_fetch_add(p, v, __ATOMIC_RELAXED, __HIP_MEMORY_SCOPE_AGENT); }
__device__ __forceinline__ unsigned xb_xcc_id() { return (unsigned)__builtin_amdgcn_s_getreg((3 << 11) | 20) & 0xFu; }
#define XB_SPIN(cond, bar) do { unsigned _sp = 0; while (cond) { __builtin_amdgcn_s_sleep(1); \
    if ((++_sp & 255u) == 0u) { if (xb_ld(&(bar)[XB_TMO])) break; if (_sp > XB_SPIN_CAP) { atomicAdd(&(bar)[XB_TMO], 1u); break; } } } } while (0)

struct XcdBarrier {
    unsigned* bar; unsigned x;
    volatile LAS unsigned* st;
};

__device__ __forceinline__ XcdBarrier xcd_barrier_post(unsigned* bar, volatile LAS unsigned* st) {
    XcdBarrier b; b.bar = bar; b.x = xb_xcc_id(); b.st = st;
    if (threadIdx.x == 0) (void)xb_add(&bar[XB_XCNT(b.x)], 1u);
    return b;
}
__device__ __forceinline__ void xcd_barrier_complete(unsigned* bar, unsigned x, unsigned& nloc, unsigned& nx) {
    const unsigned G = gridDim.x * gridDim.y * gridDim.z;
    unsigned sum, cnt, mine, sp = 0u;
    for (;;) {
        sum = 0u; cnt = 0u; mine = 0u;
#pragma unroll
        for (unsigned j = 0; j < 16; ++j) { const unsigned c = xb_ld(&bar[XB_XCNT(j)]); sum += c; cnt += (c > 0u) ? 1u : 0u; mine = (j == x) ? c : mine; }
        if (sum == G) break;
        __builtin_amdgcn_s_sleep(1);
        if ((++sp & 255u) == 0u) { if (xb_ld(&bar[XB_TMO])) break; if (sp > XB_SPIN_CAP) { atomicAdd(&bar[XB_TMO], 1u); break; } }
    }
    nloc = mine > 0u ? mine : 1u; nx = cnt > 0u ? cnt : 1u;
}

__device__ __forceinline__ void xcd_barrier(const XcdBarrier& b) {
    asm volatile("s_waitcnt vmcnt(0)" ::: "memory");
    __syncthreads();
    if (threadIdx.x == 0) {
        unsigned* bar = b.bar;
        __builtin_amdgcn_s_waitcnt(0);
        unsigned nloc = b.st[0], nx = b.st[1];
        if (nloc == 0u) { xcd_barrier_complete(bar, b.x, nloc, nx); b.st[0] = nloc; b.st[1] = nx; }
        const unsigned old = xb_add(&bar[XB_XSUB(b.x)], 1u);
        const unsigned gen = old / nloc;
        if (old + 1u == (gen + 1u) * nloc) {
            __builtin_amdgcn_fence(__ATOMIC_RELEASE, "agent");
            asm volatile("s_waitcnt vmcnt(0)" ::: "memory");
            const unsigned og = xb_add(&bar[XB_TOP], 1u);
            const unsigned tg = og / nx;
            if (og + 1u == (tg + 1u) * nx) xb_add(&bar[XB_TOPGEN], 1u);
            else XB_SPIN(xb_ld(&bar[XB_TOPGEN]) == tg, bar);
            __builtin_amdgcn_fence(__ATOMIC_ACQUIRE, "agent");
            xb_add(&bar[XB_XGEN(b.x)], 1u);
            asm volatile("s_waitcnt vmcnt(0)" ::: "memory");
        } else {
            XB_SPIN(xb_ld(&bar[XB_XGEN(b.x)]) == gen, bar);
            __builtin_amdgcn_fence(__ATOMIC_ACQUIRE, "agent");
            asm volatile("s_waitcnt vmcnt(0)" ::: "memory");
        }
    }
    __syncthreads();
}

template <int MAP> __device__ __forceinline__ int rowmap(int n) {
    if (MAP == 1) return n - 6400;
    if (MAP == 4) return n < 6400 ? n : (n < 10656 ? n + 3936 : n - 8352);
    if (MAP == 2) return (n >> 7) * 256 + (n & 127);
    if (MAP == 3) return (n >> 7) * 256 + 128 + (n & 127);
    return n;
}
__device__ __forceinline__ void p0_load(const float* W, int N, int item, f32x4 (&r)[8], int lane) {
    const int nblk = N / 32, kb = item / nblk, nb = item % nblk;
    const float* p = W + (size_t)(64 * kb + (lane >> 3)) * N + 32 * nb + 4 * (lane & 7);
#pragma unroll
    for (int i = 0; i < 8; ++i) r[i] = *(const GAS f32x4*)(p + (size_t)(8 * i) * N);
}
template <int MAP, bool SM = false> __device__ __forceinline__ void p0_finish(const f32x4 (&r)[8], int N, bf16* dst, int ldd, int koff, LAS float* scr, int item, int lane) {
    const int nblk = N / 32, kb = item / nblk, nb = item % nblk, k0 = 64 * kb, n0 = 32 * nb;
#pragma unroll
    for (int i = 0; i < 8; ++i) { LAS float* s = scr + (8 * i + (lane >> 3)) * 33 + 4 * (lane & 7); s[0] = r[i].x; s[1] = r[i].y; s[2] = r[i].z; s[3] = r[i].w; }
    LDS_WAIT(); asm volatile("" ::: "memory");
    const int c = lane & 7, r0 = rowmap<MAP>(n0);
#pragma unroll
    for (int j = 0; j < 4; ++j) { const int n = (lane >> 3) + 8 * j; const LAS float* s = scr + (8 * c) * 33 + n;
        v4u o; if (SM) { o.x = cvt_pk_bf16(rnd_sm(s[0 * 33]), rnd_sm(s[1 * 33])); o.y = cvt_pk_bf16(rnd_sm(s[2 * 33]), rnd_sm(s[3 * 33])); o.z = cvt_pk_bf16(rnd_sm(s[4 * 33]), rnd_sm(s[5 * 33])); o.w = cvt_pk_bf16(rnd_sm(s[6 * 33]), rnd_sm(s[7 * 33])); }
        else { o.x = cvt_pk_bf16(s[0 * 33], s[1 * 33]); o.y = cvt_pk_bf16(s[2 * 33], s[3 * 33]); o.z = cvt_pk_bf16(s[4 * 33], s[5 * 33]); o.w = cvt_pk_bf16(s[6 * 33], s[7 * 33]); }
        *(GAS v4u*)(dst + (size_t)(r0 + n) * ldd + koff + k0 + 8 * c) = o; }
    LDS_WAIT(); asm volatile("" ::: "memory");
}
template <int MAP> __device__ __forceinline__ void p0_finish8(const f32x4 (&r)[8], int N, unsigned char* dst, int ldd, LAS float* scr, int item, int lane) {
    const int nblk = N / 32, kb = item / nblk, nb = item % nblk, k0 = 64 * kb, n0 = rowmap<MAP>(32 * nb);
#pragma unroll
    for (int i = 0; i < 8; ++i) { LAS float* s = scr + (8 * i + (lane >> 3)) * 33 + 4 * (lane & 7); s[0] = r[i].x; s[1] = r[i].y; s[2] = r[i].z; s[3] = r[i].w; }
    LDS_WAIT(); asm volatile("" ::: "memory");
    const int c = lane & 7;
#pragma unroll
    for (int j = 0; j < 4; ++j) { const int n = (lane >> 3) + 8 * j; const LAS float* s = scr + (8 * c) * 33 + n; v2u o;
        o.x = (unsigned)__builtin_amdgcn_cvt_pk_fp8_f32(64.f * s[2 * 33], 64.f * s[3 * 33], __builtin_amdgcn_cvt_pk_fp8_f32(64.f * s[0 * 33], 64.f * s[1 * 33], 0, false), true);
        o.y = (unsigned)__builtin_amdgcn_cvt_pk_fp8_f32(64.f * s[6 * 33], 64.f * s[7 * 33], __builtin_amdgcn_cvt_pk_fp8_f32(64.f * s[4 * 33], 64.f * s[5 * 33], 0, false), true);
        *(GAS v2u*)(dst + (size_t)(n0 + n) * ldd + k0 + 8 * c) = o; }
    LDS_WAIT(); asm volatile("" ::: "memory");
}
template <int MAP> __device__ __forceinline__ void p0_finish_i8(const f32x4 (&r)[8], int N, unsigned char* dst, int ldd, float wsc, LAS float* scr, int item, int lane) {
    const int nblk = N / 32, kb = item / nblk, nb = item % nblk, k0 = 64 * kb, n0 = rowmap<MAP>(32 * nb);
#pragma unroll
    for (int i = 0; i < 8; ++i) { LAS float* s = scr + (8 * i + (lane >> 3)) * 33 + 4 * (lane & 7); s[0] = r[i].x; s[1] = r[i].y; s[2] = r[i].z; s[3] = r[i].w; }
    LDS_WAIT(); asm volatile("" ::: "memory");
    const int c = lane & 7;
#pragma unroll
    for (int j = 0; j < 4; ++j) { const int n = (lane >> 3) + 8 * j; const LAS float* s = scr + (8 * c) * 33 + n;
        *(GAS v2u*)(dst + (size_t)(n0 + n) * ldd + k0 + 8 * c) = pack8_i8((f32x4){wsc * s[0 * 33], wsc * s[1 * 33], wsc * s[2 * 33], wsc * s[3 * 33]}, (f32x4){wsc * s[4 * 33], wsc * s[5 * 33], wsc * s[6 * 33], wsc * s[7 * 33]}); }
    LDS_WAIT(); asm volatile("" ::: "memory");
}
__device__ __forceinline__ void p0_finish_i8h(const f32x4 (&r)[8], int N, unsigned char* dst, int ldd, float wsc, LAS float* scr, int item, int lane) {
    const int nblk = N / 32, kb = item / nblk, nb = item % nblk, k0 = 64 * kb, n0 = 32 * nb;
#pragma unroll
    for (int i = 0; i < 8; ++i) { LAS float* s = scr + (8 * i + (lane >> 3)) * 33 + 4 * (lane & 7); s[0] = r[i].x; s[1] = r[i].y; s[2] = r[i].z; s[3] = r[i].w; }
    LDS_WAIT(); asm volatile("" ::: "memory");
    const int n = lane & 31, half = lane >> 5; const LAS float* s = scr + (32 * half) * 33 + n;
    float v[32];
#pragma unroll
    for (int i = 0; i < 32; ++i) v[i] = s[i * 33];
#pragma unroll
    for (int h = 1; h < 32; h <<= 1)
#pragma unroll
        for (int i = 0; i < 32; ++i) if (!(i & h)) { const float a = v[i], b = v[i | h]; v[i] = a + b; v[i | h] = a - b; }
    const float c = wsc * 0.17677669529663687f;
    unsigned char* p = dst + (size_t)(n0 + n) * ldd + k0 + 32 * half;
#pragma unroll
    for (int q = 0; q < 2; ++q) { const v2u lo = pack8_i8((f32x4){v[16 * q], v[16 * q + 1], v[16 * q + 2], v[16 * q + 3]} * c, (f32x4){v[16 * q + 4], v[16 * q + 5], v[16 * q + 6], v[16 * q + 7]} * c),
                                            hi = pack8_i8((f32x4){v[16 * q + 8], v[16 * q + 9], v[16 * q + 10], v[16 * q + 11]} * c, (f32x4){v[16 * q + 12], v[16 * q + 13], v[16 * q + 14], v[16 * q + 15]} * c);
        *(GAS v4u*)(p + 16 * q) = (v4u){lo.x, lo.y, hi.x, hi.y}; }
    LDS_WAIT(); asm volatile("" ::: "memory");
}
template <bool NORM, bool GAIN, bool ROT = false> __device__ __forceinline__ void quant_row_i8(const bf16* xrow, const float* gain, unsigned char* orow, float* fac, int lane, const float clip = 4.0f, float* faca = nullptr, const float sgu = 0.f) {
    f32x4 a[8][2]; float sx = 0.f, sa = 0.f;
#pragma unroll
    for (int j = 0; j < 8; ++j) { const v4u w = *(const GAS v4u*)(xrow + (lane + 64 * j) * 8); f32x4 x0, x1; unpack8(w, x0, x1);
        if constexpr (GAIN) { const f32x4 g0 = *(const GAS f32x4*)(gain + (lane + 64 * j) * 8), g1 = *(const GAS f32x4*)(gain + (lane + 64 * j) * 8 + 4); a[j][0] = x0 * g0; a[j][1] = x1 * g1; }
        else { a[j][0] = x0; a[j][1] = x1; }
#pragma unroll
        for (int i = 0; i < 4; ++i) { sx += x0[i] * x0[i] + x1[i] * x1[i]; sa += a[j][0][i] * a[j][0][i] + a[j][1][i] * a[j][1][i]; } }
    if constexpr (NORM) sx = wave_sum(sx);
    sa = wave_sum(sa);
    float sc = 127.0f / (clip * sqrtf(sa * (1.0f / DM)) + 1e-30f);
    if constexpr (ROT) {
        const float s1_ = (lane & 1) ? -1.0f : 1.0f, s2_ = (lane & 2) ? -1.0f : 1.0f;
#pragma unroll
        for (int j = 0; j < 8; ++j) { float v_[8] = {a[j][0][0], a[j][0][1], a[j][0][2], a[j][0][3], a[j][1][0], a[j][1][1], a[j][1][2], a[j][1][3]};
#pragma unroll
            for (int h_ = 1; h_ < 8; h_ <<= 1)
#pragma unroll
                for (int i_ = 0; i_ < 8; ++i_) if (!(i_ & h_)) { const float p_ = v_[i_], q_ = v_[i_ | h_]; v_[i_] = p_ + q_; v_[i_ | h_] = p_ - q_; }
#pragma unroll
            for (int i_ = 0; i_ < 8; ++i_) { const float t_ = __int_as_float(__builtin_amdgcn_update_dpp(0, __float_as_int(v_[i_]), 0xB1, 0xF, 0xF, true)); v_[i_] = (lane & 1) ? t_ - v_[i_] : v_[i_] + t_; }
#pragma unroll
            for (int i_ = 0; i_ < 8; ++i_) { const float t_ = __int_as_float(__builtin_amdgcn_update_dpp(0, __float_as_int(v_[i_]), 0x4E, 0xF, 0xF, true)); v_[i_] = (lane & 2) ? t_ - v_[i_] : v_[i_] + t_; }
            a[j][0] = (f32x4){v_[0], v_[1], v_[2], v_[3]}; a[j][1] = (f32x4){v_[4], v_[5], v_[6], v_[7]}; }
        (void)s1_; (void)s2_;
        sc *= 0.17677669529663687f; }
#pragma unroll
    for (int j = 0; j < 8; ++j) *(GAS v2u*)(orow + (lane + 64 * j) * 8) = pack8_i8(a[j][0] * sc, a[j][1] * sc);
    if constexpr (ROT) sc *= 5.656854249492381f;
    if (lane == 0) { *fac = NORM ? (1.0f / sqrtf(sx * (1.0f / DM) + EPS)) / sc : 1.0f / sc;
        if (faca) *faca = ACT_CLIP * (sa / (sx * (1.0f / DM) + EPS)) * sgu * (1.0f / 127.0f); }
}
__device__ __forceinline__ void p0_finish4(const f32x4 (&r)[8], int N, unsigned char* dst, float wsc, LAS float* scr, int item, int lane) {
    const int nblk = N / 32, kb = item / nblk, nb = item % nblk, k0 = 64 * kb, n0 = 32 * nb - 10656;
#pragma unroll
    for (int i = 0; i < 8; ++i) { LAS float* s = scr + (8 * i + (lane >> 3)) * 33 + 4 * (lane & 7); s[0] = r[i].x; s[1] = r[i].y; s[2] = r[i].z; s[3] = r[i].w; }
    LDS_WAIT(); asm volatile("" ::: "memory");
    const int c = lane & 7;
#pragma unroll
    for (int j = 0; j < 4; ++j) { const int n = (lane >> 3) + 8 * j; const LAS float* s = scr + (8 * c) * 33 + n;
        const unsigned o = pack4_f4(wsc * s[0 * 33], wsc * s[1 * 33], wsc * s[2 * 33], wsc * s[3 * 33]) | (pack4_f4(wsc * s[4 * 33], wsc * s[5 * 33], wsc * s[6 * 33], wsc * s[7 * 33]) << 16);
        *(GAS unsigned*)(dst + (size_t)(n0 + n) * 2048 + (k0 >> 1) + 4 * c) = o; }
    LDS_WAIT(); asm volatile("" ::: "memory");
}
__device__ __forceinline__ void rms_row_to_bf16(const float* xrow, const float* gain, bf16* orow, unsigned char* orow8, unsigned char* orow4, float* fach, int lane) {
    const GAS f32x4* xr = (const GAS f32x4*)xrow + lane;
    f32x4 v[16]; float s = 0.f;
#pragma unroll
    for (int j = 0; j < 16; ++j) { v[j] = xr[64 * j]; s += (v[j].x * v[j].x + v[j].y * v[j].y) + (v[j].z * v[j].z + v[j].w * v[j].w); }
    const float r = 1.0f / sqrtf(wave_sum(s) * (1.0f / DM) + EPS);
    GAS v2u* o8 = (GAS v2u*)orow + lane; GAS unsigned* o4 = (GAS unsigned*)orow8 + lane; GAS unsigned short* o2 = (GAS unsigned short*)orow4 + lane;
    float sh = 0.f;
#pragma unroll
    for (int j = 0; j < 16; ++j) { const f32x4 gv = ((const GAS f32x4*)gain)[lane + 64 * j]; v[j] = v[j] * r * gv; sh += (v[j].x * v[j].x + v[j].y * v[j].y) + (v[j].z * v[j].z + v[j].w * v[j].w); }
    const float sc = 127.0f / (4.0f * sqrtf(wave_sum(sh) * (1.0f / DM)) + 1e-30f);
#pragma unroll
    for (int j = 0; j < 16; ++j) { const f32x4 y = v[j];
        v2u w; w.x = cvt_pk_bf16(y.x, y.y); w.y = cvt_pk_bf16(y.z, y.w); o8[64 * j] = w;
        o4[64 * j] = q8(y.x * sc) | (q8(y.y * sc) << 8) | (q8(y.z * sc) << 16) | (q8(y.w * sc) << 24);
        o2[64 * j] = (unsigned short)pack4_f4(2.0f * y.x, 2.0f * y.y, 2.0f * y.z, 2.0f * y.w); }
    if (lane == 0) *fach = 1.0f / sc;
}

__device__ __forceinline__ unsigned ordkey(float v) { const unsigned u = __float_as_uint(v); return u ^ ((u >> 31) ? 0xffffffffu : 0x80000000u); }
__device__ __forceinline__ int mbcnt64(unsigned long long m) { return (int)__builtin_amdgcn_mbcnt_hi((unsigned)(m >> 32), __builtin_amdgcn_mbcnt_lo((unsigned)m, 0u)); }

__device__ __forceinline__ int wave_count(int cl) { int c = 0;
#pragma unroll
    for (int b = 0; b < 7; ++b) c += __popcll(__ballot((cl >> b) & 1)) << b;
    return c; }
constexpr int TOPK_WAVE_LDS = 6144;
__device__ __forceinline__ void topk_row(const float* sc, int N, unsigned short* out, LAS unsigned char* wl, int lane) {
    asm volatile("" : "+v"(lane));
    if (N <= TOPK) { v2u w; w.x = (unsigned)(4 * lane) | ((unsigned)(4 * lane + 1) << 16); w.y = (unsigned)(4 * lane + 2) | ((unsigned)(4 * lane + 3) << 16); *(GAS v2u*)(out + 4 * lane) = w; return; }
    LAS unsigned* hist = (LAS unsigned*)wl; LAS unsigned short* stg = (LAS unsigned short*)(wl + 4096);
    LAS unsigned* ckl = (LAS unsigned*)(wl + 4608); LAS unsigned short* cel = (LAS unsigned short*)(wl + 5632);
    const int ng = (N + 1023) >> 10;
    unsigned key[4][16]; int npos = 0;
#pragma unroll
    for (int g = 0; g < 4; ++g) {
#pragma unroll
        for (int j = 0; j < 16; ++j) key[g][j] = 0u;
        if (g < ng) {
            float v_[16];
#pragma unroll
            for (int j = 0; j < 16; ++j) v_[j] = sc[g * 1024 + j * 64 + lane];
            asm volatile("" : "+v"(v_[0]), "+v"(v_[1]), "+v"(v_[2]), "+v"(v_[3]), "+v"(v_[4]), "+v"(v_[5]), "+v"(v_[6]), "+v"(v_[7]), "+v"(v_[8]), "+v"(v_[9]), "+v"(v_[10]), "+v"(v_[11]), "+v"(v_[12]), "+v"(v_[13]), "+v"(v_[14]), "+v"(v_[15]));
#pragma unroll
            for (int j = 0; j < 16; ++j) { const int e = g * 1024 + j * 64 + lane; key[g][j] = e < N ? ordkey(v_[j]) : 0u; }
#pragma unroll
            for (int j = 0; j < 16; ++j) { const bool pos = key[g][j] > 0x80000000u; npos += __popcll(__ballot(pos));
                if (pos) (void)__hip_atomic_fetch_add(hist + (key[g][j] >> 22), 1u << ((key[g][j] >> 17) & 16u), __ATOMIC_RELAXED, __HIP_MEMORY_SCOPE_WORKGROUP); }
        } }
    if (npos < TOPK) {
#pragma unroll
        for (int g = 0; g < 4; ++g) if (g < ng) {
#pragma unroll
            for (int j = 0; j < 16; ++j) if (!(key[g][j] > 0x80000000u)) (void)__hip_atomic_fetch_add(hist + (key[g][j] >> 22), 1u << ((key[g][j] >> 17) & 16u), __ATOMIC_RELAXED, __HIP_MEMORY_SCOPE_WORKGROUP); } }
    unsigned h[32]; unsigned sl = 0u;
    { const LAS v4u* hp = (const LAS v4u*)(hist + 1024 - 16 * (lane + 1));
#pragma unroll
      for (int i = 0; i < 4; ++i) { const v4u t = hp[i];
          h[8 * i] = t.x & 0xffffu; h[8 * i + 1] = t.x >> 16; h[8 * i + 2] = t.y & 0xffffu; h[8 * i + 3] = t.y >> 16; h[8 * i + 4] = t.z & 0xffffu; h[8 * i + 5] = t.z >> 16; h[8 * i + 6] = t.w & 0xffffu; h[8 * i + 7] = t.w >> 16;
          sl += ((t.x & 0xffffu) + (t.x >> 16)) + ((t.y & 0xffffu) + (t.y >> 16)) + ((t.z & 0xffffu) + (t.z >> 16)) + ((t.w & 0xffffu) + (t.w >> 16)); }
      LAS v4u* hz = (LAS v4u*)(hist + 1024 - 16 * (lane + 1));
#pragma unroll
      for (int i = 0; i < 4; ++i) hz[i] = (v4u){0u, 0u, 0u, 0u}; }
    unsigned El = 0u;
#pragma unroll
    for (int b = 0; b < 13; ++b) El += (unsigned)mbcnt64(__ballot((sl >> b) & 1u)) << b;
    int kb = 0; unsigned ab = 0u, cb = 0u; { unsigned acc = El;
#pragma unroll
      for (int k = 31; k >= 0; --k) { const bool hit = acc < (unsigned)TOPK && acc + h[k] >= (unsigned)TOPK; kb = hit ? k : kb; ab = hit ? acc : ab; cb = hit ? h[k] : cb; acc += h[k]; } }
    const int Ls = __ffsll((long long)__ballot(El < (unsigned)TOPK && El + sl >= (unsigned)TOPK)) - 1;
    const unsigned b1 = (unsigned)(2048 - 32 * (Ls + 1) + __builtin_amdgcn_readlane(kb, Ls));
    const int above = (int)__builtin_amdgcn_readlane((int)ab, Ls), C = (int)__builtin_amdgcn_readlane((int)cb, Ls);
    int base = 0;
    if (C <= 256) {
        int cbase = 0;
#pragma unroll
        for (int g = 0; g < 4; ++g) if (g < ng) {
#pragma unroll
            for (int j = 0; j < 16; ++j) { const unsigned d = key[g][j] >> 21; const bool up = d > b1, cd = d == b1;
                const unsigned long long mu = __ballot(up), mc = __ballot(cd);
                if (up) stg[base + mbcnt64(mu)] = (unsigned short)(g * 1024 + j * 64 + lane);
                if (cd) { const int cp = cbase + mbcnt64(mc); ckl[cp] = key[g][j]; cel[cp] = (unsigned short)(g * 1024 + j * 64 + lane); }
                base += __popcll(mu); cbase += __popcll(mc); } }
        LDS_WAIT();
        unsigned ck[4]; unsigned ce[4];
#pragma unroll
        for (int m = 0; m < 4; ++m) { const int i = lane + 64 * m; ck[m] = i < C ? ckl[i] : 0u; ce[m] = cel[i]; }
        const int need = TOPK - above;
        unsigned T = b1 << 21; bool exact = false;
#pragma unroll 1
        for (int bit = 20; bit >= 0; --bit) { const unsigned cand = T | (1u << bit); int c = 0;
#pragma unroll
            for (int m = 0; m < 4; ++m) c += __popcll(__ballot(ck[m] >= cand));
            if (c >= need) { T = cand; if (c == need) { exact = true; break; } } }
        int need_eq = 1 << 30;
        if (!exact) { int cg = 0;
#pragma unroll
            for (int m = 0; m < 4; ++m) cg += __popcll(__ballot(ck[m] > T));
            need_eq = need - cg; }
        int eqb = 0;
#pragma unroll
        for (int m = 0; m < 4; ++m) { const bool gt = ck[m] > T, eq = ck[m] == T && ck[m] != 0u; const unsigned long long meq = __ballot(eq);
            const bool sel = gt || (eq && (eqb + mbcnt64(meq)) < need_eq); const unsigned long long ms = __ballot(sel);
            if (sel) stg[base + mbcnt64(ms)] = (unsigned short)ce[m];
            base += __popcll(ms); eqb += __popcll(meq); }
    } else {
        unsigned T = 0u; bool exact = false;
#pragma unroll 1
        for (int bit = 31; bit >= 0; --bit) {
            const unsigned cand = T | (1u << bit); int c = 0;
#pragma unroll
            for (int g = 0; g < 4; ++g) if (g < ng) {
#pragma unroll
                for (int j = 0; j < 16; ++j) c += __popcll(__ballot(key[g][j] >= cand)); }
            if (c >= TOPK) { T = cand; if (c == TOPK) { exact = true; break; } }
        }
        int need_eq = 1 << 30;
        if (!exact) { int cg = 0;
#pragma unroll
            for (int g = 0; g < 4; ++g) if (g < ng) {
#pragma unroll
                for (int j = 0; j < 16; ++j) cg += __popcll(__ballot(key[g][j] > T)); }
            need_eq = TOPK - cg; }
        int eqb = 0;
#pragma unroll
        for (int g = 0; g < 4; ++g) if (g < ng) {
#pragma unroll
            for (int j = 0; j < 16; ++j) { const bool gt = key[g][j] > T, eq = key[g][j] == T; const unsigned long long meq = __ballot(eq);
                const bool sel = gt || (eq && (eqb + mbcnt64(meq)) < need_eq); const unsigned long long ms = __ballot(sel);
                if (sel) stg[base + mbcnt64(ms)] = (unsigned short)(g * 1024 + j * 64 + lane);
                base += __popcll(ms); eqb += __popcll(meq); } }
    }
    LDS_WAIT();
    *(GAS v2u*)(out + 4 * lane) = *(const LAS v2u*)(stg + 4 * lane);
    LDS_WAIT();
}

#ifndef IDX_SCHED_BARRIER
#define IDX_SCHED_BARRIER 2
#endif
__device__ __forceinline__ void indexer_unit(LAS unsigned char* lds, int tid, int wave, int lane, int b, int qg,
                                             const bf16* QIDX, const bf16* KIDX, const float* WIDX, float* SC, unsigned short* IDX) {
    LAS unsigned char* KT = lds;
    LAS float* WT = (LAS float*)(lds + 65536);
    asm volatile("" : "+v"(lane), "+v"(tid));
    const int q0 = qg * 32, nkeys = q0 + 32, r = lane & 31, hh = lane >> 5;
    const size_t rowb = (size_t)b * SEQ;
    __syncthreads();
    const int hl = lane & 15, g = lane >> 4;
    bf16x8 A[4][2][4]; f32x4 W4[4][2];
#pragma unroll
    for (int qi = 0; qi < 4; ++qi)
#pragma unroll
        for (int hf = 0; hf < 2; ++hf) { W4[qi][hf] = *(const GAS f32x4*)(WIDX + (rowb + q0 + 4 * wave + qi) * 32 + 16 * hf + 4 * g);
#pragma unroll
            for (int kk = 0; kk < 4; ++kk) A[qi][hf][kk] = *(const GAS bf16x8*)(QIDX + (rowb + q0 + 4 * wave + qi) * 4096 + (16 * hf + hl) * 128 + 32 * kk + 8 * g); }
    const int nch = (nkeys + 127) >> 7;
    const int srow = 16 * wave + (lane >> 4), slot = lane & 15;
#define IDX_STAGE(ch_, buf_) do { _Pragma("unroll") for (int i_ = 0; i_ < 4; ++i_) { const int krow_ = srow + 4 * i_; \
        __builtin_amdgcn_global_load_lds((const GAS unsigned*)(KIDX + (rowb + (ch_) * 128 + krow_) * 128 + ((slot ^ (krow_ & 15)) << 3)), (LAS unsigned*)((buf_) + (16 * wave + 4 * i_) * 256), 16, 0, 0); } } while (0)
    IDX_STAGE(0, KT);
    for (int ch = 0; ch < nch; ++ch) {
        LAS unsigned char* buf = KT + (ch & 1) * 32768;
        if (ch == 0) VM_WAIT(); else asm volatile("s_waitcnt vmcnt(16)" ::: "memory");
        __syncthreads();
        if (ch + 1 < nch) IDX_STAGE(ch + 1, KT + ((ch + 1) & 1) * 32768);
        const int rem = (nkeys - ch * 128) >> 5, ntile = rem < 4 ? rem : 4;
        for (int tile = 0; tile < ntile; ++tile) {
            bf16x8 Bf[2][4];
#pragma unroll
            for (int st = 0; st < 2; ++st)
#pragma unroll
                for (int kk = 0; kk < 4; ++kk) Bf[st][kk] = *(const LAS bf16x8*)(buf + (tile * 32 + 16 * st + hl) * 256 + (((4 * kk + g) ^ hl) << 4));
            const int key = ch * 128 + tile * 32 + 16 * (g & 1) + hl;
#pragma unroll
            for (int qi = 0; qi < 4; ++qi) {
                float s2[2];
#pragma unroll
                for (int st = 0; st < 2; ++st) { f32x4 a0 = {0.f, 0.f, 0.f, 0.f}, a1 = {0.f, 0.f, 0.f, 0.f};
#pragma unroll
                    for (int kk = 0; kk < 4; ++kk) { a0 = __builtin_amdgcn_mfma_f32_16x16x32_bf16(A[qi][0][kk], Bf[st][kk], a0, 0, 0, 0); a1 = __builtin_amdgcn_mfma_f32_16x16x32_bf16(A[qi][1][kk], Bf[st][kk], a1, 0, 0, 0); }
                    float sc = 0.f;
#pragma unroll
                    for (int i = 0; i < 4; ++i) sc += fmaxf(a0[i], 0.f) * W4[qi][0][i] + fmaxf(a1[i], 0.f) * W4[qi][1][i];
                    s2[st] = sc; }
                float tt; { const auto p16 = __builtin_amdgcn_permlane16_swap(__float_as_uint(s2[0]), __float_as_uint(s2[1]), false, false); tt = __uint_as_float(p16[0]) + __uint_as_float(p16[1]);
                            const auto p32 = __builtin_amdgcn_permlane32_swap(__float_as_uint(tt), __float_as_uint(tt), false, false); tt = __uint_as_float(p32[0]) + __uint_as_float(p32[1]); }
                const int qpos = q0 + 4 * wave + qi;
                if (g < 2) SC[(rowb + qpos) * 4096 + key] = tt;
                if (IDX_SCHED_BARRIER == 1 || (IDX_SCHED_BARRIER == 2 && (qi & 1))) __builtin_amdgcn_sched_barrier(0);
            }
        }
    }
#undef IDX_STAGE
    VM_WAIT();
#ifndef DUP_TOPK
#define DUP_TOPK 1
#endif
#pragma unroll 1
    for (int qi = 0; qi < 4 * DUP_TOPK; ++qi) { const int qpos = q0 + 4 * wave + (qi & 3); topk_row(SC + (rowb + qpos) * 4096, qpos + 1, IDX + (rowb + qpos) * 256, lds + 69632 + wave * TOPK_WAVE_LDS, lane); }
}

__device__ __forceinline__ void sgu_unit(LAS unsigned char* lds, int tid, int wave, int lane, int cidx, int grp,
                                         const bf16* UV, const float* LNP, const bf16* SGUW, const float* lng, const float* lnb, const float* sgub, bf16* YAB) {
    constexpr int VP = 544, WP = 272;
    LAS unsigned char* VN = lds;
    LAS unsigned char* WL = lds + 128 * VP;
    LAS float* ST = (LAS float*)(lds + 128 * VP + 128 * WP);
    const int t0 = cidx * 128;
    __syncthreads();
    if (tid < 128) { float s = 0.f, q = 0.f;
#pragma unroll
        for (int i = 0; i < 8; ++i) { const GAS f32x4* p = (const GAS f32x4*)(LNP + ((size_t)i * MTOK + t0 + tid) * 8); const f32x4 a = p[0], b = p[1]; s += (a[0] + a[2]) + (b[0] + b[2]); q += (a[1] + a[3]) + (b[1] + b[3]); }
        const float mean = s * (1.0f / GWID), var = q * (1.0f / GWID) - mean * mean;
        ST[2 * tid] = mean; ST[2 * tid + 1] = 1.0f / sqrtf(var + EPS); }
#pragma unroll
    for (int i = 0; i < 4; ++i) { const int c = (tid & 3) * 4 + i; *(LAS v4u*)(WL + (tid >> 2) * WP + c * 16) = *(const GAS v4u*)(SGUW + ((size_t)grp * 128 + (tid >> 2)) * 128 + c * 8); }
    __syncthreads();
#pragma unroll
    for (int i = 0; i < 8; ++i) { const int id = tid + 512 * i, s = id >> 5, dc = id & 31;
        const v4u w = *(const GAS v4u*)(UV + (size_t)(t0 + s) * 4096 + GWID + grp * GDIM + dc * 8); f32x4 v0, v1; unpack8(w, v0, v1);
        const float mean = ST[2 * s], rstd = ST[2 * s + 1];
        const f32x4 g0 = *(const GAS f32x4*)(lng + grp * GDIM + dc * 8), g1 = *(const GAS f32x4*)(lng + grp * GDIM + dc * 8 + 4);
        const f32x4 b0 = *(const GAS f32x4*)(lnb + grp * GDIM + dc * 8), b1 = *(const GAS f32x4*)(lnb + grp * GDIM + dc * 8 + 4);
        v0 = (v0 - mean) * rstd * g0 + b0; v1 = (v1 - mean) * rstd * g1 + b1;
        *(LAS v4u*)(VN + s * VP + dc * 16) = pack8(v0, v1); }
    __syncthreads();
    const int g = lane >> 4, hl = lane & 15, q = hl >> 2, p = lane & 3;
    f32x4 acc[2][8];
#pragma unroll
    for (int a = 0; a < 2; ++a)
#pragma unroll
        for (int t = 0; t < 8; ++t) acc[a][t] = (f32x4){0.f, 0.f, 0.f, 0.f};
#pragma unroll
    for (int ks = 0; ks < 4; ++ks) {
        bf16x8 vf[2];
#pragma unroll
        for (int ds = 0; ds < 2; ++ds) { const int d0 = (2 * wave + ds) * 16;
            const s16x4 a1 = __builtin_amdgcn_ds_read_tr16_b64_v4i16((LAS s16x4*)(VN + (32 * ks + 4 * g + q) * VP + (d0 + 4 * p) * 2));
            const s16x4 a2 = __builtin_amdgcn_ds_read_tr16_b64_v4i16((LAS s16x4*)(VN + (32 * ks + 16 + 4 * g + q) * VP + (d0 + 4 * p) * 2));
            vf[ds] = (bf16x8){a1[0], a1[1], a1[2], a1[3], a2[0], a2[1], a2[2], a2[3]}; }
#pragma unroll
        for (int tt = 0; tt < 8; ++tt) if (tt >= 2 * ks) {
            const int t = 16 * tt + hl;
            const s16x4 w1 = *(const LAS s16x4*)(WL + t * WP + (32 * ks + 4 * g) * 2), w2 = *(const LAS s16x4*)(WL + t * WP + (32 * ks + 16 + 4 * g) * 2);
            const bf16x8 wf = (bf16x8){w1[0], w1[1], w1[2], w1[3], w2[0], w2[1], w2[2], w2[3]};
#pragma unroll
            for (int ds = 0; ds < 2; ++ds) acc[ds][tt] = __builtin_amdgcn_mfma_f32_16x16x32_bf16(vf[ds], wf, acc[ds][tt], 0, 0, 0);
        }
    }
#pragma unroll
    for (int tt = 0; tt < 8; ++tt) { const int t = 16 * tt + hl; const float bs = sgub[grp * 128 + t]; const size_t rowo = (size_t)(t0 + t) * 4096;
#pragma unroll
        for (int ds = 0; ds < 2; ++ds) { const int d = grp * GDIM + (2 * wave + ds) * 16 + 4 * g;
            const v2u uw = *(const GAS v2u*)(UV + rowo + d);
            v2u o; o.x = cvt_pk_bf16(bf_lo(uw.x) * (acc[ds][tt][0] + bs), bf_hi(uw.x) * (acc[ds][tt][1] + bs)); o.y = cvt_pk_bf16(bf_lo(uw.y) * (acc[ds][tt][2] + bs), bf_hi(uw.y) * (acc[ds][tt][3] + bs));
            *(GAS v2u*)(YAB + (size_t)(t0 + t) * GWID + d) = o; } }
}

#ifndef KB_T
#define KB_T 4
#endif
constexpr int ATT_VB = 32 * 288, ATT_WAVE = ATT_VB + 512, ATT_BL = 8 * ATT_WAVE;
__device__ __forceinline__ void attn_query(LAS unsigned char* wl, const LAS float* BL, int lane, int b, int qpos,
                                           const bf16* Q, const bf16* KN, const bf16* V, const unsigned short* IDX, const float* qgain, bf16* YAB) {
    const int g = lane >> 4, hl = lane & 15, q4 = hl >> 2, p4 = lane & 3;
    const size_t rowb = (size_t)b * SEQ, row = rowb + qpos;
    const int cnt = qpos + 1 < TOPK ? qpos + 1 : TOPK;
    LAS unsigned short* IL = (LAS unsigned short*)(wl + ATT_VB);
    *(LAS v2u*)(IL + 4 * lane) = *(const GAS v2u*)(IDX + row * 256 + 4 * lane);
    bf16x8 qf[4];
    { v2u w[4]; float ss = 0.f;
#pragma unroll
      for (int kk = 0; kk < 4; ++kk) { w[kk] = *(const GAS v2u*)((const unsigned char*)Q + row * 2048 + hl * 128 + kk * 32 + g * 8); f32x4 a, c; unpack8_f8(w[kk], a, c);
          ss += (a[0] * a[0] + a[1] * a[1]) + (a[2] * a[2] + a[3] * a[3]) + (c[0] * c[0] + c[1] * c[1]) + (c[2] * c[2] + c[3] * c[3]); }
      ss += __shfl_xor(ss, 16); ss += __shfl_xor(ss, 32);
      const float rinv = (1.0f / sqrtf(ss * (1.0f / HDA) + EPS)) * 0.08838834764831845f;
#pragma unroll
      for (int kk = 0; kk < 4; ++kk) { f32x4 a, c; unpack8_f8(w[kk], a, c); const f32x4 g0 = *(const GAS f32x4*)(qgain + kk * 32 + g * 8), g1 = *(const GAS f32x4*)(qgain + kk * 32 + g * 8 + 4);
          const v4u o = pack8(a * rinv * g0, c * rinv * g1); qf[kk] = __builtin_bit_cast(bf16x8, o); } }
    f32x4 s[16];
#pragma unroll
    for (int hf = 0; hf < 16 / KB_T; ++hf) {
        bf16x8 kf[KB_T][4];
#pragma unroll
        for (int t8 = 0; t8 < KB_T; ++t8) { const int ki = IL[16 * (KB_T * hf + t8) + hl] & (SEQ - 1); const bf16* kp = KN + (rowb + ki) * 128 + g * 8;
#pragma unroll
            for (int kk = 0; kk < 4; ++kk) kf[t8][kk] = *(const GAS bf16x8*)(kp + kk * 32); }
        __builtin_amdgcn_sched_barrier(0);
#pragma unroll
        for (int t8 = 0; t8 < KB_T; ++t8) { const int t = KB_T * hf + t8; s[t] = (f32x4){0.f, 0.f, 0.f, 0.f};
#pragma unroll
            for (int kk = 0; kk < 4; ++kk) s[t] = __builtin_amdgcn_mfma_f32_16x16x32_bf16(kf[t8][kk], qf[kk], s[t], 0, 0, 0); }
    }
    float mx = -__builtin_inff();
#pragma unroll
    for (int t = 0; t < 16; ++t) { const v2u id = *(const LAS v2u*)(IL + 16 * t + 4 * g); const int kx[4] = {(int)(id.x & 0xffffu), (int)(id.x >> 16), (int)(id.y & 0xffffu), (int)(id.y >> 16)};
#pragma unroll
        for (int i = 0; i < 4; ++i) { int n = qpos - kx[i]; n = n < 0 ? 0 : (n > 128 ? 128 : n);
            const float v = (16 * t + 4 * g + i) < cnt ? s[t][i] + BL[n * 16 + hl] : -__builtin_inff(); s[t][i] = v; mx = fmaxf(mx, v); } }
    mx = fmaxf(mx, __shfl_xor(mx, 16)); mx = fmaxf(mx, __shfl_xor(mx, 32));
    float sum = 0.f;
#pragma unroll
    for (int t = 0; t < 16; ++t)
#pragma unroll
        for (int i = 0; i < 4; ++i) { const float e = __builtin_amdgcn_exp2f((s[t][i] - mx) * LOG2E); s[t][i] = e; sum += e; }
    sum += __shfl_xor(sum, 16); sum += __shfl_xor(sum, 32);
    const float inv = 1.0f / sum;
    bf16x8 pf[8];
#pragma unroll
    for (int T = 0; T < 8; ++T) { const v4u o = pack8(s[2 * T] * inv, s[2 * T + 1] * inv); pf[T] = __builtin_bit_cast(bf16x8, o); }
    f32x4 o[8];
#pragma unroll
    for (int dt = 0; dt < 8; ++dt) o[dt] = (f32x4){0.f, 0.f, 0.f, 0.f};
    v4u vn[8];
#pragma unroll
    for (int ins = 0; ins < 8; ++ins) { const int vi = IL[4 * ins + g] & (SEQ - 1); vn[ins] = *(const GAS v4u*)(V + (rowb + vi) * 128 + hl * 8); }
#pragma unroll
    for (int T = 0; T < 8; ++T) {
#pragma unroll
        for (int ins = 0; ins < 8; ++ins) *(LAS v4u*)(wl + (4 * ins + g) * 288 + hl * 16) = vn[ins];
        if (T < 7) {
#pragma unroll
            for (int ins = 0; ins < 8; ++ins) { const int vi = IL[32 * (T + 1) + 4 * ins + g] & (SEQ - 1); vn[ins] = *(const GAS v4u*)(V + (rowb + vi) * 128 + hl * 8); } }
        __builtin_amdgcn_sched_barrier(0);
#pragma unroll
        for (int dt = 0; dt < 8; ++dt) {
            const s16x4 a1 = __builtin_amdgcn_ds_read_tr16_b64_v4i16((LAS s16x4*)(wl + (4 * g + q4) * 288 + (16 * dt + 4 * p4) * 2));
            const s16x4 a2 = __builtin_amdgcn_ds_read_tr16_b64_v4i16((LAS s16x4*)(wl + (16 + 4 * g + q4) * 288 + (16 * dt + 4 * p4) * 2));
            const bf16x8 vf = (bf16x8){a1[0], a1[1], a1[2], a1[3], a2[0], a2[1], a2[2], a2[3]};
            o[dt] = __builtin_amdgcn_mfma_f32_16x16x32_bf16(vf, pf[T], o[dt], 0, 0, 0);
        }
    }
#pragma unroll
    for (int dt = 0; dt < 8; ++dt)
        *(GAS unsigned*)((unsigned char*)YAB + row * 2048 + hl * 128 + 16 * dt + 4 * g) = (unsigned)__builtin_amdgcn_cvt_pk_fp8_f32(o[dt][2], o[dt][3], __builtin_amdgcn_cvt_pk_fp8_f32(o[dt][0], o[dt][1], 0, false), true);
}

constexpr int NWAVES = 8;
#ifndef DUP_ATT
#define DUP_ATT 1
#endif
#ifndef DUP_SGU
#define DUP_SGU 1
#endif
#ifndef GEMM_SP2
#define GEMM_SP2 true
#endif
#ifndef GEMM_ALIGN
#define GEMM_ALIGN true
#endif
#ifndef MK_N_LAUNCHES
#define MK_N_LAUNCHES 1
#endif
constexpr int N_PHASES = 9;
constexpr int N_LAUNCHES = MK_N_LAUNCHES;
constexpr size_t WS_PB = WS_END;
constexpr size_t WS_NEED = WS_END + 8 * MiB;

__device__ __forceinline__ int lane_now() { int l; asm volatile("v_mbcnt_lo_u32_b32 %0, -1, 0\n\tv_mbcnt_hi_u32_b32 %0, -1, %0" : "=v"(l)); return l; }
struct Args { const float* in[22]; float* out; unsigned char* ws; int ph_lo, ph_hi, li, pad; };
enum { I_X = 0, I_P, I_WIN, I_QNG, I_KNG, I_RELB, I_LNG, I_LNB, I_SGUW, I_SGUB, I_WA, I_WB, I_WOUT, I_NMIX, I_NFFN, I_WG, I_WU, I_WD, I_WPLE, I_PLENG, I_WPG, I_NPLE };

__global__ void __launch_bounds__(NWAVES * 64, 2) fwd_kernel(Args args) {
    extern __shared__ __attribute__((aligned(16))) unsigned char lds_raw[];
    LAS unsigned char* lds = (LAS unsigned char*)lds_raw;
    volatile LAS unsigned* MISC = (volatile LAS unsigned*)(lds + MISC_OFF);
    const int wave = __builtin_amdgcn_readfirstlane(threadIdx.x >> 6);
#define PHASE_IDS() const int lane = lane_now(), tid = wave * 64 + lane
    const int G = gridDim.x, cu = blockIdx.x;
    const int gw = cu * NWAVES + wave, NGW = G * NWAVES;
    unsigned char* ws = args.ws;
    gu32* ctl = (gu32*)(ws + WS_CTL);
    for (int u = threadIdx.x; u < (LDS_BYTES - LDSCTL_OFF) / 4; u += NWAVES * 64) ((LAS unsigned*)(lds + LDSCTL_OFF))[u] = 0u;
    __syncthreads();
    { const unsigned t_ = threadIdx.x; volatile LAS float* sm_ = (volatile LAS float*)(lds + RING_OFF);
      const float* wi_ = args.in[I_WIN] + (size_t)(8 * t_) * INCOLS + 10656; const int ci_ = (int)((t_ * 37u) & 4095u);
      const float* wg_ = args.in[I_WG] + (size_t)(8 * t_) * DFF; const float* wu_ = args.in[I_WU] + (size_t)(8 * t_) * DFF; const int cg_ = (int)((t_ * 37u) % 5504u);
      const float* wo_ = args.in[I_WOUT] + (size_t)(8 * t_) * DM; const float* wp_ = args.in[I_WPG] + (size_t)(8 * t_) * DM; const float* wd_ = args.in[I_WD] + (size_t)(8 * t_) * DM;
      sm_[t_] = fabsf(wi_[ci_]) + fabsf(wi_[(ci_ + 2048) & 4095]); sm_[512 + t_] = fabsf(wg_[cg_]) + fabsf(wg_[cg_ + 5504]); sm_[1024 + t_] = fabsf(wu_[cg_]) + fabsf(wu_[cg_ + 5504]); sm_[1536 + t_] = fabsf(wo_[ci_]) + fabsf(wo_[(ci_ + 2048) & 4095]); sm_[2048 + t_] = fabsf(wp_[ci_]) + fabsf(wp_[(ci_ + 2048) & 4095]); sm_[2560 + t_] = fabsf(wd_[ci_]) + fabsf(wd_[(ci_ + 2048) & 4095]);
      __syncthreads();
      if (t_ < 48) { float a_ = 0.f; for (int i = 0; i < 64; ++i) a_ += sm_[(t_ >> 3) * 512 + (t_ & 7) * 64 + i]; sm_[3072 + t_] = a_; }
      __syncthreads();
      if (t_ == 0) { float s0_ = 0.f, s1_ = 0.f, s2_ = 0.f, s3_ = 0.f, s4_ = 0.f; float s5_ = 0.f; for (int i = 0; i < 8; ++i) { s0_ += sm_[3072 + i]; s1_ += sm_[3080 + i]; s2_ += sm_[3088 + i]; s3_ += sm_[3096 + i]; s4_ += sm_[3104 + i]; s5_ += sm_[3112 + i]; }
          MISC[22] = __float_as_uint(127.0f / (4.0f * 1.2533141f * fmaxf(s5_, 1e-30f) * (1.0f / 1024.0f)));
          MISC[20] = __float_as_uint(127.0f / (4.0f * 1.2533141f * fmaxf(s3_, 1e-30f) * (1.0f / 1024.0f))); MISC[21] = __float_as_uint(127.0f / (4.0f * 1.2533141f * fmaxf(s4_, 1e-30f) * (1.0f / 1024.0f)));
          int e_ = (int)rintf(__log2f(1.596f * 1024.0f / fmaxf(s0_, 1e-30f))); e_ = e_ < -40 ? -40 : (e_ > 60 ? 60 : e_); MISC[12] = (unsigned)e_;
          MISC[15] = __float_as_uint(127.0f / (4.0f * 1.2533141f * fmaxf(s0_, 1e-30f) * (1.0f / 1024.0f)));
          MISC[13] = __float_as_uint(127.0f / (4.0f * 1.2533141f * fmaxf(s1_, 1e-30f) * (1.0f / 1024.0f))); MISC[14] = __float_as_uint(127.0f / (4.0f * 1.2533141f * fmaxf(s2_, 1e-30f) * (1.0f / 1024.0f))); }
      __syncthreads(); }
    XcdBarrier bar; bar.bar = (unsigned*)(ctl + CW_BAR) + args.li * XCD_BAR_WORDS; bar.x = 0; bar.st = nullptr;
    if (N_LAUNCHES == 1) bar = xcd_barrier_post((unsigned*)(ctl + CW_BAR), MISC + 8);
#define GRID_BAR() do { if (N_LAUNCHES == 1) xcd_barrier(bar); } while (0)
    const int lo = args.ph_lo, hi = args.ph_hi;
#ifndef PH_MASK
#define PH_MASK 0x1ff
#endif
#define IN(k) ((((PH_MASK) >> (k)) & 1) && lo <= (k) && (k) < hi)
#define BOTH(k) (IN(k) && IN((k) + 1))
#ifndef DUP_MASK
#define DUP_MASK 0
#endif
#define REPS(k) (1 + (((DUP_MASK) >> (k)) & 1))

    bf16* const H = (bf16*)(ws + WS_H); bf16* const WINB = (bf16*)(ws + WS_WINB); unsigned char* const WIN8 = ws + WS_WIN8; unsigned char* const W4 = ws + WS_WIN8 + 57 * MiB; unsigned char* const H8 = ws + WS_H8; float* const FACH = (float*)(ws + WS_SSQ2);     unsigned char* const H4 = ws + WS_SGA + 64 * MiB;     bf16* const QIDX = (bf16*)(ws + WS_QIDX); bf16* const Qb = (bf16*)(ws + WS_Q);
    bf16* const UV = (bf16*)(ws + WS_UV); bf16* const SGA = (bf16*)(ws + WS_SGA); bf16* const SGB = (bf16*)(ws + WS_SGB);
    unsigned char* const WA8 = ws + WS_WAB; bf16* const WBB = (bf16*)(ws + WS_WAB + 8 * MiB);     bf16* const WOUT = (bf16*)(ws + WS_WOUT); bf16* const WGU = (bf16*)(ws + WS_WGU); bf16* const WD = (bf16*)(ws + WS_WD);
    bf16* const WPLE = (bf16*)(ws + WS_WPLE); bf16* const WPG = (bf16*)(ws + WS_WPG); bf16* const PB = (bf16*)(ws + WS_PB);
    unsigned short* const IDX = (unsigned short*)(ws + WS_IDX); float* const LNP = (float*)(ws + WS_LNP);
    float* const SSQ1 = (float*)(ws + WS_SSQ1); float* const SSQ2 = (float*)(ws + WS_SSQ2); float* const SSQP = (float*)(ws + WS_SSQP);
    float* const WIDX = (float*)(ws + WS_WIDX); bf16* const KIDX = (bf16*)(ws + WS_KIDX); bf16* const KN = (bf16*)(ws + WS_KN); bf16* const Vb = (bf16*)(ws + WS_V);
    float* const KRAW = (float*)(ws + WS_KRAW); bf16* const SGUW = (bf16*)(ws + WS_SGUW);
    float* const SC = (float*)(ws + WS_SC); bf16* const MERGED = (bf16*)(ws + WS_MERGED); unsigned char* const T8 = ws + WS_MERGED + 128 * MiB;     bf16* const ACT = (bf16*)(ws + WS_ACT); unsigned char* const ACT8 = ws + WS_ACT; unsigned char* const WD8 = ws + WS_Q;     bf16* const YB = (bf16*)(ws + WS_YAB); unsigned char* const YA8 = ws + WS_YAB + 64 * MiB;
    bf16* const X1R = (bf16*)(ws + WS_SGB); bf16* const X2R = (bf16*)(ws + WS_WGU);     bf16* const X1G = (bf16*)(ws + WS_X1G); bf16* const X2G = (bf16*)(ws + WS_X2G); bf16* const PE = (bf16*)(ws + WS_PE);


    constexpr int I_IN = 64 * (INCOLS / 32), I_A = 32 * 128, I_SQ = 64 * 128, I_G = 64 * (DFF / 32), I_D = (DFF / 64) * 128, I_PL = 4 * 128;
    constexpr int NITEMS = I_IN + 2 * I_A + I_SQ + I_PL + 2 * I_G + I_D + I_SQ;
    constexpr int TAIL_A = 15104, TAIL_B = 15104, TAIL_U = 22016;
    static_assert(TAIL_A + TAIL_B <= I_D + I_SQ && TAIL_U <= I_G, "deferred item ranges");
#define CONV_SRC(it_, r_) do { int r_ = (it_); const float* W_; int N_; \
        if (r_ < I_IN) { W_ = args.in[I_WIN]; N_ = INCOLS; } else { r_ -= I_IN; \
        if (r_ < I_A) { W_ = args.in[I_WA]; N_ = DM; } else { r_ -= I_A; \
        if (r_ < I_A) { W_ = args.in[I_WB]; N_ = DM; } else { r_ -= I_A; \
        if (r_ < I_SQ) { W_ = args.in[I_WOUT]; N_ = DM; } else { r_ -= I_SQ; \
        if (r_ < I_PL) { W_ = args.in[I_WPLE]; N_ = DM; } else { r_ -= I_PL; \
        if (r_ < I_G) { W_ = args.in[I_WG]; N_ = DFF; } else { r_ -= I_G; \
        if (r_ < I_G) { W_ = args.in[I_WU]; N_ = DFF; } else { r_ -= I_G; \
        if (r_ < I_D) { W_ = args.in[I_WD]; N_ = DM; } else { r_ -= I_D; W_ = args.in[I_WPG]; N_ = DM; } } } } } } } } \
        p0_load(W_, N_, r_, nx, lane); } while (0)
#define CONV_ITEMS(first_, last_, widx_, wstride_) do { LAS float* scr = (LAS float*)(lds + RING_OFF + wave * 16384); f32x4 nx[8], cr[8]; \
        const int i0_ = (first_) + (widx_), iend_ = (last_), ist_ = (wstride_); \
        if (i0_ < iend_) CONV_SRC(i0_, ra_); \
        for (int it = i0_; it < iend_; it += ist_) { \
            _Pragma("unroll") for (int i = 0; i < 8; ++i) cr[i] = nx[i]; \
            asm volatile("" ::: "memory"); \
            if (it + ist_ < iend_) CONV_SRC(it + ist_, rb_); \
            int r = it; \
            if (r < I_IN) { const int nb_ = r % (INCOLS / 32); if (nb_ >= 200 && nb_ < 205) p0_finish<1>(cr, INCOLS, WINB, DM, 0, scr, r, lane); else if (nb_ >= 333 && nb_ < 461) p0_finish4(cr, INCOLS, W4, __uint_as_float((unsigned)(127 + (int)MISC[12]) << 23), scr, r, lane); else p0_finish_i8<4>(cr, INCOLS, WIN8, DM, __uint_as_float(MISC[15]), scr, r, lane); continue; } r -= I_IN; \
            if (r < I_A) { p0_finish8<0>(cr, DM, WA8, 2048, scr, r, lane); continue; } r -= I_A; \
            if (r < I_A) { p0_finish<0>(cr, DM, WBB, 2048, 0, scr, r, lane); continue; } r -= I_A; \
            if (r < I_SQ) { p0_finish_i8h(cr, DM, (unsigned char*)WOUT, DM, __uint_as_float(MISC[20]), scr, r, lane); continue; } r -= I_SQ; \
            if (r < I_PL) { p0_finish<0>(cr, DM, WPLE, DPLE, 0, scr, r, lane); continue; } r -= I_PL; \
            if (r < I_G) { p0_finish_i8<2>(cr, DFF, (unsigned char*)WGU, DM, __uint_as_float(MISC[13]), scr, r, lane); continue; } r -= I_G; \
            if (r < I_G) { p0_finish_i8<3>(cr, DFF, (unsigned char*)WGU, DM, __uint_as_float(MISC[14]), scr, r, lane); continue; } r -= I_G; \
            if (r < I_D) { if (P7F < 64) p0_finish<0>(cr, DM, WD, DFF, 0, scr, r, lane); if (P7F > 0) p0_finish_i8h(cr, DM, WD8, DFF, __uint_as_float(MISC[22]), scr, r, lane); continue; } r -= I_D; \
            p0_finish_i8<0>(cr, DM, (unsigned char*)WPG, DM, __uint_as_float(MISC[21]), scr, r, lane); } } while (0)
#define CONV_TAIL(nwg_, first_, last_) do { const int rem_ = (nwg_) % G; if (rem_ == 0) CONV_ITEMS(first_, last_, gw, NGW); \
        else if (cu >= rem_) CONV_ITEMS(first_, last_, (cu - rem_) * NWAVES + wave, (G - rem_) * NWAVES); } while (0)
    if (IN(0)) {
#pragma unroll
      for (int rep = 0; rep < REPS(0); ++rep) {
        PHASE_IDS();
        CONV_ITEMS(0, NITEMS - TAIL_A - TAIL_B - TAIL_U, gw, NGW);
        for (int m = gw; m < MTOK; m += NGW) rms_row_to_bf16(args.in[I_X] + (size_t)m * DM, args.in[I_NMIX], H + (size_t)m * DM, H8 + (size_t)m * DM, H4 + (size_t)m * (DM / 2), FACH + m, lane);
        { const float* P = args.in[I_P]; const int gt = cu * 512 + tid, NT = G * 512;
          for (int i = gt; i < MTOK * DPLE / 4; i += NT) { const f32x4 v = *(const GAS f32x4*)(P + (size_t)i * 4); v2u w; w.x = cvt_pk_bf16(v.x, v.y); w.y = cvt_pk_bf16(v.z, v.w); *(GAS v2u*)(PB + (size_t)i * 4) = w; }
          const float* SW = args.in[I_SGUW];
          for (int i = gt; i < NGRP * CHK * CHK / 2; i += NT) { const int e = 2 * i, t = (e >> 7) & 127, s = e & 127; const f32x2 v = *(const GAS f32x2*)(SW + e);
              *(GAS unsigned*)(SGUW + e) = cvt_pk_bf16(s <= t ? v.x : 0.f, (s + 1) <= t ? v.y : 0.f); } }
        if (rep + 1 < REPS(0) || BOTH(0)) GRID_BAR();
      }
    }

    if (IN(1)) {
#pragma unroll
      for (int rep = 0; rep < REPS(1); ++rep) {
        PHASE_IDS();
        { pg8::Gemm g{(const bf16*)H4, (const bf16*)W4, MTOK, 16 * 256, DM / 4}; pg8::BlockOrder S; S.init(MTOK, 16 * 256, G, cu);
          pg8::EpiInProjT<2> E{Qb, Vb, QIDX, KIDX, UV, SGA, SGB, KRAW, WIDX, LNP, nullptr, 1.0f};
          pg8::gemm_phase<pg8::EpiInProjT<2>, pg8::BlockOrder, GEMM_ALIGN, GEMM_SP2, false, true>(lds + RING_OFF, g, S, E, tid, 127 - (int)MISC[12]); }
        { pg8::Gemm g{(const bf16*)H8, (const bf16*)WIN8, MTOK, 57 * 256, DM / 2}; pg8::BlockOrder S; S.init(MTOK, 57 * 256, G, cu);
          const float isw_ = __uint_as_float(__builtin_amdgcn_readfirstlane(__float_as_uint(1.0f / __uint_as_float(MISC[15]))));
          pg8::EpiInProjT<0> E{Qb, Vb, QIDX, KIDX, UV, SGA, SGB, KRAW, WIDX, LNP, FACH, isw_};
          pg8::gemm_phase<pg8::EpiInProjT<0>, pg8::BlockOrder, GEMM_ALIGN, GEMM_SP2, false, false, true>(lds + RING_OFF, g, S, E, tid); }
        { pg8::Gemm g{H, WINB, MTOK, 1 * 256, DM}; pg8::BlockOrder S; S.init(MTOK, 1 * 256, G, G - 1 - cu);
          pg8::EpiInProjT<1> E{Qb, Vb, QIDX, KIDX, UV, SGA, SGB, KRAW, WIDX, LNP, nullptr, 1.0f};
          pg8::gemm_phase<pg8::EpiInProjT<1>, pg8::BlockOrder, GEMM_ALIGN, GEMM_SP2>(lds + RING_OFF, g, S, E, tid); }
        if (rep == 0) { const int rem_ = ((MTOK / 256) * 1) % G;
            if (rem_ == 0) CONV_ITEMS(NITEMS - TAIL_A - TAIL_B - TAIL_U, NITEMS - TAIL_A - TAIL_B, gw, NGW);
            else if (G - 1 - cu >= rem_) CONV_ITEMS(NITEMS - TAIL_A - TAIL_B - TAIL_U, NITEMS - TAIL_A - TAIL_B, (G - 1 - cu - rem_) * NWAVES + wave, (G - rem_) * NWAVES); }
        if (rep + 1 < REPS(1) || BOTH(1)) GRID_BAR();
      }
    }

#if defined(NULL_GEMM)
    if (IN(1)) { PHASE_IDS();
        pg8::Gemm g{H, WIN, MTOK, NULL_GEMM * 256, DM}; pg8::BlockOrder S; S.init(MTOK, NULL_GEMM * 256, G, cu);
        pg8::EpiNull E{SSQP};
        pg8::gemm_phase<pg8::EpiNull, pg8::BlockOrder, GEMM_ALIGN, GEMM_SP2>(lds + RING_OFF, g, S, E, tid);
        GRID_BAR(); }
#endif
    if (IN(2)) {
#pragma unroll
      for (int rep = 0; rep < REPS(2); ++rep) {
        PHASE_IDS();
        { const float* kg = args.in[I_KNG];
          for (int rp = gw; rp < MTOK / 2; rp += NGW) { const int row = 2 * rp + (lane >> 5), c = (lane & 31) * 4;
              const f32x4 v = *(const GAS f32x4*)(KRAW + (size_t)row * 128 + c); float ss = (v.x * v.x + v.y * v.y) + (v.z * v.z + v.w * v.w);
#pragma unroll
              for (int o = 1; o < 32; o <<= 1) ss += __shfl_xor(ss, o);
              const float r = 1.0f / sqrtf(ss * (1.0f / HDA) + EPS); const f32x4 gv = *(const GAS f32x4*)(kg + c);
              v2u w; w.x = cvt_pk_bf16(v.x * r * gv.x, v.y * r * gv.y); w.y = cvt_pk_bf16(v.z * r * gv.z, v.w * r * gv.w); *(GAS v2u*)(KN + (size_t)row * 128 + c) = w; } }
        for (int i = tid; i < 8 * TOPK_WAVE_LDS / 16; i += NWAVES * 64) *(LAS v4u*)(lds + RING_OFF + 69632 + i * 16) = (v4u){0u, 0u, 0u, 0u};
        constexpr int NU = NB * (SEQ / 32);
        for (int j = cu; j < NU; j += G) { const int rnd = j / G, pos = j % G; int u;
            if ((rnd & 1) == 0) u = j; else { const int hiu = (rnd + 1) * G < NU ? (rnd + 1) * G : NU; u = hiu - 1 - pos; if (u < rnd * G) continue; }
            indexer_unit(lds + RING_OFF, tid, wave, lane, u % NB, u / NB, QIDX, KIDX, WIDX, SC, IDX); }
        if (rep + 1 < REPS(2) || BOTH(2)) GRID_BAR();
      }
    }

    if (IN(3)) {
#pragma unroll
      for (int rep = 0; rep < REPS(3); ++rep) {
        PHASE_IDS();
        for (int rr = 0; rr < DUP_SGU; ++rr)
        for (int u = cu; u < (MTOK / CHK) * NGRP; u += G) sgu_unit(lds + RING_OFF, tid, wave, lane, u >> 3, u & 7, UV, LNP, SGUW, args.in[I_LNG], args.in[I_LNB], args.in[I_SGUB], YB);
        __syncthreads();
        LAS float* BL = (LAS float*)(lds + RING_OFF + ATT_BL);
        { const float* rb = args.in[I_RELB];
          for (int i = tid; i < 129 * 16; i += NWAVES * 64) { const int n = i >> 4, h = i & 15; int bk;
              if (n < 16) bk = n; else { bk = 16 + (int)(logf((float)n * (1.0f / 16.0f)) / 2.0794415416798357f * 16.0f); bk = bk > 31 ? 31 : bk; }
              BL[i] = rb[bk * 16 + h]; } }
        __syncthreads();
        for (int rr = 0; rr < DUP_ATT; ++rr)
        for (int qi = gw; qi < MTOK; qi += NGW) attn_query(lds + RING_OFF + wave * ATT_WAVE, BL, lane, qi / SEQ, qi % SEQ, Qb, KN, Vb, IDX, args.in[I_QNG], (bf16*)YA8);
        if (rep + 1 < REPS(3) || BOTH(3)) GRID_BAR();
      }
    }

#if defined(IDLE_US)
    { const unsigned long long t0 = __builtin_amdgcn_s_memrealtime(); while (__builtin_amdgcn_s_memrealtime() - t0 < (unsigned long long)(IDLE_US) * 100ull) __builtin_amdgcn_s_sleep(32); }
#endif
    if (IN(4)) {
#pragma unroll
      for (int rep = 0; rep < REPS(4); ++rep) {
        PHASE_IDS();
        { pg8::Gemm g{(const bf16*)YA8, (const bf16*)WA8, MTOK, DM, GWID / 2}; pg8::BlockOrder S; S.init(MTOK, DM, G, cu);
          pg8::EpiPlain E{(bf16*)T8};
          pg8::gemm_phase<pg8::EpiPlain, pg8::BlockOrder, GEMM_ALIGN, GEMM_SP2, true>(lds + RING_OFF, g, S, E, tid); }
        { pg8::Gemm g{YB, WBB, MTOK, DM, GWID}; pg8::BlockOrder S; S.init(MTOK, DM, G, cu);
          pg8::EpiMerge E{SGA, SGB, (const bf16*)T8, MERGED};
          pg8::gemm_phase<pg8::EpiMerge, pg8::BlockOrder, GEMM_ALIGN, GEMM_SP2>(lds + RING_OFF, g, S, E, tid); }
        if (rep + 1 < REPS(4) || BOTH(4)) GRID_BAR();
      }
    }

    if (IN(5)) {
#pragma unroll
      for (int rep = 0; rep < REPS(5); ++rep) {
        PHASE_IDS();
        unsigned char* wsl = args.ws; asm volatile("" : "+s"(wsl));
        unsigned char* const MQ = wsl + WS_MERGED + 128 * MiB; float* const FACM = (float*)(wsl + WS_LNP + 1 * MiB);
        for (int m = gw; m < MTOK; m += NGW) quant_row_i8<false, false, true>(MERGED + (size_t)m * DM, nullptr, MQ + (size_t)m * DM, FACM + m, lane, 4.25f);
        GRID_BAR();
        { pg8::Gemm g{(const bf16*)MQ, WOUT, MTOK, DM, DM / 2}; pg8::BlockOrder S; S.init(MTOK, DM, G, cu);
          const float iso_ = __uint_as_float(__builtin_amdgcn_readfirstlane(__float_as_uint(1.0f / __uint_as_float(MISC[20]))));
          pg8::EpiResid E{args.in[I_X], X1R, nullptr, args.in[I_NFFN], SSQ1, FACM, iso_};
          pg8::gemm_phase<pg8::EpiResid, pg8::BlockOrder, GEMM_ALIGN, GEMM_SP2, false, false, true>(lds + RING_OFF, g, S, E, tid); }
        { pg8::Gemm g{PB, WPLE, MTOK, DM, DPLE}; pg8::BlockOrder S; S.init(MTOK, DM, G, cu);
          pg8::EpiPe E{PE, SSQP};
          pg8::gemm_phase<pg8::EpiPe, pg8::BlockOrder, GEMM_ALIGN, GEMM_SP2>(lds + RING_OFF, g, S, E, tid); }
        if (rep + 1 < REPS(5) || BOTH(5)) GRID_BAR();
      }
    }

    if (IN(6)) {
#pragma unroll
      for (int rep = 0; rep < REPS(6); ++rep) {
        PHASE_IDS();
        if (rep == 0) { CONV_ITEMS(NITEMS - TAIL_A - TAIL_B, NITEMS - TAIL_B, gw, NGW); __syncthreads(); }
        unsigned char* wsl = args.ws; asm volatile("" : "+s"(wsl));
        const float sgu_ = (127.0f / (4.0f * __uint_as_float(MISC[13]))) * (127.0f / (4.0f * __uint_as_float(MISC[14])));
        float* const FACA = (float*)(wsl + WS_LNP + 3 * MiB);
        unsigned char* const X1Q = wsl + WS_WAB; float* const FAC1 = (float*)(wsl + WS_LNP);
        for (int m = gw; m < MTOK; m += NGW) quant_row_i8<true, true>(X1R + (size_t)m * DM, args.in[I_NFFN], X1Q + (size_t)m * DM, FAC1 + m, lane, 4.0f, FACA + m, sgu_);
        GRID_BAR();
        pg8::Gemm g{(const bf16*)X1Q, WGU, MTOK, 2 * DFF, DM / 2}; pg8::BlockOrder S; S.init(MTOK, 2 * DFF, G, cu);
        const float isg_ = __uint_as_float(__builtin_amdgcn_readfirstlane(__float_as_uint(1.0f / __uint_as_float(MISC[13])))), isu_ = __uint_as_float(__builtin_amdgcn_readfirstlane(__float_as_uint(1.0f / __uint_as_float(MISC[14]))));
        pg8::EpiGateUpQ E{FAC1, isg_, isu_, ACT, ACT8, P7F, FACA};
        pg8::gemm_phase<pg8::EpiGateUpQ, pg8::BlockOrder, GEMM_ALIGN, GEMM_SP2, false, false, true>(lds + RING_OFF, g, S, E, tid);
        if (rep == 0) CONV_TAIL((MTOK / 256) * (2 * DFF / 256), NITEMS - TAIL_B, NITEMS);
        if (rep + 1 < REPS(6) || BOTH(6)) GRID_BAR();
      }
    }

    if (IN(7)) {
#pragma unroll
      for (int rep = 0; rep < REPS(7); ++rep) {
        PHASE_IDS();
        if (P7F > 0) { pg8::Gemm g{(const bf16*)ACT8, (const bf16*)WD8, P7F * 256, DM, DFF / 2}; pg8::BlockOrder S; S.init(P7F * 256, DM, G, cu); { int rm_ = S.rmain; asm volatile("" : "+v"(rm_)); S.rmain = __builtin_amdgcn_readfirstlane(rm_); }
          const float isd_ = __uint_as_float(__builtin_amdgcn_readfirstlane(__float_as_uint(1.0f / __uint_as_float(MISC[22]))));
          pg8::EpiResidQ E{X1R, X2R, nullptr, args.in[I_NPLE], SSQ2, (const float*)(args.ws + WS_LNP + 3 * MiB), isd_};
          pg8::gemm_phase<pg8::EpiResidQ, pg8::BlockOrder, GEMM_ALIGN, GEMM_SP2, false, false, true>(lds + RING_OFF, g, S, E, tid); }
        if (P7F < 64) { pg8::Gemm g{ACT + (size_t)P7F * 256 * DFF, WD, MTOK - P7F * 256, DM, DFF}; pg8::BlockOrder S; S.init(MTOK - P7F * 256, DM, G, cu); { int rm_ = S.rmain; asm volatile("" : "+v"(rm_)); S.rmain = __builtin_amdgcn_readfirstlane(rm_); }
          constexpr size_t R0 = (size_t)P7F * 256;
          pg8::EpiResidB E{X1R + R0 * 4096, X2R + R0 * 4096, nullptr, args.in[I_NPLE], SSQ2 + R0 * 4, nullptr, 1.0f};
          pg8::gemm_phase<pg8::EpiResidB, pg8::BlockOrder, GEMM_ALIGN, GEMM_SP2>(lds + RING_OFF, g, S, E, tid); }
        if (rep + 1 < REPS(7) || BOTH(7)) GRID_BAR();
      }
    }

    if (IN(8)) {
        PHASE_IDS();
        unsigned char* wsl = args.ws; asm volatile("" : "+s"(wsl));
        unsigned char* const X2Q = wsl + WS_X2G; float* const FAC2 = (float*)(wsl + WS_LNP + 2 * MiB);
        for (int m = gw; m < MTOK; m += NGW) quant_row_i8<true, true>(X2R + (size_t)m * DM, args.in[I_NPLE], X2Q + (size_t)m * DM, FAC2 + m, lane);
        GRID_BAR();
        pg8::Gemm g{(const bf16*)X2Q, WPG, MTOK, DM, DM / 2}; pg8::BlockOrder S; S.init(MTOK, DM, G, cu);
        const float isp_ = __uint_as_float(__builtin_amdgcn_readfirstlane(__float_as_uint(1.0f / __uint_as_float(MISC[21]))));
        pg8::EpiFinal E{FAC2, SSQP, args.in[I_PLENG], PE, X2R, args.out, isp_};
        pg8::gemm_phase<pg8::EpiFinal, pg8::BlockOrder, GEMM_ALIGN, GEMM_SP2, false, false, true>(lds + RING_OFF, g, S, E, tid);
    }

#if defined(DUMP_AFTER)
    if (lo == N_PHASES) {
        const size_t gt = (size_t)cu * 512 + threadIdx.x, NT = (size_t)G * 512;
        for (size_t i = gt; i < (size_t)MTOK * DM; i += NT) { const size_t m = i >> 12; const int c = (int)(i & 4095); float v = 0.f;
#if DUMP_AFTER == 3
            v = bf_lo((unsigned)YB[i >> 1]);
#elif DUMP_AFTER == 2
            v = c < 256 ? (float)IDX[m * 256 + c] : (c < 384 ? bf_lo((unsigned)KN[m * 128 + c - 256]) : 0.f);
#elif DUMP_AFTER == 1
#if DUMP_SEL == 0
            v = bf_lo((unsigned)QIDX[i]);
#elif DUMP_SEL == 1
            v = bf_lo((unsigned)UV[i]);
#elif DUMP_SEL == 2
            v = bf_lo((unsigned)SGA[i]) + bf_lo((unsigned)SGB[i]);
#elif DUMP_SEL == 3
            v = bf_lo((unsigned)Qb[m * 2048 + (c & 2047)]);
            if (c < 128) v += KRAW[m * 128 + c] + bf_lo((unsigned)Vb[m * 128 + c]) + bf_lo((unsigned)KIDX[m * 128 + c]);
            if (c < 32) v += WIDX[m * 32 + c];
#endif
#elif DUMP_AFTER == 0
            v = bf_lo((unsigned)H[i]) + bf_lo((unsigned)WIN[i]) + bf_lo((unsigned)WIN[(size_t)(INPAD - 4096) * DM + i]) + bf_lo((unsigned)WGU[i]) + bf_lo((unsigned)WD[i]) + bf_lo((unsigned)WAB[i]);
#endif
            args.out[i] = v; }
    }
#endif
#undef IN
#undef BOTH
#undef GRID_BAR
}

extern "C" void kernel_launch(void* const* d_in, const int* in_sizes, int n_in, void* d_out, int out_size, void* d_ws, size_t ws_size, hipStream_t stream) {
    static int grid = 0;
    if (grid == 0) {
        if (n_in != 22 || in_sizes[0] != MTOK * DM || out_size != MTOK * DM || ws_size < WS_NEED) {
            fprintf(stderr, "kernel_launch: unexpected problem (n_in %d, in0 %d, out %d, ws %zu, need %zu); nothing launched\n", n_in, n_in > 0 ? in_sizes[0] : -1, out_size, ws_size, (size_t)WS_NEED); grid = -1; return; }
        int dev = 0, cus = 0, per_cu = 0;
        if (hipGetDevice(&dev) != hipSuccess || hipDeviceGetAttribute(&cus, hipDeviceAttributeMultiprocessorCount, dev) != hipSuccess) { grid = -1; return; }
        if (hipFuncSetAttribute((const void*)fwd_kernel, hipFuncAttributeMaxDynamicSharedMemorySize, LDS_BYTES) != hipSuccess) { fprintf(stderr, "kernel_launch: hipFuncSetAttribute failed\n"); grid = -1; return; }
        if (hipOccupancyMaxActiveBlocksPerMultiprocessor(&per_cu, (const void*)fwd_kernel, NWAVES * 64, LDS_BYTES) != hipSuccess || per_cu < 1)
            fprintf(stderr, "kernel_launch: note: occupancy query reports %d workgroups per CU\n", per_cu);
        (void)hipGetLastError();
        grid = cus;
    }
    if (grid < 0) return;
    if (hipMemsetAsync((char*)d_ws + WS_CTL, 0, CTL_ZERO_BYTES, stream) != hipSuccess) return;
    Args a{};
    for (int i = 0; i < 22; ++i) a.in[i] = (const float*)d_in[i];
    a.out = (float*)d_out; a.ws = (unsigned char*)d_ws;
#if defined(DUMP_AFTER)
    for (int li = 0; li <= DUMP_AFTER + 1; ++li) {
        a.ph_lo = li <= DUMP_AFTER ? li : N_PHASES; a.ph_hi = a.ph_lo + 1; a.li = 0;
#else
    for (int li = 0; li < N_LAUNCHES; ++li) {
        a.ph_lo = (N_LAUNCHES == 1) ? 0 : li; a.ph_hi = (N_LAUNCHES == 1) ? N_PHASES : li + 1; a.li = (N_LAUNCHES == 1) ? 0 : 0;
#endif
        hipLaunchKernelGGL(fwd_kernel, dim3(grid), dim3(NWAVES * 64), LDS_BYTES, stream, a);
        const hipError_t le = hipPeekAtLastError();
        if (le != hipSuccess) { fprintf(stderr, "kernel_launch: launch %d failed: %s\n", li, hipGetErrorName(le)); break; }
    }
}
```
